# Optimizing an MI355X kernel written in HIP

```python
import jax
import jax.numpy as jnp
from jax import lax
import numpy as np

D_MODEL = 1024
BATCH = 4
SEQ = 8192
DEPTH = 2

CTX_LEN = 256
GRID_W = 64
N_BRANCH = 3
BRANCH_W = 512
MLA_HEADS = 8
MLA_NOPE = 64
MLA_ROPE = 32
MLA_QK = MLA_NOPE + MLA_ROPE
MLA_V = BRANCH_W // MLA_HEADS
MLA_Q_LORA = 256
MLA_KV_LORA = 128
GLA_HEADS = 4
GLA_DK = (D_MODEL // 2) // GLA_HEADS
GLA_DV = BRANCH_W // GLA_HEADS
GLA_GATE_RANK = 16
GLA_GATE_NORMALIZER = 16.0
RET_HEADS = 4
RET_DK = BRANCH_W // RET_HEADS
RET_DV = BRANCH_W // RET_HEADS
D_FF = 2816
CONV_W = 3
CHUNK = 64
Q_BLOCK = 128
ROPE_THETA = 10000.0
RET_THETA = 10000.0
EPS = 1e-6
F32 = jnp.float32

IN_LAYOUT = (
    ('mla_q', MLA_Q_LORA),
    ('mla_kv', MLA_KV_LORA),
    ('mla_kr', MLA_ROPE),
    ('gla_q', GLA_HEADS * GLA_DK),
    ('gla_k', GLA_HEADS * GLA_DK),
    ('gla_v', GLA_HEADS * GLA_DV),
    ('gla_g', GLA_HEADS * GLA_DV),
    ('gla_rf', GLA_GATE_RANK),
    ('gla_rb', GLA_GATE_RANK),
    ('ret_q', RET_HEADS * RET_DK),
    ('ret_k', RET_HEADS * RET_DK),
    ('ret_v', RET_HEADS * RET_DV),
    ('ret_g', RET_HEADS * RET_DV),
    ('gate_mla', D_MODEL),
    ('gate_gla', D_MODEL),
    ('gate_ret', D_MODEL),
)
N_IN = sum(width for _, width in IN_LAYOUT)
CTX_SIDE = ('mla_kv', 'mla_kr', 'gla_k', 'gla_v', 'gla_rf', 'gla_rb', 'ret_k', 'ret_v')
QUERY_SIDE = ('mla_q', 'gla_q', 'gla_g', 'ret_q', 'ret_g', 'gate_mla', 'gate_gla', 'gate_ret')

kernel_name = 'hybrid_mla_gla_retention_dit_block'


def rms_norm(x, w=None):
    x32 = x.astype(F32)
    y = x32 * lax.rsqrt(jnp.mean(x32 * x32, axis=-1, keepdims=True) + EPS)
    if w is not None:
        y = y * w.astype(F32)
    return y.astype(x.dtype)


def modulate(x, shift, scale):
    return x * (1 + scale) + shift


def split_heads(t, n_heads):
    b, s, _ = t.shape
    return t.reshape(b, s, n_heads, -1).transpose(0, 2, 1, 3)


def merge_heads(t):
    b, h, s, d = t.shape
    return t.transpose(0, 2, 1, 3).reshape(b, s, h * d)


def in_proj(a, w, names):
    out, start = {}, 0
    for name, width in IN_LAYOUT:
        if name in names:
            out[name] = a @ w[:, start:start + width]
        start += width
    return out


def rope_tables(pos, dim, theta):
    inv = theta ** (-jnp.arange(dim // 2, dtype=F32) * 2.0 / dim)
    ang = pos.astype(F32)[:, None] * inv[None, :]
    return jnp.cos(ang), jnp.sin(ang)


def retention_tables(pos):
    inv = 1.0 / (RET_THETA ** jnp.linspace(0.0, 1.0, RET_DK // 2, dtype=F32))
    ang = pos.astype(F32)[:, None] * inv[None, :]
    return jnp.cos(ang), jnp.sin(ang)


def rotate_half(x, cos, sin):
    n = x.shape[-1] // 2
    x1, x2 = x[..., :n], x[..., n:]
    return jnp.concatenate([x1 * cos - x2 * sin, x1 * sin + x2 * cos], axis=-1).astype(x.dtype)


def axial_rope(x, tabs):
    cos_r, sin_r, cos_c, sin_c = tabs
    half = x.shape[-1] // 2
    return jnp.concatenate([rotate_half(x[..., :half], cos_r, sin_r),
                            rotate_half(x[..., half:], cos_c, sin_c)], axis=-1)


def mla_rope(t, tabs):
    if tabs is None:
        return t
    return jnp.concatenate([t[..., :MLA_NOPE], axial_rope(t[..., MLA_NOPE:], tabs)], axis=-1)


def mla_queries(cq, q_norm_a, w_qb, q_norm, tabs):
    q = split_heads(rms_norm(cq, q_norm_a) @ w_qb, MLA_HEADS)
    return mla_rope(rms_norm(q, q_norm), tabs)


def mla_keys_values(ckv, kr, kv_norm_a, w_kvb, k_norm, tabs):
    kv = split_heads(rms_norm(ckv, kv_norm_a) @ w_kvb, MLA_HEADS)
    b, h, t, _ = kv.shape
    k_rope = jnp.broadcast_to(kr[:, None], (b, h, t, MLA_ROPE))
    k = rms_norm(jnp.concatenate([kv[..., :MLA_NOPE], k_rope], axis=-1), k_norm)
    return mla_rope(k, tabs), kv[..., MLA_NOPE:]


def attend(q, k, v):
    s = jnp.einsum('bhqd,bhkd->bhqk', q, k, preferred_element_type=F32) * (MLA_QK ** -0.5)
    p = jax.nn.softmax(s, axis=-1).astype(v.dtype)
    return jnp.einsum('bhqk,bhkd->bhqd', p, v)


def blocked_attend(q, k, v):
    b, h, s, d = q.shape
    qb = jnp.moveaxis(q.reshape(b, h, s // Q_BLOCK, Q_BLOCK, d), 2, 0)
    ob = lax.map(lambda qi: attend(qi, k, v), qb)
    return jnp.moveaxis(ob, 0, 2).reshape(b, h, s, v.shape[-1])


def chunk_mask(inclusive):
    idx = jnp.arange(CHUNK)
    return idx[:, None] >= idx[None, :] if inclusive else idx[:, None] > idx[None, :]


def gla_chunk_scan(q, k, v, log_a, s0, inclusive):
    b_, h, t, dk = k.shape
    dv = v.shape[-1]
    n = t // CHUNK
    kc = k.reshape(b_, h, n, CHUNK, dk).astype(F32)
    vc = v.reshape(b_, h, n, CHUNK, dv).astype(F32)
    cum = jnp.cumsum(log_a.reshape(b_, h, n, CHUNK, dk).astype(F32), axis=3)
    cum_last = cum[:, :, :, -1]
    inc = jnp.einsum('bhnjd,bhnjv->bhndv', kc * jnp.exp(cum_last[:, :, :, None] - cum), vc)

    def step(s, xs):
        decay, u = xs
        return decay[..., None] * s + u, s

    s_final, s_start = lax.scan(step, s0, (jnp.moveaxis(jnp.exp(cum_last), 2, 0), jnp.moveaxis(inc, 2, 0)))
    if q is None:
        return None, s_final
    s_start = jnp.moveaxis(s_start, 0, 2)
    q_dec = q.reshape(b_, h, n, CHUNK, dk).astype(F32) * jnp.exp(cum)
    att = jnp.einsum('bhnid,bhnjd->bhnij', q_dec, kc * jnp.exp(-cum))
    att = jnp.where(chunk_mask(inclusive), att, 0.0)
    o = jnp.einsum('bhnij,bhnjv->bhniv', att, vc) + jnp.einsum('bhnid,bhndv->bhniv', q_dec, s_start)
    return o.reshape(b_, h, t, dv).astype(v.dtype), s_final


def ret_chunk_scan(q, k, v, log_g, s0, inclusive):
    b_, h, t, dk = k.shape
    dv = v.shape[-1]
    n = t // CHUNK
    idx = jnp.arange(CHUNK, dtype=F32)
    lg = log_g.astype(F32)
    kc = k.reshape(b_, h, n, CHUNK, dk).astype(F32)
    vc = v.reshape(b_, h, n, CHUNK, dv).astype(F32)
    zeta = jnp.exp((CHUNK - 1 - idx)[None, :] * lg[:, None])
    inc = jnp.einsum('bhnjd,bhnjv->bhndv', kc * zeta[None, :, None, :, None], vc)
    g_chunk = jnp.exp(CHUNK * lg)[None, :, None, None]

    def step(s, u):
        return g_chunk * s + u, s

    s_final, s_start = lax.scan(step, s0, jnp.moveaxis(inc, 2, 0))
    if q is None:
        return None, s_final
    s_start = jnp.moveaxis(s_start, 0, 2)
    mask = chunk_mask(inclusive)
    rel = jnp.where(mask, idx[:, None] - idx[None, :], 0.0)
    dmat = jnp.where(mask[None], jnp.exp(rel[None] * lg[:, None, None]), 0.0)
    xi = jnp.exp((idx + 1.0)[None, :] * lg[:, None])
    qc = q.reshape(b_, h, n, CHUNK, dk).astype(F32)
    att = jnp.einsum('bhnid,bhnjd->bhnij', qc, kc) * dmat[None, :, None]
    o = (jnp.einsum('bhnij,bhnjv->bhniv', att, vc)
         + jnp.einsum('bhnid,bhndv->bhniv', qc, s_start) * xi[None, :, None, :, None])
    return o.reshape(b_, h, t, dv).astype(v.dtype), s_final


def scan_both_directions(chunk_fn, q, k, v, dec_f, dec_b, s_f, s_b, per_token_decay):
    rev = lambda t: None if t is None else jnp.flip(t, axis=2)
    o_f, s_f = chunk_fn(q, k, v, dec_f, s_f, True)
    o_b, s_b = chunk_fn(rev(q), rev(k), rev(v), rev(dec_b) if per_token_decay else dec_b, s_b, False)
    o = None if q is None else o_f + rev(o_b)
    return o, s_f, s_b


def gla_log_decay(r, w2, b):
    return jax.nn.log_sigmoid((r @ w2 + b).astype(F32)) / GLA_GATE_NORMALIZER


def gated_head_norm(o, g, w):
    return merge_heads(rms_norm(o, w)).astype(g.dtype) * jax.nn.silu(g)


def gated_merge(ys, gs, b_gate, w_branch, w_out):
    out = None
    for n in range(N_BRANCH):
        term = jax.nn.sigmoid(gs[n] + b_gate[n]) * (ys[n] @ w_branch[n])
        out = term if out is None else out + term
    return out @ w_out


def token_mixers(a, ac, need_ctx, lat_tabs, ret_lat_tabs, ret_ctx_tabs, w_in, b_gate,
                 mla_q_norm_a, mla_w_qb, mla_kv_norm_a, mla_w_kvb, mla_q_norm, mla_k_norm,
                 gla_w_gk2, gla_b_gk, gla_o_norm, ret_decay, w_branch, w_out):
    bsz = a.shape[0]
    p = in_proj(a, w_in, CTX_SIDE + QUERY_SIDE)
    pc = in_proj(ac, w_in, CTX_SIDE + QUERY_SIDE if need_ctx else CTX_SIDE)

    k_c, v_c = mla_keys_values(pc['mla_kv'], pc['mla_kr'], mla_kv_norm_a, mla_w_kvb, mla_k_norm, None)
    k_l, v_l = mla_keys_values(p['mla_kv'], p['mla_kr'], mla_kv_norm_a, mla_w_kvb, mla_k_norm, lat_tabs)
    q_l = mla_queries(p['mla_q'], mla_q_norm_a, mla_w_qb, mla_q_norm, lat_tabs)
    y_mla = merge_heads(blocked_attend(q_l, jnp.concatenate([k_c, k_l], axis=2),
                                       jnp.concatenate([v_c, v_l], axis=2)))

    def gla_inputs(z, with_q):
        q = split_heads(z['gla_q'], GLA_HEADS) * (GLA_DK ** -0.5) if with_q else None
        k = split_heads(z['gla_k'], GLA_HEADS)
        v = split_heads(z['gla_v'], GLA_HEADS)
        la_f = split_heads(gla_log_decay(z['gla_rf'], gla_w_gk2[0], gla_b_gk[0]), GLA_HEADS)
        la_b = split_heads(gla_log_decay(z['gla_rb'], gla_w_gk2[1], gla_b_gk[1]), GLA_HEADS)
        return q, k, v, la_f, la_b

    zg = jnp.zeros((bsz, GLA_HEADS, GLA_DK, GLA_DV), F32)
    o_gc, sg_f, sg_b = scan_both_directions(gla_chunk_scan, *gla_inputs(pc, need_ctx), zg, zg, True)
    o_gl, _, _ = scan_both_directions(gla_chunk_scan, *gla_inputs(p, True), sg_f, sg_b, True)
    y_gla = gated_head_norm(o_gl, p['gla_g'], gla_o_norm)

    log_g = -jnp.exp(ret_decay.astype(F32))

    def ret_inputs(z, tabs, with_q):
        q = rotate_half(split_heads(z['ret_q'], RET_HEADS), *tabs) if with_q else None
        k = rotate_half(split_heads(z['ret_k'], RET_HEADS), *tabs) * (RET_DK ** -0.5)
        v = split_heads(z['ret_v'], RET_HEADS)
        return q, k, v

    zr = jnp.zeros((bsz, RET_HEADS, RET_DK, RET_DV), F32)
    o_rc, sr_f, sr_b = scan_both_directions(ret_chunk_scan, *ret_inputs(pc, ret_ctx_tabs, need_ctx),
                                            log_g[0], log_g[1], zr, zr, False)
    o_rl, _, _ = scan_both_directions(ret_chunk_scan, *ret_inputs(p, ret_lat_tabs, True),
                                      log_g[0], log_g[1], sr_f, sr_b, False)
    y_ret = gated_head_norm(o_rl, p['ret_g'], None)

    y = gated_merge((y_mla, y_gla, y_ret), (p['gate_mla'], p['gate_gla'], p['gate_ret']),
                    b_gate, w_branch, w_out)
    if not need_ctx:
        return y, None
    q_c = mla_queries(pc['mla_q'], mla_q_norm_a, mla_w_qb, mla_q_norm, None)
    y_c = gated_merge((merge_heads(attend(q_c, k_c, v_c)),
                       gated_head_norm(o_gc, pc['gla_g'], gla_o_norm),
                       gated_head_norm(o_rc, pc['ret_g'], None)),
                      (pc['gate_mla'], pc['gate_gla'], pc['gate_ret']), b_gate, w_branch, w_out)
    return y, y_c


def conv_ffn(a, w_in, w_dw, b_dw, w_out):
    gate = a @ w_in[:, :D_FF]
    up = a @ w_in[:, D_FF:]
    gate = lax.conv_general_dilated(gate, w_dw[:, None, :], window_strides=(1,),
                                    padding=[(CONV_W // 2, CONV_W // 2)],
                                    dimension_numbers=('NWC', 'WIO', 'NWC'),
                                    feature_group_count=D_FF) + b_dw
    return (jax.nn.gelu(gate) * up) @ w_out


def setup_inputs(seed: int = 0) -> dict:
    key = jax.random.key(seed)
    ks = iter(jax.random.split(key, 32))

    def nrm(shape, scale):
        return scale * jax.random.normal(next(ks), shape, F32)

    def gain(shape):
        return 1.0 + nrm(shape, 0.02)

    L, D = DEPTH, D_MODEL
    ret_base = jnp.log(-jnp.log1p(-(2.0 ** (-5.0 - jnp.arange(RET_HEADS, dtype=F32)))))
    return {
        'x': nrm((BATCH, SEQ, D), 1.0),
        'c': nrm((BATCH, D), 1.0),
        'ctx': nrm((BATCH, CTX_LEN, D), 1.0),
        'c_ctx': nrm((D,), 1.0),
        'w_ada': nrm((L, D, 6 * D), 0.5 * D ** -0.5),
        'b_ada': nrm((L, 6 * D), 0.02),
        'norm1_w': gain((L, D)),
        'norm2_w': gain((L, D)),
        'w_in': nrm((L, D, N_IN), D ** -0.5),
        'b_gate': nrm((L, N_BRANCH, D), 0.02),
        'mla_q_norm_a': gain((L, MLA_Q_LORA)),
        'mla_w_qb': nrm((L, MLA_Q_LORA, MLA_HEADS * MLA_QK), MLA_Q_LORA ** -0.5),
        'mla_kv_norm_a': gain((L, MLA_KV_LORA)),
        'mla_w_kvb': nrm((L, MLA_KV_LORA, MLA_HEADS * (MLA_NOPE + MLA_V)), MLA_KV_LORA ** -0.5),
        'mla_q_norm': gain((L, MLA_QK)),
        'mla_k_norm': gain((L, MLA_QK)),
        'gla_w_gk2': nrm((L, 2, GLA_GATE_RANK, GLA_HEADS * GLA_DK), GLA_GATE_RANK ** -0.5),
        'gla_b_gk': nrm((L, 2, GLA_HEADS * GLA_DK), 0.1),
        'gla_o_norm': gain((L, GLA_DV)),
        'ret_decay': ret_base + nrm((L, 2, RET_HEADS), 0.01),
        'w_branch': nrm((L, N_BRANCH, BRANCH_W, D), BRANCH_W ** -0.5),
        'w_out': nrm((L, D, D), D ** -0.5),
        'w_ffn_in': nrm((L, D, 2 * D_FF), D ** -0.5),
        'w_dw': nrm((L, CONV_W, D_FF), CONV_W ** -0.5),
        'b_dw': nrm((L, D_FF), 0.02),
        'w_ffn_out': nrm((L, D_FF, D), D_FF ** -0.5),
    }


def reference(x, c, ctx, c_ctx, w_ada, b_ada, norm1_w, norm2_w, w_in, b_gate,
              mla_q_norm_a, mla_w_qb, mla_kv_norm_a, mla_w_kvb, mla_q_norm, mla_k_norm,
              gla_w_gk2, gla_b_gk, gla_o_norm, ret_decay, w_branch, w_out,
              w_ffn_in, w_dw, b_dw, w_ffn_out):
    seq = x.shape[1]
    ctx_len = ctx.shape[1]
    rows = seq // GRID_W
    row_pos = jnp.repeat(jnp.arange(rows), GRID_W)
    col_pos = jnp.tile(jnp.arange(GRID_W), rows)
    cos_r, sin_r = rope_tables(row_pos, MLA_ROPE // 2, ROPE_THETA)
    cos_c, sin_c = rope_tables(col_pos, MLA_ROPE // 2, ROPE_THETA)
    lat_tabs = (cos_r, sin_r, cos_c, sin_c)
    ret_ctx_tabs = retention_tables(jnp.arange(ctx_len))
    ret_lat_tabs = retention_tables(ctx_len + jnp.arange(seq))
    cond = jax.nn.silu(c)
    cond_c = jax.nn.silu(c_ctx)
    h, hc = x, ctx
    for l in range(DEPTH):
        need_ctx = l < DEPTH - 1
        mod = jnp.split((cond @ w_ada[l] + b_ada[l])[:, None, :], 6, axis=-1)
        mod_c = jnp.split(cond_c @ w_ada[l] + b_ada[l], 6, axis=-1)
        a = modulate(rms_norm(h, norm1_w[l]), mod[0], mod[1])
        ac = modulate(rms_norm(hc, norm1_w[l]), mod_c[0], mod_c[1])
        y, y_c = token_mixers(a, ac, need_ctx, lat_tabs, ret_lat_tabs, ret_ctx_tabs, w_in[l], b_gate[l],
                              mla_q_norm_a[l], mla_w_qb[l], mla_kv_norm_a[l], mla_w_kvb[l],
                              mla_q_norm[l], mla_k_norm[l], gla_w_gk2[l], gla_b_gk[l], gla_o_norm[l],
                              ret_decay[l], w_branch[l], w_out[l])
        h = h + mod[2] * y
        h = h + mod[5] * conv_ffn(modulate(rms_norm(h, norm2_w[l]), mod[3], mod[4]),
                                  w_ffn_in[l], w_dw[l], b_dw[l], w_ffn_out[l])
        if need_ctx:
            hc = hc + mod_c[2] * y_c
            hc = hc + mod_c[5] * conv_ffn(modulate(rms_norm(hc, norm2_w[l]), mod_c[3], mod_c[4]),
                                          w_ffn_in[l], w_dw[l], b_dw[l], w_ffn_out[l])
    return h
```

```cpp
#include <hip/hip_runtime.h>
#include <hip/hip_bf16.h>
#include <hip/hip_cooperative_groups.h>
#include <cstdio>
#include <cstdint>
namespace cg = cooperative_groups;
#define DI __device__ __forceinline__
#define LAS __attribute__((address_space(3)))
namespace pg8 {
#define PG8_LAS __attribute__((address_space(3)))
typedef unsigned short bf16_t;
typedef short bf16x8 __attribute__((ext_vector_type(8)));
typedef float f32x4 __attribute__((ext_vector_type(4)));
typedef unsigned u32x4 __attribute__((ext_vector_type(4)));
constexpr int BM = 256, BK = 64, HALF = 128, HTB = HALF * BK * 2  , STAGE_BYTES = 8 * HTB, NXCD = 8, WGM = 8;

__host__ __device__ __forceinline__ int lds_byte(int r, int c) { const int st = (r >> 4) * 2 + (c >> 5), rr = r & 15, cc = c & 31, ob = rr * 64 + cc * 2; return st * 1024 + (ob ^ (((ob >> 9) & 1) << 5)); }
__host__ __device__ __forceinline__ void stage_rc(int b, int& R, int& C) { const int st = b / 1024, sb = b % 1024, swz = sb ^ (((sb >> 9) & 1) << 5); R = (st >> 1) * 16 + swz / 64; C = (st & 1) * 32 + (swz % 64) / 2; }
__host__ __device__ __forceinline__ int perm32(int rho) { const int n = rho >> 4, i = rho & 15; return 8 * (i >> 2) + 4 * n + (i & 3); }

struct Unit { int pm, pn; };
struct Gemm { const bf16_t* A; const bf16_t* Bt; int M, N, K, lda; };

struct StaticOrder {
    int nM, nN, nwg, G, c;
    __host__ __device__ void init(int M, int N, int G_, int c_) { nM = M / BM; nN = N / BM; nwg = nM * nN; G = G_; c = c_; }
    __host__ __device__ bool next(int i, Unit& u) const {
        const long L = (long)i * G + c; if (L >= nwg) return false;
        int wgid = (int)L; { const int q = nwg / NXCD, r = nwg % NXCD, xcd = wgid % NXCD, off = wgid / NXCD; wgid = (xcd < r ? xcd * (q + 1) : r * (q + 1) + (xcd - r) * q) + off; }
        const int nig = WGM * nN, gid = wgid / nig, fm = gid * WGM, gsz = (nM - fm) < WGM ? (nM - fm) : WGM;
        u.pm = fm + ((wgid % nig) % gsz); u.pn = (wgid % nig) / gsz; return true;
    }
    __device__ __forceinline__ void a_ready(const Unit&) const {}
    __device__ __forceinline__ void done(const Unit&) const {}
};

__device__ __forceinline__ unsigned cvt_pk_bf16(float lo, float hi) { unsigned r; asm volatile("v_cvt_pk_bf16_f32 %0, %1, %2" : "=v"(r) : "v"(lo), "v"(hi)); return r; }
template <class Epi, class Sched, bool ALIGN_EPI = false, bool SP2 = false>
__device__ __forceinline__ void gemm_phase(PG8_LAS unsigned char* lds, const Gemm g, const Sched& S, const Epi& E) {
    const int tid = threadIdx.x, wid = __builtin_amdgcn_readfirstlane(tid >> 6), lane = tid & 63, wr = wid >> 2, wc = wid & 3, fr = lane & 15, fq = lane >> 4;
    const int K = g.K, nt = K / BK;
    unsigned voffA[2], voffB[2];
#pragma unroll
    for (int i = 0; i < 2; ++i) { int R, C; stage_rc(tid * 16 + i * 8192, R, C); const int Rb = Epi::PERM ? ((R & ~31) + perm32(R & 31)) : R;
        voffA[i] = (unsigned)(R * g.lda + C) * 2u; voffB[i] = (unsigned)(Rb * K + C) * 2u; }
    const size_t kstep = (size_t)(BK * 2);
    const size_t hstep = (size_t)HALF * K * 2;
    const size_t tstep = 2 * hstep; const size_t hstepA = (size_t)HALF * g.lda * 2; const size_t tstepA = 2 * hstepA;
    const unsigned ldsw = (unsigned)wid * 1024u;
    const int aoff = lds_byte(wr * 64 + fr, fq * 8), boff = lds_byte(wc * 32 + fr, fq * 8);
#define PG8_SA(b, h) (((b) * 2 + (h)) * HTB)
#define PG8_SB(b, h) ((4 + (b) * 2 + (h)) * HTB)
#define PG8_STAGE(bufoff, gbase, voff) do { _Pragma("unroll") for (int _i = 0; _i < 2; ++_i) \
        __builtin_amdgcn_global_load_lds((const unsigned*)((const char*)(gbase) + (voff)[_i]), (PG8_LAS unsigned*)(lds + (bufoff) + ldsw + _i * 8192), 16, 0, 0); } while (0)
#define PG8_LDA(dst, b, h) do { _Pragma("unroll") for (int m = 0; m < 4; ++m) _Pragma("unroll") for (int k = 0; k < 2; ++k) dst[m][k] = *(const PG8_LAS bf16x8*)(lds + PG8_SA(b, h) + aoff + m * 2048 + k * 1024); } while (0)
#define PG8_LDB(dst, b, h) do { _Pragma("unroll") for (int n = 0; n < 2; ++n) _Pragma("unroll") for (int k = 0; k < 2; ++k) dst[n][k] = *(const PG8_LAS bf16x8*)(lds + PG8_SB(b, h) + boff + n * 2048 + k * 1024); } while (0)
#define PG8_MMA(ai, bj, At, Bt) do { __builtin_amdgcn_s_setprio(1); _Pragma("unroll") for (int m = 0; m < 4; ++m) _Pragma("unroll") for (int n = 0; n < 2; ++n) _Pragma("unroll") for (int k = 0; k < 2; ++k) \
        acc[ai][bj][m][n] = __builtin_amdgcn_mfma_f32_16x16x32_bf16(Bt[n][k], At[m][k], acc[ai][bj][m][n], 0, 0, 0); __builtin_amdgcn_s_setprio(0); } while (0)
#define PG8_WAIT_V(n) asm volatile("s_waitcnt vmcnt(" #n ")" ::: "memory")
#define PG8_WAIT_L(n) asm volatile("s_waitcnt lgkmcnt(" #n ")" ::: "memory")
#define PG8_BAR __builtin_amdgcn_s_barrier()
#define PG8_SCHED __builtin_amdgcn_sched_barrier(0)
    Unit cur, nxt; int ui = 0;
    if (!S.next(0, cur)) return;
    f32x4 acc[2][2][4][2];
#pragma unroll
    for (int a = 0; a < 2; ++a)
#pragma unroll
        for (int b = 0; b < 2; ++b)
#pragma unroll
            for (int m = 0; m < 4; ++m)
#pragma unroll
                for (int n = 0; n < 2; ++n) acc[a][b][m][n] = (f32x4){0.f, 0.f, 0.f, 0.f};
    bf16x8 At[4][2], B0[2][2], B1[2][2];
    const char* cA = (const char*)g.A + (size_t)cur.pm * tstepA; const char* cB = (const char*)g.Bt + (size_t)cur.pn * tstep;
    S.a_ready(cur);
    if constexpr (SP2) {
        PG8_STAGE(PG8_SB(0, 0), cB, voffB); PG8_STAGE(PG8_SB(0, 1), cB + hstep, voffB); PG8_STAGE(PG8_SA(0, 0), cA, voffA); PG8_STAGE(PG8_SA(0, 1), cA + hstepA, voffA);
        if (wr == 1) PG8_BAR;
        PG8_WAIT_V(2); PG8_BAR;
        PG8_STAGE(PG8_SB(1, 0), cB + kstep, voffB); PG8_STAGE(PG8_SA(1, 0), cA + kstep, voffA); PG8_STAGE(PG8_SB(1, 1), cB + hstep + kstep, voffB);
        PG8_WAIT_V(6); PG8_BAR;
    } else {
        PG8_STAGE(PG8_SB(0, 0), cB, voffB); PG8_STAGE(PG8_SA(0, 0), cA, voffA); PG8_STAGE(PG8_SB(0, 1), cB + hstep, voffB); PG8_STAGE(PG8_SA(0, 1), cA + hstepA, voffA);
        if (wr == 1) PG8_BAR;
        PG8_WAIT_V(4); PG8_BAR;
        PG8_STAGE(PG8_SB(1, 0), cB + kstep, voffB); PG8_STAGE(PG8_SA(1, 0), cA + kstep, voffA); PG8_STAGE(PG8_SB(1, 1), cB + hstep + kstep, voffB);
        PG8_WAIT_V(6); PG8_BAR;
    }
    for (;;) {
        const bool has_next = S.next(ui + 1, nxt);
        const char* nA = has_next ? (const char*)g.A + (size_t)nxt.pm * tstepA : cA; const char* nB = has_next ? (const char*)g.Bt + (size_t)nxt.pn * tstep : cB;
        for (int t = 0; t < nt; t += 2) {
            const bool last = (t == nt - 2);
            const char* a1 = cA + (size_t)(t + 1) * kstep;
            const char* a2 = last ? nA : cA + (size_t)(t + 2) * kstep; const char* b2 = last ? nB : cB + (size_t)(t + 2) * kstep;
            const char* a3 = a2 + kstep; const char* b3 = b2 + kstep;
            if (last && has_next) S.a_ready(nxt);
            if constexpr (SP2) {
            PG8_LDB(B0, 0, 0); PG8_LDB(B1, 0, 1); PG8_SCHED; PG8_LDA(At, 0, 0); PG8_STAGE(PG8_SA(1, 1), a1 + hstepA, voffA);
            PG8_WAIT_V(8); PG8_WAIT_L(0); PG8_BAR; PG8_MMA(0, 0, At, B0); PG8_MMA(0, 1, At, B1); PG8_BAR; PG8_SCHED;
            PG8_LDA(At, 0, 1); PG8_STAGE(PG8_SB(0, 0), b2, voffB); PG8_STAGE(PG8_SB(0, 1), b2 + hstep, voffB); PG8_STAGE(PG8_SA(0, 0), a2, voffA);
            PG8_WAIT_V(8); PG8_WAIT_L(0); PG8_BAR; PG8_MMA(1, 0, At, B0); PG8_MMA(1, 1, At, B1); PG8_BAR; PG8_SCHED;
            PG8_LDB(B0, 1, 0); PG8_LDB(B1, 1, 1); PG8_SCHED; PG8_LDA(At, 1, 0); PG8_STAGE(PG8_SA(0, 1), a2 + hstepA, voffA);
            PG8_WAIT_V(8); PG8_WAIT_L(0); PG8_BAR; PG8_MMA(0, 0, At, B0); PG8_MMA(0, 1, At, B1); PG8_BAR; PG8_SCHED;
            PG8_LDA(At, 1, 1); PG8_STAGE(PG8_SB(1, 0), b3, voffB); PG8_STAGE(PG8_SB(1, 1), b3 + hstep, voffB); PG8_STAGE(PG8_SA(1, 0), a3, voffA);
            PG8_WAIT_V(8); PG8_WAIT_L(0); PG8_BAR; PG8_MMA(1, 0, At, B0); PG8_MMA(1, 1, At, B1); PG8_BAR; PG8_SCHED;
            } else {
            PG8_LDB(B0, 0, 0); PG8_SCHED; PG8_LDA(At, 0, 0); PG8_STAGE(PG8_SA(1, 1), a1 + hstepA, voffA);
            PG8_WAIT_L(8); PG8_BAR; PG8_WAIT_L(0); PG8_MMA(0, 0, At, B0); PG8_BAR; PG8_SCHED;
            PG8_LDB(B1, 0, 1); PG8_STAGE(PG8_SB(0, 0), b2, voffB);
            PG8_BAR; PG8_WAIT_L(0); PG8_MMA(0, 1, At, B1); PG8_BAR;
            PG8_LDA(At, 0, 1); PG8_STAGE(PG8_SA(0, 0), a2, voffA);
            PG8_BAR; PG8_WAIT_L(0); PG8_MMA(1, 0, At, B0); PG8_BAR; PG8_SCHED;
            PG8_STAGE(PG8_SB(0, 1), b2 + hstep, voffB);
            PG8_WAIT_V(6); PG8_BAR; PG8_MMA(1, 1, At, B1); PG8_BAR;
            PG8_LDB(B0, 1, 0); PG8_SCHED; PG8_LDA(At, 1, 0); PG8_STAGE(PG8_SA(0, 1), a2 + hstepA, voffA);
            PG8_WAIT_L(8); PG8_BAR; PG8_WAIT_L(0); PG8_MMA(0, 0, At, B0); PG8_BAR; PG8_SCHED;
            PG8_LDB(B1, 1, 1); PG8_STAGE(PG8_SB(1, 0), b3, voffB);
            PG8_BAR; PG8_WAIT_L(0); PG8_MMA(0, 1, At, B1); PG8_BAR;
            PG8_LDA(At, 1, 1); PG8_STAGE(PG8_SA(1, 0), a3, voffA);
            PG8_BAR; PG8_WAIT_L(0); PG8_MMA(1, 0, At, B0); PG8_BAR; PG8_SCHED;
            PG8_STAGE(PG8_SB(1, 1), b3 + hstep, voffB);
            PG8_WAIT_V(6); PG8_BAR; PG8_MMA(1, 1, At, B1); PG8_BAR;
            }
        }
        if constexpr (ALIGN_EPI) { if (wr == 0) PG8_BAR; }
        if constexpr (!Epi::AFTER_DRAIN) { E(acc, cur, wr, wc, fr, fq); S.done(cur); }
        if (!has_next) break;
#pragma unroll
        for (int a = 0; a < 2; ++a)
#pragma unroll
            for (int b = 0; b < 2; ++b)
#pragma unroll
                for (int m = 0; m < 4; ++m)
#pragma unroll
                    for (int n = 0; n < 2; ++n) acc[a][b][m][n] = (f32x4){0.f, 0.f, 0.f, 0.f};
        cur = nxt; cA = nA; cB = nB; ++ui;
        if constexpr (ALIGN_EPI) { if (wr == 1) PG8_BAR; }
    }
    PG8_WAIT_V(0);
    if constexpr (!ALIGN_EPI) { if (wr == 0) PG8_BAR; }
    PG8_BAR;
    if constexpr (Epi::AFTER_DRAIN) { E.fused(acc, cur, wr, wc, fr, fq, lds, wid, lane); S.done(cur); }
#undef PG8_SA
#undef PG8_SB
#undef PG8_STAGE
#undef PG8_LDA
#undef PG8_LDB
#undef PG8_MMA
#undef PG8_WAIT_V
#undef PG8_WAIT_L
#undef PG8_BAR
#undef PG8_SCHED
}
}

typedef unsigned short bf16_t;
typedef short bf16x8 __attribute__((ext_vector_type(8)));
typedef short s16x4 __attribute__((ext_vector_type(4)));
typedef float f32x4 __attribute__((ext_vector_type(4)));
typedef float f32x2 __attribute__((ext_vector_type(2)));
typedef float f32x16 __attribute__((ext_vector_type(16)));
typedef unsigned u32x4 __attribute__((ext_vector_type(4)));
typedef unsigned u32x2 __attribute__((ext_vector_type(2)));

constexpr int DM = 1024, NB = 4, SEQ = 8192, CTX = 256, TL = NB * SEQ, TC = NB * CTX, TA = TL + TC;
constexpr int DFF = 2816, NIN = 7616;
constexpr float EPS = 1e-6f;
constexpr int NTHREADS = 512, NWAVES = 8;

constexpr size_t al256(size_t x) { return (x + 255) / 256 * 256; }
constexpr size_t WS_MOD = 0;
constexpr size_t WS_PAR = al256(WS_MOD + (size_t)2 * 5 * 6144 * 4);
constexpr size_t WS_ROT = al256(WS_PAR + (size_t)1024 * 256);
constexpr size_t WS_HC  = al256(WS_ROT + (size_t)8448 * 64 * 8);
constexpr size_t WS_WT  = al256(WS_HC + (size_t)TC * DM * 4);
constexpr size_t WT_IN = 0, WT_QB = WT_IN + (size_t)7680 * 1024, WT_KVB = WT_QB + (size_t)768 * 256, WT_BR = WT_KVB + (size_t)1024 * 128,
                 WT_OUT = WT_BR + (size_t)3 * 1024 * 512, WT_MIX_END = WT_OUT + (size_t)1024 * 1024;
constexpr size_t WT_F1 = 0, WT_F2 = (size_t)5632 * 1024, WT_FFN_END = WT_F2 + (size_t)1024 * 2816;
constexpr size_t WT_ELEMS = WT_MIX_END > WT_FFN_END ? WT_MIX_END : WT_FFN_END;
constexpr size_t WS_A   = al256(WS_WT + WT_ELEMS * 2);
constexpr size_t WS_SM  = al256(WS_A + (size_t)TA * 1024 * 2);
constexpr size_t WS_Q   = al256(WS_SM + (size_t)TA * 512 * 2);
constexpr size_t WS_R4  = al256(WS_Q + (size_t)TA * 768 * 2);
constexpr size_t WS_K   = WS_R4;
constexpr size_t WS_V   = al256(WS_K + (size_t)TA * 768 * 2);
constexpr size_t WS_OF  = al256(WS_R4 + (size_t)TA * 3072 * 2);
constexpr size_t WS_OB  = al256(WS_OF + (size_t)TA * 1024 * 2);
constexpr size_t WS_END_MIX = al256(WS_OB + (size_t)TA * 1024 * 2);
constexpr size_t WS_G   = WS_SM;
constexpr size_t WS_U   = al256(WS_G + (size_t)TA * DFF * 2);
constexpr size_t WS_END_FFN = al256(WS_U + (size_t)TA * DFF * 2);
constexpr size_t WS_NEED = WS_END_MIX > WS_END_FFN ? WS_END_MIX : WS_END_FFN;
static_assert(WS_V + (size_t)TA * 512 * 2 <= WS_OF, "K/V overlay must fit in R4");

constexpr int LDS_BYTES = 128 * 1024;

struct Params { const float* in[26]; float* out; unsigned char* ws; int ph_lo, ph_hi; };
enum { I_X = 0, I_C, I_CTX, I_CCTX, I_WADA, I_BADA, I_N1W, I_N2W, I_WIN, I_BGATE, I_QNA, I_WQB, I_KVNA, I_WKVB, I_QN, I_KN, I_GK2, I_BGK, I_GON, I_RDEC, I_WBR, I_WOUT, I_WF1, I_WDW, I_BDW, I_WF2 };

DI float bflo(unsigned w) { return __uint_as_float(w << 16); }
DI float bfhi(unsigned w) { return __uint_as_float(w & 0xffff0000u); }
DI float bf2f(bf16_t x) { return __uint_as_float((unsigned)x << 16); }
DI unsigned pk2(float lo, float hi) { unsigned r; asm volatile("v_cvt_pk_bf16_f32 %0, %1, %2" : "=v"(r) : "v"(lo), "v"(hi)); return r; }
DI bf16_t f2bf(float x) { return (bf16_t)(pk2(x, 0.f) & 0xffffu); }
DI float wave_sum(float v) {
#pragma unroll
    for (int o = 1; o < 64; o <<= 1) v += __shfl_xor(v, o);
    return v;
}
DI float sigmoidf_(float x) { return 1.f / (1.f + __expf(-x)); }
DI void unpack8(u32x4 w, float* f) { f[0] = bflo(w.x); f[1] = bfhi(w.x); f[2] = bflo(w.y); f[3] = bfhi(w.y); f[4] = bflo(w.z); f[5] = bfhi(w.z); f[6] = bflo(w.w); f[7] = bfhi(w.w); }
DI u32x4 pack8(const float* f) { u32x4 w; w.x = pk2(f[0], f[1]); w.y = pk2(f[2], f[3]); w.z = pk2(f[4], f[5]); w.w = pk2(f[6], f[7]); return w; }

DI void rowinfo(int m, int& b, int& pos, int& isctx) {
    if (m < TL) { b = m >> 13; pos = m & 8191; isctx = 0; } else { const int j = m - TL; b = j >> 8; pos = j & 255; isctx = 1; }
}

DI void phase_prologue(const Params& P, LAS unsigned char* lds) {
    const int tid = threadIdx.x, wave = tid >> 6, lane = tid & 63;
    LAS float* cond = (LAS float*)lds;
    LAS float* part = cond + 5 * 1024;
    const float* c = P.in[I_C]; const float* cc = P.in[I_CCTX];
    for (int i = tid; i < 5 * 1024; i += NTHREADS) { const int r = i >> 10, k = i & 1023; const float v = r < 4 ? c[r * 1024 + k] : cc[k]; cond[i] = v / (1.f + expf(-v)); }
    __syncthreads();
    float* MOD = (float*)(P.ws + WS_MOD);
    for (int item = blockIdx.x; item < 192; item += gridDim.x) {
        const int l = item / 96, j0 = (item % 96) * 64;
        const float* W = P.in[I_WADA] + (size_t)l * 1024 * 6144 + j0 + lane;
        float a0 = 0.f, a1 = 0.f, a2 = 0.f, a3 = 0.f, a4 = 0.f;
        for (int k = wave * 128; k < wave * 128 + 128; ++k) {
            const float w = W[(size_t)k * 6144];
            a0 += cond[k] * w; a1 += cond[1024 + k] * w; a2 += cond[2048 + k] * w; a3 += cond[3072 + k] * w; a4 += cond[4096 + k] * w;
        }
        part[(wave * 5 + 0) * 64 + lane] = a0; part[(wave * 5 + 1) * 64 + lane] = a1; part[(wave * 5 + 2) * 64 + lane] = a2;
        part[(wave * 5 + 3) * 64 + lane] = a3; part[(wave * 5 + 4) * 64 + lane] = a4;
        __syncthreads();
        if (tid < 320) { const int r = tid >> 6; float s = 0.f;
            for (int w = 0; w < 8; ++w) s += part[(w * 5 + r) * 64 + lane];
            MOD[(size_t)(l * 5 + r) * 6144 + j0 + lane] = s + P.in[I_BADA][l * 6144 + j0 + lane]; }
        __syncthreads();
    }
    f32x2* ROT = (f32x2*)(P.ws + WS_ROT);
    for (int i = blockIdx.x * NTHREADS + tid; i < 8448 * 64; i += gridDim.x * NTHREADS) {
        const int pos = i >> 6, j = i & 63;
        const float inv = 1.0f / powf(10000.0f, (float)j / 63.0f);
        const float ang = (float)pos * inv; float s, co; sincosf(ang, &s, &co);
        ROT[i] = (f32x2){co, s};
    }
}

DI int wmap(int id, int n) {
    switch (id) {
    case 1: if (n < 416) return n; if (n < 448) return 2464 + (n - 416); return -1;
    case 2: { if (n < 1536) return 416 + n;
              if (n < 2560) { const int base = n < 2048 ? 2496 : 3008; const int j = (n - 1536) & 511; const int hh = j >> 7, v = j & 127, g = v >> 3, e = v & 7;
                              const int d = e < 4 ? 4 * g + e : 64 + 4 * g + (e - 4); return base + hh * 128 + d; }
              return 3520 + (n - 2560); }
    case 3: if (n < 512) return 1952 + n; if (n < 1024) return 4032 + (n - 512); return 4544 + (n - 1024);
    case 4: if (n < 512) return (n >> 6) * 96 + (n & 63); { const int j = n - 512; return (j >> 5) * 96 + 64 + (j & 31); }
    case 5: if (n < 512) return (n >> 6) * 128 + (n & 63); { const int j = n - 512; return (j >> 6) * 128 + 64 + (j & 63); }
    default: return n;
    }
}
struct TJob { const float* W; int K, Nsrc; bf16_t* WT; int ndst, map_id; const float* kscale; };
DI void transpose_job(const TJob& J, LAS float* scr, int gw, int ngw, int lane) {
    const int nblk = J.ndst / 32, nitems = (J.K / 64) * nblk;
    for (int item = gw; item < nitems; item += ngw) {
        const int kb = item / nblk, nb = item % nblk, k0 = 64 * kb, n0 = 32 * nb;
        const int src = wmap(J.map_id, n0 + (lane & 31));
#pragma unroll 8
        for (int i = 0; i < 32; ++i) { const int kk = 2 * i + (lane >> 5);
            float v = 0.f; if (src >= 0) { v = J.W[(size_t)(k0 + kk) * J.Nsrc + src]; if (J.kscale) v *= J.kscale[k0 + kk]; }
            scr[kk * 33 + (lane & 31)] = v; }
        asm volatile("s_waitcnt lgkmcnt(0)" ::: "memory");
        const int c = lane & 7;
#pragma unroll
        for (int j = 0; j < 4; ++j) { const int n = (lane >> 3) + 8 * j; const LAS float* s = scr + (8 * c) * 33 + n;
            u32x4 o; o.x = pk2(s[0 * 33], s[1 * 33]); o.y = pk2(s[2 * 33], s[3 * 33]); o.z = pk2(s[4 * 33], s[5 * 33]); o.w = pk2(s[6 * 33], s[7 * 33]);
            *(u32x4*)(J.WT + (size_t)(n0 + n) * J.K + k0 + 8 * c) = o; }
        asm volatile("s_waitcnt lgkmcnt(0)" ::: "memory");
    }
}
DI void phase_wconv_mixer(const Params& P, int l, LAS unsigned char* lds) {
    const int tid = threadIdx.x, wave = tid >> 6, lane = tid & 63, gw = blockIdx.x * NWAVES + wave, ngw = gridDim.x * NWAVES;
    LAS float* scr = (LAS float*)lds + wave * (64 * 33);
    bf16_t* WT = (bf16_t*)(P.ws + WS_WT);
    const float* win = P.in[I_WIN] + (size_t)l * 1024 * NIN;
    TJob j;
    j = TJob{win, 1024, NIN, WT + WT_IN, 512, 1, nullptr}; transpose_job(j, scr, gw, ngw, lane);
    j = TJob{win, 1024, NIN, WT + WT_IN + (size_t)512 * 1024, 3072, 2, nullptr}; transpose_job(j, scr, gw, ngw, lane);
    j = TJob{win, 1024, NIN, WT + WT_IN + (size_t)3584 * 1024, 4096, 3, nullptr}; transpose_job(j, scr, gw, ngw, lane);
    j = TJob{P.in[I_WQB] + (size_t)l * 256 * 768, 256, 768, WT + WT_QB, 768, 4, P.in[I_QNA] + l * 256}; transpose_job(j, scr, gw, ngw, lane);
    j = TJob{P.in[I_WKVB] + (size_t)l * 128 * 1024, 128, 1024, WT + WT_KVB, 1024, 5, P.in[I_KVNA] + l * 128}; transpose_job(j, scr, gw, ngw, lane);
    for (int n = 0; n < 3; ++n) { j = TJob{P.in[I_WBR] + ((size_t)l * 3 + n) * 512 * 1024, 512, 1024, WT + WT_BR + (size_t)n * 1024 * 512, 1024, 0, nullptr}; transpose_job(j, scr, gw, ngw, lane); }
    j = TJob{P.in[I_WOUT] + (size_t)l * 1024 * 1024, 1024, 1024, WT + WT_OUT, 1024, 0, nullptr}; transpose_job(j, scr, gw, ngw, lane);
}
DI void phase_wconv_ffn(const Params& P, int l, LAS unsigned char* lds) {
    const int tid = threadIdx.x, wave = tid >> 6, lane = tid & 63, gw = blockIdx.x * NWAVES + wave, ngw = gridDim.x * NWAVES;
    LAS float* scr = (LAS float*)lds + wave * (64 * 33);
    bf16_t* WT = (bf16_t*)(P.ws + WS_WT);
    TJob j;
    j = TJob{P.in[I_WF1] + (size_t)l * 1024 * 5632, 1024, 5632, WT + WT_F1, 5632, 0, nullptr}; transpose_job(j, scr, gw, ngw, lane);
    j = TJob{P.in[I_WF2] + (size_t)l * 2816 * 1024, 2816, 1024, WT + WT_F2, 1024, 0, nullptr}; transpose_job(j, scr, gw, ngw, lane);
}

DI void phase_norm(const float* hl, const float* hc, const float* nw, const float* MODl, int ishift, int iscale, bf16_t* A, int nrows) {
    const int tid = threadIdx.x, wave = tid >> 6, lane = tid & 63, gw = blockIdx.x * NWAVES + wave, ngw = gridDim.x * NWAVES;
    for (int m = gw; m < nrows; m += ngw) {
        int b, pos, isctx; rowinfo(m, b, pos, isctx);
        const float* xr = isctx ? hc + (size_t)(m - TL) * DM : hl + (size_t)m * DM;
        const float* mod = MODl + (size_t)(isctx ? 4 : b) * 6144;
        f32x4 v[4]; float ss = 0.f;
#pragma unroll
        for (int j = 0; j < 4; ++j) { v[j] = *(const f32x4*)(xr + 4 * lane + 256 * j); ss += (v[j].x * v[j].x + v[j].y * v[j].y) + (v[j].z * v[j].z + v[j].w * v[j].w); }
        const float rstd = rsqrtf(wave_sum(ss) * (1.f / DM) + EPS);
#pragma unroll
        for (int j = 0; j < 4; ++j) { const int c = 4 * lane + 256 * j;
            const f32x4 w = *(const f32x4*)(nw + c), sh = *(const f32x4*)(mod + ishift * 1024 + c), sc = *(const f32x4*)(mod + iscale * 1024 + c);
            const f32x4 y = v[j] * rstd * w * (sc + 1.f) + sh;
            u32x2 o; o.x = pk2(y.x, y.y); o.y = pk2(y.z, y.w);
            *(u32x2*)(A + (size_t)m * DM + c) = o; }
    }
}

enum { EM_PLAIN = 0, EM_KV, EM_BIG, EM_GATES, EM_BRANCH, EM_RES, EM_FFNIN };
template <int MODE> struct Epi {
    static constexpr bool PERM = true, AFTER_DRAIN = false;
    bf16_t* O0; int ld0; bf16_t* O1; int ld1;
    const bf16_t* Gsrc;
    const float* fa;
    const float* hin_l; const float* hin_c; float* hout_l; float* hout_c;
    int ipar;
    DI void emit(int row, int col, f32x4 v0, f32x4 v1) const {
        float f[8] = {v0[0], v0[1], v0[2], v0[3], v1[0], v1[1], v1[2], v1[3]};
        if (MODE == EM_PLAIN) {
            *(u32x4*)(O0 + (size_t)row * ld0 + col) = pack8(f);
        } else if (MODE == EM_KV) {
            if (col < 512) *(u32x4*)(O0 + (size_t)row * 768 + col) = pack8(f);
            else           *(u32x4*)(O1 + (size_t)row * 512 + (col - 512)) = pack8(f);
        } else if (MODE == EM_FFNIN) {
            if (col < DFF) *(u32x4*)(O0 + (size_t)row * DFF + col) = pack8(f);
            else           *(u32x4*)(O1 + (size_t)row * DFF + (col - DFF)) = pack8(f);
        } else if (MODE == EM_BIG) {
            const float QS = 0.08838834764831845f;
            if (col < 512) { for (int i = 0; i < 8; ++i) f[i] *= QS; }
            else if (col >= 1536 && col < 2560) {
                int b, pos, isctx; rowinfo(row, b, pos, isctx);
                const int sp = isctx ? pos : CTX + pos;
                const int g = ((col - 1536) & 127) >> 3;
                const f32x2* rot = (const f32x2*)fa + (size_t)sp * 64 + 4 * g;
                const float sc = col >= 2048 ? QS : 1.f;
#pragma unroll
                for (int e = 0; e < 4; ++e) { const f32x2 cs = rot[e]; const float x1 = f[e], x2 = f[4 + e];
                    f[e] = (x1 * cs.x - x2 * cs.y) * sc; f[4 + e] = (x1 * cs.y + x2 * cs.x) * sc; }
            }
            *(u32x4*)(O0 + (size_t)row * 3072 + col) = pack8(f);
        } else if (MODE == EM_GATES) {
            if (col < 1024) {
                bf16_t* p = O1 + (size_t)row * 1024 + col; float on[8]; unpack8(*(const u32x4*)p, on);
#pragma unroll
                for (int i = 0; i < 8; ++i) f[i] = on[i] * f[i] * sigmoidf_(f[i]);
                *(u32x4*)p = pack8(f);
            } else {
                const int cc = col - 1024; const f32x4 b0 = *(const f32x4*)(fa + cc), b1 = *(const f32x4*)(fa + cc + 4);
                const float bb[8] = {b0[0], b0[1], b0[2], b0[3], b1[0], b1[1], b1[2], b1[3]};
#pragma unroll
                for (int i = 0; i < 8; ++i) f[i] = sigmoidf_(f[i] + bb[i]);
                *(u32x4*)(O0 + (size_t)row * 3072 + cc) = pack8(f);
            }
        } else if (MODE == EM_BRANCH) {
            float g[8]; unpack8(*(const u32x4*)(Gsrc + (size_t)row * 3072 + col), g);
            bf16_t* p = O0 + (size_t)row * 1024 + col;
            if (ipar > 0) { float pr[8]; unpack8(*(const u32x4*)p, pr);
#pragma unroll
                for (int i = 0; i < 8; ++i) f[i] = pr[i] + g[i] * f[i]; }
            else {
#pragma unroll
                for (int i = 0; i < 8; ++i) f[i] = g[i] * f[i]; }
            *(u32x4*)p = pack8(f);
        } else if (MODE == EM_RES) {
            int b, pos, isctx; rowinfo(row, b, pos, isctx);
            const float* hi_ = isctx ? hin_c + (size_t)(row - TL) * DM : hin_l + (size_t)row * DM;
            float* ho_ = isctx ? hout_c + (size_t)(row - TL) * DM : hout_l + (size_t)row * DM;
            const float* mod = fa + (size_t)(isctx ? 4 : b) * 6144 + ipar * 1024 + col;
            const f32x4 m0 = *(const f32x4*)mod, m1 = *(const f32x4*)(mod + 4);
            const f32x4 h0 = *(const f32x4*)(hi_ + col), h1 = *(const f32x4*)(hi_ + col + 4);
            *(f32x4*)(ho_ + col) = h0 + m0 * v0; *(f32x4*)(ho_ + col + 4) = h1 + m1 * v1;
        }
    }
    DI void operator()(const pg8::f32x4 (&acc)[2][2][4][2], const pg8::Unit& u, int wr, int wc, int fr, int fq) const {
#pragma unroll
        for (int ai = 0; ai < 2; ++ai)
#pragma unroll
            for (int m = 0; m < 4; ++m) { const int row = u.pm * 256 + ai * 128 + wr * 64 + m * 16 + fr;
#pragma unroll
                for (int bj = 0; bj < 2; ++bj) { const int col = u.pn * 256 + bj * 128 + wc * 32 + 8 * fq;
                    emit(row, col, acc[ai][bj][m][0], acc[ai][bj][m][1]); } }
    }
};
template <int MODE>
DI void run_gemm(LAS unsigned char* lds, const bf16_t* A, int lda, const bf16_t* Bt, int M, int N, int K, const Epi<MODE>& E) {
    int Kop = K; if (K < 512) asm volatile("" : "+s"(Kop));
    pg8::Gemm g{A, Bt, M, N, Kop, lda}; pg8::StaticOrder S; S.init(M, N, (int)gridDim.x, (int)blockIdx.x);
    pg8::gemm_phase<Epi<MODE>, pg8::StaticOrder, true, true>((PG8_LAS unsigned char*)lds, g, S, E);
}

DI void phase_qkpost(const Params& P, int l) {
    const int tid = threadIdx.x, wave = tid >> 6, lane = tid & 63, gw = blockIdx.x * NWAVES + wave, ngw = gridDim.x * NWAVES;
    const bf16_t* SM = (const bf16_t*)(P.ws + WS_SM); bf16_t* Q = (bf16_t*)(P.ws + WS_Q); bf16_t* K = (bf16_t*)(P.ws + WS_K); bf16_t* V = (bf16_t*)(P.ws + WS_V);
    const float* qn = P.in[I_QN] + l * 96; const float* kn = P.in[I_KN] + l * 96;
    const int s = lane & 7, h = lane >> 3;
    float qnw[12], knw[12];
#pragma unroll
    for (int i = 0; i < 8; ++i) { qnw[i] = qn[8 * s + i]; knw[i] = kn[8 * s + i]; }
#pragma unroll
    for (int i = 0; i < 4; ++i) { qnw[8 + i] = qn[64 + 4 * s + i]; knw[8 + i] = kn[64 + 4 * s + i]; }
    for (int m = gw; m < TA; m += ngw) {
        int b, pos, isctx; rowinfo(m, b, pos, isctx);
        const bf16_t* sm = SM + (size_t)m * 512;
        const u32x2 cq = *(const u32x2*)(sm + 4 * lane); const unsigned ckv = *(const unsigned*)(sm + 256 + 2 * lane);
        float a0 = bflo(cq.x), a1 = bfhi(cq.x), a2 = bflo(cq.y), a3 = bfhi(cq.y), c0 = bflo(ckv), c1 = bfhi(ckv);
        const float s_q = rsqrtf(wave_sum(a0 * a0 + a1 * a1 + a2 * a2 + a3 * a3) * (1.f / 256.f) + EPS);
        const float s_kv = rsqrtf(wave_sum(c0 * c0 + c1 * c1) * (1.f / 128.f) + EPS);
        float cs[4], sn[4];
        if (!isctx) { const float p = (float)((s < 4) ? (pos >> 6) : (pos & 63));
#pragma unroll
            for (int e = 0; e < 4; ++e) { const float inv = powf(10000.0f, -(float)(4 * (s & 1) + e) * 0.125f); sincosf(p * inv, &sn[e], &cs[e]); } }
        else {
#pragma unroll
            for (int e = 0; e < 4; ++e) { cs[e] = 1.f; sn[e] = 0.f; } }
        const bool second = (s & 2) != 0;
        {
            bf16_t* qp = Q + (size_t)m * 768;
            float z[12]; unpack8(*(const u32x4*)(qp + 64 * h + 8 * s), z);
            const u32x2 zr = *(const u32x2*)(qp + 512 + 32 * h + 4 * s); z[8] = bflo(zr.x); z[9] = bfhi(zr.x); z[10] = bflo(zr.y); z[11] = bfhi(zr.y);
            float ss = 0.f;
#pragma unroll
            for (int i = 0; i < 12; ++i) { z[i] *= s_q; ss += z[i] * z[i]; }
            ss += __shfl_xor(ss, 1); ss += __shfl_xor(ss, 2); ss += __shfl_xor(ss, 4);
            const float r = rsqrtf(ss * (1.f / 96.f) + EPS);
#pragma unroll
            for (int i = 0; i < 12; ++i) z[i] *= r * qnw[i];
#pragma unroll
            for (int e = 0; e < 4; ++e) { const float mine = z[8 + e], other = __shfl_xor(mine, 2);
                z[8 + e] = second ? (other * sn[e] + mine * cs[e]) : (mine * cs[e] - other * sn[e]); }
            *(u32x4*)(qp + 64 * h + 8 * s) = pack8(z);
            u32x2 o; o.x = pk2(z[8], z[9]); o.y = pk2(z[10], z[11]); *(u32x2*)(qp + 512 + 32 * h + 4 * s) = o;
        }
        {
            bf16_t* kp = K + (size_t)m * 768;
            float z[12]; unpack8(*(const u32x4*)(kp + 64 * h + 8 * s), z);
#pragma unroll
            for (int i = 0; i < 8; ++i) z[i] *= s_kv;
            const u32x2 zr = *(const u32x2*)(sm + 384 + 4 * s); z[8] = bflo(zr.x); z[9] = bfhi(zr.x); z[10] = bflo(zr.y); z[11] = bfhi(zr.y);
            float ss = 0.f;
#pragma unroll
            for (int i = 0; i < 12; ++i) ss += z[i] * z[i];
            ss += __shfl_xor(ss, 1); ss += __shfl_xor(ss, 2); ss += __shfl_xor(ss, 4);
            const float r = rsqrtf(ss * (1.f / 96.f) + EPS);
#pragma unroll
            for (int i = 0; i < 12; ++i) z[i] *= r * knw[i];
#pragma unroll
            for (int e = 0; e < 4; ++e) { const float mine = z[8 + e], other = __shfl_xor(mine, 2);
                z[8 + e] = second ? (other * sn[e] + mine * cs[e]) : (mine * cs[e] - other * sn[e]); }
            *(u32x4*)(kp + 64 * h + 8 * s) = pack8(z);
            u32x2 o; o.x = pk2(z[8], z[9]); o.y = pk2(z[10], z[11]); *(u32x2*)(kp + 512 + 32 * h + 4 * s) = o;
            bf16_t* vp = V + (size_t)m * 512 + 8 * lane; float vv[8]; unpack8(*(const u32x4*)vp, vv);
#pragma unroll
            for (int i = 0; i < 8; ++i) vv[i] *= s_kv;
            *(u32x4*)vp = pack8(vv);
        }
    }
}

DI void phase_scanpost(const Params& P, int l, int nrows) {
    const int tid = threadIdx.x, wave = tid >> 6, lane = tid & 63, gw = blockIdx.x * NWAVES + wave, ngw = gridDim.x * NWAVES;
    bf16_t* OF = (bf16_t*)(P.ws + WS_OF); const bf16_t* OB = (const bf16_t*)(P.ws + WS_OB);
    const float* gw_ = P.in[I_GON] + l * 128;
    const int sub = lane & 7, hd = lane >> 3;
    float w[16];
#pragma unroll
    for (int i = 0; i < 16; ++i) w[i] = hd < 4 ? gw_[16 * sub + i] : 1.f;
    for (int m = gw; m < nrows; m += ngw) {
        bf16_t* pf = OF + (size_t)m * 1024 + 16 * lane; const bf16_t* pb = OB + (size_t)m * 1024 + 16 * lane;
        float a[16], bq[16];
        unpack8(*(const u32x4*)pf, a); unpack8(*(const u32x4*)(pf + 8), a + 8); unpack8(*(const u32x4*)pb, bq); unpack8(*(const u32x4*)(pb + 8), bq + 8);
        float ss = 0.f;
#pragma unroll
        for (int i = 0; i < 16; ++i) { a[i] += bq[i]; ss += a[i] * a[i]; }
        ss += __shfl_xor(ss, 1); ss += __shfl_xor(ss, 2); ss += __shfl_xor(ss, 4);
        const float r = rsqrtf(ss * (1.f / 128.f) + EPS);
#pragma unroll
        for (int i = 0; i < 16; ++i) a[i] *= r * w[i];
        *(u32x4*)pf = pack8(a); *(u32x4*)(pf + 8) = pack8(a + 8);
    }
}

DI void phase_conv(const Params& P, int l, int nrows) {
    const bf16_t* G = (const bf16_t*)(P.ws + WS_G); bf16_t* U = (bf16_t*)(P.ws + WS_U);
    const float* wdw = P.in[I_WDW] + (size_t)l * 3 * DFF; const float* bdw = P.in[I_BDW] + (size_t)l * DFF;
    const long total = (long)nrows * 352;
    for (long i = (long)blockIdx.x * NTHREADS + threadIdx.x; i < total; i += (long)gridDim.x * NTHREADS) {
        const int m = (int)(i / 352), c = (int)(i % 352) * 8;
        int b, pos, isctx; rowinfo(m, b, pos, isctx);
        const int last = isctx ? CTX - 1 : SEQ - 1;
        float g0[8], g1[8], g2[8], u[8];
        unpack8(*(const u32x4*)(G + (size_t)m * DFF + c), g1);
        if (pos > 0) unpack8(*(const u32x4*)(G + (size_t)(m - 1) * DFF + c), g0); else { for (int k = 0; k < 8; ++k) g0[k] = 0.f; }
        if (pos < last) unpack8(*(const u32x4*)(G + (size_t)(m + 1) * DFF + c), g2); else { for (int k = 0; k < 8; ++k) g2[k] = 0.f; }
        unpack8(*(const u32x4*)(U + (size_t)m * DFF + c), u);
        float o[8];
#pragma unroll
        for (int k = 0; k < 8; ++k) {
            const float x = wdw[c + k] * g0[k] + wdw[DFF + c + k] * g1[k] + wdw[2 * DFF + c + k] * g2[k] + bdw[c + k];
            const float t = tanhf(0.7978845608028654f * (x + 0.044715f * x * x * x));
            o[k] = 0.5f * x * (1.f + t) * u[k];
        }
        *(u32x4*)(U + (size_t)m * DFF + c) = pack8(o);
    }
}

namespace att {
constexpr int NW = 8, QBLK = 32, KVBLK = 64;
constexpr float SCALE = 0.10206207261596575f;
constexpr float THR = 8.f;
constexpr int SHM_V = 64 * 128 * 2, SHM_K = 64 * 256, SHM_ATTN = 2 * SHM_V + 2 * SHM_K + NW * 64 * 4;
#define KSWZ(row, colB) ((row) * 256 + ((colB) ^ (((row) & 7) << 4)))
#define SBAR() __builtin_amdgcn_sched_barrier(0)
DI int crow(int r, int hi) { return (r & 3) + 8 * (r >> 2) + 4 * hi; }
DI unsigned cvtpk(float lo, float hi) { unsigned r; asm volatile("v_cvt_pk_bf16_f32 %0, %1, %2" : "=v"(r) : "v"(lo), "v"(hi)); return r; }
DI bf16x8 ld8(const bf16_t* p) { return *reinterpret_cast<const bf16x8*>(p); }

DI void partialSM(f32x16& p0, f32x16& p1, float& m_reg, float& mn, float& alpha) {
  constexpr float C = SCALE * 1.4426950408889634f;
  float pmax = p0[0]; for (int r = 1; r < 16; ++r) pmax = fmaxf(pmax, p0[r]); for (int r = 0; r < 16; ++r) pmax = fmaxf(pmax, p1[r]);
  { auto rr = __builtin_amdgcn_permlane32_swap(__float_as_uint(pmax), __float_as_uint(pmax), false, false);
    pmax = fmaxf(__uint_as_float(rr[0]), __uint_as_float(rr[1])); }
  if (__builtin_expect(__all(pmax - m_reg <= THR / SCALE), 1)) { mn = m_reg; alpha = 1.f; }
  else { mn = fmaxf(m_reg, pmax); alpha = __builtin_amdgcn_exp2f((m_reg - mn) * C); m_reg = mn; }
  float mnC = -mn * C;
  for (int r = 0; r < 16; ++r) p0[r] = fmaf(p0[r], C, mnC); for (int r = 0; r < 16; ++r) p1[r] = fmaf(p1[r], C, mnC);
  for (int r = 0; r < 16; ++r) p0[r] = __builtin_amdgcn_exp2f(p0[r]);
}
DI void finishSM(f32x16& p0, f32x16& p1, float alpha, float& l_reg, bf16x8& pa0, bf16x8& pa1, bf16x8& pa2, bf16x8& pa3) {
  for (int r = 0; r < 16; ++r) p1[r] = __builtin_amdgcn_exp2f(p1[r]);
  float ps = 0; for (int r = 0; r < 16; ++r) ps += p0[r]; for (int r = 0; r < 16; ++r) ps += p1[r];
  { auto rr = __builtin_amdgcn_permlane32_swap(__float_as_uint(ps), __float_as_uint(ps), false, false);
    ps = __uint_as_float(rr[0]) + __uint_as_float(rr[1]); }
  l_reg = l_reg * alpha + ps;
#define PK4(P, BASE, OUT) do { unsigned a0 = cvtpk(P[BASE + 0], P[BASE + 1]), a1 = cvtpk(P[BASE + 2], P[BASE + 3]);   \
    unsigned b0 = cvtpk(P[BASE + 4], P[BASE + 5]), b1 = cvtpk(P[BASE + 6], P[BASE + 7]);                              \
    auto r0 = __builtin_amdgcn_permlane32_swap(a0, b0, false, false); auto r1 = __builtin_amdgcn_permlane32_swap(a1, b1, false, false); \
    u32x4 w = {r0[0], r1[0], r0[1], r1[1]}; OUT = *reinterpret_cast<bf16x8*>(&w); } while (0)
  PK4(p0, 0, pa0); PK4(p0, 8, pa1); PK4(p1, 0, pa2); PK4(p1, 8, pa3);
#undef PK4
}
DI void qkt(f32x16& p0, f32x16& p1, const char* Ks, const bf16x8* qr, int r32, int hi) {
  p0 = f32x16{}; p1 = f32x16{};
#pragma unroll
  for (int d0 = 0; d0 < 6; ++d0) { int cb = (d0 * 16 + hi * 8) * 2;
    bf16x8 b0 = *reinterpret_cast<const bf16x8*>(Ks + KSWZ(r32, cb));
    bf16x8 b1 = *reinterpret_cast<const bf16x8*>(Ks + KSWZ(32 + r32, cb));
    p0 = __builtin_amdgcn_mfma_f32_32x32x16_bf16(b0, qr[d0], p0, 0, 0, 0);
    p1 = __builtin_amdgcn_mfma_f32_32x32x16_bf16(b1, qr[d0], p1, 0, 0, 0); }
}
DI int v_st(int k, int c) { const int kk = (k & ~0xC) | ((k & 4) << 1) | ((k & 8) >> 1); return ((kk >> 3) * 4 + (c >> 5)) * 512 + ((kk & 7) * 32 + (c & 31)) * 2; }
DI int v_rd_base(int lane) { return ((lane & 3) << 3) | (((lane >> 2) & 3) << 6) | (((lane >> 4) & 1) << 5) | (((lane >> 5) & 1) << 8); }
constexpr int v_rd_off(int d0, int ks, int half) { return d0 * 512 + ks * 4096 + half * 2048; }
template <int OFF> DI s16x4 tr_read(int vb) {
  s16x4 r; asm volatile("ds_read_b64_tr_b16 %0, %1 offset:%2" : "=&v"(r) : "v"(vb), "i"(OFF) : "memory"); return r;
}
template <int D0> DI void pv_one(f32x16& od, int vb, bf16x8 pa0, bf16x8 pa1, bf16x8 pa2, bf16x8 pa3) {
  const s16x4 l0 = tr_read<v_rd_off(D0, 0, 0)>(vb), h0 = tr_read<v_rd_off(D0, 0, 1)>(vb), l1 = tr_read<v_rd_off(D0, 1, 0)>(vb), h1 = tr_read<v_rd_off(D0, 1, 1)>(vb);
  const s16x4 l2 = tr_read<v_rd_off(D0, 2, 0)>(vb), h2 = tr_read<v_rd_off(D0, 2, 1)>(vb), l3 = tr_read<v_rd_off(D0, 3, 0)>(vb), h3 = tr_read<v_rd_off(D0, 3, 1)>(vb);
  asm volatile("s_waitcnt lgkmcnt(0)" ::: "memory"); SBAR();
#define PK(L, H) (bf16x8){L[0], L[1], L[2], L[3], H[0], H[1], H[2], H[3]}
  od = __builtin_amdgcn_mfma_f32_32x32x16_bf16(pa0, PK(l0, h0), od, 0, 0, 0);
  od = __builtin_amdgcn_mfma_f32_32x32x16_bf16(pa1, PK(l1, h1), od, 0, 0, 0);
  od = __builtin_amdgcn_mfma_f32_32x32x16_bf16(pa2, PK(l2, h2), od, 0, 0, 0);
  od = __builtin_amdgcn_mfma_f32_32x32x16_bf16(pa3, PK(l3, h3), od, 0, 0, 0);
#undef PK
}
DI void pv_d0(f32x16* o, int vb, bf16x8 pa0, bf16x8 pa1, bf16x8 pa2, bf16x8 pa3) {
  pv_one<0>(o[0], vb, pa0, pa1, pa2, pa3); pv_one<1>(o[1], vb, pa0, pa1, pa2, pa3);
}

DI void attn_unit(bf16_t* Qg, const bf16_t* Kg, const bf16_t* Vg, int qrow0, int h, int ctxrow0, int latrow0, int NT, char* lds) {
  const int tid = threadIdx.x, wid = tid >> 6, lane = tid & 63, r32 = lane & 31, hi = lane >> 5;
  char* V_lds = lds; char* K_lds = lds + 2 * SHM_V;
  float* ws = (float*)(lds + 2 * SHM_V + 2 * SHM_K) + wid * 64; float* li_l = ws; float* al_l = ws + 32;
  float m_reg = -1e30f, l_reg = 0; f32x16 o[2] = {}; bf16x8 qr[6];
  const bf16_t* Qw = Qg + (size_t)(qrow0 + wid * QBLK + r32) * 768;
#pragma unroll
  for (int d0 = 0; d0 < 6; ++d0) qr[d0] = ld8(Qw + (d0 < 4 ? 64 * h + 16 * d0 + 8 * hi : 512 + 32 * h + 16 * (d0 - 4) + 8 * hi));
  const int vr = tid >> 3, vc = tid & 7, vst = v_st(vr, 8 * vc), vcol = 64 * h + 8 * vc;
  const int c0 = tid, c1 = 512 + (tid & 255);
  const int kr0 = c0 / 12, kc0 = c0 % 12, kr1 = c1 / 12, kc1 = c1 % 12;
  const int kcol0 = kc0 < 8 ? 64 * h + 8 * kc0 : 512 + 32 * h + 8 * (kc0 - 8), kcol1 = kc1 < 8 ? 64 * h + 8 * kc1 : 512 + 32 * h + 8 * (kc1 - 8);
  const int kst0 = KSWZ(kr0, kc0 * 16), kst1 = KSWZ(kr1, kc1 * 16);
  const int vb0 = (int)(uintptr_t)V_lds + v_rd_base(lane);
  struct { bf16x8 vs0, ks0, ks1; } sr_[2];
#define TROW(j) ((j) < 4 ? ctxrow0 + 64 * (j) : latrow0 + 64 * ((j) - 4))
#define SLOAD(i, j) do { const int rb_ = TROW(j); sr_[i].vs0 = ld8(Vg + (size_t)(rb_ + vr) * 512 + vcol); \
    sr_[i].ks0 = ld8(Kg + (size_t)(rb_ + kr0) * 768 + kcol0); sr_[i].ks1 = ld8(Kg + (size_t)(rb_ + kr1) * 768 + kcol1); } while (0)
#define SWRITE(b, i) do { *(bf16x8*)(V_lds + (b) * SHM_V + vst) = sr_[i].vs0; \
    *(bf16x8*)(K_lds + (b) * SHM_K + kst0) = sr_[i].ks0; *(bf16x8*)(K_lds + (b) * SHM_K + kst1) = sr_[i].ks1; } while (0)
#define SWAIT() asm volatile("s_waitcnt vmcnt(3)" ::: "memory")
#define RESC(a) do { if (__any((a) < 1.f)) { if (hi == 0) al_l[r32] = (a); asm volatile("s_waitcnt lgkmcnt(0)" ::: "memory"); \
    for (int d = 0; d < 2; ++d) for (int r = 0; r < 16; ++r) o[d][r] *= al_l[crow(r, hi)]; } } while (0)
  f32x16 pA0, pA1, pB0, pB1; float mnA, mnB, alA, alB; bf16x8 pa0, pa1, pa2, pa3;
  constexpr int SE = 0, SO = 1;
  SLOAD(SE, 0); asm volatile("s_waitcnt vmcnt(0)" ::: "memory"); SWRITE(0, SE); __syncthreads();
  qkt(pA0, pA1, K_lds, qr, r32, hi); partialSM(pA0, pA1, m_reg, mnA, alA);
  SLOAD(SO, 1); if (2 < NT) SLOAD(SE, 2);
  SWAIT(); SWRITE(1, SO); __syncthreads();
  for (int j = 1; j + 1 < NT; j += 2) {
    SBAR(); qkt(pB0, pB1, K_lds + SHM_K, qr, r32, hi);
    finishSM(pA0, pA1, alA, l_reg, pa0, pa1, pa2, pa3); SBAR();
    SLOAD(SO, j + 2); SBAR();
    pv_d0(o, vb0, pa0, pa1, pa2, pa3); partialSM(pB0, pB1, m_reg, mnB, alB);
    __syncthreads(); SWAIT(); SWRITE(0, SE);
    RESC(alB); __syncthreads();
    SBAR(); qkt(pA0, pA1, K_lds, qr, r32, hi);
    finishSM(pB0, pB1, alB, l_reg, pa0, pa1, pa2, pa3); SBAR();
    if (j + 3 < NT) SLOAD(SE, j + 3); SBAR();
    pv_d0(o, vb0 + SHM_V, pa0, pa1, pa2, pa3); partialSM(pA0, pA1, m_reg, mnA, alA);
    __syncthreads(); SWAIT(); SWRITE(1, SO);
    RESC(alA); __syncthreads();
  }
  SBAR(); qkt(pB0, pB1, K_lds + SHM_K, qr, r32, hi);
  finishSM(pA0, pA1, alA, l_reg, pa0, pa1, pa2, pa3); SBAR();
  pv_d0(o, vb0, pa0, pa1, pa2, pa3); partialSM(pB0, pB1, m_reg, mnB, alB);
  __syncthreads(); RESC(alB);
  finishSM(pB0, pB1, alB, l_reg, pa0, pa1, pa2, pa3); SBAR();
  pv_d0(o, vb0 + SHM_V, pa0, pa1, pa2, pa3);
  if (hi == 0) li_l[r32] = l_reg; asm volatile("s_waitcnt lgkmcnt(0)" ::: "memory");
  float rli[16];
#pragma unroll
  for (int r = 0; r < 16; ++r) rli[r] = __builtin_amdgcn_rcpf(li_l[crow(r, hi)]);
  bf16_t* Ow = Qg + (size_t)(qrow0 + wid * QBLK) * 768 + 64 * h;
#pragma unroll
  for (int r = 0; r < 16; ++r) { const int orow = crow(r, hi);
#pragma unroll
    for (int d0 = 0; d0 < 2; ++d0) Ow[(size_t)orow * 768 + d0 * 32 + r32] = f2bf(o[d0][r] * rli[r]); }
#undef TROW
#undef SLOAD
#undef SWRITE
#undef SWAIT
#undef RESC
}
}

DI void phase_attention(const Params& P, int l, char* lds) {
    bf16_t* Q = (bf16_t*)(P.ws + WS_Q); const bf16_t* K = (const bf16_t*)(P.ws + WS_K); const bf16_t* V = (const bf16_t*)(P.ws + WS_V);
    for (int u = blockIdx.x; u < 1024; u += gridDim.x) {
        const int bh = (u >> 8) * 8 + (u & 7), qb = (u >> 3) & 31, b = bh >> 3, h = bh & 7;
        __syncthreads();
        att::attn_unit(Q, K, V, b * SEQ + 256 * qb, h, TL + b * CTX, b * SEQ, 132, lds);
    }
    if (l == 0) {
        for (int u = blockIdx.x; u < 32; u += gridDim.x) {
            const int b = u >> 3, h = u & 7;
            __syncthreads();
            att::attn_unit(Q, K, V, TL + b * CTX, h, TL + b * CTX, 0, 4, lds);
        }
    }
    __syncthreads();
}

namespace scn {
constexpr int RQ = 0, RK = RQ + 16384, RV = RK + 16384, RR = RV + 4096;
constexpr int QD = RR + 2048;
constexpr int KN = QD + 64 * 272;
constexpr int KET = KN + 64 * 272;
constexpr int VT = KET + 128 * 144;
constexpr int ST = VT + 32 * 144;
constexpr int PM = ST + 32 * 272;
constexpr int DEC = PM + 64 * 144;
constexpr int END = DEC + 512;
static_assert(END <= LDS_BYTES, "scan LDS");
DI int crow(int r, int hi) { return (r & 3) + 8 * (r >> 2) + 4 * hi; }
#define SMFMA(a, b, c) __builtin_amdgcn_mfma_f32_32x32x16_bf16((a), (b), (c), 0, 0, 0)
}
DI void phase_scan(const Params& P, int l, char* lds) {
    using namespace scn;
    const int tid = threadIdx.x, wid = tid >> 6, lane = tid & 63, r32 = lane & 31, hi = lane >> 5;
    const bf16_t* R4 = (const bf16_t*)(P.ws + WS_R4); const bf16_t* SM = (const bf16_t*)(P.ws + WS_SM);
    for (int item = blockIdx.x; item < 256; item += gridDim.x) {
        const int slice = item & 3, dir = (item >> 2) & 1, hd = (item >> 3) & 7, b = item >> 6;
        const bool gla = hd < 4; const int hh = hd & 3;
        const int qcol = gla ? hh * 128 : 1536 + hh * 128, kcol = gla ? 512 + hh * 128 : 2048 + hh * 128, vcol = (gla ? 1024 : 2560) + hh * 128 + slice * 32;
        bf16_t* Od = (bf16_t*)(P.ws + (dir ? WS_OB : WS_OF)); const int ocol = hd * 128 + slice * 32;
        const int d = 16 * wid + (lane & 15), seg = lane >> 4;
        float w2[16], bias = 0.f, lg = 0.f;
#pragma unroll
        for (int k = 0; k < 16; ++k) w2[k] = 0.f;
        if (gla) { const float* W2 = P.in[I_GK2] + (size_t)(l * 2 + dir) * 16 * 512 + hh * 128 + d;
#pragma unroll
            for (int k = 0; k < 16; ++k) w2[k] = W2[k * 512];
            bias = P.in[I_BGK][(l * 2 + dir) * 512 + hh * 128 + d]; }
        else lg = -expf(P.in[I_RDEC][(l * 2 + dir) * 4 + hh]);
        f32x16 S0 = {}, S1 = {};
        __syncthreads();
        for (int i = tid; i < 32 * 272 / 4; i += NTHREADS) ((unsigned*)(lds + ST))[i] = 0u;
        u32x4 pq0, pq1, pk0, pk1, pvr = {0u, 0u, 0u, 0u};
#define ROWBASE(n) (dir == 0 ? ((n) < 4 ? TL + b * CTX + 64 * (n) : b * SEQ + 64 * ((n) - 4)) : ((n) < 4 ? TL + b * CTX + 64 * (3 - (n)) : b * SEQ + 64 * (127 - ((n) - 4))))
#define SC_LOAD(n) do { const int rb_ = ROWBASE(n); \
        pq0 = *(const u32x4*)(R4 + (size_t)(rb_ + (tid >> 4)) * 3072 + qcol + 8 * (tid & 15)); pq1 = *(const u32x4*)(R4 + (size_t)(rb_ + 32 + (tid >> 4)) * 3072 + qcol + 8 * (tid & 15)); \
        pk0 = *(const u32x4*)(R4 + (size_t)(rb_ + (tid >> 4)) * 3072 + kcol + 8 * (tid & 15)); pk1 = *(const u32x4*)(R4 + (size_t)(rb_ + 32 + (tid >> 4)) * 3072 + kcol + 8 * (tid & 15)); \
        if (tid < 256) pvr = *(const u32x4*)(R4 + (size_t)(rb_ + (tid >> 2)) * 3072 + vcol + 8 * (tid & 3)); \
        else if (tid < 384) pvr = *(const u32x4*)(SM + (size_t)(rb_ + ((tid - 256) >> 1)) * 512 + 416 + dir * 16 + 8 * (tid & 1)); } while (0)
#define SC_STORE() do { *(u32x4*)(lds + RQ + sr0 * 256 + (tid & 15) * 16) = pq0; *(u32x4*)(lds + RQ + sr1 * 256 + (tid & 15) * 16) = pq1; \
        *(u32x4*)(lds + RK + sr0 * 256 + (tid & 15) * 16) = pk0; *(u32x4*)(lds + RK + sr1 * 256 + (tid & 15) * 16) = pk1; \
        if (tid < 256) *(u32x4*)(lds + RV + srv * 64 + (tid & 3) * 16) = pvr; \
        else if (tid < 384) *(u32x4*)(lds + RR + srr * 32 + (tid & 1) * 16) = pvr; } while (0)
        const int sr0 = dir ? 63 - (tid >> 4) : (tid >> 4), sr1 = dir ? 31 - (tid >> 4) : 32 + (tid >> 4);
        const int srv = dir ? 63 - (tid >> 2) : (tid >> 2), srr = dir ? 63 - ((tid - 256) >> 1) : ((tid - 256) >> 1);
        SC_LOAD(0); SC_STORE(); SC_LOAD(1);
        for (int n = 0; n < 132; ++n) {
            __syncthreads();
            {
                float c[16];
                if (gla) {
#pragma unroll
                    for (int ii = 0; ii < 16; ++ii) { const int i = 16 * seg + ii, r = i;
                        float rr[16]; unpack8(*(const u32x4*)(lds + RR + r * 32), rr); unpack8(*(const u32x4*)(lds + RR + r * 32 + 16), rr + 8);
                        float x = bias;
#pragma unroll
                        for (int k = 0; k < 16; ++k) x += rr[k] * w2[k];
                        const float ls = fminf(x, 0.f) - __logf(1.f + __expf(-fabsf(x)));
                        c[ii] = ls * (1.f / 16.f); asm volatile("" ::: "memory"); }
                } else {
#pragma unroll
                    for (int ii = 0; ii < 16; ++ii) c[ii] = lg;
                }
#pragma unroll
                for (int ii = 1; ii < 16; ++ii) c[ii] += c[ii - 1];
                const float tot = c[15];
                const float t0 = __shfl(tot, (lane & 15)), t1 = __shfl(tot, (lane & 15) + 16), t2 = __shfl(tot, (lane & 15) + 32), t3 = __shfl(tot, (lane & 15) + 48);
                const float off = (seg > 0 ? t0 : 0.f) + (seg > 1 ? t1 : 0.f) + (seg > 2 ? t2 : 0.f);
                const float cl = (t0 + t1) + (t2 + t3);
#pragma unroll
                for (int ii = 0; ii < 16; ++ii) { const int i = 16 * seg + ii, r = i;
                    const float cum = off + c[ii]; const float e1 = __expf(cum), e2 = __expf(-cum), e3 = __expf(cl - cum);
                    const float q = bf2f(*(const bf16_t*)(lds + RQ + r * 256 + d * 2)), k = bf2f(*(const bf16_t*)(lds + RK + r * 256 + d * 2));
                    *(bf16_t*)(lds + QD + i * 272 + d * 2) = f2bf(q * e1);
                    *(bf16_t*)(lds + KN + i * 272 + d * 2) = f2bf(k * e2);
                    *(bf16_t*)(lds + KET + d * 144 + i * 2) = f2bf(k * e3); asm volatile("" ::: "memory"); }
                if (seg == 3) *(float*)(lds + DEC + d * 4) = __expf(cl);
                { const int v = tid & 31, ig = tid >> 5; float vv[4];
#pragma unroll
                  for (int e = 0; e < 4; ++e) { const int i = 4 * ig + e, r = i; vv[e] = bf2f(*(const bf16_t*)(lds + RV + r * 64 + v * 2)); }
                  u32x2 o; o.x = pk2(vv[0], vv[1]); o.y = pk2(vv[2], vv[3]); *(u32x2*)(lds + VT + v * 144 + ig * 8) = o; }
            }
            __syncthreads();
            if (n + 1 < 132) { SC_STORE(); if (n + 2 < 132) SC_LOAD(n + 2); }
            if (wid < 4) {
                const int ti = wid >> 1, tj = wid & 1; S0 = f32x16{};
                if (!(ti == 0 && tj == 1)) {
#pragma unroll
                    for (int kk = 0; kk < 8; ++kk) { const bf16x8 a = *(const bf16x8*)(lds + QD + (32 * ti + r32) * 272 + (16 * kk + 8 * hi) * 2), bb = *(const bf16x8*)(lds + KN + (32 * tj + r32) * 272 + (16 * kk + 8 * hi) * 2);
                        S0 = SMFMA(a, bb, S0); }
                }
#pragma unroll
                for (int r = 0; r < 16; ++r) { const int i = 32 * ti + crow(r, hi), j = 32 * tj + r32; int jm = j - (dir ? 0 : 1); asm volatile("" : "+v"(jm));
                    *(bf16_t*)(lds + PM + i * 144 + j * 2) = f2bf(i > jm ? S0[r] : 0.f); }
            } else if (wid < 6) {
                const int ti = wid - 4; S0 = f32x16{};
#pragma unroll
                for (int kk = 0; kk < 8; ++kk) { const bf16x8 a = *(const bf16x8*)(lds + QD + (32 * ti + r32) * 272 + (16 * kk + 8 * hi) * 2), bb = *(const bf16x8*)(lds + ST + r32 * 272 + (16 * kk + 8 * hi) * 2);
                    S0 = SMFMA(a, bb, S0); }
            } else {
                const int dt0 = 2 * (wid - 6);
                const float dc0 = *(const float*)(lds + DEC + (32 * dt0 + r32) * 4), dc1 = *(const float*)(lds + DEC + (32 * (dt0 + 1) + r32) * 4);
#pragma unroll
                for (int r = 0; r < 16; ++r) { S0[r] *= dc0; S1[r] *= dc1; }
#pragma unroll
                for (int kk = 0; kk < 4; ++kk) { const bf16x8 a = *(const bf16x8*)(lds + VT + r32 * 144 + (16 * kk + 8 * hi) * 2);
                    const bf16x8 b0 = *(const bf16x8*)(lds + KET + (32 * dt0 + r32) * 144 + (16 * kk + 8 * hi) * 2), b1 = *(const bf16x8*)(lds + KET + (32 * (dt0 + 1) + r32) * 144 + (16 * kk + 8 * hi) * 2);
                    S0 = SMFMA(a, b0, S0); S1 = SMFMA(a, b1, S1); }
            }
            __syncthreads();
            if (wid >= 4 && wid < 6) {
                const int ti = wid - 4;
#pragma unroll
                for (int kk = 0; kk < 4; ++kk) { const bf16x8 a = *(const bf16x8*)(lds + PM + (32 * ti + r32) * 144 + (16 * kk + 8 * hi) * 2), bb = *(const bf16x8*)(lds + VT + r32 * 144 + (16 * kk + 8 * hi) * 2);
                    S0 = SMFMA(a, bb, S0); }
                const int rb = ROWBASE(n);
#pragma unroll
                for (int r = 0; r < 16; ++r) { const int i = 32 * ti + crow(r, hi), row = rb + (dir ? 63 - i : i);
                    Od[(size_t)row * 1024 + ocol + r32] = f2bf(S0[r]); }
            } else if (wid >= 6) {
                const int dt0 = 2 * (wid - 6);
#pragma unroll
                for (int r = 0; r < 16; ++r) { const int v = crow(r, hi);
                    *(bf16_t*)(lds + ST + v * 272 + (32 * dt0 + r32) * 2) = f2bf(S0[r]); *(bf16_t*)(lds + ST + v * 272 + (32 * (dt0 + 1) + r32) * 2) = f2bf(S1[r]); }
            }
        }
#undef ROWBASE
#undef SC_LOAD
#undef SC_STORE
    }
    __syncthreads();
}

constexpr int PH_PER_LAYER = 15, N_PHASES = 1 + 2 * PH_PER_LAYER;
#ifndef PHEN
#define PHEN(q) 1
#endif
#define PH(k) if (lo <= (k) && (k) < hi && ((k) == lo || (grid.sync(), true)))
template <int l>
DI void layer_program(const Params& P, int lo, int hi, LAS unsigned char* lds, unsigned char* lds_raw) {
    cg::grid_group grid = cg::this_grid();
    constexpr int base = 1 + PH_PER_LAYER * l;
    constexpr int Mlat = (l == 0) ? TA : TL;
#define WSP(T, off) ((T*)(P.ws + (off)))
#define MODL (WSP(const float, WS_MOD) + (size_t)l * 5 * 6144)
#define HIN_L ((l == 0) ? P.in[I_X] : (const float*)P.out)
#define HIN_C ((l == 0) ? P.in[I_CTX] : WSP(const float, WS_HC))
    PH(base + 0) if (PHEN(0)) { phase_norm(HIN_L, HIN_C, P.in[I_N1W] + l * DM, MODL, 0, 1, WSP(bf16_t, WS_A), TA); phase_wconv_mixer(P, l, lds); }
    PH(base + 1) if (PHEN(1)) { Epi<EM_PLAIN> E{}; E.O0 = WSP(bf16_t, WS_SM); E.ld0 = 512; run_gemm<EM_PLAIN>(lds, WSP(bf16_t, WS_A), 1024, WSP(bf16_t, WS_WT) + WT_IN, TA, 512, 1024, E); }
    PH(base + 2) if (PHEN(2)) { { Epi<EM_PLAIN> E{}; E.O0 = WSP(bf16_t, WS_Q); E.ld0 = 768; run_gemm<EM_PLAIN>(lds, WSP(bf16_t, WS_SM), 512, WSP(bf16_t, WS_WT) + WT_QB, TA, 768, 256, E); }
                  { Epi<EM_KV> E2{}; E2.O0 = WSP(bf16_t, WS_K); E2.O1 = WSP(bf16_t, WS_V); run_gemm<EM_KV>(lds, WSP(bf16_t, WS_SM) + 256, 512, WSP(bf16_t, WS_WT) + WT_KVB, TA, 1024, 128, E2); } }
    PH(base + 3) if (PHEN(3)) phase_qkpost(P, l);
    PH(base + 4) if (PHEN(4)) phase_attention(P, l, (char*)lds_raw);
    PH(base + 5) if (PHEN(5)) { Epi<EM_BIG> E{}; E.O0 = WSP(bf16_t, WS_R4); E.fa = WSP(const float, WS_ROT); run_gemm<EM_BIG>(lds, WSP(bf16_t, WS_A), 1024, WSP(bf16_t, WS_WT) + WT_IN + (size_t)512 * 1024, TA, 3072, 1024, E); }
    PH(base + 6) if (PHEN(6)) phase_scan(P, l, (char*)lds_raw);
    PH(base + 7) if (PHEN(7)) phase_scanpost(P, l, Mlat);
    PH(base + 8) if (PHEN(8)) { Epi<EM_GATES> E{}; E.O0 = WSP(bf16_t, WS_R4); E.O1 = WSP(bf16_t, WS_OF); E.fa = P.in[I_BGATE] + (size_t)l * 3072; run_gemm<EM_GATES>(lds, WSP(bf16_t, WS_A), 1024, WSP(bf16_t, WS_WT) + WT_IN + (size_t)3584 * 1024, Mlat, 4096, 1024, E); }
    PH(base + 9) if (PHEN(9)) {
        { Epi<EM_BRANCH> E{}; E.O0 = WSP(bf16_t, WS_OB); E.Gsrc = WSP(bf16_t, WS_R4); E.ipar = 0; run_gemm<EM_BRANCH>(lds, WSP(bf16_t, WS_Q), 768, WSP(bf16_t, WS_WT) + WT_BR, Mlat, 1024, 512, E); }
        { Epi<EM_BRANCH> E{}; E.O0 = WSP(bf16_t, WS_OB); E.Gsrc = WSP(bf16_t, WS_R4) + 1024; E.ipar = 1; run_gemm<EM_BRANCH>(lds, WSP(bf16_t, WS_OF), 1024, WSP(bf16_t, WS_WT) + WT_BR + (size_t)1024 * 512, Mlat, 1024, 512, E); }
        { Epi<EM_BRANCH> E{}; E.O0 = WSP(bf16_t, WS_OB); E.Gsrc = WSP(bf16_t, WS_R4) + 2048; E.ipar = 2; run_gemm<EM_BRANCH>(lds, WSP(bf16_t, WS_OF) + 512, 1024, WSP(bf16_t, WS_WT) + WT_BR + (size_t)2048 * 512, Mlat, 1024, 512, E); } }
    PH(base + 10) if (PHEN(10)) { Epi<EM_RES> E{}; E.fa = MODL; E.ipar = 2; E.hin_l = HIN_L; E.hin_c = HIN_C; E.hout_l = P.out; E.hout_c = WSP(float, WS_HC);
                   run_gemm<EM_RES>(lds, WSP(bf16_t, WS_OB), 1024, WSP(bf16_t, WS_WT) + WT_OUT, Mlat, 1024, 1024, E); }
    PH(base + 11) if (PHEN(11)) { phase_norm(P.out, WSP(const float, WS_HC), P.in[I_N2W] + l * DM, MODL, 3, 4, WSP(bf16_t, WS_A), Mlat); phase_wconv_ffn(P, l, lds); }
    PH(base + 12) if (PHEN(12)) { Epi<EM_FFNIN> E{}; E.O0 = WSP(bf16_t, WS_G); E.O1 = WSP(bf16_t, WS_U); run_gemm<EM_FFNIN>(lds, WSP(bf16_t, WS_A), 1024, WSP(bf16_t, WS_WT) + WT_F1, Mlat, 5632, 1024, E); }
    PH(base + 13) if (PHEN(13)) phase_conv(P, l, Mlat);
    PH(base + 14) if (PHEN(14)) { Epi<EM_RES> E{}; E.fa = MODL; E.ipar = 5; E.hin_l = P.out; E.hin_c = WSP(const float, WS_HC); E.hout_l = P.out; E.hout_c = WSP(float, WS_HC);
                   run_gemm<EM_RES>(lds, WSP(bf16_t, WS_U), DFF, WSP(bf16_t, WS_WT) + WT_F2, Mlat, 1024, DFF, E); }
}
__global__ void __launch_bounds__(NTHREADS, 2) fwd_kernel(Params P) {
    extern __shared__ __attribute__((aligned(16))) unsigned char lds_raw[];
    LAS unsigned char* lds = (LAS unsigned char*)lds_raw;
    cg::grid_group grid = cg::this_grid();
    const int lo = P.ph_lo, hi = P.ph_hi;
    Params* G = (Params*)(P.ws + WS_PAR + (size_t)blockIdx.x * 256);
    if (threadIdx.x == 0) {
#pragma unroll
        for (int i = 0; i < 26; ++i) G->in[i] = P.in[i];
        G->out = P.out; G->ws = P.ws; G->ph_lo = lo; G->ph_hi = hi;
    }
    __syncthreads();
    asm volatile("" ::: "memory");
    const Params& Q = *G;
    PH(0) phase_prologue(Q, lds);
    layer_program<0>(Q, lo, hi, lds, lds_raw);
    layer_program<1>(Q, lo, hi, lds, lds_raw);
}

#ifndef N_LAUNCH_MODE
#define N_LAUNCH_MODE 1
#endif
extern "C" void kernel_launch(void* const* d_in, const int* in_sizes, int n_in, void* d_out, int out_size, void* d_ws, size_t ws_size, hipStream_t stream) {
    static int grid_blocks = 0;
    if (!grid_blocks) {
        if (n_in != 26 || ws_size < WS_NEED) { fprintf(stderr, "kernel_launch: bad inputs (n_in %d, ws %zu < %zu)\n", n_in, ws_size, (size_t)WS_NEED); return; }
        if (hipFuncSetAttribute((const void*)fwd_kernel, hipFuncAttributeMaxDynamicSharedMemorySize, LDS_BYTES) != hipSuccess) { fprintf(stderr, "kernel_launch: hipFuncSetAttribute failed\n"); return; }
        int dev = 0, cus = 0, per_cu = 0;
        hipGetDevice(&dev);
        hipDeviceGetAttribute(&cus, hipDeviceAttributeMultiprocessorCount, dev);
        hipOccupancyMaxActiveBlocksPerMultiprocessor(&per_cu, fwd_kernel, NTHREADS, LDS_BYTES);
        if (per_cu < 1) { fprintf(stderr, "kernel_launch: occupancy query returned %d\n", per_cu); return; }
        grid_blocks = cus * 1;
    }
    Params p{};
    for (int i = 0; i < 26; ++i) p.in[i] = (const float*)d_in[i];
    p.out = (float*)d_out; p.ws = (unsigned char*)d_ws;
#if N_LAUNCH_MODE == 1
    p.ph_lo = 0; p.ph_hi = N_PHASES;
    void* args[] = {&p};
    hipError_t e = hipLaunchCooperativeKernel((const void*)fwd_kernel, dim3(grid_blocks), dim3(NTHREADS), args, LDS_BYTES, stream);
    if (e != hipSuccess) fprintf(stderr, "cooperative launch failed: %s (grid %d)\n", hipGetErrorString(e), grid_blocks);
#else
    for (int ph = 0; ph < N_PHASES; ++ph) {
        p.ph_lo = ph; p.ph_hi = ph + 1;
        hipLaunchKernelGGL(fwd_kernel, dim3(grid_blocks), dim3(NTHREADS), LDS_BYTES, stream, p);
    }
#endif
}
```

```cpp
#include <hip/hip_runtime.h>
#include <hip/hip_bf16.h>
#include <hip/hip_cooperative_groups.h>
#include <cstdio>
#include <cstdint>
namespace cg = cooperative_groups;
#define DI __device__ __forceinline__
#define LAS __attribute__((address_space(3)))
namespace pg8 {
#define PG8_LAS __attribute__((address_space(3)))
typedef unsigned short bf16_t;
typedef short bf16x8 __attribute__((ext_vector_type(8)));
typedef float f32x4 __attribute__((ext_vector_type(4)));
typedef unsigned u32x4 __attribute__((ext_vector_type(4)));
constexpr int BM = 256, BK = 64, HALF = 128, HTB = HALF * BK * 2  , STAGE_BYTES = 8 * HTB, NXCD = 8, WGM = 8;

__host__ __device__ __forceinline__ int lds_byte(int r, int c) { const int st = (r >> 4) * 2 + (c >> 5), rr = r & 15, cc = c & 31, ob = rr * 64 + cc * 2; return st * 1024 + (ob ^ (((ob >> 9) & 1) << 5)); }
__host__ __device__ __forceinline__ void stage_rc(int b, int& R, int& C) { const int st = b / 1024, sb = b % 1024, swz = sb ^ (((sb >> 9) & 1) << 5); R = (st >> 1) * 16 + swz / 64; C = (st & 1) * 32 + (swz % 64) / 2; }
__host__ __device__ __forceinline__ int perm32(int rho) { const int n = rho >> 4, i = rho & 15; return 8 * (i >> 2) + 4 * n + (i & 3); }

struct Unit { int pm, pn; };
struct Gemm { const bf16_t* A; const bf16_t* Bt; int M, N, K, lda; };

struct StaticOrder {
    int nM, nN, nwg, G, c;
    __host__ __device__ void init(int M, int N, int G_, int c_) { nM = M / BM; nN = N / BM; nwg = nM * nN; G = G_; c = c_; }
    __host__ __device__ bool next(int i, Unit& u) const {
        const long L = (long)i * G + c; if (L >= nwg) return false;
        int wgid = (int)L; { const int q = nwg / NXCD, r = nwg % NXCD, xcd = wgid % NXCD, off = wgid / NXCD; wgid = (xcd < r ? xcd * (q + 1) : r * (q + 1) + (xcd - r) * q) + off; }
        const int nig = WGM * nN, gid = wgid / nig, fm = gid * WGM, gsz = (nM - fm) < WGM ? (nM - fm) : WGM;
        u.pm = fm + ((wgid % nig) % gsz); u.pn = (wgid % nig) / gsz; return true;
    }
    __device__ __forceinline__ void a_ready(const Unit&) const {}
    __device__ __forceinline__ void done(const Unit&) const {}
};

__device__ __forceinline__ unsigned cvt_pk_bf16(float lo, float hi) { unsigned r; asm volatile("v_cvt_pk_bf16_f32 %0, %1, %2" : "=v"(r) : "v"(lo), "v"(hi)); return r; }
template <class Epi, class Sched, bool ALIGN_EPI = false, bool SP2 = false>
__device__ __forceinline__ void gemm_phase(PG8_LAS unsigned char* lds, const Gemm g, const Sched& S, const Epi& E) {
    const int tid = threadIdx.x, wid = __builtin_amdgcn_readfirstlane(tid >> 6), lane = tid & 63, wr = wid >> 2, wc = wid & 3, fr = lane & 15, fq = lane >> 4;
    const int K = g.K, nt = K / BK;
    unsigned voffA[2], voffB[2];
#pragma unroll
    for (int i = 0; i < 2; ++i) { int R, C; stage_rc(tid * 16 + i * 8192, R, C); const int Rb = Epi::PERM ? ((R & ~31) + perm32(R & 31)) : R;
        voffA[i] = (unsigned)(R * g.lda + C) * 2u; voffB[i] = (unsigned)(Rb * K + C) * 2u; }
    const size_t kstep = (size_t)(BK * 2);
    const size_t hstep = (size_t)HALF * K * 2;
    const size_t tstep = 2 * hstep; const size_t hstepA = (size_t)HALF * g.lda * 2; const size_t tstepA = 2 * hstepA;
    const unsigned ldsw = (unsigned)wid * 1024u;
    const int aoff = lds_byte(wr * 64 + fr, fq * 8), boff = lds_byte(wc * 32 + fr, fq * 8);
#define PG8_SA(b, h) (((b) * 2 + (h)) * HTB)
#define PG8_SB(b, h) ((4 + (b) * 2 + (h)) * HTB)
#define PG8_STAGE(bufoff, gbase, voff) do { _Pragma("unroll") for (int _i = 0; _i < 2; ++_i) \
        __builtin_amdgcn_global_load_lds((const unsigned*)((const char*)(gbase) + (voff)[_i]), (PG8_LAS unsigned*)(lds + (bufoff) + ldsw + _i * 8192), 16, 0, 0); } while (0)
#define PG8_LDA(dst, b, h) do { _Pragma("unroll") for (int m = 0; m < 4; ++m) _Pragma("unroll") for (int k = 0; k < 2; ++k) dst[m][k] = *(const PG8_LAS bf16x8*)(lds + PG8_SA(b, h) + aoff + m * 2048 + k * 1024); } while (0)
#define PG8_LDB(dst, b, h) do { _Pragma("unroll") for (int n = 0; n < 2; ++n) _Pragma("unroll") for (int k = 0; k < 2; ++k) dst[n][k] = *(const PG8_LAS bf16x8*)(lds + PG8_SB(b, h) + boff + n * 2048 + k * 1024); } while (0)
#define PG8_MMA(ai, bj, At, Bt) do { __builtin_amdgcn_s_setprio(1); _Pragma("unroll") for (int m = 0; m < 4; ++m) _Pragma("unroll") for (int n = 0; n < 2; ++n) _Pragma("unroll") for (int k = 0; k < 2; ++k) \
        acc[ai][bj][m][n] = __builtin_amdgcn_mfma_f32_16x16x32_bf16(Bt[n][k], At[m][k], acc[ai][bj][m][n], 0, 0, 0); __builtin_amdgcn_s_setprio(0); } while (0)
#define PG8_WAIT_V(n) asm volatile("s_waitcnt vmcnt(" #n ")" ::: "memory")
#define PG8_WAIT_L(n) asm volatile("s_waitcnt lgkmcnt(" #n ")" ::: "memory")
#define PG8_BAR __builtin_amdgcn_s_barrier()
#define PG8_SCHED __builtin_amdgcn_sched_barrier(0)
    Unit cur, nxt; int ui = 0;
    if (!S.next(0, cur)) return;
    f32x4 acc[2][2][4][2];
#pragma unroll
    for (int a = 0; a < 2; ++a)
#pragma unroll
        for (int b = 0; b < 2; ++b)
#pragma unroll
            for (int m = 0; m < 4; ++m)
#pragma unroll
                for (int n = 0; n < 2; ++n) acc[a][b][m][n] = (f32x4){0.f, 0.f, 0.f, 0.f};
    bf16x8 At[4][2], B0[2][2], B1[2][2];
    const char* cA = (const char*)g.A + (size_t)cur.pm * tstepA; const char* cB = (const char*)g.Bt + (size_t)cur.pn * tstep;
    S.a_ready(cur);
    if constexpr (SP2) {
        PG8_STAGE(PG8_SB(0, 0), cB, voffB); PG8_STAGE(PG8_SB(0, 1), cB + hstep, voffB); PG8_STAGE(PG8_SA(0, 0), cA, voffA); PG8_STAGE(PG8_SA(0, 1), cA + hstepA, voffA);
        if (wr == 1) PG8_BAR;
        PG8_WAIT_V(2); PG8_BAR;
        PG8_STAGE(PG8_SB(1, 0), cB + kstep, voffB); PG8_STAGE(PG8_SA(1, 0), cA + kstep, voffA); PG8_STAGE(PG8_SB(1, 1), cB + hstep + kstep, voffB);
        PG8_WAIT_V(6); PG8_BAR;
    } else {
        PG8_STAGE(PG8_SB(0, 0), cB, voffB); PG8_STAGE(PG8_SA(0, 0), cA, voffA); PG8_STAGE(PG8_SB(0, 1), cB + hstep, voffB); PG8_STAGE(PG8_SA(0, 1), cA + hstepA, voffA);
        if (wr == 1) PG8_BAR;
        PG8_WAIT_V(4); PG8_BAR;
        PG8_STAGE(PG8_SB(1, 0), cB + kstep, voffB); PG8_STAGE(PG8_SA(1, 0), cA + kstep, voffA); PG8_STAGE(PG8_SB(1, 1), cB + hstep + kstep, voffB);
        PG8_WAIT_V(6); PG8_BAR;
    }
    for (;;) {
        const bool has_next = S.next(ui + 1, nxt);
        const char* nA = has_next ? (const char*)g.A + (size_t)nxt.pm * tstepA : cA; const char* nB = has_next ? (const char*)g.Bt + (size_t)nxt.pn * tstep : cB;
        for (int t = 0; t < nt; t += 2) {
            const bool last = (t == nt - 2);
            const char* a1 = cA + (size_t)(t + 1) * kstep;
            const char* a2 = last ? nA : cA + (size_t)(t + 2) * kstep; const char* b2 = last ? nB : cB + (size_t)(t + 2) * kstep;
            const char* a3 = a2 + kstep; const char* b3 = b2 + kstep;
            if (last && has_next) S.a_ready(nxt);
            if constexpr (SP2) {
            PG8_LDB(B0, 0, 0); PG8_LDB(B1, 0, 1); PG8_SCHED; PG8_LDA(At, 0, 0); PG8_STAGE(PG8_SA(1, 1), a1 + hstepA, voffA);
            PG8_WAIT_V(8); PG8_WAIT_L(0); PG8_BAR; PG8_MMA(0, 0, At, B0); PG8_MMA(0, 1, At, B1); PG8_BAR; PG8_SCHED;
            PG8_LDA(At, 0, 1); PG8_STAGE(PG8_SB(0, 0), b2, voffB); PG8_STAGE(PG8_SB(0, 1), b2 + hstep, voffB); PG8_STAGE(PG8_SA(0, 0), a2, voffA);
            PG8_WAIT_V(8); PG8_WAIT_L(0); PG8_BAR; PG8_MMA(1, 0, At, B0); PG8_MMA(1, 1, At, B1); PG8_BAR; PG8_SCHED;
            PG8_LDB(B0, 1, 0); PG8_LDB(B1, 1, 1); PG8_SCHED; PG8_LDA(At, 1, 0); PG8_STAGE(PG8_SA(0, 1), a2 + hstepA, voffA);
            PG8_WAIT_V(8); PG8_WAIT_L(0); PG8_BAR; PG8_MMA(0, 0, At, B0); PG8_MMA(0, 1, At, B1); PG8_BAR; PG8_SCHED;
            PG8_LDA(At, 1, 1); PG8_STAGE(PG8_SB(1, 0), b3, voffB); PG8_STAGE(PG8_SB(1, 1), b3 + hstep, voffB); PG8_STAGE(PG8_SA(1, 0), a3, voffA);
            PG8_WAIT_V(8); PG8_WAIT_L(0); PG8_BAR; PG8_MMA(1, 0, At, B0); PG8_MMA(1, 1, At, B1); PG8_BAR; PG8_SCHED;
            } else {
            PG8_LDB(B0, 0, 0); PG8_SCHED; PG8_LDA(At, 0, 0); PG8_STAGE(PG8_SA(1, 1), a1 + hstepA, voffA);
            PG8_WAIT_L(8); PG8_BAR; PG8_WAIT_L(0); PG8_MMA(0, 0, At, B0); PG8_BAR; PG8_SCHED;
            PG8_LDB(B1, 0, 1); PG8_STAGE(PG8_SB(0, 0), b2, voffB);
            PG8_BAR; PG8_WAIT_L(0); PG8_MMA(0, 1, At, B1); PG8_BAR;
            PG8_LDA(At, 0, 1); PG8_STAGE(PG8_SA(0, 0), a2, voffA);
            PG8_BAR; PG8_WAIT_L(0); PG8_MMA(1, 0, At, B0); PG8_BAR; PG8_SCHED;
            PG8_STAGE(PG8_SB(0, 1), b2 + hstep, voffB);
            PG8_WAIT_V(6); PG8_BAR; PG8_MMA(1, 1, At, B1); PG8_BAR;
            PG8_LDB(B0, 1, 0); PG8_SCHED; PG8_LDA(At, 1, 0); PG8_STAGE(PG8_SA(0, 1), a2 + hstepA, voffA);
            PG8_WAIT_L(8); PG8_BAR; PG8_WAIT_L(0); PG8_MMA(0, 0, At, B0); PG8_BAR; PG8_SCHED;
            PG8_LDB(B1, 1, 1); PG8_STAGE(PG8_SB(1, 0), b3, voffB);
            PG8_BAR; PG8_WAIT_L(0); PG8_MMA(0, 1, At, B1); PG8_BAR;
            PG8_LDA(At, 1, 1); PG8_STAGE(PG8_SA(1, 0), a3, voffA);
            PG8_BAR; PG8_WAIT_L(0); PG8_MMA(1, 0, At, B0); PG8_BAR; PG8_SCHED;
            PG8_STAGE(PG8_SB(1, 1), b3 + hstep, voffB);
            PG8_WAIT_V(6); PG8_BAR; PG8_MMA(1, 1, At, B1); PG8_BAR;
            }
        }
        if constexpr (ALIGN_EPI) { if (wr == 0) PG8_BAR; }
        if constexpr (!Epi::AFTER_DRAIN) { E(acc, cur, wr, wc, fr, fq); S.done(cur); }
        if (!has_next) break;
#pragma unroll
        for (int a = 0; a < 2; ++a)
#pragma unroll
            for (int b = 0; b < 2; ++b)
#pragma unroll
                for (int m = 0; m < 4; ++m)
#pragma unroll
                    for (int n = 0; n < 2; ++n) acc[a][b][m][n] = (f32x4){0.f, 0.f, 0.f, 0.f};
        cur = nxt; cA = nA; cB = nB; ++ui;
        if constexpr (ALIGN_EPI) { if (wr == 1) PG8_BAR; }
    }
    PG8_WAIT_V(0);
    if constexpr (!ALIGN_EPI) { if (wr == 0) PG8_BAR; }
    PG8_BAR;
    if constexpr (Epi::AFTER_DRAIN) { E.fused(acc, cur, wr, wc, fr, fq, lds, wid, lane); S.done(cur); }
#undef PG8_SA
#undef PG8_SB
#undef PG8_STAGE
#undef PG8_LDA
#undef PG8_LDB
#undef PG8_MMA
#undef PG8_WAIT_V
#undef PG8_WAIT_L
#undef PG8_BAR
#undef PG8_SCHED
}
}

typedef unsigned short bf16_t;
typedef short bf16x8 __attribute__((ext_vector_type(8)));
typedef short s16x4 __attribute__((ext_vector_type(4)));
typedef float f32x4 __attribute__((ext_vector_type(4)));
typedef float f32x2 __attribute__((ext_vector_type(2)));
typedef float f32x16 __attribute__((ext_vector_type(16)));
typedef unsigned u32x4 __attribute__((ext_vector_type(4)));
typedef unsigned u32x2 __attribute__((ext_vector_type(2)));

constexpr int DM = 1024, NB = 4, SEQ = 8192, CTX = 256, TL = NB * SEQ, TC = NB * CTX, TA = TL + TC;
constexpr int DFF = 2816, NIN = 7616;
constexpr float EPS = 1e-6f;
constexpr int NTHREADS = 512, NWAVES = 8;

constexpr size_t al256(size_t x) { return (x + 255) / 256 * 256; }
constexpr size_t WS_MOD = 0;
constexpr size_t WS_PAR = al256(WS_MOD + (size_t)2 * 5 * 6144 * 4);
constexpr size_t WS_BAR = al256(WS_PAR + (size_t)1024 * 256);
constexpr size_t WS_ROT = al256(WS_BAR + (size_t)3456 * 4);
constexpr size_t WS_HC  = al256(WS_ROT + (size_t)8448 * 64 * 8);
constexpr size_t WS_WT  = al256(WS_HC + (size_t)TC * DM * 4);
constexpr size_t WT_IN = 0, WT_QB = WT_IN + (size_t)7680 * 1024, WT_KVB = WT_QB + (size_t)768 * 256, WT_BR = WT_KVB + (size_t)1024 * 128,
                 WT_OUT = WT_BR + (size_t)3 * 1024 * 512, WT_MIX_END = WT_OUT + (size_t)1024 * 1024;
constexpr size_t WT_F1 = 0, WT_F2 = (size_t)5632 * 1024, WT_FFN_END = WT_F2 + (size_t)1024 * 2816;
constexpr size_t WT_ELEMS = WT_MIX_END > WT_FFN_END ? WT_MIX_END : WT_FFN_END;
constexpr size_t WS_A   = al256(WS_WT + WT_ELEMS * 2);
constexpr size_t WS_SM  = al256(WS_A + (size_t)TA * 1024 * 2);
constexpr size_t WS_Q   = al256(WS_SM + (size_t)TA * 512 * 2);
constexpr size_t WS_R4  = al256(WS_Q + (size_t)TA * 768 * 2);
constexpr size_t WS_K   = WS_R4;
constexpr size_t WS_V   = al256(WS_K + (size_t)TA * 768 * 2);
constexpr size_t WS_OF  = al256(WS_R4 + (size_t)TA * 3072 * 2);
constexpr size_t WS_OB  = al256(WS_OF + (size_t)TA * 1024 * 2);
constexpr size_t WS_END_MIX = al256(WS_OB + (size_t)TA * 1024 * 2);
constexpr size_t WS_G   = WS_SM;
constexpr size_t WS_U   = al256(WS_G + (size_t)TA * DFF * 2);
constexpr size_t WS_END_FFN = al256(WS_U + (size_t)TA * DFF * 2);
constexpr size_t WS_NEED = WS_END_MIX > WS_END_FFN ? WS_END_MIX : WS_END_FFN;
static_assert(WS_V + (size_t)TA * 512 * 2 <= WS_OF, "K/V overlay must fit in R4");

constexpr int LDS_BYTES = 128 * 1024 + 16;

struct Params { const float* in[26]; float* out; unsigned char* ws; int ph_lo, ph_hi; };
enum { I_X = 0, I_C, I_CTX, I_CCTX, I_WADA, I_BADA, I_N1W, I_N2W, I_WIN, I_BGATE, I_QNA, I_WQB, I_KVNA, I_WKVB, I_QN, I_KN, I_GK2, I_BGK, I_GON, I_RDEC, I_WBR, I_WOUT, I_WF1, I_WDW, I_BDW, I_WF2 };

DI float bflo(unsigned w) { return __uint_as_float(w << 16); }
DI float bfhi(unsigned w) { return __uint_as_float(w & 0xffff0000u); }
DI float bf2f(bf16_t x) { return __uint_as_float((unsigned)x << 16); }
DI unsigned pk2(float lo, float hi) { unsigned r; asm volatile("v_cvt_pk_bf16_f32 %0, %1, %2" : "=v"(r) : "v"(lo), "v"(hi)); return r; }
DI bf16_t f2bf(float x) { return (bf16_t)(pk2(x, 0.f) & 0xffffu); }
DI float wave_sum(float v) {
#pragma unroll
    for (int o = 1; o < 64; o <<= 1) v += __shfl_xor(v, o);
    return v;
}
DI float sigmoidf_(float x) { return 1.f / (1.f + __expf(-x)); }
DI void unpack8(u32x4 w, float* f) { f[0] = bflo(w.x); f[1] = bfhi(w.x); f[2] = bflo(w.y); f[3] = bfhi(w.y); f[4] = bflo(w.z); f[5] = bfhi(w.z); f[6] = bflo(w.w); f[7] = bfhi(w.w); }
DI u32x4 pack8(const float* f) { u32x4 w; w.x = pk2(f[0], f[1]); w.y = pk2(f[2], f[3]); w.z = pk2(f[4], f[5]); w.w = pk2(f[6], f[7]); return w; }

DI void rowinfo(int m, int& b, int& pos, int& isctx) {
    if (m < TL) { b = m >> 13; pos = m & 8191; isctx = 0; } else { const int j = m - TL; b = j >> 8; pos = j & 255; isctx = 1; }
}

DI void phase_prologue(const Params& P, LAS unsigned char* lds) {
    const int tid = threadIdx.x, wave = tid >> 6, lane = tid & 63;
    LAS float* cond = (LAS float*)lds;
    LAS float* part = cond + 5 * 1024;
    const float* c = P.in[I_C]; const float* cc = P.in[I_CCTX];
    for (int i = tid; i < 5 * 1024; i += NTHREADS) { const int r = i >> 10, k = i & 1023; const float v = r < 4 ? c[r * 1024 + k] : cc[k]; cond[i] = v / (1.f + expf(-v)); }
    __syncthreads();
    float* MOD = (float*)(P.ws + WS_MOD);
    for (int item = blockIdx.x; item < 192; item += gridDim.x) {
        const int l = item / 96, j0 = (item % 96) * 64;
        const float* W = P.in[I_WADA] + (size_t)l * 1024 * 6144 + j0 + lane;
        float a0 = 0.f, a1 = 0.f, a2 = 0.f, a3 = 0.f, a4 = 0.f;
        for (int k = wave * 128; k < wave * 128 + 128; ++k) {
            const float w = W[(size_t)k * 6144];
            a0 += cond[k] * w; a1 += cond[1024 + k] * w; a2 += cond[2048 + k] * w; a3 += cond[3072 + k] * w; a4 += cond[4096 + k] * w;
        }
        part[(wave * 5 + 0) * 64 + lane] = a0; part[(wave * 5 + 1) * 64 + lane] = a1; part[(wave * 5 + 2) * 64 + lane] = a2;
        part[(wave * 5 + 3) * 64 + lane] = a3; part[(wave * 5 + 4) * 64 + lane] = a4;
        __syncthreads();
        if (tid < 320) { const int r = tid >> 6; float s = 0.f;
            for (int w = 0; w < 8; ++w) s += part[(w * 5 + r) * 64 + lane];
            MOD[(size_t)(l * 5 + r) * 6144 + j0 + lane] = s + P.in[I_BADA][l * 6144 + j0 + lane]; }
        __syncthreads();
    }
    f32x2* ROT = (f32x2*)(P.ws + WS_ROT);
    for (int i = blockIdx.x * NTHREADS + tid; i < 8448 * 64; i += gridDim.x * NTHREADS) {
        const int pos = i >> 6, j = i & 63;
        const float inv = 1.0f / powf(10000.0f, (float)j / 63.0f);
        const float ang = (float)pos * inv; float s, co; sincosf(ang, &s, &co);
        ROT[i] = (f32x2){co, s};
    }
}

DI int wmap(int id, int n) {
    switch (id) {
    case 1: if (n < 416) return n; if (n < 448) return 2464 + (n - 416); return -1;
    case 2: { if (n < 1536) return 416 + n;
              if (n < 2560) { const int base = n < 2048 ? 2496 : 3008; const int j = (n - 1536) & 511; const int hh = j >> 7, v = j & 127, g = v >> 3, e = v & 7;
                              const int d = e < 4 ? 4 * g + e : 64 + 4 * g + (e - 4); return base + hh * 128 + d; }
              return 3520 + (n - 2560); }
    case 3: if (n < 512) return 1952 + n; if (n < 1024) return 4032 + (n - 512); return 4544 + (n - 1024);
    case 4: if (n < 512) return (n >> 6) * 96 + (n & 63); { const int j = n - 512; return (j >> 5) * 96 + 64 + (j & 31); }
    case 5: if (n < 512) return (n >> 6) * 128 + (n & 63); { const int j = n - 512; return (j >> 6) * 128 + 64 + (j & 63); }
    default: return n;
    }
}
struct TJob { const float* W; int K, Nsrc; bf16_t* WT; int ndst, map_id; const float* kscale; };
DI void transpose_job(const TJob& J, LAS float* scr, int gw, int ngw, int lane) {
    const int nblk = J.ndst / 32, nitems = (J.K / 64) * nblk;
    for (int item = gw; item < nitems; item += ngw) {
        const int kb = item / nblk, nb = item % nblk, k0 = 64 * kb, n0 = 32 * nb;
        const int src = wmap(J.map_id, n0 + (lane & 31));
#pragma unroll 8
        for (int i = 0; i < 32; ++i) { const int kk = 2 * i + (lane >> 5);
            float v = 0.f; if (src >= 0) { v = J.W[(size_t)(k0 + kk) * J.Nsrc + src]; if (J.kscale) v *= J.kscale[k0 + kk]; }
            scr[kk * 33 + (lane & 31)] = v; }
        asm volatile("s_waitcnt lgkmcnt(0)" ::: "memory");
        const int c = lane & 7;
#pragma unroll
        for (int j = 0; j < 4; ++j) { const int n = (lane >> 3) + 8 * j; const LAS float* s = scr + (8 * c) * 33 + n;
            u32x4 o; o.x = pk2(s[0 * 33], s[1 * 33]); o.y = pk2(s[2 * 33], s[3 * 33]); o.z = pk2(s[4 * 33], s[5 * 33]); o.w = pk2(s[6 * 33], s[7 * 33]);
            *(u32x4*)(J.WT + (size_t)(n0 + n) * J.K + k0 + 8 * c) = o; }
        asm volatile("s_waitcnt lgkmcnt(0)" ::: "memory");
    }
}
DI void phase_wconv_mixer(const Params& P, int l, LAS unsigned char* lds) {
    const int tid = threadIdx.x, wave = tid >> 6, lane = tid & 63, gw = blockIdx.x * NWAVES + wave, ngw = gridDim.x * NWAVES;
    LAS float* scr = (LAS float*)lds + wave * (64 * 33);
    bf16_t* WT = (bf16_t*)(P.ws + WS_WT);
    const float* win = P.in[I_WIN] + (size_t)l * 1024 * NIN;
    TJob j;
    j = TJob{win, 1024, NIN, WT + WT_IN, 512, 1, nullptr}; transpose_job(j, scr, gw, ngw, lane);
    j = TJob{win, 1024, NIN, WT + WT_IN + (size_t)512 * 1024, 3072, 2, nullptr}; transpose_job(j, scr, gw, ngw, lane);
    j = TJob{win, 1024, NIN, WT + WT_IN + (size_t)3584 * 1024, 4096, 3, nullptr}; transpose_job(j, scr, gw, ngw, lane);
    j = TJob{P.in[I_WQB] + (size_t)l * 256 * 768, 256, 768, WT + WT_QB, 768, 4, P.in[I_QNA] + l * 256}; transpose_job(j, scr, gw, ngw, lane);
    j = TJob{P.in[I_WKVB] + (size_t)l * 128 * 1024, 128, 1024, WT + WT_KVB, 1024, 5, P.in[I_KVNA] + l * 128}; transpose_job(j, scr, gw, ngw, lane);
    for (int n = 0; n < 3; ++n) { j = TJob{P.in[I_WBR] + ((size_t)l * 3 + n) * 512 * 1024, 512, 1024, WT + WT_BR + (size_t)n * 1024 * 512, 1024, 0, nullptr}; transpose_job(j, scr, gw, ngw, lane); }
    j = TJob{P.in[I_WOUT] + (size_t)l * 1024 * 1024, 1024, 1024, WT + WT_OUT, 1024, 0, nullptr}; transpose_job(j, scr, gw, ngw, lane);
}
DI void phase_wconv_ffn(const Params& P, int l, LAS unsigned char* lds) {
    const int tid = threadIdx.x, wave = tid >> 6, lane = tid & 63, gw = blockIdx.x * NWAVES + wave, ngw = gridDim.x * NWAVES;
    LAS float* scr = (LAS float*)lds + wave * (64 * 33);
    bf16_t* WT = (bf16_t*)(P.ws + WS_WT);
    TJob j;
    j = TJob{P.in[I_WF1] + (size_t)l * 1024 * 5632, 1024, 5632, WT + WT_F1, 5632, 0, nullptr}; transpose_job(j, scr, gw, ngw, lane);
    j = TJob{P.in[I_WF2] + (size_t)l * 2816 * 1024, 2816, 1024, WT + WT_F2, 1024, 0, nullptr}; transpose_job(j, scr, gw, ngw, lane);
}

DI void phase_norm(const float* hl, const float* hc, const float* nw, const float* MODl, int ishift, int iscale, bf16_t* A, int nrows) {
    const int tid = threadIdx.x, wave = tid >> 6, lane = tid & 63, gw = blockIdx.x * NWAVES + wave, ngw = gridDim.x * NWAVES;
    for (int m = gw; m < nrows; m += ngw) {
        int b, pos, isctx; rowinfo(m, b, pos, isctx);
        const float* xr = isctx ? hc + (size_t)(m - TL) * DM : hl + (size_t)m * DM;
        const float* mod = MODl + (size_t)(isctx ? 4 : b) * 6144;
        f32x4 v[4]; float ss = 0.f;
#pragma unroll
        for (int j = 0; j < 4; ++j) { v[j] = *(const f32x4*)(xr + 4 * lane + 256 * j); ss += (v[j].x * v[j].x + v[j].y * v[j].y) + (v[j].z * v[j].z + v[j].w * v[j].w); }
        const float rstd = rsqrtf(wave_sum(ss) * (1.f / DM) + EPS);
#pragma unroll
        for (int j = 0; j < 4; ++j) { const int c = 4 * lane + 256 * j;
            const f32x4 w = *(const f32x4*)(nw + c), sh = *(const f32x4*)(mod + ishift * 1024 + c), sc = *(const f32x4*)(mod + iscale * 1024 + c);
            const f32x4 y = v[j] * rstd * w * (sc + 1.f) + sh;
            u32x2 o; o.x = pk2(y.x, y.y); o.y = pk2(y.z, y.w);
            *(u32x2*)(A + (size_t)m * DM + c) = o; }
    }
}
#include <cstdlib>
#include <vector>

#define XB_TMO      128
#define XB_XCNT(j)  (256  + 64 * (j))
#define XB_XSUB(j)  (1280 + 64 * (j))
#define XB_XGEN(j)  (2304 + 64 * (j))
#define XB_TOP      3328
#define XB_TOPGEN   3392
#define XCD_BAR_WORDS 3456
#define XB_SPIN_CAP (1u << 18)

__device__ __forceinline__ unsigned xb_ld(unsigned* p)              { return __hip_atomic_load(p, __ATOMIC_RELAXED, __HIP_MEMORY_SCOPE_AGENT); }
__device__ __forceinline__ unsigned xb_add(unsigned* p, unsigned v) { return __hip_atomic_fetch_add(p, v, __ATOMIC_RELAXED, __HIP_MEMORY_SCOPE_AGENT); }
__device__ __forceinline__ unsigned xb_xcc_id() { return (unsigned)__builtin_amdgcn_s_getreg((3 << 11) | 20) & 0xFu; }
#define XB_SPIN(cond, bar) do { unsigned _sp = 0; while (cond) { __builtin_amdgcn_s_sleep(1); \
    if ((++_sp & 255u) == 0u) { if (xb_ld(&(bar)[XB_TMO])) break; if (_sp > XB_SPIN_CAP) { atomicAdd(&(bar)[XB_TMO], 1u); break; } } } } while (0)

struct XcdBarrier {
    unsigned* bar; unsigned x;
    volatile LAS unsigned* st;
};

__device__ __forceinline__ XcdBarrier xcd_barrier_post(unsigned* bar, volatile LAS unsigned* st) {
    XcdBarrier b; b.bar = bar; b.x = xb_xcc_id(); b.st = st;
    if (threadIdx.x == 0) (void)xb_add(&bar[XB_XCNT(b.x)], 1u);
    return b;
}
__device__ __forceinline__ void xcd_barrier_complete(unsigned* bar, unsigned x, unsigned& nloc, unsigned& nx) {
    const unsigned G = gridDim.x * gridDim.y * gridDim.z;
    unsigned sum, cnt, mine, sp = 0u;
    for (;;) {
        sum = 0u; cnt = 0u; mine = 0u;
#pragma unroll
        for (unsigned j = 0; j < 16; ++j) { const unsigned c = xb_ld(&bar[XB_XCNT(j)]); sum += c; cnt += (c > 0u) ? 1u : 0u; mine = (j == x) ? c : mine; }
        if (sum == G) break;
        __builtin_amdgcn_s_sleep(1);
        if ((++sp & 255u) == 0u) { if (xb_ld(&bar[XB_TMO])) break; if (sp > XB_SPIN_CAP) { atomicAdd(&bar[XB_TMO], 1u); break; } }
    }
    nloc = mine > 0u ? mine : 1u; nx = cnt > 0u ? cnt : 1u;
}

__device__ __forceinline__ void xcd_barrier(const XcdBarrier& b) {
    asm volatile("s_waitcnt vmcnt(0)" ::: "memory");
    __syncthreads();
    if (threadIdx.x == 0) {
        unsigned* bar = b.bar;
        __builtin_amdgcn_s_waitcnt(0);
        unsigned nloc = b.st[0], nx = b.st[1];
        if (nloc == 0u) { xcd_barrier_complete(bar, b.x, nloc, nx); b.st[0] = nloc; b.st[1] = nx; }
        const unsigned old = xb_add(&bar[XB_XSUB(b.x)], 1u);
        const unsigned gen = old / nloc;
        if (old + 1u == (gen + 1u) * nloc) {
            __builtin_amdgcn_fence(__ATOMIC_RELEASE, "agent");
            asm volatile("s_waitcnt vmcnt(0)" ::: "memory");
            const unsigned og = xb_add(&bar[XB_TOP], 1u);
            const unsigned tg = og / nx;
            if (og + 1u == (tg + 1u) * nx) xb_add(&bar[XB_TOPGEN], 1u);
            else XB_SPIN(xb_ld(&bar[XB_TOPGEN]) == tg, bar);
            __builtin_amdgcn_fence(__ATOMIC_ACQUIRE, "agent");
            xb_add(&bar[XB_XGEN(b.x)], 1u);
            asm volatile("s_waitcnt vmcnt(0)" ::: "memory");
        } else {
            XB_SPIN(xb_ld(&bar[XB_XGEN(b.x)]) == gen, bar);
            __builtin_amdgcn_fence(__ATOMIC_ACQUIRE, "agent");
            asm volatile("s_waitcnt vmcnt(0)" ::: "memory");
        }
    }
    __syncthreads();
}

enum { EM_PLAIN = 0, EM_KV, EM_BIG, EM_GATES, EM_BRANCH, EM_RES, EM_FFNIN };
template <int MODE> struct Epi {
    static constexpr bool PERM = true, AFTER_DRAIN = false;
    bf16_t* O0; int ld0; bf16_t* O1; int ld1;
    const bf16_t* Gsrc;
    const float* fa;
    const float* hin_l; const float* hin_c; float* hout_l; float* hout_c;
    int ipar;
    DI void emit(int row, int col, f32x4 v0, f32x4 v1) const {
        float f[8] = {v0[0], v0[1], v0[2], v0[3], v1[0], v1[1], v1[2], v1[3]};
        if (MODE == EM_PLAIN) {
            *(u32x4*)(O0 + (size_t)row * ld0 + col) = pack8(f);
        } else if (MODE == EM_KV) {
            if (col < 512) *(u32x4*)(O0 + (size_t)row * 768 + col) = pack8(f);
            else           *(u32x4*)(O1 + (size_t)row * 512 + (col - 512)) = pack8(f);
        } else if (MODE == EM_FFNIN) {
            if (col < DFF) *(u32x4*)(O0 + (size_t)row * DFF + col) = pack8(f);
            else           *(u32x4*)(O1 + (size_t)row * DFF + (col - DFF)) = pack8(f);
        } else if (MODE == EM_BIG) {
            const float QS = 0.08838834764831845f;
            if (col < 512) { for (int i = 0; i < 8; ++i) f[i] *= QS; }
            else if (col >= 1536 && col < 2560) {
                int b, pos, isctx; rowinfo(row, b, pos, isctx);
                const int sp = isctx ? pos : CTX + pos;
                const int g = ((col - 1536) & 127) >> 3;
                const f32x2* rot = (const f32x2*)fa + (size_t)sp * 64 + 4 * g;
                const float sc = col >= 2048 ? QS : 1.f;
#pragma unroll
                for (int e = 0; e < 4; ++e) { const f32x2 cs = rot[e]; const float x1 = f[e], x2 = f[4 + e];
                    f[e] = (x1 * cs.x - x2 * cs.y) * sc; f[4 + e] = (x1 * cs.y + x2 * cs.x) * sc; }
            }
            *(u32x4*)(O0 + (size_t)row * 3072 + col) = pack8(f);
        } else if (MODE == EM_GATES) {
            if (col < 1024) {
                bf16_t* p = O1 + (size_t)row * 1024 + col; float on[8]; unpack8(*(const u32x4*)p, on);
#pragma unroll
                for (int i = 0; i < 8; ++i) f[i] = on[i] * f[i] * sigmoidf_(f[i]);
                *(u32x4*)p = pack8(f);
            } else {
                const int cc = col - 1024; const f32x4 b0 = *(const f32x4*)(fa + cc), b1 = *(const f32x4*)(fa + cc + 4);
                const float bb[8] = {b0[0], b0[1], b0[2], b0[3], b1[0], b1[1], b1[2], b1[3]};
#pragma unroll
                for (int i = 0; i < 8; ++i) f[i] = sigmoidf_(f[i] + bb[i]);
                *(u32x4*)(O0 + (size_t)row * 3072 + cc) = pack8(f);
            }
        } else if (MODE == EM_BRANCH) {
            float g[8]; unpack8(*(const u32x4*)(Gsrc + (size_t)row * 3072 + col), g);
            bf16_t* p = O0 + (size_t)row * 1024 + col;
            if (ipar > 0) { float pr[8]; unpack8(*(const u32x4*)p, pr);
#pragma unroll
                for (int i = 0; i < 8; ++i) f[i] = pr[i] + g[i] * f[i]; }
            else {
#pragma unroll
                for (int i = 0; i < 8; ++i) f[i] = g[i] * f[i]; }
            *(u32x4*)p = pack8(f);
        } else if (MODE == EM_RES) {
            int b, pos, isctx; rowinfo(row, b, pos, isctx);
            const float* hi_ = isctx ? hin_c + (size_t)(row - TL) * DM : hin_l + (size_t)row * DM;
            float* ho_ = isctx ? hout_c + (size_t)(row - TL) * DM : hout_l + (size_t)row * DM;
            const float* mod = fa + (size_t)(isctx ? 4 : b) * 6144 + ipar * 1024 + col;
            const f32x4 m0 = *(const f32x4*)mod, m1 = *(const f32x4*)(mod + 4);
            const f32x4 h0 = *(const f32x4*)(hi_ + col), h1 = *(const f32x4*)(hi_ + col + 4);
            *(f32x4*)(ho_ + col) = h0 + m0 * v0; *(f32x4*)(ho_ + col + 4) = h1 + m1 * v1;
        }
    }
    DI void operator()(const pg8::f32x4 (&acc)[2][2][4][2], const pg8::Unit& u, int wr, int wc, int fr, int fq) const {
#pragma unroll
        for (int ai = 0; ai < 2; ++ai)
#pragma unroll
            for (int m = 0; m < 4; ++m) { const int row = u.pm * 256 + ai * 128 + wr * 64 + m * 16 + fr;
#pragma unroll
                for (int bj = 0; bj < 2; ++bj) { const int col = u.pn * 256 + bj * 128 + wc * 32 + 8 * fq;
                    emit(row, col, acc[ai][bj][m][0], acc[ai][bj][m][1]); } }
    }
};
template <int MODE>
DI void run_gemm(LAS unsigned char* lds, const bf16_t* A, int lda, const bf16_t* Bt, int M, int N, int K, const Epi<MODE>& E) {
    int Kop = K; if (K < 512) asm volatile("" : "+s"(Kop));
    pg8::Gemm g{A, Bt, M, N, Kop, lda}; pg8::StaticOrder S; S.init(M, N, (int)gridDim.x, (int)blockIdx.x);
    pg8::gemm_phase<Epi<MODE>, pg8::StaticOrder, true, true>((PG8_LAS unsigned char*)lds, g, S, E);
}

DI void phase_qkpost(const Params& P, int l) {
    const int tid = threadIdx.x, wave = tid >> 6, lane = tid & 63, gw = blockIdx.x * NWAVES + wave, ngw = gridDim.x * NWAVES;
    const bf16_t* SM = (const bf16_t*)(P.ws + WS_SM); bf16_t* Q = (bf16_t*)(P.ws + WS_Q); bf16_t* K = (bf16_t*)(P.ws + WS_K); bf16_t* V = (bf16_t*)(P.ws + WS_V);
    const float* qn = P.in[I_QN] + l * 96; const float* kn = P.in[I_KN] + l * 96;
    const int s = lane & 7, h = lane >> 3;
    float qnw[12], knw[12];
#pragma unroll
    for (int i = 0; i < 8; ++i) { qnw[i] = qn[8 * s + i]; knw[i] = kn[8 * s + i]; }
#pragma unroll
    for (int i = 0; i < 4; ++i) { qnw[8 + i] = qn[64 + 4 * s + i]; knw[8 + i] = kn[64 + 4 * s + i]; }
    for (int m = gw; m < TA; m += ngw) {
        int b, pos, isctx; rowinfo(m, b, pos, isctx);
        const bf16_t* sm = SM + (size_t)m * 512;
        const u32x2 cq = *(const u32x2*)(sm + 4 * lane); const unsigned ckv = *(const unsigned*)(sm + 256 + 2 * lane);
        float a0 = bflo(cq.x), a1 = bfhi(cq.x), a2 = bflo(cq.y), a3 = bfhi(cq.y), c0 = bflo(ckv), c1 = bfhi(ckv);
        const float s_q = rsqrtf(wave_sum(a0 * a0 + a1 * a1 + a2 * a2 + a3 * a3) * (1.f / 256.f) + EPS);
        const float s_kv = rsqrtf(wave_sum(c0 * c0 + c1 * c1) * (1.f / 128.f) + EPS);
        float cs[4], sn[4];
        if (!isctx) { const float p = (float)((s < 4) ? (pos >> 6) : (pos & 63));
#pragma unroll
            for (int e = 0; e < 4; ++e) { const float inv = powf(10000.0f, -(float)(4 * (s & 1) + e) * 0.125f); sincosf(p * inv, &sn[e], &cs[e]); } }
        else {
#pragma unroll
            for (int e = 0; e < 4; ++e) { cs[e] = 1.f; sn[e] = 0.f; } }
        const bool second = (s & 2) != 0;
        {
            bf16_t* qp = Q + (size_t)m * 768;
            float z[12]; unpack8(*(const u32x4*)(qp + 64 * h + 8 * s), z);
            const u32x2 zr = *(const u32x2*)(qp + 512 + 32 * h + 4 * s); z[8] = bflo(zr.x); z[9] = bfhi(zr.x); z[10] = bflo(zr.y); z[11] = bfhi(zr.y);
            float ss = 0.f;
#pragma unroll
            for (int i = 0; i < 12; ++i) { z[i] *= s_q; ss += z[i] * z[i]; }
            ss += __shfl_xor(ss, 1); ss += __shfl_xor(ss, 2); ss += __shfl_xor(ss, 4);
            const float r = rsqrtf(ss * (1.f / 96.f) + EPS);
#pragma unroll
            for (int i = 0; i < 12; ++i) z[i] *= r * qnw[i];
#pragma unroll
            for (int e = 0; e < 4; ++e) { const float mine = z[8 + e], other = __shfl_xor(mine, 2);
                z[8 + e] = second ? (other * sn[e] + mine * cs[e]) : (mine * cs[e] - other * sn[e]); }
            *(u32x4*)(qp + 64 * h + 8 * s) = pack8(z);
            u32x2 o; o.x = pk2(z[8], z[9]); o.y = pk2(z[10], z[11]); *(u32x2*)(qp + 512 + 32 * h + 4 * s) = o;
        }
        {
            bf16_t* kp = K + (size_t)m * 768;
            float z[12]; unpack8(*(const u32x4*)(kp + 64 * h + 8 * s), z);
#pragma unroll
            for (int i = 0; i < 8; ++i) z[i] *= s_kv;
            const u32x2 zr = *(const u32x2*)(sm + 384 + 4 * s); z[8] = bflo(zr.x); z[9] = bfhi(zr.x); z[10] = bflo(zr.y); z[11] = bfhi(zr.y);
            float ss = 0.f;
#pragma unroll
            for (int i = 0; i < 12; ++i) ss += z[i] * z[i];
            ss += __shfl_xor(ss, 1); ss += __shfl_xor(ss, 2); ss += __shfl_xor(ss, 4);
            const float r = rsqrtf(ss * (1.f / 96.f) + EPS);
#pragma unroll
            for (int i = 0; i < 12; ++i) z[i] *= r * knw[i];
#pragma unroll
            for (int e = 0; e < 4; ++e) { const float mine = z[8 + e], other = __shfl_xor(mine, 2);
                z[8 + e] = second ? (other * sn[e] + mine * cs[e]) : (mine * cs[e] - other * sn[e]); }
            *(u32x4*)(kp + 64 * h + 8 * s) = pack8(z);
            u32x2 o; o.x = pk2(z[8], z[9]); o.y = pk2(z[10], z[11]); *(u32x2*)(kp + 512 + 32 * h + 4 * s) = o;
            bf16_t* vp = V + (size_t)m * 512 + 8 * lane; float vv[8]; unpack8(*(const u32x4*)vp, vv);
#pragma unroll
            for (int i = 0; i < 8; ++i) vv[i] *= s_kv;
            *(u32x4*)vp = pack8(vv);
        }
    }
}

DI void phase_scanpost(const Params& P, int l, int nrows) {
    const int tid = threadIdx.x, wave = tid >> 6, lane = tid & 63, gw = blockIdx.x * NWAVES + wave, ngw = gridDim.x * NWAVES;
    bf16_t* OF = (bf16_t*)(P.ws + WS_OF); const bf16_t* OB = (const bf16_t*)(P.ws + WS_OB);
    const float* gw_ = P.in[I_GON] + l * 128;
    const int sub = lane & 7, hd = lane >> 3;
    float w[16];
#pragma unroll
    for (int i = 0; i < 16; ++i) w[i] = hd < 4 ? gw_[16 * sub + i] : 1.f;
    for (int m = gw; m < nrows; m += ngw) {
        bf16_t* pf = OF + (size_t)m * 1024 + 16 * lane; const bf16_t* pb = OB + (size_t)m * 1024 + 16 * lane;
        float a[16], bq[16];
        unpack8(*(const u32x4*)pf, a); unpack8(*(const u32x4*)(pf + 8), a + 8); unpack8(*(const u32x4*)pb, bq); unpack8(*(const u32x4*)(pb + 8), bq + 8);
        float ss = 0.f;
#pragma unroll
        for (int i = 0; i < 16; ++i) { a[i] += bq[i]; ss += a[i] * a[i]; }
        ss += __shfl_xor(ss, 1); ss += __shfl_xor(ss, 2); ss += __shfl_xor(ss, 4);
        const float r = rsqrtf(ss * (1.f / 128.f) + EPS);
#pragma unroll
        for (int i = 0; i < 16; ++i) a[i] *= r * w[i];
        *(u32x4*)pf = pack8(a); *(u32x4*)(pf + 8) = pack8(a + 8);
    }
}

DI void phase_conv(const Params& P, int l, int nrows) {
    const bf16_t* G = (const bf16_t*)(P.ws + WS_G); bf16_t* U = (bf16_t*)(P.ws + WS_U);
    const float* wdw = P.in[I_WDW] + (size_t)l * 3 * DFF; const float* bdw = P.in[I_BDW] + (size_t)l * DFF;
    const long total = (long)nrows * 352;
    for (long i = (long)blockIdx.x * NTHREADS + threadIdx.x; i < total; i += (long)gridDim.x * NTHREADS) {
        const int m = (int)(i / 352), c = (int)(i % 352) * 8;
        int b, pos, isctx; rowinfo(m, b, pos, isctx);
        const int last = isctx ? CTX - 1 : SEQ - 1;
        float g0[8], g1[8], g2[8], u[8];
        unpack8(*(const u32x4*)(G + (size_t)m * DFF + c), g1);
        if (pos > 0) unpack8(*(const u32x4*)(G + (size_t)(m - 1) * DFF + c), g0); else { for (int k = 0; k < 8; ++k) g0[k] = 0.f; }
        if (pos < last) unpack8(*(const u32x4*)(G + (size_t)(m + 1) * DFF + c), g2); else { for (int k = 0; k < 8; ++k) g2[k] = 0.f; }
        unpack8(*(const u32x4*)(U + (size_t)m * DFF + c), u);
        float o[8];
#pragma unroll
        for (int k = 0; k < 8; ++k) {
            const float x = wdw[c + k] * g0[k] + wdw[DFF + c + k] * g1[k] + wdw[2 * DFF + c + k] * g2[k] + bdw[c + k];
            const float t = tanhf(0.7978845608028654f * (x + 0.044715f * x * x * x));
            o[k] = 0.5f * x * (1.f + t) * u[k];
        }
        *(u32x4*)(U + (size_t)m * DFF + c) = pack8(o);
    }
}

namespace att {
constexpr int NW = 8, QBLK = 32, KVBLK = 64;
constexpr float SCALE = 0.10206207261596575f;
constexpr float THR = 8.f;
constexpr int SHM_V = 64 * 128 * 2, SHM_K = 64 * 256, SHM_ATTN = 2 * SHM_V + 2 * SHM_K + NW * 64 * 4;
#define KSWZ(row, colB) ((row) * 256 + ((colB) ^ (((row) & 7) << 4)))
#define SBAR() __builtin_amdgcn_sched_barrier(0)
DI int crow(int r, int hi) { return (r & 3) + 8 * (r >> 2) + 4 * hi; }
DI unsigned cvtpk(float lo, float hi) { unsigned r; asm volatile("v_cvt_pk_bf16_f32 %0, %1, %2" : "=v"(r) : "v"(lo), "v"(hi)); return r; }
DI bf16x8 ld8(const bf16_t* p) { return *reinterpret_cast<const bf16x8*>(p); }

DI void partialSM(f32x16& p0, f32x16& p1, float& m_reg, float& mn, float& alpha) {
  constexpr float C = SCALE * 1.4426950408889634f;
  float pmax = p0[0]; for (int r = 1; r < 16; ++r) pmax = fmaxf(pmax, p0[r]); for (int r = 0; r < 16; ++r) pmax = fmaxf(pmax, p1[r]);
  { auto rr = __builtin_amdgcn_permlane32_swap(__float_as_uint(pmax), __float_as_uint(pmax), false, false);
    pmax = fmaxf(__uint_as_float(rr[0]), __uint_as_float(rr[1])); }
  if (__builtin_expect(__all(pmax - m_reg <= THR / SCALE), 1)) { mn = m_reg; alpha = 1.f; }
  else { mn = fmaxf(m_reg, pmax); alpha = __builtin_amdgcn_exp2f((m_reg - mn) * C); m_reg = mn; }
  float mnC = -mn * C;
  for (int r = 0; r < 16; ++r) p0[r] = fmaf(p0[r], C, mnC); for (int r = 0; r < 16; ++r) p1[r] = fmaf(p1[r], C, mnC);
  for (int r = 0; r < 16; ++r) p0[r] = __builtin_amdgcn_exp2f(p0[r]);
}
DI void finishSM(f32x16& p0, f32x16& p1, float alpha, float& l_reg, bf16x8& pa0, bf16x8& pa1, bf16x8& pa2, bf16x8& pa3) {
  for (int r = 0; r < 16; ++r) p1[r] = __builtin_amdgcn_exp2f(p1[r]);
  float ps = 0; for (int r = 0; r < 16; ++r) ps += p0[r]; for (int r = 0; r < 16; ++r) ps += p1[r];
  { auto rr = __builtin_amdgcn_permlane32_swap(__float_as_uint(ps), __float_as_uint(ps), false, false);
    ps = __uint_as_float(rr[0]) + __uint_as_float(rr[1]); }
  l_reg = l_reg * alpha + ps;
#define PK4(P, BASE, OUT) do { unsigned a0 = cvtpk(P[BASE + 0], P[BASE + 1]), a1 = cvtpk(P[BASE + 2], P[BASE + 3]);   \
    unsigned b0 = cvtpk(P[BASE + 4], P[BASE + 5]), b1 = cvtpk(P[BASE + 6], P[BASE + 7]);                              \
    auto r0 = __builtin_amdgcn_permlane32_swap(a0, b0, false, false); auto r1 = __builtin_amdgcn_permlane32_swap(a1, b1, false, false); \
    u32x4 w = {r0[0], r1[0], r0[1], r1[1]}; OUT = *reinterpret_cast<bf16x8*>(&w); } while (0)
  PK4(p0, 0, pa0); PK4(p0, 8, pa1); PK4(p1, 0, pa2); PK4(p1, 8, pa3);
#undef PK4
}
DI void qkt(f32x16& p0, f32x16& p1, const char* Ks, const bf16x8* qr, int r32, int hi) {
  p0 = f32x16{}; p1 = f32x16{};
#pragma unroll
  for (int d0 = 0; d0 < 6; ++d0) { int cb = (d0 * 16 + hi * 8) * 2;
    bf16x8 b0 = *reinterpret_cast<const bf16x8*>(Ks + KSWZ(r32, cb));
    bf16x8 b1 = *reinterpret_cast<const bf16x8*>(Ks + KSWZ(32 + r32, cb));
    p0 = __builtin_amdgcn_mfma_f32_32x32x16_bf16(b0, qr[d0], p0, 0, 0, 0);
    p1 = __builtin_amdgcn_mfma_f32_32x32x16_bf16(b1, qr[d0], p1, 0, 0, 0); }
}
DI int v_st(int k, int c) { const int kk = (k & ~0xC) | ((k & 4) << 1) | ((k & 8) >> 1); return ((kk >> 3) * 4 + (c >> 5)) * 512 + ((kk & 7) * 32 + (c & 31)) * 2; }
DI int v_rd_base(int lane) { return ((lane & 3) << 3) | (((lane >> 2) & 3) << 6) | (((lane >> 4) & 1) << 5) | (((lane >> 5) & 1) << 8); }
constexpr int v_rd_off(int d0, int ks, int half) { return d0 * 512 + ks * 4096 + half * 2048; }
template <int OFF> DI s16x4 tr_read(int vb) {
  s16x4 r; asm volatile("ds_read_b64_tr_b16 %0, %1 offset:%2" : "=&v"(r) : "v"(vb), "i"(OFF) : "memory"); return r;
}
template <int D0> DI void pv_one(f32x16& od, int vb, bf16x8 pa0, bf16x8 pa1, bf16x8 pa2, bf16x8 pa3) {
  const s16x4 l0 = tr_read<v_rd_off(D0, 0, 0)>(vb), h0 = tr_read<v_rd_off(D0, 0, 1)>(vb), l1 = tr_read<v_rd_off(D0, 1, 0)>(vb), h1 = tr_read<v_rd_off(D0, 1, 1)>(vb);
  const s16x4 l2 = tr_read<v_rd_off(D0, 2, 0)>(vb), h2 = tr_read<v_rd_off(D0, 2, 1)>(vb), l3 = tr_read<v_rd_off(D0, 3, 0)>(vb), h3 = tr_read<v_rd_off(D0, 3, 1)>(vb);
  asm volatile("s_waitcnt lgkmcnt(0)" ::: "memory"); SBAR();
#define PK(L, H) (bf16x8){L[0], L[1], L[2], L[3], H[0], H[1], H[2], H[3]}
  od = __builtin_amdgcn_mfma_f32_32x32x16_bf16(pa0, PK(l0, h0), od, 0, 0, 0);
  od = __builtin_amdgcn_mfma_f32_32x32x16_bf16(pa1, PK(l1, h1), od, 0, 0, 0);
  od = __builtin_amdgcn_mfma_f32_32x32x16_bf16(pa2, PK(l2, h2), od, 0, 0, 0);
  od = __builtin_amdgcn_mfma_f32_32x32x16_bf16(pa3, PK(l3, h3), od, 0, 0, 0);
#undef PK
}
DI void pv_d0(f32x16* o, int vb, bf16x8 pa0, bf16x8 pa1, bf16x8 pa2, bf16x8 pa3) {
  pv_one<0>(o[0], vb, pa0, pa1, pa2, pa3); pv_one<1>(o[1], vb, pa0, pa1, pa2, pa3);
}

DI void attn_unit(const bf16_t* Qg, bf16_t* Og, int ldo, const bf16_t* Kg, const bf16_t* Vg, int qrow0, int h, int ctxrow0, int latrow0, int NT, char* lds) {
  const int tid = threadIdx.x, wid = tid >> 6, lane = tid & 63, r32 = lane & 31, hi = lane >> 5;
  char* V_lds = lds; char* K_lds = lds + 2 * SHM_V;
  float* ws = (float*)(lds + 2 * SHM_V + 2 * SHM_K) + wid * 64; float* li_l = ws; float* al_l = ws + 32;
  float m_reg = -1e30f, l_reg = 0; f32x16 o[2] = {}; bf16x8 qr[6];
  const bf16_t* Qw = Qg + (size_t)(qrow0 + wid * QBLK + r32) * 768;
#pragma unroll
  for (int d0 = 0; d0 < 6; ++d0) qr[d0] = ld8(Qw + (d0 < 4 ? 64 * h + 16 * d0 + 8 * hi : 512 + 32 * h + 16 * (d0 - 4) + 8 * hi));
  const int vr = tid >> 3, vc = tid & 7, vst = v_st(vr, 8 * vc), vcol = 64 * h + 8 * vc;
  const int c0 = tid, c1 = 512 + (tid & 255);
  const int kr0 = c0 / 12, kc0 = c0 % 12, kr1 = c1 / 12, kc1 = c1 % 12;
  const int kcol0 = kc0 < 8 ? 64 * h + 8 * kc0 : 512 + 32 * h + 8 * (kc0 - 8), kcol1 = kc1 < 8 ? 64 * h + 8 * kc1 : 512 + 32 * h + 8 * (kc1 - 8);
  const int kst0 = KSWZ(kr0, kc0 * 16), kst1 = KSWZ(kr1, kc1 * 16);
  const int vb0 = (int)(uintptr_t)V_lds + v_rd_base(lane);
  struct { bf16x8 vs0, ks0, ks1; } sr_[2];
#define TROW(j) ((j) < 4 ? ctxrow0 + 64 * (j) : latrow0 + 64 * ((j) - 4))
#define SLOAD(i, j) do { const int rb_ = TROW(j); sr_[i].vs0 = ld8(Vg + (size_t)(rb_ + vr) * 512 + vcol); \
    sr_[i].ks0 = ld8(Kg + (size_t)(rb_ + kr0) * 768 + kcol0); sr_[i].ks1 = ld8(Kg + (size_t)(rb_ + kr1) * 768 + kcol1); } while (0)
#define SWRITE(b, i) do { *(bf16x8*)(V_lds + (b) * SHM_V + vst) = sr_[i].vs0; \
    *(bf16x8*)(K_lds + (b) * SHM_K + kst0) = sr_[i].ks0; *(bf16x8*)(K_lds + (b) * SHM_K + kst1) = sr_[i].ks1; } while (0)
#define SWAIT() asm volatile("s_waitcnt vmcnt(3)" ::: "memory")
#define RESC(a) do { if (__any((a) < 1.f)) { if (hi == 0) al_l[r32] = (a); asm volatile("s_waitcnt lgkmcnt(0)" ::: "memory"); \
    for (int d = 0; d < 2; ++d) for (int r = 0; r < 16; ++r) o[d][r] *= al_l[crow(r, hi)]; } } while (0)
  f32x16 pA0, pA1, pB0, pB1; float mnA, mnB, alA, alB; bf16x8 pa0, pa1, pa2, pa3;
  constexpr int SE = 0, SO = 1;
  SLOAD(SE, 0); asm volatile("s_waitcnt vmcnt(0)" ::: "memory"); SWRITE(0, SE); __syncthreads();
  qkt(pA0, pA1, K_lds, qr, r32, hi); partialSM(pA0, pA1, m_reg, mnA, alA);
  SLOAD(SO, 1); if (2 < NT) SLOAD(SE, 2);
  SWAIT(); SWRITE(1, SO); __syncthreads();
  for (int j = 1; j + 1 < NT; j += 2) {
    SBAR(); qkt(pB0, pB1, K_lds + SHM_K, qr, r32, hi);
    finishSM(pA0, pA1, alA, l_reg, pa0, pa1, pa2, pa3); SBAR();
    SLOAD(SO, j + 2); SBAR();
    pv_d0(o, vb0, pa0, pa1, pa2, pa3); partialSM(pB0, pB1, m_reg, mnB, alB);
    __syncthreads(); SWAIT(); SWRITE(0, SE);
    RESC(alB); __syncthreads();
    SBAR(); qkt(pA0, pA1, K_lds, qr, r32, hi);
    finishSM(pB0, pB1, alB, l_reg, pa0, pa1, pa2, pa3); SBAR();
    if (j + 3 < NT) SLOAD(SE, j + 3); SBAR();
    pv_d0(o, vb0 + SHM_V, pa0, pa1, pa2, pa3); partialSM(pA0, pA1, m_reg, mnA, alA);
    __syncthreads(); SWAIT(); SWRITE(1, SO);
    RESC(alA); __syncthreads();
  }
  SBAR(); qkt(pB0, pB1, K_lds + SHM_K, qr, r32, hi);
  finishSM(pA0, pA1, alA, l_reg, pa0, pa1, pa2, pa3); SBAR();
  pv_d0(o, vb0, pa0, pa1, pa2, pa3); partialSM(pB0, pB1, m_reg, mnB, alB);
  __syncthreads(); RESC(alB);
  finishSM(pB0, pB1, alB, l_reg, pa0, pa1, pa2, pa3); SBAR();
  pv_d0(o, vb0 + SHM_V, pa0, pa1, pa2, pa3);
  if (hi == 0) li_l[r32] = l_reg; asm volatile("s_waitcnt lgkmcnt(0)" ::: "memory");
  float rli[16];
#pragma unroll
  for (int r = 0; r < 16; ++r) rli[r] = __builtin_amdgcn_rcpf(li_l[crow(r, hi)]);
  bf16_t* Ow = Og + (size_t)(qrow0 + wid * QBLK) * ldo + 64 * h;
#pragma unroll
  for (int r = 0; r < 16; ++r) { const int orow = crow(r, hi);
#pragma unroll
    for (int d0 = 0; d0 < 2; ++d0) Ow[(size_t)orow * ldo + d0 * 32 + r32] = f2bf(o[d0][r] * rli[r]); }
#undef TROW
#undef SLOAD
#undef SWRITE
#undef SWAIT
#undef RESC
}
}

DI void phase_attention(const Params& P, int l, char* lds, bf16_t* Og, int ldo) {
    bf16_t* Q = (bf16_t*)(P.ws + WS_Q); const bf16_t* K = (const bf16_t*)(P.ws + WS_K); const bf16_t* V = (const bf16_t*)(P.ws + WS_V);
    for (int u = blockIdx.x; u < 1024; u += gridDim.x) {
        const int bh = (u >> 8) * 8 + (u & 7), qb = (u >> 3) & 31, b = bh >> 3, h = bh & 7;
        __syncthreads();
        att::attn_unit(Q, Og, ldo, K, V, b * SEQ + 256 * qb, h, TL + b * CTX, b * SEQ, 132, lds);
    }
    if (l == 0) {
        for (int u = blockIdx.x; u < 32; u += gridDim.x) {
            const int b = u >> 3, h = u & 7;
            __syncthreads();
            att::attn_unit(Q, Og, ldo, K, V, TL + b * CTX, h, TL + b * CTX, 0, 4, lds);
        }
    }
    __syncthreads();
}

namespace scn {
constexpr int RQ = 0, RK = RQ + 16384, RV = RK + 16384, RR = RV + 4096;
constexpr int QD = RR + 2048;
constexpr int KN = QD + 64 * 272;
constexpr int KET = KN + 64 * 272;
constexpr int VT = KET + 128 * 144;
constexpr int ST = VT + 32 * 144;
constexpr int PM = ST + 32 * 272;
constexpr int DEC = PM + 64 * 144;
constexpr int END = DEC + 512;
static_assert(END <= LDS_BYTES, "scan LDS");
DI int crow(int r, int hi) { return (r & 3) + 8 * (r >> 2) + 4 * hi; }
#define SC_BAR() do { asm volatile("s_waitcnt lgkmcnt(0)" ::: "memory"); __builtin_amdgcn_s_barrier(); asm volatile("" ::: "memory"); } while (0)
#define SMFMA(a, b, c) __builtin_amdgcn_mfma_f32_32x32x16_bf16((a), (b), (c), 0, 0, 0)
}
DI void phase_scan(const Params& P, int l, char* lds) {
    using namespace scn;
    const int tid = threadIdx.x, wid = tid >> 6, lane = tid & 63, r32 = lane & 31, hi = lane >> 5;
    const bf16_t* R4 = (const bf16_t*)(P.ws + WS_R4); const bf16_t* SM = (const bf16_t*)(P.ws + WS_SM);
    for (int item = blockIdx.x; item < 256; item += gridDim.x) {
        const int slice = item & 3, dir = (item >> 2) & 1, hd = (item >> 3) & 7, b = item >> 6;
        const bool gla = hd < 4; const int hh = hd & 3;
        const int qcol = gla ? hh * 128 : 1536 + hh * 128, kcol = gla ? 512 + hh * 128 : 2048 + hh * 128, vcol = (gla ? 1024 : 2560) + hh * 128 + slice * 32;
        bf16_t* Od = (bf16_t*)(P.ws + (dir ? WS_OB : WS_OF)); const int ocol = hd * 128 + slice * 32;
        const int pti = wid >> 2, pdj = wid & 3, pd = 32 * pdj + r32;
        bf16x8 w2h = {0, 0, 0, 0, 0, 0, 0, 0}, w2l = {0, 0, 0, 0, 0, 0, 0, 0}; float bias = 0.f, lg = 0.f;
        if (gla) { const float* W2 = P.in[I_GK2] + (size_t)(l * 2 + dir) * 16 * 512 + hh * 128 + pd;
#pragma unroll
            for (int j = 0; j < 8; ++j) { const float w = W2[(8 * hi + j) * 512]; const unsigned u = __float_as_uint(w) & 0xffff0000u; const float res = w - __uint_as_float(u);
                w2h[j] = (short)(u >> 16); w2l[j] = (short)(__float_as_uint(res) >> 16); }
            bias = P.in[I_BGK][(l * 2 + dir) * 512 + hh * 128 + pd]; }
        else lg = -expf(P.in[I_RDEC][(l * 2 + dir) * 4 + hh]);
        f32x16 S0 = {}, S1 = {};
        __syncthreads();
        for (int i = tid; i < 32 * 272 / 4; i += NTHREADS) ((unsigned*)(lds + ST))[i] = 0u;
        u32x4 pq0, pq1, pk0, pk1, pvr = {0u, 0u, 0u, 0u};
#define ROWBASE(n) (dir == 0 ? ((n) < 4 ? TL + b * CTX + 64 * (n) : b * SEQ + 64 * ((n) - 4)) : ((n) < 4 ? TL + b * CTX + 64 * (3 - (n)) : b * SEQ + 64 * (127 - ((n) - 4))))
#define SC_LOAD(n) do { const int rb_ = ROWBASE(n); \
        pq0 = *(const u32x4*)(R4 + (size_t)(rb_ + (tid >> 4)) * 3072 + qcol + 8 * (tid & 15)); pq1 = *(const u32x4*)(R4 + (size_t)(rb_ + 32 + (tid >> 4)) * 3072 + qcol + 8 * (tid & 15)); \
        pk0 = *(const u32x4*)(R4 + (size_t)(rb_ + (tid >> 4)) * 3072 + kcol + 8 * (tid & 15)); pk1 = *(const u32x4*)(R4 + (size_t)(rb_ + 32 + (tid >> 4)) * 3072 + kcol + 8 * (tid & 15)); \
        if (tid < 256) pvr = *(const u32x4*)(R4 + (size_t)(rb_ + (tid >> 2)) * 3072 + vcol + 8 * (tid & 3)); \
        else if (tid < 384) pvr = *(const u32x4*)(SM + (size_t)(rb_ + ((tid - 256) >> 1)) * 512 + 416 + dir * 16 + 8 * (tid & 1)); } while (0)
#define SC_STORE() do { *(u32x4*)(lds + RQ + sr0 * 256 + (tid & 15) * 16) = pq0; *(u32x4*)(lds + RQ + sr1 * 256 + (tid & 15) * 16) = pq1; \
        *(u32x4*)(lds + RK + sr0 * 256 + (tid & 15) * 16) = pk0; *(u32x4*)(lds + RK + sr1 * 256 + (tid & 15) * 16) = pk1; \
        if (tid < 256) *(u32x4*)(lds + RV + srv * 64 + (tid & 3) * 16) = pvr; \
        else if (tid < 384) *(u32x4*)(lds + RR + srr * 32 + (tid & 1) * 16) = pvr; } while (0)
        const int sr0 = dir ? 63 - (tid >> 4) : (tid >> 4), sr1 = dir ? 31 - (tid >> 4) : 32 + (tid >> 4);
        const int srv = dir ? 63 - (tid >> 2) : (tid >> 2), srr = dir ? 63 - ((tid - 256) >> 1) : ((tid - 256) >> 1);
        SC_LOAD(0); SC_STORE(); SC_LOAD(1);
        for (int n = 0; n < 132; ++n) {
            int r32v = r32, hiv = hi; asm volatile("" : "+v"(r32v), "+v"(hiv));
            SC_BAR();
            {
                f32x16 cum; float cl;
                if (gla) {
                    f32x16 la0, la1;
                    { const bf16x8 a0 = *(const bf16x8*)(lds + RR + r32v * 32 + hiv * 16), a1 = *(const bf16x8*)(lds + RR + (32 + r32v) * 32 + hiv * 16);
                      la0 = SMFMA(a0, w2h, (f32x16{})); la0 = SMFMA(a0, w2l, la0); la1 = SMFMA(a1, w2h, (f32x16{})); la1 = SMFMA(a1, w2l, la1); }
                    float ssum = 0.f;
#pragma unroll
                    for (int r = 0; r < 16; ++r) { const float x0 = la0[r] + bias, x1 = la1[r] + bias;
                        la0[r] = (fminf(x0, 0.f) - __logf(1.f + __expf(-fabsf(x0)))) * (1.f / 16.f);
                        la1[r] = (fminf(x1, 0.f) - __logf(1.f + __expf(-fabsf(x1)))) * (1.f / 16.f);
                        ssum += la0[r] + la1[r]; }
                    cl = ssum + __shfl_xor(ssum, 32);
                    __builtin_amdgcn_sched_barrier(0);
                    cum = f32x16{};
                    bf16x8 tri0, tri1;
                    {
#pragma unroll
                      for (int j = 0; j < 8; ++j) { const int k0 = 8 * (j >> 2) + 4 * hiv + (j & 3);
                          tri0[j] = (short)(r32v >= k0 ? 0x3F80 : 0); tri1[j] = (short)(r32v >= k0 + 16 ? 0x3F80 : 0); } }
                    const bf16x8 ones = {0x3F80, 0x3F80, 0x3F80, 0x3F80, 0x3F80, 0x3F80, 0x3F80, 0x3F80};
                    const bf16x8 atk0_0 = pti ? ones : tri0, atk0_1 = pti ? ones : tri1;
#pragma unroll
                    for (int st = 0; st < 2; ++st) { bf16x8 h8, l8;
#pragma unroll
                        for (int j = 0; j < 8; ++j) { const float v = la0[8 * st + j]; const unsigned u = __float_as_uint(v) & 0xffff0000u; const float res = v - __uint_as_float(u);
                            h8[j] = (short)(u >> 16); l8[j] = (short)(__float_as_uint(res) >> 16); }
                        const bf16x8 am = st ? atk0_1 : atk0_0; cum = SMFMA(am, h8, cum); cum = SMFMA(am, l8, cum); }
                    if (pti) {
#pragma unroll
                        for (int st = 0; st < 2; ++st) { bf16x8 h8, l8;
#pragma unroll
                            for (int j = 0; j < 8; ++j) { const float v = la1[8 * st + j]; const unsigned u = __float_as_uint(v) & 0xffff0000u; const float res = v - __uint_as_float(u);
                                h8[j] = (short)(u >> 16); l8[j] = (short)(__float_as_uint(res) >> 16); }
                            const bf16x8 am = st ? tri1 : tri0; cum = SMFMA(am, h8, cum); cum = SMFMA(am, l8, cum); } }
                    __builtin_amdgcn_sched_barrier(0);
                } else {
#pragma unroll
                    for (int r = 0; r < 16; ++r) cum[r] = (float)(32 * pti + crow(r, hiv) + 1) * lg;
                    cl = 64.f * lg;
                }
                {
                    const int ibase = 32 * pti + 4 * hiv;
                    const char* rqb = lds + RQ + ibase * 256 + pd * 2; const char* rkb = lds + RK + ibase * 256 + pd * 2;
                    char* qdb = lds + QD + ibase * 272 + pd * 2; char* knb = lds + KN + ibase * 272 + pd * 2; char* keb = lds + KET + pd * 144 + ibase * 2;
#pragma unroll
                    for (int r = 0; r < 16; ++r) { constexpr int dummy = 0; const int cr = (r & 3) + 8 * (r >> 2);
                        const float c = cum[r]; const float e1 = __expf(c), e2 = __expf(-c), e3 = __expf(cl - c);
                        const float q = bf2f(*(const bf16_t*)(rqb + cr * 256)), k = bf2f(*(const bf16_t*)(rkb + cr * 256));
                        *(bf16_t*)(qdb + cr * 272) = f2bf(q * e1);
                        *(bf16_t*)(knb + cr * 272) = f2bf(k * e2);
                        *(bf16_t*)(keb + cr * 2) = f2bf(k * e3);
                        if ((r & 3) == 3) { asm volatile("" ::: "memory"); } }
                }
                if (pti == 0 && hiv == 0) *(float*)(lds + DEC + pd * 4) = __expf(cl);
                { const int v = tid & 31, ig = tid >> 5; float vv[4];
#pragma unroll
                  for (int e = 0; e < 4; ++e) { const int i = 4 * ig + e, r = i; vv[e] = bf2f(*(const bf16_t*)(lds + RV + r * 64 + v * 2)); }
                  u32x2 o; o.x = pk2(vv[0], vv[1]); o.y = pk2(vv[2], vv[3]); *(u32x2*)(lds + VT + v * 144 + ig * 8) = o; }
            }
            SC_BAR();
            if (n + 1 < 132) { SC_STORE(); if (n + 2 < 132) SC_LOAD(n + 2); }
            if (wid < 4) {
                const int ti = wid >> 1, tj = wid & 1; S0 = f32x16{};
                if (!(ti == 0 && tj == 1)) {
#pragma unroll
                    for (int kk = 0; kk < 8; ++kk) { const bf16x8 a = *(const bf16x8*)(lds + QD + (32 * ti + r32v) * 272 + (16 * kk + 8 * hiv) * 2), bb = *(const bf16x8*)(lds + KN + (32 * tj + r32v) * 272 + (16 * kk + 8 * hiv) * 2);
                        S0 = SMFMA(a, bb, S0); }
                }
#pragma unroll
                for (int r = 0; r < 16; ++r) { const int cr = (r & 3) + 8 * (r >> 2); const int ib = 32 * ti + 4 * hiv, j = 32 * tj + r32v; int jm = j - (dir ? 0 : 1) - ib; asm volatile("" : "+v"(jm));
                    *(bf16_t*)(lds + PM + ib * 144 + j * 2 + cr * 144) = f2bf(cr > jm ? S0[r] : 0.f); }
            } else if (wid < 6) {
                const int ti = wid - 4; S0 = f32x16{};
#pragma unroll
                for (int kk = 0; kk < 8; ++kk) { const bf16x8 a = *(const bf16x8*)(lds + QD + (32 * ti + r32v) * 272 + (16 * kk + 8 * hiv) * 2), bb = *(const bf16x8*)(lds + ST + r32v * 272 + (16 * kk + 8 * hiv) * 2);
                    S0 = SMFMA(a, bb, S0); }
            } else {
                const int dt0 = 2 * (wid - 6);
                const float dc0 = *(const float*)(lds + DEC + (32 * dt0 + r32v) * 4), dc1 = *(const float*)(lds + DEC + (32 * (dt0 + 1) + r32v) * 4);
#pragma unroll
                for (int r = 0; r < 16; ++r) { S0[r] *= dc0; S1[r] *= dc1; }
#pragma unroll
                for (int kk = 0; kk < 4; ++kk) { const bf16x8 a = *(const bf16x8*)(lds + VT + r32v * 144 + (16 * kk + 8 * hiv) * 2);
                    const bf16x8 b0 = *(const bf16x8*)(lds + KET + (32 * dt0 + r32v) * 144 + (16 * kk + 8 * hiv) * 2), b1 = *(const bf16x8*)(lds + KET + (32 * (dt0 + 1) + r32v) * 144 + (16 * kk + 8 * hiv) * 2);
                    S0 = SMFMA(a, b0, S0); S1 = SMFMA(a, b1, S1); }
            }
            SC_BAR();
            if (wid >= 4 && wid < 6) {
                const int ti = wid - 4;
#pragma unroll
                for (int kk = 0; kk < 4; ++kk) { const bf16x8 a = *(const bf16x8*)(lds + PM + (32 * ti + r32v) * 144 + (16 * kk + 8 * hiv) * 2), bb = *(const bf16x8*)(lds + VT + r32v * 144 + (16 * kk + 8 * hiv) * 2);
                    S0 = SMFMA(a, bb, S0); }
                const int rb = ROWBASE(n);
#pragma unroll
                for (int r = 0; r < 16; ++r) { const int i = 32 * ti + crow(r, hiv), row = rb + (dir ? 63 - i : i);
                    Od[(size_t)row * 1024 + ocol + r32v] = f2bf(S0[r]); }
            } else if (wid >= 6) {
                const int dt0 = 2 * (wid - 6);
#pragma unroll
                for (int r = 0; r < 16; ++r) { const int cr = (r & 3) + 8 * (r >> 2); char* stb = lds + ST + (4 * hiv) * 272 + (32 * dt0 + r32v) * 2;
                    *(bf16_t*)(stb + cr * 272) = f2bf(S0[r]); *(bf16_t*)(stb + cr * 272 + 64) = f2bf(S1[r]); }
            }
        }
#undef ROWBASE
#undef SC_LOAD
#undef SC_STORE
    }
    __syncthreads();
}

constexpr int PH_PER_LAYER = 15, N_PHASES = 1 + 2 * PH_PER_LAYER;
#ifndef PHEN
#define PHEN(q) 1
#endif
#ifdef PROBE_GEMM
#define REPG for (int rep_ = 0; rep_ < 2; ++rep_)
#else
#define REPG
#endif
#define PH(k) if (lo <= (k) && (k) < hi && ((k) == lo || (xcd_barrier(xbar), true)))
template <int l>
DI void layer_program(const Params& P, int lo, int hi, LAS unsigned char* lds, unsigned char* lds_raw, const XcdBarrier& xbar) {
    constexpr int base = 1 + PH_PER_LAYER * l;
    constexpr int Mlat = (l == 0) ? TA : TL;
#define WSP(T, off) ((T*)(P.ws + (off)))
#define MODL (WSP(const float, WS_MOD) + (size_t)l * 5 * 6144)
#define HIN_L ((l == 0) ? P.in[I_X] : (const float*)P.out)
#define HIN_C ((l == 0) ? P.in[I_CTX] : WSP(const float, WS_HC))
    PH(base + 0) if (PHEN(0)) { phase_norm(HIN_L, HIN_C, P.in[I_N1W] + l * DM, MODL, 0, 1, WSP(bf16_t, WS_A), TA); phase_wconv_mixer(P, l, lds); }
    PH(base + 1) if (PHEN(1)) REPG { Epi<EM_PLAIN> E{}; E.O0 = WSP(bf16_t, WS_SM); E.ld0 = 512; run_gemm<EM_PLAIN>(lds, WSP(bf16_t, WS_A), 1024, WSP(bf16_t, WS_WT) + WT_IN, TA, 512, 1024, E); }
    PH(base + 2) if (PHEN(2)) REPG { { Epi<EM_PLAIN> E{}; E.O0 = WSP(bf16_t, WS_Q); E.ld0 = 768; run_gemm<EM_PLAIN>(lds, WSP(bf16_t, WS_SM), 512, WSP(bf16_t, WS_WT) + WT_QB, TA, 768, 256, E); }
                  { Epi<EM_KV> E2{}; E2.O0 = WSP(bf16_t, WS_K); E2.O1 = WSP(bf16_t, WS_V); run_gemm<EM_KV>(lds, WSP(bf16_t, WS_SM) + 256, 512, WSP(bf16_t, WS_WT) + WT_KVB, TA, 1024, 128, E2); } }
    PH(base + 3) if (PHEN(3)) phase_qkpost(P, l);
    PH(base + 4) if (PHEN(4)) {
#ifdef PROBE_ATTN
        phase_attention(P, l, (char*)lds_raw, WSP(bf16_t, WS_OF), 1024);
#endif
        phase_attention(P, l, (char*)lds_raw, WSP(bf16_t, WS_Q), 768); }
    PH(base + 5) if (PHEN(5)) REPG { Epi<EM_BIG> E{}; E.O0 = WSP(bf16_t, WS_R4); E.fa = WSP(const float, WS_ROT); run_gemm<EM_BIG>(lds, WSP(bf16_t, WS_A), 1024, WSP(bf16_t, WS_WT) + WT_IN + (size_t)512 * 1024, TA, 3072, 1024, E); }
    PH(base + 6) if (PHEN(6)) { phase_scan(P, l, (char*)lds_raw);
#ifdef PROBE_SCAN
        phase_scan(P, l, (char*)lds_raw);
#endif
    }
    PH(base + 7) if (PHEN(7)) phase_scanpost(P, l, Mlat);
    PH(base + 8) if (PHEN(8)) { Epi<EM_GATES> E{}; E.O0 = WSP(bf16_t, WS_R4); E.O1 = WSP(bf16_t, WS_OF); E.fa = P.in[I_BGATE] + (size_t)l * 3072; run_gemm<EM_GATES>(lds, WSP(bf16_t, WS_A), 1024, WSP(bf16_t, WS_WT) + WT_IN + (size_t)3584 * 1024, Mlat, 4096, 1024, E); }
    PH(base + 9) if (PHEN(9)) REPG {
        { Epi<EM_BRANCH> E{}; E.O0 = WSP(bf16_t, WS_OB); E.Gsrc = WSP(bf16_t, WS_R4); E.ipar = 0; run_gemm<EM_BRANCH>(lds, WSP(bf16_t, WS_Q), 768, WSP(bf16_t, WS_WT) + WT_BR, Mlat, 1024, 512, E); }
        { Epi<EM_BRANCH> E{}; E.O0 = WSP(bf16_t, WS_OB); E.Gsrc = WSP(bf16_t, WS_R4) + 1024; E.ipar = 1; run_gemm<EM_BRANCH>(lds, WSP(bf16_t, WS_OF), 1024, WSP(bf16_t, WS_WT) + WT_BR + (size_t)1024 * 512, Mlat, 1024, 512, E); }
        { Epi<EM_BRANCH> E{}; E.O0 = WSP(bf16_t, WS_OB); E.Gsrc = WSP(bf16_t, WS_R4) + 2048; E.ipar = 2; run_gemm<EM_BRANCH>(lds, WSP(bf16_t, WS_OF) + 512, 1024, WSP(bf16_t, WS_WT) + WT_BR + (size_t)2048 * 512, Mlat, 1024, 512, E); } }
    PH(base + 10) if (PHEN(10)) { Epi<EM_RES> E{}; E.fa = MODL; E.ipar = 2; E.hin_l = HIN_L; E.hin_c = HIN_C; E.hout_l = P.out; E.hout_c = WSP(float, WS_HC);
                   run_gemm<EM_RES>(lds, WSP(bf16_t, WS_OB), 1024, WSP(bf16_t, WS_WT) + WT_OUT, Mlat, 1024, 1024, E); }
    PH(base + 11) if (PHEN(11)) { phase_norm(P.out, WSP(const float, WS_HC), P.in[I_N2W] + l * DM, MODL, 3, 4, WSP(bf16_t, WS_A), Mlat); phase_wconv_ffn(P, l, lds); }
    PH(base + 12) if (PHEN(12)) REPG { Epi<EM_FFNIN> E{}; E.O0 = WSP(bf16_t, WS_G); E.O1 = WSP(bf16_t, WS_U); run_gemm<EM_FFNIN>(lds, WSP(bf16_t, WS_A), 1024, WSP(bf16_t, WS_WT) + WT_F1, Mlat, 5632, 1024, E); }
    PH(base + 13) if (PHEN(13)) phase_conv(P, l, Mlat);
    PH(base + 14) if (PHEN(14)) { Epi<EM_RES> E{}; E.fa = MODL; E.ipar = 5; E.hin_l = P.out; E.hin_c = WSP(const float, WS_HC); E.hout_l = P.out; E.hout_c = WSP(float, WS_HC);
                   run_gemm<EM_RES>(lds, WSP(bf16_t, WS_U), DFF, WSP(bf16_t, WS_WT) + WT_F2, Mlat, 1024, DFF, E); }
}
__global__ void __launch_bounds__(NTHREADS, 2) fwd_kernel(Params P) {
    extern __shared__ __attribute__((aligned(16))) unsigned char lds_raw[];
    LAS unsigned char* lds = (LAS unsigned char*)lds_raw;
    cg::grid_group grid = cg::this_grid();
    const int lo = P.ph_lo, hi = P.ph_hi;
    Params* G = (Params*)(P.ws + WS_PAR + (size_t)blockIdx.x * 256);
    if (threadIdx.x == 0) {
#pragma unroll
        for (int i = 0; i < 26; ++i) G->in[i] = P.in[i];
        G->out = P.out; G->ws = P.ws; G->ph_lo = lo; G->ph_hi = hi;
    }
    __syncthreads();
    asm volatile("" ::: "memory");
    const Params& Q = *G;
    if (threadIdx.x < 4) ((LAS unsigned*)(lds + 131072))[threadIdx.x] = 0u;
    __syncthreads();
    const XcdBarrier xbar = xcd_barrier_post((unsigned*)(P.ws + WS_BAR), (volatile LAS unsigned*)(lds + 131072));
    if (lo < 0) grid.sync();
    PH(0) phase_prologue(Q, lds);
    layer_program<0>(Q, lo, hi, lds, lds_raw, xbar);
    layer_program<1>(Q, lo, hi, lds, lds_raw, xbar);
#ifdef PROBE_SYNC
    for (int i = 0; i < 20; ++i) xcd_barrier(xbar);
#endif
}

#ifndef N_LAUNCH_MODE
#define N_LAUNCH_MODE 1
#endif
extern "C" void kernel_launch(void* const* d_in, const int* in_sizes, int n_in, void* d_out, int out_size, void* d_ws, size_t ws_size, hipStream_t stream) {
    static int grid_blocks = 0;
    if (!grid_blocks) {
        if (n_in != 26 || ws_size < WS_NEED) { fprintf(stderr, "kernel_launch: bad inputs (n_in %d, ws %zu < %zu)\n", n_in, ws_size, (size_t)WS_NEED); return; }
        if (hipFuncSetAttribute((const void*)fwd_kernel, hipFuncAttributeMaxDynamicSharedMemorySize, LDS_BYTES) != hipSuccess) { fprintf(stderr, "kernel_launch: hipFuncSetAttribute failed\n"); return; }
        int dev = 0, cus = 0, per_cu = 0;
        hipGetDevice(&dev);
        hipDeviceGetAttribute(&cus, hipDeviceAttributeMultiprocessorCount, dev);
        hipOccupancyMaxActiveBlocksPerMultiprocessor(&per_cu, fwd_kernel, NTHREADS, LDS_BYTES);
        if (per_cu < 1) { fprintf(stderr, "kernel_launch: occupancy query returned %d\n", per_cu); return; }
        grid_blocks = cus * 1;
    }
    Params p{};
    for (int i = 0; i < 26; ++i) p.in[i] = (const float*)d_in[i];
    p.out = (float*)d_out; p.ws = (unsigned char*)d_ws;
#if N_LAUNCH_MODE == 1
    p.ph_lo = 0; p.ph_hi = N_PHASES;
    if (hipMemsetAsync((unsigned char*)d_ws + WS_BAR, 0, XCD_BAR_WORDS * 4, stream) != hipSuccess) { fprintf(stderr, "kernel_launch: memset of the barrier words failed\n"); return; }
    void* args[] = {&p};
    hipError_t e = hipLaunchCooperativeKernel((const void*)fwd_kernel, dim3(grid_blocks), dim3(NTHREADS), args, LDS_BYTES, stream);
    if (e != hipSuccess) fprintf(stderr, "cooperative launch failed: %s (grid %d)\n", hipGetErrorString(e), grid_blocks);
#else
    for (int ph = 0; ph < N_PHASES; ++ph) {
        p.ph_lo = ph; p.ph_hi = ph + 1;
        hipLaunchKernelGGL(fwd_kernel, dim3(grid_blocks), dim3(NTHREADS), LDS_BYTES, stream, p);
    }
#endif
}
```

```cpp
#include <hip/hip_runtime.h>
#include <hip/hip_bf16.h>
#include <hip/hip_cooperative_groups.h>
#include <cstdio>
#include <cstdint>
namespace cg = cooperative_groups;
#define DI __device__ __forceinline__
#define LAS __attribute__((address_space(3)))
namespace pg8 {
#define PG8_LAS __attribute__((address_space(3)))
typedef unsigned short bf16_t;
typedef short bf16x8 __attribute__((ext_vector_type(8)));
typedef float f32x4 __attribute__((ext_vector_type(4)));
typedef unsigned u32x4 __attribute__((ext_vector_type(4)));
constexpr int BM = 256, BK = 64, HALF = 128, HTB = HALF * BK * 2  , STAGE_BYTES = 8 * HTB, NXCD = 8, WGM = 8;

__host__ __device__ __forceinline__ int lds_byte(int r, int c) { const int st = (r >> 4) * 2 + (c >> 5), rr = r & 15, cc = c & 31, ob = rr * 64 + cc * 2; return st * 1024 + (ob ^ (((ob >> 9) & 1) << 5)); }
__host__ __device__ __forceinline__ void stage_rc(int b, int& R, int& C) { const int st = b / 1024, sb = b % 1024, swz = sb ^ (((sb >> 9) & 1) << 5); R = (st >> 1) * 16 + swz / 64; C = (st & 1) * 32 + (swz % 64) / 2; }
__host__ __device__ __forceinline__ int perm32(int rho) { const int n = rho >> 4, i = rho & 15; return 8 * (i >> 2) + 4 * n + (i & 3); }

struct Unit { int pm, pn; };
struct Gemm { const bf16_t* A; const bf16_t* Bt; int M, N, K, lda; };

struct StaticOrder {
    int nM, nN, nwg, G, c;
    __host__ __device__ void init(int M, int N, int G_, int c_) { nM = M / BM; nN = N / BM; nwg = nM * nN; G = G_; c = c_; }
    __host__ __device__ bool next(int i, Unit& u) const {
        const long L = (long)i * G + c; if (L >= nwg) return false;
        int wgid = (int)L; { const int q = nwg / NXCD, r = nwg % NXCD, xcd = wgid % NXCD, off = wgid / NXCD; wgid = (xcd < r ? xcd * (q + 1) : r * (q + 1) + (xcd - r) * q) + off; }
        const int nig = WGM * nN, gid = wgid / nig, fm = gid * WGM, gsz = (nM - fm) < WGM ? (nM - fm) : WGM;
        u.pm = fm + ((wgid % nig) % gsz); u.pn = (wgid % nig) / gsz; return true;
    }
    __device__ __forceinline__ void a_ready(const Unit&) const {}
    __device__ __forceinline__ void done(const Unit&) const {}
};

__device__ __forceinline__ unsigned cvt_pk_bf16(float lo, float hi) { unsigned r; asm volatile("v_cvt_pk_bf16_f32 %0, %1, %2" : "=v"(r) : "v"(lo), "v"(hi)); return r; }
template <class Epi, class Sched, bool ALIGN_EPI = false, bool SP2 = false>
__device__ __forceinline__ void gemm_phase(PG8_LAS unsigned char* lds, const Gemm g, const Sched& S, const Epi& E) {
    const int tid = threadIdx.x, wid = __builtin_amdgcn_readfirstlane(tid >> 6), lane = tid & 63, wr = wid >> 2, wc = wid & 3, fr = lane & 15, fq = lane >> 4;
    const int K = g.K, nt = K / BK;
    unsigned voffA[2], voffB[2];
#pragma unroll
    for (int i = 0; i < 2; ++i) { int R, C; stage_rc(tid * 16 + i * 8192, R, C); const int Rb = Epi::PERM ? ((R & ~31) + perm32(R & 31)) : R;
        voffA[i] = (unsigned)(R * g.lda + C) * 2u; voffB[i] = (unsigned)(Rb * K + C) * 2u; }
    const size_t kstep = (size_t)(BK * 2);
    const size_t hstep = (size_t)HALF * K * 2;
    const size_t tstep = 2 * hstep; const size_t hstepA = (size_t)HALF * g.lda * 2; const size_t tstepA = 2 * hstepA;
    const unsigned ldsw = (unsigned)wid * 1024u;
    const int aoff = lds_byte(wr * 64 + fr, fq * 8), boff = lds_byte(wc * 32 + fr, fq * 8);
#define PG8_SA(b, h) (((b) * 2 + (h)) * HTB)
#define PG8_SB(b, h) ((4 + (b) * 2 + (h)) * HTB)
#define PG8_STAGE(bufoff, gbase, voff) do { _Pragma("unroll") for (int _i = 0; _i < 2; ++_i) \
        __builtin_amdgcn_global_load_lds((const unsigned*)((const char*)(gbase) + (voff)[_i]), (PG8_LAS unsigned*)(lds + (bufoff) + ldsw + _i * 8192), 16, 0, 0); } while (0)
#define PG8_LDA(dst, b, h) do { _Pragma("unroll") for (int m = 0; m < 4; ++m) _Pragma("unroll") for (int k = 0; k < 2; ++k) dst[m][k] = *(const PG8_LAS bf16x8*)(lds + PG8_SA(b, h) + aoff + m * 2048 + k * 1024); } while (0)
#define PG8_LDB(dst, b, h) do { _Pragma("unroll") for (int n = 0; n < 2; ++n) _Pragma("unroll") for (int k = 0; k < 2; ++k) dst[n][k] = *(const PG8_LAS bf16x8*)(lds + PG8_SB(b, h) + boff + n * 2048 + k * 1024); } while (0)
#define PG8_MMA(ai, bj, At, Bt) do { __builtin_amdgcn_s_setprio(1); _Pragma("unroll") for (int m = 0; m < 4; ++m) _Pragma("unroll") for (int n = 0; n < 2; ++n) _Pragma("unroll") for (int k = 0; k < 2; ++k) \
        acc[ai][bj][m][n] = __builtin_amdgcn_mfma_f32_16x16x32_bf16(Bt[n][k], At[m][k], acc[ai][bj][m][n], 0, 0, 0); __builtin_amdgcn_s_setprio(0); } while (0)
#define PG8_WAIT_V(n) asm volatile("s_waitcnt vmcnt(" #n ")" ::: "memory")
#define PG8_WAIT_L(n) asm volatile("s_waitcnt lgkmcnt(" #n ")" ::: "memory")
#define PG8_BAR __builtin_amdgcn_s_barrier()
#define PG8_SCHED __builtin_amdgcn_sched_barrier(0)
    Unit cur, nxt; int ui = 0;
    if (!S.next(0, cur)) return;
    f32x4 acc[2][2][4][2];
#pragma unroll
    for (int a = 0; a < 2; ++a)
#pragma unroll
        for (int b = 0; b < 2; ++b)
#pragma unroll
            for (int m = 0; m < 4; ++m)
#pragma unroll
                for (int n = 0; n < 2; ++n) acc[a][b][m][n] = (f32x4){0.f, 0.f, 0.f, 0.f};
    bf16x8 At[4][2], B0[2][2], B1[2][2];
    const char* cA = (const char*)g.A + (size_t)cur.pm * tstepA; const char* cB = (const char*)g.Bt + (size_t)cur.pn * tstep;
    S.a_ready(cur);
    if constexpr (SP2) {
        PG8_STAGE(PG8_SB(0, 0), cB, voffB); PG8_STAGE(PG8_SB(0, 1), cB + hstep, voffB); PG8_STAGE(PG8_SA(0, 0), cA, voffA); PG8_STAGE(PG8_SA(0, 1), cA + hstepA, voffA);
        if (wr == 1) PG8_BAR;
        PG8_WAIT_V(2); PG8_BAR;
        PG8_STAGE(PG8_SB(1, 0), cB + kstep, voffB); PG8_STAGE(PG8_SA(1, 0), cA + kstep, voffA); PG8_STAGE(PG8_SB(1, 1), cB + hstep + kstep, voffB);
        PG8_WAIT_V(6); PG8_BAR;
    } else {
        PG8_STAGE(PG8_SB(0, 0), cB, voffB); PG8_STAGE(PG8_SA(0, 0), cA, voffA); PG8_STAGE(PG8_SB(0, 1), cB + hstep, voffB); PG8_STAGE(PG8_SA(0, 1), cA + hstepA, voffA);
        if (wr == 1) PG8_BAR;
        PG8_WAIT_V(4); PG8_BAR;
        PG8_STAGE(PG8_SB(1, 0), cB + kstep, voffB); PG8_STAGE(PG8_SA(1, 0), cA + kstep, voffA); PG8_STAGE(PG8_SB(1, 1), cB + hstep + kstep, voffB);
        PG8_WAIT_V(6); PG8_BAR;
    }
    for (;;) {
        const bool has_next = S.next(ui + 1, nxt);
        const char* nA = has_next ? (const char*)g.A + (size_t)nxt.pm * tstepA : cA; const char* nB = has_next ? (const char*)g.Bt + (size_t)nxt.pn * tstep : cB;
        for (int t = 0; t < nt; t += 2) {
            const bool last = (t == nt - 2);
            const char* a1 = cA + (size_t)(t + 1) * kstep;
            const char* a2 = last ? nA : cA + (size_t)(t + 2) * kstep; const char* b2 = last ? nB : cB + (size_t)(t + 2) * kstep;
            const char* a3 = a2 + kstep; const char* b3 = b2 + kstep;
            if (last && has_next) S.a_ready(nxt);
            if constexpr (SP2) {
            PG8_LDB(B0, 0, 0); PG8_LDB(B1, 0, 1); PG8_SCHED; PG8_LDA(At, 0, 0); PG8_STAGE(PG8_SA(1, 1), a1 + hstepA, voffA);
            PG8_WAIT_V(8); PG8_WAIT_L(0); PG8_BAR; PG8_MMA(0, 0, At, B0); PG8_MMA(0, 1, At, B1); PG8_BAR; PG8_SCHED;
            PG8_LDA(At, 0, 1); PG8_STAGE(PG8_SB(0, 0), b2, voffB); PG8_STAGE(PG8_SB(0, 1), b2 + hstep, voffB); PG8_STAGE(PG8_SA(0, 0), a2, voffA);
            PG8_WAIT_V(8); PG8_WAIT_L(0); PG8_BAR; PG8_MMA(1, 0, At, B0); PG8_MMA(1, 1, At, B1); PG8_BAR; PG8_SCHED;
            PG8_LDB(B0, 1, 0); PG8_LDB(B1, 1, 1); PG8_SCHED; PG8_LDA(At, 1, 0); PG8_STAGE(PG8_SA(0, 1), a2 + hstepA, voffA);
            PG8_WAIT_V(8); PG8_WAIT_L(0); PG8_BAR; PG8_MMA(0, 0, At, B0); PG8_MMA(0, 1, At, B1); PG8_BAR; PG8_SCHED;
            PG8_LDA(At, 1, 1); PG8_STAGE(PG8_SB(1, 0), b3, voffB); PG8_STAGE(PG8_SB(1, 1), b3 + hstep, voffB); PG8_STAGE(PG8_SA(1, 0), a3, voffA);
            PG8_WAIT_V(8); PG8_WAIT_L(0); PG8_BAR; PG8_MMA(1, 0, At, B0); PG8_MMA(1, 1, At, B1); PG8_BAR; PG8_SCHED;
            } else {
            PG8_LDB(B0, 0, 0); PG8_SCHED; PG8_LDA(At, 0, 0); PG8_STAGE(PG8_SA(1, 1), a1 + hstepA, voffA);
            PG8_WAIT_L(8); PG8_BAR; PG8_WAIT_L(0); PG8_MMA(0, 0, At, B0); PG8_BAR; PG8_SCHED;
            PG8_LDB(B1, 0, 1); PG8_STAGE(PG8_SB(0, 0), b2, voffB);
            PG8_BAR; PG8_WAIT_L(0); PG8_MMA(0, 1, At, B1); PG8_BAR;
            PG8_LDA(At, 0, 1); PG8_STAGE(PG8_SA(0, 0), a2, voffA);
            PG8_BAR; PG8_WAIT_L(0); PG8_MMA(1, 0, At, B0); PG8_BAR; PG8_SCHED;
            PG8_STAGE(PG8_SB(0, 1), b2 + hstep, voffB);
            PG8_WAIT_V(6); PG8_BAR; PG8_MMA(1, 1, At, B1); PG8_BAR;
            PG8_LDB(B0, 1, 0); PG8_SCHED; PG8_LDA(At, 1, 0); PG8_STAGE(PG8_SA(0, 1), a2 + hstepA, voffA);
            PG8_WAIT_L(8); PG8_BAR; PG8_WAIT_L(0); PG8_MMA(0, 0, At, B0); PG8_BAR; PG8_SCHED;
            PG8_LDB(B1, 1, 1); PG8_STAGE(PG8_SB(1, 0), b3, voffB);
            PG8_BAR; PG8_WAIT_L(0); PG8_MMA(0, 1, At, B1); PG8_BAR;
            PG8_LDA(At, 1, 1); PG8_STAGE(PG8_SA(1, 0), a3, voffA);
            PG8_BAR; PG8_WAIT_L(0); PG8_MMA(1, 0, At, B0); PG8_BAR; PG8_SCHED;
            PG8_STAGE(PG8_SB(1, 1), b3 + hstep, voffB);
            PG8_WAIT_V(6); PG8_BAR; PG8_MMA(1, 1, At, B1); PG8_BAR;
            }
        }
        if constexpr (ALIGN_EPI) { if (wr == 0) PG8_BAR; }
        if constexpr (!Epi::AFTER_DRAIN) { E(acc, cur, wr, wc, fr, fq); S.done(cur); }
        if (!has_next) break;
#pragma unroll
        for (int a = 0; a < 2; ++a)
#pragma unroll
            for (int b = 0; b < 2; ++b)
#pragma unroll
                for (int m = 0; m < 4; ++m)
#pragma unroll
                    for (int n = 0; n < 2; ++n) acc[a][b][m][n] = (f32x4){0.f, 0.f, 0.f, 0.f};
        cur = nxt; cA = nA; cB = nB; ++ui;
        if constexpr (ALIGN_EPI) { if (wr == 1) PG8_BAR; }
    }
    PG8_WAIT_V(0);
    if constexpr (!ALIGN_EPI) { if (wr == 0) PG8_BAR; }
    PG8_BAR;
    if constexpr (Epi::AFTER_DRAIN) { E.fused(acc, cur, wr, wc, fr, fq, lds, wid, lane); S.done(cur); }
#undef PG8_SA
#undef PG8_SB
#undef PG8_STAGE
#undef PG8_LDA
#undef PG8_LDB
#undef PG8_MMA
#undef PG8_WAIT_V
#undef PG8_WAIT_L
#undef PG8_BAR
#undef PG8_SCHED
}
}

typedef unsigned short bf16_t;
typedef short bf16x8 __attribute__((ext_vector_type(8)));
typedef short s16x4 __attribute__((ext_vector_type(4)));
typedef float f32x4 __attribute__((ext_vector_type(4)));
typedef float f32x2 __attribute__((ext_vector_type(2)));
typedef float f32x16 __attribute__((ext_vector_type(16)));
typedef unsigned u32x4 __attribute__((ext_vector_type(4)));
typedef unsigned u32x2 __attribute__((ext_vector_type(2)));

constexpr int DM = 1024, NB = 4, SEQ = 8192, CTX = 256, TL = NB * SEQ, TC = NB * CTX, TA = TL + TC;
constexpr int DFF = 2816, NIN = 7616;
constexpr float EPS = 1e-6f;
constexpr int NTHREADS = 512, NWAVES = 8;

constexpr size_t al256(size_t x) { return (x + 255) / 256 * 256; }
constexpr size_t WS_MOD = 0;
constexpr size_t WS_PAR = al256(WS_MOD + (size_t)2 * 5 * 6144 * 4);
constexpr size_t WS_BAR = al256(WS_PAR + (size_t)1024 * 256);
constexpr size_t WS_ROT = al256(WS_BAR + (size_t)3456 * 4);
constexpr size_t WS_HC  = al256(WS_ROT + (size_t)8448 * 64 * 8);
constexpr size_t WS_WT  = al256(WS_HC + (size_t)TC * DM * 4);
constexpr size_t WT_IN = 0, WT_QB = WT_IN + (size_t)7680 * 1024, WT_KVB = WT_QB + (size_t)768 * 256, WT_BR = WT_KVB + (size_t)1024 * 128,
                 WT_OUT = WT_BR + (size_t)3 * 1024 * 512, WT_MIX_END = WT_OUT + (size_t)1024 * 1024;
constexpr size_t WT_F1 = 0, WT_F2 = (size_t)5632 * 1024, WT_FFN_END = WT_F2 + (size_t)1024 * 2816;
constexpr size_t WT_ELEMS = WT_MIX_END > WT_FFN_END ? WT_MIX_END : WT_FFN_END;
constexpr size_t WS_A   = al256(WS_WT + WT_ELEMS * 2);
constexpr size_t WS_SM  = al256(WS_A + (size_t)TA * 1024 * 2);
constexpr size_t WS_Q   = al256(WS_SM + (size_t)TA * 512 * 2);
constexpr size_t WS_R4  = al256(WS_Q + (size_t)TA * 768 * 2);
constexpr size_t WS_K   = WS_R4;
constexpr size_t WS_V   = al256(WS_K + (size_t)TA * 768 * 2);
constexpr size_t WS_OF  = al256(WS_R4 + (size_t)TA * 3072 * 2);
constexpr size_t WS_OB  = al256(WS_OF + (size_t)TA * 1024 * 2);
constexpr size_t WS_END_MIX = al256(WS_OB + (size_t)TA * 1024 * 2);
constexpr size_t WS_G   = WS_SM;
constexpr size_t WS_U   = al256(WS_G + (size_t)TA * DFF * 2);
constexpr size_t WS_END_FFN = al256(WS_U + (size_t)TA * DFF * 2);
constexpr size_t WS_NEED = WS_END_MIX > WS_END_FFN ? WS_END_MIX : WS_END_FFN;
static_assert(WS_V + (size_t)TA * 512 * 2 <= WS_OF, "K/V overlay must fit in R4");

constexpr int LDS_BYTES = 148 * 1024;
constexpr int LDS_BARW = LDS_BYTES - 16;

struct Params { const float* in[26]; float* out; unsigned char* ws; int ph_lo, ph_hi; };
enum { I_X = 0, I_C, I_CTX, I_CCTX, I_WADA, I_BADA, I_N1W, I_N2W, I_WIN, I_BGATE, I_QNA, I_WQB, I_KVNA, I_WKVB, I_QN, I_KN, I_GK2, I_BGK, I_GON, I_RDEC, I_WBR, I_WOUT, I_WF1, I_WDW, I_BDW, I_WF2 };

DI float bflo(unsigned w) { return __uint_as_float(w << 16); }
DI float bfhi(unsigned w) { return __uint_as_float(w & 0xffff0000u); }
DI float bf2f(bf16_t x) { return __uint_as_float((unsigned)x << 16); }
DI unsigned pk2(float lo, float hi) { unsigned r; asm volatile("v_cvt_pk_bf16_f32 %0, %1, %2" : "=v"(r) : "v"(lo), "v"(hi)); return r; }
DI bf16_t f2bf(float x) { return (bf16_t)(pk2(x, 0.f) & 0xffffu); }
DI float wave_sum(float v) {
#pragma unroll
    for (int o = 1; o < 64; o <<= 1) v += __shfl_xor(v, o);
    return v;
}
DI float sigmoidf_(float x) { return 1.f / (1.f + __expf(-x)); }
DI void unpack8(u32x4 w, float* f) { f[0] = bflo(w.x); f[1] = bfhi(w.x); f[2] = bflo(w.y); f[3] = bfhi(w.y); f[4] = bflo(w.z); f[5] = bfhi(w.z); f[6] = bflo(w.w); f[7] = bfhi(w.w); }
DI u32x4 pack8(const float* f) { u32x4 w; w.x = pk2(f[0], f[1]); w.y = pk2(f[2], f[3]); w.z = pk2(f[4], f[5]); w.w = pk2(f[6], f[7]); return w; }

DI void rowinfo(int m, int& b, int& pos, int& isctx) {
    if (m < TL) { b = m >> 13; pos = m & 8191; isctx = 0; } else { const int j = m - TL; b = j >> 8; pos = j & 255; isctx = 1; }
}

DI void phase_prologue(const Params& P, LAS unsigned char* lds) {
    const int tid = threadIdx.x, wave = tid >> 6, lane = tid & 63;
    LAS float* cond = (LAS float*)lds;
    LAS float* part = cond + 5 * 1024;
    const float* c = P.in[I_C]; const float* cc = P.in[I_CCTX];
    for (int i = tid; i < 5 * 1024; i += NTHREADS) { const int r = i >> 10, k = i & 1023; const float v = r < 4 ? c[r * 1024 + k] : cc[k]; cond[i] = v / (1.f + expf(-v)); }
    __syncthreads();
    float* MOD = (float*)(P.ws + WS_MOD);
    for (int item = blockIdx.x; item < 192; item += gridDim.x) {
        const int l = item / 96, j0 = (item % 96) * 64;
        const float* W = P.in[I_WADA] + (size_t)l * 1024 * 6144 + j0 + lane;
        float a0 = 0.f, a1 = 0.f, a2 = 0.f, a3 = 0.f, a4 = 0.f;
        for (int k = wave * 128; k < wave * 128 + 128; ++k) {
            const float w = W[(size_t)k * 6144];
            a0 += cond[k] * w; a1 += cond[1024 + k] * w; a2 += cond[2048 + k] * w; a3 += cond[3072 + k] * w; a4 += cond[4096 + k] * w;
        }
        part[(wave * 5 + 0) * 64 + lane] = a0; part[(wave * 5 + 1) * 64 + lane] = a1; part[(wave * 5 + 2) * 64 + lane] = a2;
        part[(wave * 5 + 3) * 64 + lane] = a3; part[(wave * 5 + 4) * 64 + lane] = a4;
        __syncthreads();
        if (tid < 320) { const int r = tid >> 6; float s = 0.f;
            for (int w = 0; w < 8; ++w) s += part[(w * 5 + r) * 64 + lane];
            MOD[(size_t)(l * 5 + r) * 6144 + j0 + lane] = s + P.in[I_BADA][l * 6144 + j0 + lane]; }
        __syncthreads();
    }
    f32x2* ROT = (f32x2*)(P.ws + WS_ROT);
    for (int i = blockIdx.x * NTHREADS + tid; i < 8448 * 64; i += gridDim.x * NTHREADS) {
        const int pos = i >> 6, j = i & 63;
        const float inv = 1.0f / powf(10000.0f, (float)j / 63.0f);
        const float ang = (float)pos * inv; float s, co; sincosf(ang, &s, &co);
        ROT[i] = (f32x2){co, s};
    }
}

DI int wmap(int id, int n) {
    switch (id) {
    case 1: if (n < 416) return n; if (n < 448) return 2464 + (n - 416); return -1;
    case 2: { if (n < 1536) return 416 + n;
              if (n < 2560) { const int base = n < 2048 ? 2496 : 3008; const int j = (n - 1536) & 511; const int hh = j >> 7, v = j & 127, g = v >> 3, e = v & 7;
                              const int d = e < 4 ? 4 * g + e : 64 + 4 * g + (e - 4); return base + hh * 128 + d; }
              return 3520 + (n - 2560); }
    case 3: if (n < 512) return 1952 + n; if (n < 1024) return 4032 + (n - 512); return 4544 + (n - 1024);
    case 4: if (n < 512) return (n >> 6) * 96 + (n & 63); { const int j = n - 512; return (j >> 5) * 96 + 64 + (j & 31); }
    case 5: if (n < 512) return (n >> 6) * 128 + (n & 63); { const int j = n - 512; return (j >> 6) * 128 + 64 + (j & 63); }
    default: return n;
    }
}
struct TJob { const float* W; int K, Nsrc; bf16_t* WT; int ndst, map_id; const float* kscale; };
DI void transpose_job(const TJob& J, LAS float* scr, int gw, int ngw, int lane) {
    const int nblk = J.ndst / 32, nitems = (J.K / 64) * nblk;
    for (int item = gw; item < nitems; item += ngw) {
        const int kb = item / nblk, nb = item % nblk, k0 = 64 * kb, n0 = 32 * nb;
        const int src = wmap(J.map_id, n0 + (lane & 31));
#pragma unroll 8
        for (int i = 0; i < 32; ++i) { const int kk = 2 * i + (lane >> 5);
            float v = 0.f; if (src >= 0) { v = J.W[(size_t)(k0 + kk) * J.Nsrc + src]; if (J.kscale) v *= J.kscale[k0 + kk]; }
            scr[kk * 33 + (lane & 31)] = v; }
        asm volatile("s_waitcnt lgkmcnt(0)" ::: "memory");
        const int c = lane & 7;
#pragma unroll
        for (int j = 0; j < 4; ++j) { const int n = (lane >> 3) + 8 * j; const LAS float* s = scr + (8 * c) * 33 + n;
            u32x4 o; o.x = pk2(s[0 * 33], s[1 * 33]); o.y = pk2(s[2 * 33], s[3 * 33]); o.z = pk2(s[4 * 33], s[5 * 33]); o.w = pk2(s[6 * 33], s[7 * 33]);
            *(u32x4*)(J.WT + (size_t)(n0 + n) * J.K + k0 + 8 * c) = o; }
        asm volatile("s_waitcnt lgkmcnt(0)" ::: "memory");
    }
}
DI void phase_wconv_mixer(const Params& P, int l, LAS unsigned char* lds) {
    const int tid = threadIdx.x, wave = tid >> 6, lane = tid & 63, gw = blockIdx.x * NWAVES + wave, ngw = gridDim.x * NWAVES;
    LAS float* scr = (LAS float*)lds + wave * (64 * 33);
    bf16_t* WT = (bf16_t*)(P.ws + WS_WT);
    const float* win = P.in[I_WIN] + (size_t)l * 1024 * NIN;
    TJob j;
    j = TJob{win, 1024, NIN, WT + WT_IN, 512, 1, nullptr}; transpose_job(j, scr, gw, ngw, lane);
    j = TJob{win, 1024, NIN, WT + WT_IN + (size_t)512 * 1024, 3072, 2, nullptr}; transpose_job(j, scr, gw, ngw, lane);
    j = TJob{win, 1024, NIN, WT + WT_IN + (size_t)3584 * 1024, 4096, 3, nullptr}; transpose_job(j, scr, gw, ngw, lane);
    j = TJob{P.in[I_WQB] + (size_t)l * 256 * 768, 256, 768, WT + WT_QB, 768, 4, P.in[I_QNA] + l * 256}; transpose_job(j, scr, gw, ngw, lane);
    j = TJob{P.in[I_WKVB] + (size_t)l * 128 * 1024, 128, 1024, WT + WT_KVB, 1024, 5, P.in[I_KVNA] + l * 128}; transpose_job(j, scr, gw, ngw, lane);
    for (int n = 0; n < 3; ++n) { j = TJob{P.in[I_WBR] + ((size_t)l * 3 + n) * 512 * 1024, 512, 1024, WT + WT_BR + (size_t)n * 1024 * 512, 1024, 0, nullptr}; transpose_job(j, scr, gw, ngw, lane); }
    j = TJob{P.in[I_WOUT] + (size_t)l * 1024 * 1024, 1024, 1024, WT + WT_OUT, 1024, 0, nullptr}; transpose_job(j, scr, gw, ngw, lane);
}
DI void phase_wconv_ffn(const Params& P, int l, LAS unsigned char* lds) {
    const int tid = threadIdx.x, wave = tid >> 6, lane = tid & 63, gw = blockIdx.x * NWAVES + wave, ngw = gridDim.x * NWAVES;
    LAS float* scr = (LAS float*)lds + wave * (64 * 33);
    bf16_t* WT = (bf16_t*)(P.ws + WS_WT);
    TJob j;
    j = TJob{P.in[I_WF1] + (size_t)l * 1024 * 5632, 1024, 5632, WT + WT_F1, 5632, 0, nullptr}; transpose_job(j, scr, gw, ngw, lane);
    j = TJob{P.in[I_WF2] + (size_t)l * 2816 * 1024, 2816, 1024, WT + WT_F2, 1024, 0, nullptr}; transpose_job(j, scr, gw, ngw, lane);
}

DI void phase_norm(const float* hl, const float* hc, const float* nw, const float* MODl, int ishift, int iscale, bf16_t* A, int nrows) {
    const int tid = threadIdx.x, wave = tid >> 6, lane = tid & 63, gw = blockIdx.x * NWAVES + wave, ngw = gridDim.x * NWAVES;
    for (int m = gw; m < nrows; m += ngw) {
        int b, pos, isctx; rowinfo(m, b, pos, isctx);
        const float* xr = isctx ? hc + (size_t)(m - TL) * DM : hl + (size_t)m * DM;
        const float* mod = MODl + (size_t)(isctx ? 4 : b) * 6144;
        f32x4 v[4]; float ss = 0.f;
#pragma unroll
        for (int j = 0; j < 4; ++j) { v[j] = *(const f32x4*)(xr + 4 * lane + 256 * j); ss += (v[j].x * v[j].x + v[j].y * v[j].y) + (v[j].z * v[j].z + v[j].w * v[j].w); }
        const float rstd = rsqrtf(wave_sum(ss) * (1.f / DM) + EPS);
#pragma unroll
        for (int j = 0; j < 4; ++j) { const int c = 4 * lane + 256 * j;
            const f32x4 w = *(const f32x4*)(nw + c), sh = *(const f32x4*)(mod + ishift * 1024 + c), sc = *(const f32x4*)(mod + iscale * 1024 + c);
            const f32x4 y = v[j] * rstd * w * (sc + 1.f) + sh;
            u32x2 o; o.x = pk2(y.x, y.y); o.y = pk2(y.z, y.w);
            *(u32x2*)(A + (size_t)m * DM + c) = o; }
    }
}
#include <cstdlib>
#include <vector>

#define XB_TMO      128
#define XB_XCNT(j)  (256  + 64 * (j))
#define XB_XSUB(j)  (1280 + 64 * (j))
#define XB_XGEN(j)  (2304 + 64 * (j))
#define XB_TOP      3328
#define XB_TOPGEN   3392
#define XCD_BAR_WORDS 3456
#define XB_SPIN_CAP (1u << 18)

__device__ __forceinline__ unsigned xb_ld(unsigned* p)              { return __hip_atomic_load(p, __ATOMIC_RELAXED, __HIP_MEMORY_SCOPE_AGENT); }
__device__ __forceinline__ unsigned xb_add(unsigned* p, unsigned v) { return __hip_atomic_fetch_add(p, v, __ATOMIC_RELAXED, __HIP_MEMORY_SCOPE_AGENT); }
__device__ __forceinline__ unsigned xb_xcc_id() { return (unsigned)__builtin_amdgcn_s_getreg((3 << 11) | 20) & 0xFu; }
#define XB_SPIN(cond, bar) do { unsigned _sp = 0; while (cond) { __builtin_amdgcn_s_sleep(1); \
    if ((++_sp & 255u) == 0u) { if (xb_ld(&(bar)[XB_TMO])) break; if (_sp > XB_SPIN_CAP) { atomicAdd(&(bar)[XB_TMO], 1u); break; } } } } while (0)

struct XcdBarrier {
    unsigned* bar; unsigned x;
    volatile LAS unsigned* st;
};

__device__ __forceinline__ XcdBarrier xcd_barrier_post(unsigned* bar, volatile LAS unsigned* st) {
    XcdBarrier b; b.bar = bar; b.x = xb_xcc_id(); b.st = st;
    if (threadIdx.x == 0) (void)xb_add(&bar[XB_XCNT(b.x)], 1u);
    return b;
}
__device__ __forceinline__ void xcd_barrier_complete(unsigned* bar, unsigned x, unsigned& nloc, unsigned& nx) {
    const unsigned G = gridDim.x * gridDim.y * gridDim.z;
    unsigned sum, cnt, mine, sp = 0u;
    for (;;) {
        sum = 0u; cnt = 0u; mine = 0u;
#pragma unroll
        for (unsigned j = 0; j < 16; ++j) { const unsigned c = xb_ld(&bar[XB_XCNT(j)]); sum += c; cnt += (c > 0u) ? 1u : 0u; mine = (j == x) ? c : mine; }
        if (sum == G) break;
        __builtin_amdgcn_s_sleep(1);
        if ((++sp & 255u) == 0u) { if (xb_ld(&bar[XB_TMO])) break; if (sp > XB_SPIN_CAP) { atomicAdd(&bar[XB_TMO], 1u); break; } }
    }
    nloc = mine > 0u ? mine : 1u; nx = cnt > 0u ? cnt : 1u;
}

__device__ __forceinline__ void xcd_barrier(const XcdBarrier& b) {
    asm volatile("s_waitcnt vmcnt(0)" ::: "memory");
    __syncthreads();
    if (threadIdx.x == 0) {
        unsigned* bar = b.bar;
        __builtin_amdgcn_s_waitcnt(0);
        unsigned nloc = b.st[0], nx = b.st[1];
        if (nloc == 0u) { xcd_barrier_complete(bar, b.x, nloc, nx); b.st[0] = nloc; b.st[1] = nx; }
        const unsigned old = xb_add(&bar[XB_XSUB(b.x)], 1u);
        const unsigned gen = old / nloc;
        if (old + 1u == (gen + 1u) * nloc) {
            __builtin_amdgcn_fence(__ATOMIC_RELEASE, "agent");
            asm volatile("s_waitcnt vmcnt(0)" ::: "memory");
            const unsigned og = xb_add(&bar[XB_TOP], 1u);
            const unsigned tg = og / nx;
            if (og + 1u == (tg + 1u) * nx) xb_add(&bar[XB_TOPGEN], 1u);
            else XB_SPIN(xb_ld(&bar[XB_TOPGEN]) == tg, bar);
            __builtin_amdgcn_fence(__ATOMIC_ACQUIRE, "agent");
            xb_add(&bar[XB_XGEN(b.x)], 1u);
            asm volatile("s_waitcnt vmcnt(0)" ::: "memory");
        } else {
            XB_SPIN(xb_ld(&bar[XB_XGEN(b.x)]) == gen, bar);
            __builtin_amdgcn_fence(__ATOMIC_ACQUIRE, "agent");
            asm volatile("s_waitcnt vmcnt(0)" ::: "memory");
        }
    }
    __syncthreads();
}

enum { EM_PLAIN = 0, EM_KV, EM_BIG, EM_GATES, EM_BRANCH, EM_RES, EM_FFNIN };
template <int MODE> struct Epi {
    static constexpr bool PERM = true, AFTER_DRAIN = false;
    bf16_t* O0; int ld0; bf16_t* O1; int ld1;
    const bf16_t* Gsrc;
    const float* fa;
    const float* hin_l; const float* hin_c; float* hout_l; float* hout_c;
    int ipar;
    DI void emit(int row, int col, f32x4 v0, f32x4 v1) const {
        float f[8] = {v0[0], v0[1], v0[2], v0[3], v1[0], v1[1], v1[2], v1[3]};
        if (MODE == EM_PLAIN) {
            *(u32x4*)(O0 + (size_t)row * ld0 + col) = pack8(f);
        } else if (MODE == EM_KV) {
            if (col < 512) *(u32x4*)(O0 + (size_t)row * 768 + col) = pack8(f);
            else           *(u32x4*)(O1 + (size_t)row * 512 + (col - 512)) = pack8(f);
        } else if (MODE == EM_FFNIN) {
            if (col < DFF) *(u32x4*)(O0 + (size_t)row * DFF + col) = pack8(f);
            else           *(u32x4*)(O1 + (size_t)row * DFF + (col - DFF)) = pack8(f);
        } else if (MODE == EM_BIG) {
            const float QS = 0.08838834764831845f;
            if (col < 512) { for (int i = 0; i < 8; ++i) f[i] *= QS; }
            else if (col >= 1536 && col < 2560) {
                int b, pos, isctx; rowinfo(row, b, pos, isctx);
                const int sp = isctx ? pos : CTX + pos;
                const int g = ((col - 1536) & 127) >> 3;
                const f32x2* rot = (const f32x2*)fa + (size_t)sp * 64 + 4 * g;
                const float sc = col >= 2048 ? QS : 1.f;
#pragma unroll
                for (int e = 0; e < 4; ++e) { const f32x2 cs = rot[e]; const float x1 = f[e], x2 = f[4 + e];
                    f[e] = (x1 * cs.x - x2 * cs.y) * sc; f[4 + e] = (x1 * cs.y + x2 * cs.x) * sc; }
            }
            *(u32x4*)(O0 + (size_t)row * 3072 + col) = pack8(f);
        } else if (MODE == EM_GATES) {
            if (col < 1024) {
                bf16_t* p = O1 + (size_t)row * 1024 + col; float on[8]; unpack8(*(const u32x4*)p, on);
#pragma unroll
                for (int i = 0; i < 8; ++i) f[i] = on[i] * f[i] * sigmoidf_(f[i]);
                *(u32x4*)p = pack8(f);
            } else {
                const int cc = col - 1024; const f32x4 b0 = *(const f32x4*)(fa + cc), b1 = *(const f32x4*)(fa + cc + 4);
                const float bb[8] = {b0[0], b0[1], b0[2], b0[3], b1[0], b1[1], b1[2], b1[3]};
#pragma unroll
                for (int i = 0; i < 8; ++i) f[i] = sigmoidf_(f[i] + bb[i]);
                *(u32x4*)(O0 + (size_t)row * 3072 + cc) = pack8(f);
            }
        } else if (MODE == EM_BRANCH) {
            float g[8]; unpack8(*(const u32x4*)(Gsrc + (size_t)row * 3072 + col), g);
            bf16_t* p = O0 + (size_t)row * 1024 + col;
            if (ipar > 0) { float pr[8]; unpack8(*(const u32x4*)p, pr);
#pragma unroll
                for (int i = 0; i < 8; ++i) f[i] = pr[i] + g[i] * f[i]; }
            else {
#pragma unroll
                for (int i = 0; i < 8; ++i) f[i] = g[i] * f[i]; }
            *(u32x4*)p = pack8(f);
        } else if (MODE == EM_RES) {
            int b, pos, isctx; rowinfo(row, b, pos, isctx);
            const float* hi_ = isctx ? hin_c + (size_t)(row - TL) * DM : hin_l + (size_t)row * DM;
            float* ho_ = isctx ? hout_c + (size_t)(row - TL) * DM : hout_l + (size_t)row * DM;
            const float* mod = fa + (size_t)(isctx ? 4 : b) * 6144 + ipar * 1024 + col;
            const f32x4 m0 = *(const f32x4*)mod, m1 = *(const f32x4*)(mod + 4);
            const f32x4 h0 = *(const f32x4*)(hi_ + col), h1 = *(const f32x4*)(hi_ + col + 4);
            *(f32x4*)(ho_ + col) = h0 + m0 * v0; *(f32x4*)(ho_ + col + 4) = h1 + m1 * v1;
        }
    }
    DI void operator()(const pg8::f32x4 (&acc)[2][2][4][2], const pg8::Unit& u, int wr, int wc, int fr, int fq) const {
#pragma unroll
        for (int ai = 0; ai < 2; ++ai)
#pragma unroll
            for (int m = 0; m < 4; ++m) { const int row = u.pm * 256 + ai * 128 + wr * 64 + m * 16 + fr;
#pragma unroll
                for (int bj = 0; bj < 2; ++bj) { const int col = u.pn * 256 + bj * 128 + wc * 32 + 8 * fq;
                    emit(row, col, acc[ai][bj][m][0], acc[ai][bj][m][1]); } }
    }
};
template <int MODE>
DI void run_gemm(LAS unsigned char* lds, const bf16_t* A, int lda, const bf16_t* Bt, int M, int N, int K, const Epi<MODE>& E) {
    int Kop = K; if (K < 512) asm volatile("" : "+s"(Kop));
    pg8::Gemm g{A, Bt, M, N, Kop, lda}; pg8::StaticOrder S; S.init(M, N, (int)gridDim.x, (int)blockIdx.x);
    pg8::gemm_phase<Epi<MODE>, pg8::StaticOrder, true, true>((PG8_LAS unsigned char*)lds, g, S, E);
}

DI void phase_qkpost(const Params& P, int l) {
    const int tid = threadIdx.x, wave = tid >> 6, lane = tid & 63, gw = blockIdx.x * NWAVES + wave, ngw = gridDim.x * NWAVES;
    const bf16_t* SM = (const bf16_t*)(P.ws + WS_SM); bf16_t* Q = (bf16_t*)(P.ws + WS_Q); bf16_t* K = (bf16_t*)(P.ws + WS_K); bf16_t* V = (bf16_t*)(P.ws + WS_V);
    const float* qn = P.in[I_QN] + l * 96; const float* kn = P.in[I_KN] + l * 96;
    const int s = lane & 7, h = lane >> 3;
    float qnw[12], knw[12];
#pragma unroll
    for (int i = 0; i < 8; ++i) { qnw[i] = qn[8 * s + i]; knw[i] = kn[8 * s + i]; }
#pragma unroll
    for (int i = 0; i < 4; ++i) { qnw[8 + i] = qn[64 + 4 * s + i]; knw[8 + i] = kn[64 + 4 * s + i]; }
    for (int m = gw; m < TA; m += ngw) {
        int b, pos, isctx; rowinfo(m, b, pos, isctx);
        const bf16_t* sm = SM + (size_t)m * 512;
        const u32x2 cq = *(const u32x2*)(sm + 4 * lane); const unsigned ckv = *(const unsigned*)(sm + 256 + 2 * lane);
        float a0 = bflo(cq.x), a1 = bfhi(cq.x), a2 = bflo(cq.y), a3 = bfhi(cq.y), c0 = bflo(ckv), c1 = bfhi(ckv);
        const float s_q = rsqrtf(wave_sum(a0 * a0 + a1 * a1 + a2 * a2 + a3 * a3) * (1.f / 256.f) + EPS);
        const float s_kv = rsqrtf(wave_sum(c0 * c0 + c1 * c1) * (1.f / 128.f) + EPS);
        float cs[4], sn[4];
        if (!isctx) { const float p = (float)((s < 4) ? (pos >> 6) : (pos & 63));
#pragma unroll
            for (int e = 0; e < 4; ++e) { const float inv = powf(10000.0f, -(float)(4 * (s & 1) + e) * 0.125f); sincosf(p * inv, &sn[e], &cs[e]); } }
        else {
#pragma unroll
            for (int e = 0; e < 4; ++e) { cs[e] = 1.f; sn[e] = 0.f; } }
        const bool second = (s & 2) != 0;
        {
            bf16_t* qp = Q + (size_t)m * 768;
            float z[12]; unpack8(*(const u32x4*)(qp + 64 * h + 8 * s), z);
            const u32x2 zr = *(const u32x2*)(qp + 512 + 32 * h + 4 * s); z[8] = bflo(zr.x); z[9] = bfhi(zr.x); z[10] = bflo(zr.y); z[11] = bfhi(zr.y);
            float ss = 0.f;
#pragma unroll
            for (int i = 0; i < 12; ++i) { z[i] *= s_q; ss += z[i] * z[i]; }
            ss += __shfl_xor(ss, 1); ss += __shfl_xor(ss, 2); ss += __shfl_xor(ss, 4);
            const float r = rsqrtf(ss * (1.f / 96.f) + EPS);
#pragma unroll
            for (int i = 0; i < 12; ++i) z[i] *= r * qnw[i];
#pragma unroll
            for (int e = 0; e < 4; ++e) { const float mine = z[8 + e], other = __shfl_xor(mine, 2);
                z[8 + e] = second ? (other * sn[e] + mine * cs[e]) : (mine * cs[e] - other * sn[e]); }
            *(u32x4*)(qp + 64 * h + 8 * s) = pack8(z);
            u32x2 o; o.x = pk2(z[8], z[9]); o.y = pk2(z[10], z[11]); *(u32x2*)(qp + 512 + 32 * h + 4 * s) = o;
        }
        {
            bf16_t* kp = K + (size_t)m * 768;
            float z[12]; unpack8(*(const u32x4*)(kp + 64 * h + 8 * s), z);
#pragma unroll
            for (int i = 0; i < 8; ++i) z[i] *= s_kv;
            const u32x2 zr = *(const u32x2*)(sm + 384 + 4 * s); z[8] = bflo(zr.x); z[9] = bfhi(zr.x); z[10] = bflo(zr.y); z[11] = bfhi(zr.y);
            float ss = 0.f;
#pragma unroll
            for (int i = 0; i < 12; ++i) ss += z[i] * z[i];
            ss += __shfl_xor(ss, 1); ss += __shfl_xor(ss, 2); ss += __shfl_xor(ss, 4);
            const float r = rsqrtf(ss * (1.f / 96.f) + EPS);
#pragma unroll
            for (int i = 0; i < 12; ++i) z[i] *= r * knw[i];
#pragma unroll
            for (int e = 0; e < 4; ++e) { const float mine = z[8 + e], other = __shfl_xor(mine, 2);
                z[8 + e] = second ? (other * sn[e] + mine * cs[e]) : (mine * cs[e] - other * sn[e]); }
            *(u32x4*)(kp + 64 * h + 8 * s) = pack8(z);
            u32x2 o; o.x = pk2(z[8], z[9]); o.y = pk2(z[10], z[11]); *(u32x2*)(kp + 512 + 32 * h + 4 * s) = o;
            bf16_t* vp = V + (size_t)m * 512 + 8 * lane; float vv[8]; unpack8(*(const u32x4*)vp, vv);
#pragma unroll
            for (int i = 0; i < 8; ++i) vv[i] *= s_kv;
            *(u32x4*)vp = pack8(vv);
        }
    }
}

DI void phase_scanpost(const Params& P, int l, int nrows) {
    const int tid = threadIdx.x, wave = tid >> 6, lane = tid & 63, gw = blockIdx.x * NWAVES + wave, ngw = gridDim.x * NWAVES;
    bf16_t* OF = (bf16_t*)(P.ws + WS_OF); const bf16_t* OB = (const bf16_t*)(P.ws + WS_OB);
    const float* gw_ = P.in[I_GON] + l * 128;
    const int sub = lane & 7, hd = lane >> 3;
    float w[16];
#pragma unroll
    for (int i = 0; i < 16; ++i) w[i] = hd < 4 ? gw_[16 * sub + i] : 1.f;
    for (int m = gw; m < nrows; m += ngw) {
        bf16_t* pf = OF + (size_t)m * 1024 + 16 * lane; const bf16_t* pb = OB + (size_t)m * 1024 + 16 * lane;
        float a[16], bq[16];
        unpack8(*(const u32x4*)pf, a); unpack8(*(const u32x4*)(pf + 8), a + 8); unpack8(*(const u32x4*)pb, bq); unpack8(*(const u32x4*)(pb + 8), bq + 8);
        float ss = 0.f;
#pragma unroll
        for (int i = 0; i < 16; ++i) { a[i] += bq[i]; ss += a[i] * a[i]; }
        ss += __shfl_xor(ss, 1); ss += __shfl_xor(ss, 2); ss += __shfl_xor(ss, 4);
        const float r = rsqrtf(ss * (1.f / 128.f) + EPS);
#pragma unroll
        for (int i = 0; i < 16; ++i) a[i] *= r * w[i];
        *(u32x4*)pf = pack8(a); *(u32x4*)(pf + 8) = pack8(a + 8);
    }
}

DI void phase_conv(const Params& P, int l, int nrows) {
    const bf16_t* G = (const bf16_t*)(P.ws + WS_G); bf16_t* U = (bf16_t*)(P.ws + WS_U);
    const float* wdw = P.in[I_WDW] + (size_t)l * 3 * DFF; const float* bdw = P.in[I_BDW] + (size_t)l * DFF;
    const long total = (long)nrows * 352;
    for (long i = (long)blockIdx.x * NTHREADS + threadIdx.x; i < total; i += (long)gridDim.x * NTHREADS) {
        const int m = (int)(i / 352), c = (int)(i % 352) * 8;
        int b, pos, isctx; rowinfo(m, b, pos, isctx);
        const int last = isctx ? CTX - 1 : SEQ - 1;
        float g0[8], g1[8], g2[8], u[8];
        unpack8(*(const u32x4*)(G + (size_t)m * DFF + c), g1);
        if (pos > 0) unpack8(*(const u32x4*)(G + (size_t)(m - 1) * DFF + c), g0); else { for (int k = 0; k < 8; ++k) g0[k] = 0.f; }
        if (pos < last) unpack8(*(const u32x4*)(G + (size_t)(m + 1) * DFF + c), g2); else { for (int k = 0; k < 8; ++k) g2[k] = 0.f; }
        unpack8(*(const u32x4*)(U + (size_t)m * DFF + c), u);
        float o[8];
#pragma unroll
        for (int k = 0; k < 8; ++k) {
            const float x = wdw[c + k] * g0[k] + wdw[DFF + c + k] * g1[k] + wdw[2 * DFF + c + k] * g2[k] + bdw[c + k];
            const float t = tanhf(0.7978845608028654f * (x + 0.044715f * x * x * x));
            o[k] = 0.5f * x * (1.f + t) * u[k];
        }
        *(u32x4*)(U + (size_t)m * DFF + c) = pack8(o);
    }
}

namespace att {
constexpr int NW = 8, QBLK = 32, KVBLK = 64;
constexpr float SCALE = 0.10206207261596575f;
constexpr float THR = 8.f;
constexpr int SHM_V = 64 * 128 * 2, SHM_K = 64 * 256, SHM_ATTN = 2 * SHM_V + 2 * SHM_K + NW * 64 * 4;
#define KSWZ(row, colB) ((row) * 256 + ((colB) ^ (((row) & 7) << 4)))
#define SBAR() __builtin_amdgcn_sched_barrier(0)
DI int crow(int r, int hi) { return (r & 3) + 8 * (r >> 2) + 4 * hi; }
DI unsigned cvtpk(float lo, float hi) { unsigned r; asm volatile("v_cvt_pk_bf16_f32 %0, %1, %2" : "=v"(r) : "v"(lo), "v"(hi)); return r; }
DI bf16x8 ld8(const bf16_t* p) { return *reinterpret_cast<const bf16x8*>(p); }

DI void partialSM(f32x16& p0, f32x16& p1, float& m_reg, float& mn, float& alpha) {
  constexpr float C = SCALE * 1.4426950408889634f;
  float pmax = p0[0]; for (int r = 1; r < 16; ++r) pmax = fmaxf(pmax, p0[r]); for (int r = 0; r < 16; ++r) pmax = fmaxf(pmax, p1[r]);
  { auto rr = __builtin_amdgcn_permlane32_swap(__float_as_uint(pmax), __float_as_uint(pmax), false, false);
    pmax = fmaxf(__uint_as_float(rr[0]), __uint_as_float(rr[1])); }
  if (__builtin_expect(__all(pmax - m_reg <= THR / SCALE), 1)) { mn = m_reg; alpha = 1.f; }
  else { mn = fmaxf(m_reg, pmax); alpha = __builtin_amdgcn_exp2f((m_reg - mn) * C); m_reg = mn; }
  float mnC = -mn * C;
  for (int r = 0; r < 16; ++r) p0[r] = fmaf(p0[r], C, mnC); for (int r = 0; r < 16; ++r) p1[r] = fmaf(p1[r], C, mnC);
  for (int r = 0; r < 16; ++r) p0[r] = __builtin_amdgcn_exp2f(p0[r]);
}
DI void finishSM(f32x16& p0, f32x16& p1, float alpha, float& l_reg, bf16x8& pa0, bf16x8& pa1, bf16x8& pa2, bf16x8& pa3) {
  for (int r = 0; r < 16; ++r) p1[r] = __builtin_amdgcn_exp2f(p1[r]);
  float ps = 0; for (int r = 0; r < 16; ++r) ps += p0[r]; for (int r = 0; r < 16; ++r) ps += p1[r];
  { auto rr = __builtin_amdgcn_permlane32_swap(__float_as_uint(ps), __float_as_uint(ps), false, false);
    ps = __uint_as_float(rr[0]) + __uint_as_float(rr[1]); }
  l_reg = l_reg * alpha + ps;
#define PK4(P, BASE, OUT) do { unsigned a0 = cvtpk(P[BASE + 0], P[BASE + 1]), a1 = cvtpk(P[BASE + 2], P[BASE + 3]);   \
    unsigned b0 = cvtpk(P[BASE + 4], P[BASE + 5]), b1 = cvtpk(P[BASE + 6], P[BASE + 7]);                              \
    auto r0 = __builtin_amdgcn_permlane32_swap(a0, b0, false, false); auto r1 = __builtin_amdgcn_permlane32_swap(a1, b1, false, false); \
    u32x4 w = {r0[0], r1[0], r0[1], r1[1]}; OUT = *reinterpret_cast<bf16x8*>(&w); } while (0)
  PK4(p0, 0, pa0); PK4(p0, 8, pa1); PK4(p1, 0, pa2); PK4(p1, 8, pa3);
#undef PK4
}
DI void qkt(f32x16& p0, f32x16& p1, const char* Ks, const bf16x8* qr, int r32, int hi) {
  p0 = f32x16{}; p1 = f32x16{};
#pragma unroll
  for (int d0 = 0; d0 < 6; ++d0) { int cb = (d0 * 16 + hi * 8) * 2;
    bf16x8 b0 = *reinterpret_cast<const bf16x8*>(Ks + KSWZ(r32, cb));
    bf16x8 b1 = *reinterpret_cast<const bf16x8*>(Ks + KSWZ(32 + r32, cb));
    p0 = __builtin_amdgcn_mfma_f32_32x32x16_bf16(b0, qr[d0], p0, 0, 0, 0);
    p1 = __builtin_amdgcn_mfma_f32_32x32x16_bf16(b1, qr[d0], p1, 0, 0, 0); }
}
DI int v_st(int k, int c) { const int kk = (k & ~0xC) | ((k & 4) << 1) | ((k & 8) >> 1); return ((kk >> 3) * 4 + (c >> 5)) * 512 + ((kk & 7) * 32 + (c & 31)) * 2; }
DI int v_rd_base(int lane) { return ((lane & 3) << 3) | (((lane >> 2) & 3) << 6) | (((lane >> 4) & 1) << 5) | (((lane >> 5) & 1) << 8); }
constexpr int v_rd_off(int d0, int ks, int half) { return d0 * 512 + ks * 4096 + half * 2048; }
template <int OFF> DI s16x4 tr_read(int vb) {
  s16x4 r; asm volatile("ds_read_b64_tr_b16 %0, %1 offset:%2" : "=&v"(r) : "v"(vb), "i"(OFF) : "memory"); return r;
}
template <int D0> DI void pv_one(f32x16& od, int vb, bf16x8 pa0, bf16x8 pa1, bf16x8 pa2, bf16x8 pa3) {
  const s16x4 l0 = tr_read<v_rd_off(D0, 0, 0)>(vb), h0 = tr_read<v_rd_off(D0, 0, 1)>(vb), l1 = tr_read<v_rd_off(D0, 1, 0)>(vb), h1 = tr_read<v_rd_off(D0, 1, 1)>(vb);
  const s16x4 l2 = tr_read<v_rd_off(D0, 2, 0)>(vb), h2 = tr_read<v_rd_off(D0, 2, 1)>(vb), l3 = tr_read<v_rd_off(D0, 3, 0)>(vb), h3 = tr_read<v_rd_off(D0, 3, 1)>(vb);
  asm volatile("s_waitcnt lgkmcnt(0)" ::: "memory"); SBAR();
#define PK(L, H) (bf16x8){L[0], L[1], L[2], L[3], H[0], H[1], H[2], H[3]}
  od = __builtin_amdgcn_mfma_f32_32x32x16_bf16(pa0, PK(l0, h0), od, 0, 0, 0);
  od = __builtin_amdgcn_mfma_f32_32x32x16_bf16(pa1, PK(l1, h1), od, 0, 0, 0);
  od = __builtin_amdgcn_mfma_f32_32x32x16_bf16(pa2, PK(l2, h2), od, 0, 0, 0);
  od = __builtin_amdgcn_mfma_f32_32x32x16_bf16(pa3, PK(l3, h3), od, 0, 0, 0);
#undef PK
}
DI void pv_d0(f32x16* o, int vb, bf16x8 pa0, bf16x8 pa1, bf16x8 pa2, bf16x8 pa3) {
  pv_one<0>(o[0], vb, pa0, pa1, pa2, pa3); pv_one<1>(o[1], vb, pa0, pa1, pa2, pa3);
}

DI void attn_unit(const bf16_t* Qg, bf16_t* Og, int ldo, const bf16_t* Kg, const bf16_t* Vg, int qrow0, int h, int ctxrow0, int latrow0, int NT, char* lds) {
  const int tid = threadIdx.x, wid = tid >> 6, lane = tid & 63, r32 = lane & 31, hi = lane >> 5;
  char* V_lds = lds; char* K_lds = lds + 2 * SHM_V;
  float* ws = (float*)(lds + 2 * SHM_V + 2 * SHM_K) + wid * 64; float* li_l = ws; float* al_l = ws + 32;
  float m_reg = -1e30f, l_reg = 0; f32x16 o[2] = {}; bf16x8 qr[6];
  const bf16_t* Qw = Qg + (size_t)(qrow0 + wid * QBLK + r32) * 768;
#pragma unroll
  for (int d0 = 0; d0 < 6; ++d0) qr[d0] = ld8(Qw + (d0 < 4 ? 64 * h + 16 * d0 + 8 * hi : 512 + 32 * h + 16 * (d0 - 4) + 8 * hi));
  const int vr = tid >> 3, vc = tid & 7, vst = v_st(vr, 8 * vc), vcol = 64 * h + 8 * vc;
  const int c0 = tid, c1 = 512 + (tid & 255);
  const int kr0 = c0 / 12, kc0 = c0 % 12, kr1 = c1 / 12, kc1 = c1 % 12;
  const int kcol0 = kc0 < 8 ? 64 * h + 8 * kc0 : 512 + 32 * h + 8 * (kc0 - 8), kcol1 = kc1 < 8 ? 64 * h + 8 * kc1 : 512 + 32 * h + 8 * (kc1 - 8);
  const int kst0 = KSWZ(kr0, kc0 * 16), kst1 = KSWZ(kr1, kc1 * 16);
  const int vb0 = (int)(uintptr_t)V_lds + v_rd_base(lane);
  struct { bf16x8 vs0, ks0, ks1; } sr_[2];
#define TROW(j) ((j) < 4 ? ctxrow0 + 64 * (j) : latrow0 + 64 * ((j) - 4))
#define SLOAD(i, j) do { const int rb_ = TROW(j); sr_[i].vs0 = ld8(Vg + (size_t)(rb_ + vr) * 512 + vcol); \
    sr_[i].ks0 = ld8(Kg + (size_t)(rb_ + kr0) * 768 + kcol0); sr_[i].ks1 = ld8(Kg + (size_t)(rb_ + kr1) * 768 + kcol1); } while (0)
#define SWRITE(b, i) do { *(bf16x8*)(V_lds + (b) * SHM_V + vst) = sr_[i].vs0; \
    *(bf16x8*)(K_lds + (b) * SHM_K + kst0) = sr_[i].ks0; *(bf16x8*)(K_lds + (b) * SHM_K + kst1) = sr_[i].ks1; } while (0)
#define SWAIT() asm volatile("s_waitcnt vmcnt(3)" ::: "memory")
#define RESC(a) do { if (__any((a) < 1.f)) { if (hi == 0) al_l[r32] = (a); asm volatile("s_waitcnt lgkmcnt(0)" ::: "memory"); \
    for (int d = 0; d < 2; ++d) for (int r = 0; r < 16; ++r) o[d][r] *= al_l[crow(r, hi)]; } } while (0)
  f32x16 pA0, pA1, pB0, pB1; float mnA, mnB, alA, alB; bf16x8 pa0, pa1, pa2, pa3;
  constexpr int SE = 0, SO = 1;
  SLOAD(SE, 0); asm volatile("s_waitcnt vmcnt(0)" ::: "memory"); SWRITE(0, SE); __syncthreads();
  qkt(pA0, pA1, K_lds, qr, r32, hi); partialSM(pA0, pA1, m_reg, mnA, alA);
  SLOAD(SO, 1); if (2 < NT) SLOAD(SE, 2);
  SWAIT(); SWRITE(1, SO); __syncthreads();
  for (int j = 1; j + 1 < NT; j += 2) {
    SBAR(); qkt(pB0, pB1, K_lds + SHM_K, qr, r32, hi);
    finishSM(pA0, pA1, alA, l_reg, pa0, pa1, pa2, pa3); SBAR();
    SLOAD(SO, j + 2); SBAR();
    pv_d0(o, vb0, pa0, pa1, pa2, pa3); partialSM(pB0, pB1, m_reg, mnB, alB);
    __syncthreads(); SWAIT(); SWRITE(0, SE);
    RESC(alB); __syncthreads();
    SBAR(); qkt(pA0, pA1, K_lds, qr, r32, hi);
    finishSM(pB0, pB1, alB, l_reg, pa0, pa1, pa2, pa3); SBAR();
    if (j + 3 < NT) SLOAD(SE, j + 3); SBAR();
    pv_d0(o, vb0 + SHM_V, pa0, pa1, pa2, pa3); partialSM(pA0, pA1, m_reg, mnA, alA);
    __syncthreads(); SWAIT(); SWRITE(1, SO);
    RESC(alA); __syncthreads();
  }
  SBAR(); qkt(pB0, pB1, K_lds + SHM_K, qr, r32, hi);
  finishSM(pA0, pA1, alA, l_reg, pa0, pa1, pa2, pa3); SBAR();
  pv_d0(o, vb0, pa0, pa1, pa2, pa3); partialSM(pB0, pB1, m_reg, mnB, alB);
  __syncthreads(); RESC(alB);
  finishSM(pB0, pB1, alB, l_reg, pa0, pa1, pa2, pa3); SBAR();
  pv_d0(o, vb0 + SHM_V, pa0, pa1, pa2, pa3);
  if (hi == 0) li_l[r32] = l_reg; asm volatile("s_waitcnt lgkmcnt(0)" ::: "memory");
  float rli[16];
#pragma unroll
  for (int r = 0; r < 16; ++r) rli[r] = __builtin_amdgcn_rcpf(li_l[crow(r, hi)]);
  bf16_t* Ow = Og + (size_t)(qrow0 + wid * QBLK) * ldo + 64 * h;
#pragma unroll
  for (int r = 0; r < 16; ++r) { const int orow = crow(r, hi);
#pragma unroll
    for (int d0 = 0; d0 < 2; ++d0) Ow[(size_t)orow * ldo + d0 * 32 + r32] = f2bf(o[d0][r] * rli[r]); }
#undef TROW
#undef SLOAD
#undef SWRITE
#undef SWAIT
#undef RESC
}
}

DI void phase_attention(const Params& P, int l, char* lds, bf16_t* Og, int ldo) {
    bf16_t* Q = (bf16_t*)(P.ws + WS_Q); const bf16_t* K = (const bf16_t*)(P.ws + WS_K); const bf16_t* V = (const bf16_t*)(P.ws + WS_V);
    for (int u = blockIdx.x; u < 1024; u += gridDim.x) {
        const int bh = (u >> 8) * 8 + (u & 7), qb = (u >> 3) & 31, b = bh >> 3, h = bh & 7;
        __syncthreads();
        att::attn_unit(Q, Og, ldo, K, V, b * SEQ + 256 * qb, h, TL + b * CTX, b * SEQ, 132, lds);
    }
    if (l == 0) {
        for (int u = blockIdx.x; u < 32; u += gridDim.x) {
            const int b = u >> 3, h = u & 7;
            __syncthreads();
            att::attn_unit(Q, Og, ldo, K, V, TL + b * CTX, h, TL + b * CTX, 0, 4, lds);
        }
    }
    __syncthreads();
}

namespace scn {
constexpr int RQ = 0, RK = 16384, RR = 32768;
constexpr int QD = 34816;
constexpr int KN = QD + 64 * 272;
constexpr int KET = KN + 64 * 272;
constexpr int VT = KET + 128 * 144;
constexpr int ST = VT + 128 * 144;
constexpr int PM = ST + 128 * 272;
constexpr int DEC = PM + 64 * 144;
constexpr int END = DEC + 512;
static_assert(END <= LDS_BYTES - 16, "scan LDS");
constexpr size_t US_OFF = 0, DL_OFF = (size_t)64 * 3 * 16384 * 2;
static_assert(DL_OFF + (size_t)64 * 3 * 128 * 4 <= (size_t)3584 * 1024 * 2, "scan hand-off must fit in the dead part of the weight region");
DI int crow(int r, int hi) { return (r & 3) + 8 * (r >> 2) + 4 * hi; }
#define SC_BAR() do { asm volatile("s_waitcnt lgkmcnt(0)" ::: "memory"); __builtin_amdgcn_s_barrier(); asm volatile("" ::: "memory"); } while (0)
#define SMFMA(a, b, c) __builtin_amdgcn_mfma_f32_32x32x16_bf16((a), (b), (c), 0, 0, 0)
}
DI void phase_scan(const Params& P, int l, char* lds, const int pass) {
    using namespace scn;
    const int tid = threadIdx.x, wid = tid >> 6, lane = tid & 63, r32 = lane & 31, hi = lane >> 5;
    const bf16_t* R4 = (const bf16_t*)(P.ws + WS_R4); const bf16_t* SM = (const bf16_t*)(P.ws + WS_SM);
    bf16_t* UST = (bf16_t*)(P.ws + WS_WT + US_OFF); float* DLG = (float*)(P.ws + WS_WT + DL_OFF);
    const int nitems = pass == 1 ? 192 : 256;
    for (int item = blockIdx.x; item < nitems; item += gridDim.x) {
        int seg, scan; if (pass == 1) { seg = item % 3; scan = item / 3; } else { seg = item & 3; scan = item >> 2; }
        const int dir = scan & 1, hd = (scan >> 1) & 7, b = scan >> 4;
        const bool gla = hd < 4; const int hh = hd & 3;
        const int qcol = gla ? hh * 128 : 1536 + hh * 128, kcol = gla ? 512 + hh * 128 : 2048 + hh * 128, vcol = (gla ? 1024 : 2560) + hh * 128;
        bf16_t* Od = (bf16_t*)(P.ws + (dir ? WS_OB : WS_OF)); const int ocol = hd * 128;
        const int pti = wid >> 2, pdj = wid & 3, pd = 32 * pdj + r32;
        const int vt = wid >> 1, dt0 = 2 * (wid & 1);
        bf16x8 w2h = {0, 0, 0, 0, 0, 0, 0, 0}, w2l = {0, 0, 0, 0, 0, 0, 0, 0}; float bias = 0.f, lg = 0.f;
        if (gla) { const float* W2 = P.in[I_GK2] + (size_t)(l * 2 + dir) * 16 * 512 + hh * 128 + pd;
#pragma unroll
            for (int j = 0; j < 8; ++j) { const float w = W2[(8 * hi + j) * 512]; const unsigned u = __float_as_uint(w) & 0xffff0000u; const float res = w - __uint_as_float(u);
                w2h[j] = (short)(u >> 16); w2l[j] = (short)(__float_as_uint(res) >> 16); }
            bias = P.in[I_BGK][(l * 2 + dir) * 512 + hh * 128 + pd]; }
        else lg = -expf(P.in[I_RDEC][(l * 2 + dir) * 4 + hh]);
        f32x16 S0 = {}, S1 = {}; float clsum = 0.f;
        __syncthreads();
        if (pass == 2) {
            for (int sp = 0; sp < seg; ++sp) {
                const bf16_t* U = UST + (size_t)(scan * 3 + sp) * 16384; const float* DL = DLG + (size_t)(scan * 3 + sp) * 128;
                const float e0 = __expf(DL[32 * dt0 + r32]), e1 = __expf(DL[32 * (dt0 + 1) + r32]);
#pragma unroll
                for (int r = 0; r < 16; ++r) { const int v = 32 * vt + crow(r, hi);
                    S0[r] = S0[r] * e0 + bf2f(U[v * 128 + 32 * dt0 + r32]); S1[r] = S1[r] * e1 + bf2f(U[v * 128 + 32 * (dt0 + 1) + r32]); }
            }
#pragma unroll
            for (int r = 0; r < 16; ++r) { const int v = 32 * vt + crow(r, hi);
                *(bf16_t*)(lds + ST + v * 272 + (32 * dt0 + r32) * 2) = f2bf(S0[r]); *(bf16_t*)(lds + ST + v * 272 + (32 * (dt0 + 1) + r32) * 2) = f2bf(S1[r]); }
            { const int i = tid >> 4, j = 32 + (tid & 15) * 2; *(unsigned*)(lds + PM + i * 144 + j * 2) = 0u; }
        }
        u32x4 pq0 = {0u, 0u, 0u, 0u}, pq1 = pq0, pk0, pk1, pr = pq0, pv0, pv1;
#define ROWBASE(n) (dir == 0 ? ((n) < 4 ? TL + b * CTX + 64 * (n) : b * SEQ + 64 * ((n) - 4)) : ((n) < 4 ? TL + b * CTX + 64 * (3 - (n)) : b * SEQ + 64 * (127 - ((n) - 4))))
#define SC_LOADQK(n) do { const int rb_ = ROWBASE(n); \
        if (pass == 2) { pq0 = *(const u32x4*)(R4 + (size_t)(rb_ + (tid >> 4)) * 3072 + qcol + 8 * (tid & 15)); pq1 = *(const u32x4*)(R4 + (size_t)(rb_ + 32 + (tid >> 4)) * 3072 + qcol + 8 * (tid & 15)); } \
        pk0 = *(const u32x4*)(R4 + (size_t)(rb_ + (tid >> 4)) * 3072 + kcol + 8 * (tid & 15)); pk1 = *(const u32x4*)(R4 + (size_t)(rb_ + 32 + (tid >> 4)) * 3072 + kcol + 8 * (tid & 15)); \
        if (tid < 128) pr = *(const u32x4*)(SM + (size_t)(rb_ + (tid >> 1)) * 512 + 416 + dir * 16 + 8 * (tid & 1)); } while (0)
#define SC_LOADV(n) do { const int rb_ = ROWBASE(n); \
        pv0 = *(const u32x4*)(R4 + (size_t)(rb_ + lane) * 3072 + vcol + 8 * wid); pv1 = *(const u32x4*)(R4 + (size_t)(rb_ + lane) * 3072 + vcol + 64 + 8 * wid); } while (0)
#define SC_STOREQK() do { if (pass == 2) { *(u32x4*)(lds + RQ + sr0 * 256 + (tid & 15) * 16) = pq0; *(u32x4*)(lds + RQ + sr1 * 256 + (tid & 15) * 16) = pq1; } \
        *(u32x4*)(lds + RK + sr0 * 256 + (tid & 15) * 16) = pk0; *(u32x4*)(lds + RK + sr1 * 256 + (tid & 15) * 16) = pk1; \
        if (tid < 128) *(u32x4*)(lds + RR + srr * 32 + (tid & 1) * 16) = pr; } while (0)
        const int sr0 = dir ? 63 - (tid >> 4) : (tid >> 4), sr1 = dir ? 31 - (tid >> 4) : 32 + (tid >> 4);
        const int srr = dir ? 63 - (tid >> 1) : (tid >> 1), svi = dir ? 63 - lane : lane;
        const int n0 = 33 * seg;
        SC_LOADQK(n0); SC_STOREQK(); SC_LOADQK(n0 + 1); SC_LOADV(n0);
        for (int n = n0; n < n0 + 33; ++n) {
            int r32v = r32, hiv = hi; asm volatile("" : "+v"(r32v), "+v"(hiv));
            SC_BAR();
            { char* vb = lds + VT + (8 * wid) * 144 + svi * 2;
              const unsigned w0[4] = {pv0.x, pv0.y, pv0.z, pv0.w}, w1[4] = {pv1.x, pv1.y, pv1.z, pv1.w};
#pragma unroll
              for (int e = 0; e < 4; ++e) { *(bf16_t*)(vb + (2 * e) * 144) = (bf16_t)(w0[e] & 0xffffu); *(bf16_t*)(vb + (2 * e + 1) * 144) = (bf16_t)(w0[e] >> 16);
                  *(bf16_t*)(vb + (64 + 2 * e) * 144) = (bf16_t)(w1[e] & 0xffffu); *(bf16_t*)(vb + (64 + 2 * e + 1) * 144) = (bf16_t)(w1[e] >> 16); }
              if (n + 1 < n0 + 33) SC_LOADV(n + 1); }
            {
                f32x16 cum; float cl;
                if (gla) {
                    f32x16 la0, la1;
                    { const bf16x8 a0 = *(const bf16x8*)(lds + RR + r32v * 32 + hiv * 16), a1 = *(const bf16x8*)(lds + RR + (32 + r32v) * 32 + hiv * 16);
                      la0 = SMFMA(a0, w2h, (f32x16{})); la0 = SMFMA(a0, w2l, la0); la1 = SMFMA(a1, w2h, (f32x16{})); la1 = SMFMA(a1, w2l, la1); }
                    float ssum = 0.f;
#pragma unroll
                    for (int r = 0; r < 16; ++r) { const float x0 = la0[r] + bias, x1 = la1[r] + bias;
                        la0[r] = (fminf(x0, 0.f) - __logf(1.f + __expf(-fabsf(x0)))) * (1.f / 16.f);
                        la1[r] = (fminf(x1, 0.f) - __logf(1.f + __expf(-fabsf(x1)))) * (1.f / 16.f);
                        ssum += la0[r] + la1[r]; }
                    cl = ssum + __shfl_xor(ssum, 32);
                    __builtin_amdgcn_sched_barrier(0);
                    cum = f32x16{};
                    bf16x8 tri0, tri1;
#pragma unroll
                    for (int j = 0; j < 8; ++j) { const int k0 = 8 * (j >> 2) + 4 * hiv + (j & 3);
                        tri0[j] = (short)(r32v >= k0 ? 0x3F80 : 0); tri1[j] = (short)(r32v >= k0 + 16 ? 0x3F80 : 0); }
                    const bf16x8 ones = {0x3F80, 0x3F80, 0x3F80, 0x3F80, 0x3F80, 0x3F80, 0x3F80, 0x3F80};
                    const bf16x8 atk0_0 = pti ? ones : tri0, atk0_1 = pti ? ones : tri1;
#pragma unroll
                    for (int st = 0; st < 2; ++st) { bf16x8 h8, l8;
#pragma unroll
                        for (int j = 0; j < 8; ++j) { const float v = la0[8 * st + j]; const unsigned u = __float_as_uint(v) & 0xffff0000u; const float res = v - __uint_as_float(u);
                            h8[j] = (short)(u >> 16); l8[j] = (short)(__float_as_uint(res) >> 16); }
                        const bf16x8 am = st ? atk0_1 : atk0_0; cum = SMFMA(am, h8, cum); cum = SMFMA(am, l8, cum); }
                    if (pti) {
#pragma unroll
                        for (int st = 0; st < 2; ++st) { bf16x8 h8, l8;
#pragma unroll
                            for (int j = 0; j < 8; ++j) { const float v = la1[8 * st + j]; const unsigned u = __float_as_uint(v) & 0xffff0000u; const float res = v - __uint_as_float(u);
                                h8[j] = (short)(u >> 16); l8[j] = (short)(__float_as_uint(res) >> 16); }
                            const bf16x8 am = st ? tri1 : tri0; cum = SMFMA(am, h8, cum); cum = SMFMA(am, l8, cum); } }
                    __builtin_amdgcn_sched_barrier(0);
                } else {
#pragma unroll
                    for (int r = 0; r < 16; ++r) cum[r] = (float)(32 * pti + crow(r, hiv) + 1) * lg;
                    cl = 64.f * lg;
                }
                clsum += cl;
                {
                    const int ibase = 32 * pti + 4 * hiv; const float ecl = __expf(cl);
                    const char* rqb = lds + RQ + ibase * 256 + pd * 2; const char* rkb = lds + RK + ibase * 256 + pd * 2;
                    char* qdb = lds + QD + ibase * 272 + pd * 2; char* knb = lds + KN + ibase * 272 + pd * 2; char* keb = lds + KET + pd * 144 + ibase * 2;
                    if (pass == 2) {
#pragma unroll
                        for (int r = 0; r < 16; ++r) { const int cr = (r & 3) + 8 * (r >> 2);
                            const float c = cum[r]; const float e1 = __expf(c), e2 = __expf(-c);
                            const float q = bf2f(*(const bf16_t*)(rqb + cr * 256)), k = bf2f(*(const bf16_t*)(rkb + cr * 256));
                            const float kn = k * e2;
                            *(bf16_t*)(qdb + cr * 272) = f2bf(q * e1);
                            *(bf16_t*)(knb + cr * 272) = f2bf(kn);
                            *(bf16_t*)(keb + cr * 2) = f2bf(kn * ecl);
                            if ((r & 3) == 3) { asm volatile("" ::: "memory"); } }
                    } else {
#pragma unroll
                        for (int r = 0; r < 16; ++r) { const int cr = (r & 3) + 8 * (r >> 2);
                            const float k = bf2f(*(const bf16_t*)(rkb + cr * 256));
                            *(bf16_t*)(keb + cr * 2) = f2bf(k * __expf(cl - cum[r]));
                            if ((r & 3) == 3) { asm volatile("" ::: "memory"); } }
                    }
                    if (pti == 0 && hiv == 0) *(float*)(lds + DEC + pd * 4) = ecl;
                }
            }
            SC_BAR();
            if (n + 1 < n0 + 33) { SC_STOREQK(); if (n + 2 < n0 + 33) SC_LOADQK(n + 2); }
            f32x16 oacc = {};
            if (pass == 2) {
                if (wid < 3) {
                    const int ti = (wid + 1) >> 1, tj = wid >> 1; f32x16 T0 = {};
#pragma unroll
                    for (int kk = 0; kk < 8; ++kk) { const bf16x8 a = *(const bf16x8*)(lds + QD + (32 * ti + r32v) * 272 + (16 * kk + 8 * hiv) * 2), bb = *(const bf16x8*)(lds + KN + (32 * tj + r32v) * 272 + (16 * kk + 8 * hiv) * 2);
                        T0 = SMFMA(a, bb, T0); }
#pragma unroll
                    for (int r = 0; r < 16; ++r) { const int cr = (r & 3) + 8 * (r >> 2); const int ib = 32 * ti + 4 * hiv, j = 32 * tj + r32v; int jm = j - (dir ? 0 : 1) - ib; asm volatile("" : "+v"(jm));
                        *(bf16_t*)(lds + PM + ib * 144 + j * 2 + cr * 144) = f2bf(cr > jm ? T0[r] : 0.f); }
                }
                { const int ti = wid >> 2, vj = wid & 3;
#pragma unroll
                  for (int kk = 0; kk < 8; ++kk) { const bf16x8 a = *(const bf16x8*)(lds + QD + (32 * ti + r32v) * 272 + (16 * kk + 8 * hiv) * 2), bb = *(const bf16x8*)(lds + ST + (32 * vj + r32v) * 272 + (16 * kk + 8 * hiv) * 2);
                      oacc = SMFMA(a, bb, oacc); } }
            }
            {
                const float dc0 = *(const float*)(lds + DEC + (32 * dt0 + r32v) * 4), dc1 = *(const float*)(lds + DEC + (32 * (dt0 + 1) + r32v) * 4);
#pragma unroll
                for (int r = 0; r < 16; ++r) { S0[r] *= dc0; S1[r] *= dc1; }
#pragma unroll
                for (int kk = 0; kk < 4; ++kk) { const bf16x8 a = *(const bf16x8*)(lds + VT + (32 * vt + r32v) * 144 + (16 * kk + 8 * hiv) * 2);
                    const bf16x8 b0 = *(const bf16x8*)(lds + KET + (32 * dt0 + r32v) * 144 + (16 * kk + 8 * hiv) * 2), b1 = *(const bf16x8*)(lds + KET + (32 * (dt0 + 1) + r32v) * 144 + (16 * kk + 8 * hiv) * 2);
                    S0 = SMFMA(a, b0, S0); S1 = SMFMA(a, b1, S1); }
            }
            if (pass == 2) {
                SC_BAR();
                { const int ti = wid >> 2, vj = wid & 3;
#pragma unroll
                  for (int kk = 0; kk < 4; ++kk) { const bf16x8 a = *(const bf16x8*)(lds + PM + (32 * ti + r32v) * 144 + (16 * kk + 8 * hiv) * 2), bb = *(const bf16x8*)(lds + VT + (32 * vj + r32v) * 144 + (16 * kk + 8 * hiv) * 2);
                      oacc = SMFMA(a, bb, oacc); }
                  const int rb = ROWBASE(n);
#pragma unroll
                  for (int r = 0; r < 16; ++r) { const int i = 32 * ti + crow(r, hiv), row = rb + (dir ? 63 - i : i);
                      Od[(size_t)row * 1024 + ocol + 32 * vj + r32v] = f2bf(oacc[r]); } }
#pragma unroll
                for (int r = 0; r < 16; ++r) { const int cr = (r & 3) + 8 * (r >> 2); char* stb = lds + ST + (32 * vt + 4 * hiv) * 272 + (32 * dt0 + r32v) * 2;
                    *(bf16_t*)(stb + cr * 272) = f2bf(S0[r]); *(bf16_t*)(stb + cr * 272 + 64) = f2bf(S1[r]); }
            }
        }
        if (pass == 1) {
            bf16_t* U = UST + (size_t)(scan * 3 + seg) * 16384;
#pragma unroll
            for (int r = 0; r < 16; ++r) { const int v = 32 * vt + crow(r, hi);
                U[v * 128 + 32 * dt0 + r32] = f2bf(S0[r]); U[v * 128 + 32 * (dt0 + 1) + r32] = f2bf(S1[r]); }
            if (pti == 0 && hi == 0) DLG[(size_t)(scan * 3 + seg) * 128 + pd] = clsum;
        }
#undef ROWBASE
#undef SC_LOADQK
#undef SC_LOADV
#undef SC_STOREQK
    }
    __syncthreads();
}

constexpr int PH_PER_LAYER = 16, N_PHASES = 1 + 2 * PH_PER_LAYER;
#ifndef PHEN
#define PHEN(q) 1
#endif
#ifdef PROBE_GEMM
#define REPG for (int rep_ = 0; rep_ < 2; ++rep_)
#else
#define REPG
#endif
#ifdef PROBE_EW
#define REPE for (int rep_ = 0; rep_ < 2; ++rep_)
#else
#define REPE
#endif
#define PH(k) if (lo <= (k) && (k) < hi && ((k) == lo || (xcd_barrier(xbar), true)))
template <int l>
DI void layer_program(const Params& P, int lo, int hi, LAS unsigned char* lds, unsigned char* lds_raw, const XcdBarrier& xbar) {
    constexpr int base = 1 + PH_PER_LAYER * l;
    constexpr int Mlat = (l == 0) ? TA : TL;
#define WSP(T, off) ((T*)(P.ws + (off)))
#define MODL (WSP(const float, WS_MOD) + (size_t)l * 5 * 6144)
#define HIN_L ((l == 0) ? P.in[I_X] : (const float*)P.out)
#define HIN_C ((l == 0) ? P.in[I_CTX] : WSP(const float, WS_HC))
    PH(base + 0) if (PHEN(0)) REPE { phase_norm(HIN_L, HIN_C, P.in[I_N1W] + l * DM, MODL, 0, 1, WSP(bf16_t, WS_A), TA); phase_wconv_mixer(P, l, lds); }
    PH(base + 1) if (PHEN(1)) REPG { Epi<EM_PLAIN> E{}; E.O0 = WSP(bf16_t, WS_SM); E.ld0 = 512; run_gemm<EM_PLAIN>(lds, WSP(bf16_t, WS_A), 1024, WSP(bf16_t, WS_WT) + WT_IN, TA, 512, 1024, E); }
    PH(base + 2) if (PHEN(2)) REPG { { Epi<EM_PLAIN> E{}; E.O0 = WSP(bf16_t, WS_Q); E.ld0 = 768; run_gemm<EM_PLAIN>(lds, WSP(bf16_t, WS_SM), 512, WSP(bf16_t, WS_WT) + WT_QB, TA, 768, 256, E); }
                  { Epi<EM_KV> E2{}; E2.O0 = WSP(bf16_t, WS_K); E2.O1 = WSP(bf16_t, WS_V); run_gemm<EM_KV>(lds, WSP(bf16_t, WS_SM) + 256, 512, WSP(bf16_t, WS_WT) + WT_KVB, TA, 1024, 128, E2); } }
    PH(base + 3) if (PHEN(3)) phase_qkpost(P, l);
    PH(base + 4) if (PHEN(4)) {
#ifdef PROBE_ATTN
        phase_attention(P, l, (char*)lds_raw, WSP(bf16_t, WS_OF), 1024);
#endif
        phase_attention(P, l, (char*)lds_raw, WSP(bf16_t, WS_Q), 768); }
    PH(base + 5) if (PHEN(5)) REPG { Epi<EM_BIG> E{}; E.O0 = WSP(bf16_t, WS_R4); E.fa = WSP(const float, WS_ROT); run_gemm<EM_BIG>(lds, WSP(bf16_t, WS_A), 1024, WSP(bf16_t, WS_WT) + WT_IN + (size_t)512 * 1024, TA, 3072, 1024, E); }
    PH(base + 6) if (PHEN(6)) phase_scan(P, l, (char*)lds_raw, 1);
    PH(base + 7) if (PHEN(6)) phase_scan(P, l, (char*)lds_raw, 2);
    PH(base + 8) if (PHEN(7)) phase_scanpost(P, l, Mlat);
    PH(base + 9) if (PHEN(8)) { Epi<EM_GATES> E{}; E.O0 = WSP(bf16_t, WS_R4); E.O1 = WSP(bf16_t, WS_OF); E.fa = P.in[I_BGATE] + (size_t)l * 3072; run_gemm<EM_GATES>(lds, WSP(bf16_t, WS_A), 1024, WSP(bf16_t, WS_WT) + WT_IN + (size_t)3584 * 1024, Mlat, 4096, 1024, E); }
    PH(base + 10) if (PHEN(9)) REPG {
        { Epi<EM_BRANCH> E{}; E.O0 = WSP(bf16_t, WS_OB); E.Gsrc = WSP(bf16_t, WS_R4); E.ipar = 0; run_gemm<EM_BRANCH>(lds, WSP(bf16_t, WS_Q), 768, WSP(bf16_t, WS_WT) + WT_BR, Mlat, 1024, 512, E); }
        { Epi<EM_BRANCH> E{}; E.O0 = WSP(bf16_t, WS_OB); E.Gsrc = WSP(bf16_t, WS_R4) + 1024; E.ipar = 1; run_gemm<EM_BRANCH>(lds, WSP(bf16_t, WS_OF), 1024, WSP(bf16_t, WS_WT) + WT_BR + (size_t)1024 * 512, Mlat, 1024, 512, E); }
        { Epi<EM_BRANCH> E{}; E.O0 = WSP(bf16_t, WS_OB); E.Gsrc = WSP(bf16_t, WS_R4) + 2048; E.ipar = 2; run_gemm<EM_BRANCH>(lds, WSP(bf16_t, WS_OF) + 512, 1024, WSP(bf16_t, WS_WT) + WT_BR + (size_t)2048 * 512, Mlat, 1024, 512, E); } }
    PH(base + 11) if (PHEN(10)) { Epi<EM_RES> E{}; E.fa = MODL; E.ipar = 2; E.hin_l = HIN_L; E.hin_c = HIN_C; E.hout_l = P.out; E.hout_c = WSP(float, WS_HC);
                   run_gemm<EM_RES>(lds, WSP(bf16_t, WS_OB), 1024, WSP(bf16_t, WS_WT) + WT_OUT, Mlat, 1024, 1024, E); }
    PH(base + 12) if (PHEN(11)) REPE { phase_norm(P.out, WSP(const float, WS_HC), P.in[I_N2W] + l * DM, MODL, 3, 4, WSP(bf16_t, WS_A), Mlat); phase_wconv_ffn(P, l, lds); }
    PH(base + 13) if (PHEN(12)) REPG { Epi<EM_FFNIN> E{}; E.O0 = WSP(bf16_t, WS_G); E.O1 = WSP(bf16_t, WS_U); run_gemm<EM_FFNIN>(lds, WSP(bf16_t, WS_A), 1024, WSP(bf16_t, WS_WT) + WT_F1, Mlat, 5632, 1024, E); }
    PH(base + 14) if (PHEN(13)) phase_conv(P, l, Mlat);
    PH(base + 15) if (PHEN(14)) { Epi<EM_RES> E{}; E.fa = MODL; E.ipar = 5; E.hin_l = P.out; E.hin_c = WSP(const float, WS_HC); E.hout_l = P.out; E.hout_c = WSP(float, WS_HC);
                   run_gemm<EM_RES>(lds, WSP(bf16_t, WS_U), DFF, WSP(bf16_t, WS_WT) + WT_F2, Mlat, 1024, DFF, E); }
}
__global__ void __launch_bounds__(NTHREADS, 2) fwd_kernel(Params P) {
    extern __shared__ __attribute__((aligned(16))) unsigned char lds_raw[];
    LAS unsigned char* lds = (LAS unsigned char*)lds_raw;
    cg::grid_group grid = cg::this_grid();
    const int lo = P.ph_lo, hi = P.ph_hi;
    Params* G = (Params*)(P.ws + WS_PAR + (size_t)blockIdx.x * 256);
    if (threadIdx.x == 0) {
#pragma unroll
        for (int i = 0; i < 26; ++i) G->in[i] = P.in[i];
        G->out = P.out; G->ws = P.ws; G->ph_lo = lo; G->ph_hi = hi;
    }
    __syncthreads();
    asm volatile("" ::: "memory");
    const Params& Q = *G;
    if (threadIdx.x < 4) ((LAS unsigned*)(lds + LDS_BARW))[threadIdx.x] = 0u;
    __syncthreads();
    const XcdBarrier xbar = xcd_barrier_post((unsigned*)(P.ws + WS_BAR), (volatile LAS unsigned*)(lds + LDS_BARW));
    if (lo < 0) grid.sync();
    PH(0) REPE phase_prologue(Q, lds);
    layer_program<0>(Q, lo, hi, lds, lds_raw, xbar);
    layer_program<1>(Q, lo, hi, lds, lds_raw, xbar);
#ifdef PROBE_SYNC
    for (int i = 0; i < 20; ++i) xcd_barrier(xbar);
#endif
}

#ifndef N_LAUNCH_MODE
#define N_LAUNCH_MODE 1
#endif
extern "C" void kernel_launch(void* const* d_in, const int* in_sizes, int n_in, void* d_out, int out_size, void* d_ws, size_t ws_size, hipStream_t stream) {
    static int grid_blocks = 0;
    if (!grid_blocks) {
        if (n_in != 26 || ws_size < WS_NEED) { fprintf(stderr, "kernel_launch: bad inputs (n_in %d, ws %zu < %zu)\n", n_in, ws_size, (size_t)WS_NEED); return; }
        if (hipFuncSetAttribute((const void*)fwd_kernel, hipFuncAttributeMaxDynamicSharedMemorySize, LDS_BYTES) != hipSuccess) { fprintf(stderr, "kernel_launch: hipFuncSetAttribute failed\n"); return; }
        int dev = 0, cus = 0, per_cu = 0;
        hipGetDevice(&dev);
        hipDeviceGetAttribute(&cus, hipDeviceAttributeMultiprocessorCount, dev);
        hipOccupancyMaxActiveBlocksPerMultiprocessor(&per_cu, fwd_kernel, NTHREADS, LDS_BYTES);
        if (per_cu < 1) { fprintf(stderr, "kernel_launch: occupancy query returned %d\n", per_cu); return; }
        grid_blocks = cus * 1;
    }
    Params p{};
    for (int i = 0; i < 26; ++i) p.in[i] = (const float*)d_in[i];
    p.out = (float*)d_out; p.ws = (unsigned char*)d_ws;
#if N_LAUNCH_MODE == 1
    p.ph_lo = 0; p.ph_hi = N_PHASES;
    if (hipMemsetAsync((unsigned char*)d_ws + WS_BAR, 0, XCD_BAR_WORDS * 4, stream) != hipSuccess) { fprintf(stderr, "kernel_launch: memset of the barrier words failed\n"); return; }
    void* args[] = {&p};
    hipError_t e = hipLaunchCooperativeKernel((const void*)fwd_kernel, dim3(grid_blocks), dim3(NTHREADS), args, LDS_BYTES, stream);
    if (e != hipSuccess) fprintf(stderr, "cooperative launch failed: %s (grid %d)\n", hipGetErrorString(e), grid_blocks);
#else
    for (int ph = 0; ph < N_PHASES; ++ph) {
        p.ph_lo = ph; p.ph_hi = ph + 1;
        hipLaunchKernelGGL(fwd_kernel, dim3(grid_blocks), dim3(NTHREADS), LDS_BYTES, stream, p);
    }
#endif
}
```

```cpp
#include <hip/hip_runtime.h>
#include <hip/hip_bf16.h>
#include <hip/hip_cooperative_groups.h>
#include <cstdio>
#include <cstdint>
namespace cg = cooperative_groups;
#define DI __device__ __forceinline__
#define LAS __attribute__((address_space(3)))
namespace pg8 {
#define PG8_LAS __attribute__((address_space(3)))
typedef unsigned short bf16_t;
typedef short bf16x8 __attribute__((ext_vector_type(8)));
typedef float f32x4 __attribute__((ext_vector_type(4)));
typedef unsigned u32x4 __attribute__((ext_vector_type(4)));
constexpr int BM = 256, BK = 64, HALF = 128, HTB = HALF * BK * 2  , STAGE_BYTES = 8 * HTB, NXCD = 8, WGM = 8;

__host__ __device__ __forceinline__ int lds_byte(int r, int c) { const int st = (r >> 4) * 2 + (c >> 5), rr = r & 15, cc = c & 31, ob = rr * 64 + cc * 2; return st * 1024 + (ob ^ (((ob >> 9) & 1) << 5)); }
__host__ __device__ __forceinline__ void stage_rc(int b, int& R, int& C) { const int st = b / 1024, sb = b % 1024, swz = sb ^ (((sb >> 9) & 1) << 5); R = (st >> 1) * 16 + swz / 64; C = (st & 1) * 32 + (swz % 64) / 2; }
__host__ __device__ __forceinline__ int perm32(int rho) { const int n = rho >> 4, i = rho & 15; return 8 * (i >> 2) + 4 * n + (i & 3); }

struct Unit { int pm, pn; };
struct Gemm { const bf16_t* A; const bf16_t* Bt; int M, N, K, lda; };

struct StaticOrder {
    int nM, nN, nwg, G, c;
    __host__ __device__ void init(int M, int N, int G_, int c_) { nM = M / BM; nN = N / BM; nwg = nM * nN; G = G_; c = c_; }
    __host__ __device__ bool next(int i, Unit& u) const {
        const long L = (long)i * G + c; if (L >= nwg) return false;
        int wgid = (int)L; { const int q = nwg / NXCD, r = nwg % NXCD, xcd = wgid % NXCD, off = wgid / NXCD; wgid = (xcd < r ? xcd * (q + 1) : r * (q + 1) + (xcd - r) * q) + off; }
        const int nig = WGM * nN, gid = wgid / nig, fm = gid * WGM, gsz = (nM - fm) < WGM ? (nM - fm) : WGM;
        u.pm = fm + ((wgid % nig) % gsz); u.pn = (wgid % nig) / gsz; return true;
    }
    __device__ __forceinline__ void a_ready(const Unit&) const {}
    __device__ __forceinline__ void done(const Unit&) const {}
};

__device__ __forceinline__ unsigned cvt_pk_bf16(float lo, float hi) { unsigned r; asm volatile("v_cvt_pk_bf16_f32 %0, %1, %2" : "=v"(r) : "v"(lo), "v"(hi)); return r; }
template <class Epi, class Sched, bool ALIGN_EPI = false, bool SP2 = false>
__device__ __forceinline__ void gemm_phase(PG8_LAS unsigned char* lds, const Gemm g, const Sched& S, const Epi& E) {
    const int tid = threadIdx.x, wid = __builtin_amdgcn_readfirstlane(tid >> 6), lane = tid & 63, wr = wid >> 2, wc = wid & 3, fr = lane & 15, fq = lane >> 4;
    const int K = g.K, nt = K / BK;
    unsigned voffA[2], voffB[2];
#pragma unroll
    for (int i = 0; i < 2; ++i) { int R, C; stage_rc(tid * 16 + i * 8192, R, C); const int Rb = Epi::PERM ? ((R & ~31) + perm32(R & 31)) : R;
        voffA[i] = (unsigned)(R * g.lda + C) * 2u; voffB[i] = (unsigned)(Rb * K + C) * 2u; }
    const size_t kstep = (size_t)(BK * 2);
    const size_t hstep = (size_t)HALF * K * 2;
    const size_t tstep = 2 * hstep; const size_t hstepA = (size_t)HALF * g.lda * 2; const size_t tstepA = 2 * hstepA;
    const unsigned ldsw = (unsigned)wid * 1024u;
    const int aoff = lds_byte(wr * 64 + fr, fq * 8), boff = lds_byte(wc * 32 + fr, fq * 8);
#define PG8_SA(b, h) (((b) * 2 + (h)) * HTB)
#define PG8_SB(b, h) ((4 + (b) * 2 + (h)) * HTB)
#define PG8_STAGE(bufoff, gbase, voff) do { _Pragma("unroll") for (int _i = 0; _i < 2; ++_i) \
        __builtin_amdgcn_global_load_lds((const unsigned*)((const char*)(gbase) + (voff)[_i]), (PG8_LAS unsigned*)(lds + (bufoff) + ldsw + _i * 8192), 16, 0, 0); } while (0)
#define PG8_LDA(dst, b, h) do { _Pragma("unroll") for (int m = 0; m < 4; ++m) _Pragma("unroll") for (int k = 0; k < 2; ++k) dst[m][k] = *(const PG8_LAS bf16x8*)(lds + PG8_SA(b, h) + aoff + m * 2048 + k * 1024); } while (0)
#define PG8_LDB(dst, b, h) do { _Pragma("unroll") for (int n = 0; n < 2; ++n) _Pragma("unroll") for (int k = 0; k < 2; ++k) dst[n][k] = *(const PG8_LAS bf16x8*)(lds + PG8_SB(b, h) + boff + n * 2048 + k * 1024); } while (0)
#define PG8_MMA(ai, bj, At, Bt) do { __builtin_amdgcn_s_setprio(1); _Pragma("unroll") for (int m = 0; m < 4; ++m) _Pragma("unroll") for (int n = 0; n < 2; ++n) _Pragma("unroll") for (int k = 0; k < 2; ++k) \
        acc[ai][bj][m][n] = __builtin_amdgcn_mfma_f32_16x16x32_bf16(Bt[n][k], At[m][k], acc[ai][bj][m][n], 0, 0, 0); __builtin_amdgcn_s_setprio(0); } while (0)
#define PG8_WAIT_V(n) asm volatile("s_waitcnt vmcnt(" #n ")" ::: "memory")
#define PG8_WAIT_L(n) asm volatile("s_waitcnt lgkmcnt(" #n ")" ::: "memory")
#define PG8_BAR __builtin_amdgcn_s_barrier()
#define PG8_SCHED __builtin_amdgcn_sched_barrier(0)
    Unit cur, nxt; int ui = 0;
    if (!S.next(0, cur)) return;
    f32x4 acc[2][2][4][2];
#pragma unroll
    for (int a = 0; a < 2; ++a)
#pragma unroll
        for (int b = 0; b < 2; ++b)
#pragma unroll
            for (int m = 0; m < 4; ++m)
#pragma unroll
                for (int n = 0; n < 2; ++n) acc[a][b][m][n] = (f32x4){0.f, 0.f, 0.f, 0.f};
    bf16x8 At[4][2], B0[2][2], B1[2][2];
    const char* cA = (const char*)g.A + (size_t)cur.pm * tstepA; const char* cB = (const char*)g.Bt + (size_t)cur.pn * tstep;
    S.a_ready(cur);
    if constexpr (SP2) {
        PG8_STAGE(PG8_SB(0, 0), cB, voffB); PG8_STAGE(PG8_SB(0, 1), cB + hstep, voffB); PG8_STAGE(PG8_SA(0, 0), cA, voffA); PG8_STAGE(PG8_SA(0, 1), cA + hstepA, voffA);
        if (wr == 1) PG8_BAR;
        PG8_WAIT_V(2); PG8_BAR;
        PG8_STAGE(PG8_SB(1, 0), cB + kstep, voffB); PG8_STAGE(PG8_SA(1, 0), cA + kstep, voffA); PG8_STAGE(PG8_SB(1, 1), cB + hstep + kstep, voffB);
        PG8_WAIT_V(6); PG8_BAR;
    } else {
        PG8_STAGE(PG8_SB(0, 0), cB, voffB); PG8_STAGE(PG8_SA(0, 0), cA, voffA); PG8_STAGE(PG8_SB(0, 1), cB + hstep, voffB); PG8_STAGE(PG8_SA(0, 1), cA + hstepA, voffA);
        if (wr == 1) PG8_BAR;
        PG8_WAIT_V(4); PG8_BAR;
        PG8_STAGE(PG8_SB(1, 0), cB + kstep, voffB); PG8_STAGE(PG8_SA(1, 0), cA + kstep, voffA); PG8_STAGE(PG8_SB(1, 1), cB + hstep + kstep, voffB);
        PG8_WAIT_V(6); PG8_BAR;
    }
    for (;;) {
        const bool has_next = S.next(ui + 1, nxt);
        const char* nA = has_next ? (const char*)g.A + (size_t)nxt.pm * tstepA : cA; const char* nB = has_next ? (const char*)g.Bt + (size_t)nxt.pn * tstep : cB;
        for (int t = 0; t < nt; t += 2) {
            const bool last = (t == nt - 2);
            const char* a1 = cA + (size_t)(t + 1) * kstep;
            const char* a2 = last ? nA : cA + (size_t)(t + 2) * kstep; const char* b2 = last ? nB : cB + (size_t)(t + 2) * kstep;
            const char* a3 = a2 + kstep; const char* b3 = b2 + kstep;
            if (last && has_next) S.a_ready(nxt);
            if constexpr (SP2) {
            PG8_LDB(B0, 0, 0); PG8_LDB(B1, 0, 1); PG8_SCHED; PG8_LDA(At, 0, 0); PG8_STAGE(PG8_SA(1, 1), a1 + hstepA, voffA);
            PG8_WAIT_V(8); PG8_WAIT_L(0); PG8_BAR; PG8_MMA(0, 0, At, B0); PG8_MMA(0, 1, At, B1); PG8_BAR; PG8_SCHED;
            PG8_LDA(At, 0, 1); PG8_STAGE(PG8_SB(0, 0), b2, voffB); PG8_STAGE(PG8_SB(0, 1), b2 + hstep, voffB); PG8_STAGE(PG8_SA(0, 0), a2, voffA);
            PG8_WAIT_V(8); PG8_WAIT_L(0); PG8_BAR; PG8_MMA(1, 0, At, B0); PG8_MMA(1, 1, At, B1); PG8_BAR; PG8_SCHED;
            PG8_LDB(B0, 1, 0); PG8_LDB(B1, 1, 1); PG8_SCHED; PG8_LDA(At, 1, 0); PG8_STAGE(PG8_SA(0, 1), a2 + hstepA, voffA);
            PG8_WAIT_V(8); PG8_WAIT_L(0); PG8_BAR; PG8_MMA(0, 0, At, B0); PG8_MMA(0, 1, At, B1); PG8_BAR; PG8_SCHED;
            PG8_LDA(At, 1, 1); PG8_STAGE(PG8_SB(1, 0), b3, voffB); PG8_STAGE(PG8_SB(1, 1), b3 + hstep, voffB); PG8_STAGE(PG8_SA(1, 0), a3, voffA);
            PG8_WAIT_V(8); PG8_WAIT_L(0); PG8_BAR; PG8_MMA(1, 0, At, B0); PG8_MMA(1, 1, At, B1); PG8_BAR; PG8_SCHED;
            } else {
            PG8_LDB(B0, 0, 0); PG8_SCHED; PG8_LDA(At, 0, 0); PG8_STAGE(PG8_SA(1, 1), a1 + hstepA, voffA);
            PG8_WAIT_L(8); PG8_BAR; PG8_WAIT_L(0); PG8_MMA(0, 0, At, B0); PG8_BAR; PG8_SCHED;
            PG8_LDB(B1, 0, 1); PG8_STAGE(PG8_SB(0, 0), b2, voffB);
            PG8_BAR; PG8_WAIT_L(0); PG8_MMA(0, 1, At, B1); PG8_BAR;
            PG8_LDA(At, 0, 1); PG8_STAGE(PG8_SA(0, 0), a2, voffA);
            PG8_BAR; PG8_WAIT_L(0); PG8_MMA(1, 0, At, B0); PG8_BAR; PG8_SCHED;
            PG8_STAGE(PG8_SB(0, 1), b2 + hstep, voffB);
            PG8_WAIT_V(6); PG8_BAR; PG8_MMA(1, 1, At, B1); PG8_BAR;
            PG8_LDB(B0, 1, 0); PG8_SCHED; PG8_LDA(At, 1, 0); PG8_STAGE(PG8_SA(0, 1), a2 + hstepA, voffA);
            PG8_WAIT_L(8); PG8_BAR; PG8_WAIT_L(0); PG8_MMA(0, 0, At, B0); PG8_BAR; PG8_SCHED;
            PG8_LDB(B1, 1, 1); PG8_STAGE(PG8_SB(1, 0), b3, voffB);
            PG8_BAR; PG8_WAIT_L(0); PG8_MMA(0, 1, At, B1); PG8_BAR;
            PG8_LDA(At, 1, 1); PG8_STAGE(PG8_SA(1, 0), a3, voffA);
            PG8_BAR; PG8_WAIT_L(0); PG8_MMA(1, 0, At, B0); PG8_BAR; PG8_SCHED;
            PG8_STAGE(PG8_SB(1, 1), b3 + hstep, voffB);
            PG8_WAIT_V(6); PG8_BAR; PG8_MMA(1, 1, At, B1); PG8_BAR;
            }
        }
        if constexpr (ALIGN_EPI) { if (wr == 0) PG8_BAR; }
        if constexpr (!Epi::AFTER_DRAIN) { E(acc, cur, wr, wc, fr, fq); S.done(cur); }
        if (!has_next) break;
#pragma unroll
        for (int a = 0; a < 2; ++a)
#pragma unroll
            for (int b = 0; b < 2; ++b)
#pragma unroll
                for (int m = 0; m < 4; ++m)
#pragma unroll
                    for (int n = 0; n < 2; ++n) acc[a][b][m][n] = (f32x4){0.f, 0.f, 0.f, 0.f};
        cur = nxt; cA = nA; cB = nB; ++ui;
        if constexpr (ALIGN_EPI) { if (wr == 1) PG8_BAR; }
    }
    PG8_WAIT_V(0);
    if constexpr (!ALIGN_EPI) { if (wr == 0) PG8_BAR; }
    PG8_BAR;
    if constexpr (Epi::AFTER_DRAIN) { E.fused(acc, cur, wr, wc, fr, fq, lds, wid, lane); S.done(cur); }
#undef PG8_SA
#undef PG8_SB
#undef PG8_STAGE
#undef PG8_LDA
#undef PG8_LDB
#undef PG8_MMA
#undef PG8_WAIT_V
#undef PG8_WAIT_L
#undef PG8_BAR
#undef PG8_SCHED
}
}

typedef unsigned short bf16_t;
typedef short bf16x8 __attribute__((ext_vector_type(8)));
typedef short s16x4 __attribute__((ext_vector_type(4)));
typedef float f32x4 __attribute__((ext_vector_type(4)));
typedef float f32x2 __attribute__((ext_vector_type(2)));
typedef float f32x16 __attribute__((ext_vector_type(16)));
typedef unsigned u32x4 __attribute__((ext_vector_type(4)));
typedef unsigned u32x2 __attribute__((ext_vector_type(2)));

constexpr int DM = 1024, NB = 4, SEQ = 8192, CTX = 256, TL = NB * SEQ, TC = NB * CTX, TA = TL + TC;
constexpr int DFF = 2816, NIN = 7616;
constexpr float EPS = 1e-6f;
constexpr int NTHREADS = 512, NWAVES = 8;

constexpr size_t al256(size_t x) { return (x + 255) / 256 * 256; }
constexpr size_t WS_MOD = 0;
constexpr size_t WS_PAR = al256(WS_MOD + (size_t)2 * 5 * 6144 * 4);
constexpr size_t WS_BAR = al256(WS_PAR + (size_t)1024 * 256);
constexpr size_t WS_ROPE = al256(WS_BAR + (size_t)3456 * 4);
constexpr size_t WS_ROT = al256(WS_ROPE + (size_t)192 * 8 * 8);
constexpr size_t WS_HC  = al256(WS_ROT + (size_t)8448 * 64 * 8);
constexpr size_t WS_WT  = al256(WS_HC + (size_t)TC * DM * 4);
constexpr size_t WT_IN = 0, WT_QB = WT_IN + (size_t)7680 * 1024, WT_KVB = WT_QB + (size_t)768 * 256, WT_BR = WT_KVB + (size_t)1024 * 128,
                 WT_OUT = WT_BR + (size_t)3 * 1024 * 512, WT_MIX_END = WT_OUT + (size_t)1024 * 1024;
constexpr size_t WT_F1 = 0, WT_F2 = (size_t)5632 * 1024, WT_FFN_END = WT_F2 + (size_t)1024 * 2816;
constexpr size_t WT_ELEMS = WT_MIX_END > WT_FFN_END ? WT_MIX_END : WT_FFN_END;
constexpr size_t WS_A   = al256(WS_WT + WT_ELEMS * 2);
constexpr size_t WS_SM  = al256(WS_A + (size_t)TA * 1024 * 2);
constexpr size_t WS_Q   = al256(WS_SM + (size_t)TA * 512 * 2);
constexpr size_t WS_R4  = al256(WS_Q + (size_t)TA * 768 * 2);
constexpr size_t WS_K   = WS_R4;
constexpr size_t WS_V   = al256(WS_K + (size_t)TA * 768 * 2);
constexpr size_t WS_OF  = al256(WS_R4 + (size_t)TA * 3072 * 2);
constexpr size_t WS_OB  = al256(WS_OF + (size_t)TA * 1024 * 2);
constexpr size_t WS_END_MIX = al256(WS_OB + (size_t)TA * 1024 * 2);
constexpr size_t WS_G   = WS_SM;
constexpr size_t WS_U   = al256(WS_G + (size_t)TA * DFF * 2);
constexpr size_t WS_END_FFN = al256(WS_U + (size_t)TA * DFF * 2);
constexpr size_t WS_NEED = WS_END_MIX > WS_END_FFN ? WS_END_MIX : WS_END_FFN;
static_assert(WS_V + (size_t)TA * 512 * 2 <= WS_OF, "K/V overlay must fit in R4");

constexpr int LDS_BYTES = 148 * 1024;
constexpr int LDS_BARW = LDS_BYTES - 16;

struct Params { const float* in[26]; float* out; unsigned char* ws; int ph_lo, ph_hi; };
enum { I_X = 0, I_C, I_CTX, I_CCTX, I_WADA, I_BADA, I_N1W, I_N2W, I_WIN, I_BGATE, I_QNA, I_WQB, I_KVNA, I_WKVB, I_QN, I_KN, I_GK2, I_BGK, I_GON, I_RDEC, I_WBR, I_WOUT, I_WF1, I_WDW, I_BDW, I_WF2 };

DI float bflo(unsigned w) { return __uint_as_float(w << 16); }
DI float bfhi(unsigned w) { return __uint_as_float(w & 0xffff0000u); }
DI float bf2f(bf16_t x) { return __uint_as_float((unsigned)x << 16); }
DI unsigned pk2(float lo, float hi) { unsigned r; asm volatile("v_cvt_pk_bf16_f32 %0, %1, %2" : "=v"(r) : "v"(lo), "v"(hi)); return r; }
DI bf16_t f2bf(float x) { return (bf16_t)(pk2(x, 0.f) & 0xffffu); }
DI float wave_sum(float v) {
#pragma unroll
    for (int o = 1; o < 64; o <<= 1) v += __shfl_xor(v, o);
    return v;
}
DI float sigmoidf_(float x) { return 1.f / (1.f + __expf(-x)); }
DI void unpack8(u32x4 w, float* f) { f[0] = bflo(w.x); f[1] = bfhi(w.x); f[2] = bflo(w.y); f[3] = bfhi(w.y); f[4] = bflo(w.z); f[5] = bfhi(w.z); f[6] = bflo(w.w); f[7] = bfhi(w.w); }
DI u32x4 pack8(const float* f) { u32x4 w; w.x = pk2(f[0], f[1]); w.y = pk2(f[2], f[3]); w.z = pk2(f[4], f[5]); w.w = pk2(f[6], f[7]); return w; }

DI void rowinfo(int m, int& b, int& pos, int& isctx) {
    if (m < TL) { b = m >> 13; pos = m & 8191; isctx = 0; } else { const int j = m - TL; b = j >> 8; pos = j & 255; isctx = 1; }
}

DI void phase_prologue(const Params& P, LAS unsigned char* lds) {
    const int tid = threadIdx.x, wave = tid >> 6, lane = tid & 63;
    LAS float* cond = (LAS float*)lds;
    LAS float* part = cond + 5 * 1024;
    const float* c = P.in[I_C]; const float* cc = P.in[I_CCTX];
    for (int i = tid; i < 5 * 1024; i += NTHREADS) { const int r = i >> 10, k = i & 1023; const float v = r < 4 ? c[r * 1024 + k] : cc[k]; cond[i] = v / (1.f + expf(-v)); }
    __syncthreads();
    float* MOD = (float*)(P.ws + WS_MOD);
    for (int item = blockIdx.x; item < 192; item += gridDim.x) {
        const int l = item / 96, j0 = (item % 96) * 64;
        const float* W = P.in[I_WADA] + (size_t)l * 1024 * 6144 + j0 + lane;
        float a0 = 0.f, a1 = 0.f, a2 = 0.f, a3 = 0.f, a4 = 0.f;
        for (int k = wave * 128; k < wave * 128 + 128; ++k) {
            const float w = W[(size_t)k * 6144];
            a0 += cond[k] * w; a1 += cond[1024 + k] * w; a2 += cond[2048 + k] * w; a3 += cond[3072 + k] * w; a4 += cond[4096 + k] * w;
        }
        part[(wave * 5 + 0) * 64 + lane] = a0; part[(wave * 5 + 1) * 64 + lane] = a1; part[(wave * 5 + 2) * 64 + lane] = a2;
        part[(wave * 5 + 3) * 64 + lane] = a3; part[(wave * 5 + 4) * 64 + lane] = a4;
        __syncthreads();
        if (tid < 320) { const int r = tid >> 6; float s = 0.f;
            for (int w = 0; w < 8; ++w) s += part[(w * 5 + r) * 64 + lane];
            MOD[(size_t)(l * 5 + r) * 6144 + j0 + lane] = s + P.in[I_BADA][l * 6144 + j0 + lane]; }
        __syncthreads();
    }
    { f32x2* ROPE = (f32x2*)(P.ws + WS_ROPE);
      for (int i = blockIdx.x * NTHREADS + tid; i < 192 * 8; i += gridDim.x * NTHREADS) { const int p = i >> 3, f = i & 7; const float pos = (float)(p < 128 ? p : p - 128);
          const float inv = powf(10000.0f, -(float)f * 0.125f); float s, co; sincosf(pos * inv, &s, &co); ROPE[i] = (f32x2){co, s}; } }
    f32x2* ROT = (f32x2*)(P.ws + WS_ROT);
    for (int i = blockIdx.x * NTHREADS + tid; i < 8448 * 64; i += gridDim.x * NTHREADS) {
        const int pos = i >> 6, j = i & 63;
        const float inv = 1.0f / powf(10000.0f, (float)j / 63.0f);
        const float ang = (float)pos * inv; float s, co; sincosf(ang, &s, &co);
        ROT[i] = (f32x2){co, s};
    }
}

DI int wmap(int id, int n) {
    switch (id) {
    case 1: if (n < 416) return n; if (n < 448) return 2464 + (n - 416); return -1;
    case 2: { if (n < 1536) return 416 + n;
              if (n < 2560) { const int base = n < 2048 ? 2496 : 3008; const int j = (n - 1536) & 511; const int hh = j >> 7, v = j & 127, g = v >> 3, e = v & 7;
                              const int d = e < 4 ? 4 * g + e : 64 + 4 * g + (e - 4); return base + hh * 128 + d; }
              return 3520 + (n - 2560); }
    case 3: if (n < 512) return 1952 + n; if (n < 1024) return 4032 + (n - 512); return 4544 + (n - 1024);
    case 4: if (n < 512) return (n >> 6) * 96 + (n & 63); { const int j = n - 512; return (j >> 5) * 96 + 64 + (j & 31); }
    case 5: if (n < 512) return (n >> 6) * 128 + (n & 63); { const int j = n - 512; return (j >> 6) * 128 + 64 + (j & 63); }
    default: return n;
    }
}
struct TJob { const float* W; int K, Nsrc; bf16_t* WT; int ndst, map_id; const float* kscale; };
DI void transpose_job(const TJob& J, LAS float* scr, int gw, int ngw, int lane) {
    const int nblk = J.ndst / 32, nitems = (J.K / 64) * nblk;
    for (int item = gw; item < nitems; item += ngw) {
        const int kb = item / nblk, nb = item % nblk, k0 = 64 * kb, n0 = 32 * nb;
        const int src = wmap(J.map_id, n0 + (lane & 31));
#pragma unroll 8
        for (int i = 0; i < 32; ++i) { const int kk = 2 * i + (lane >> 5);
            float v = 0.f; if (src >= 0) { v = J.W[(size_t)(k0 + kk) * J.Nsrc + src]; if (J.kscale) v *= J.kscale[k0 + kk]; }
            scr[kk * 33 + (lane & 31)] = v; }
        asm volatile("s_waitcnt lgkmcnt(0)" ::: "memory");
        const int c = lane & 7;
#pragma unroll
        for (int j = 0; j < 4; ++j) { const int n = (lane >> 3) + 8 * j; const LAS float* s = scr + (8 * c) * 33 + n;
            u32x4 o; o.x = pk2(s[0 * 33], s[1 * 33]); o.y = pk2(s[2 * 33], s[3 * 33]); o.z = pk2(s[4 * 33], s[5 * 33]); o.w = pk2(s[6 * 33], s[7 * 33]);
            *(u32x4*)(J.WT + (size_t)(n0 + n) * J.K + k0 + 8 * c) = o; }
        asm volatile("s_waitcnt lgkmcnt(0)" ::: "memory");
    }
}
DI void phase_wconv_mixer(const Params& P, int l, LAS unsigned char* lds) {
    const int tid = threadIdx.x, wave = tid >> 6, lane = tid & 63, gw = blockIdx.x * NWAVES + wave, ngw = gridDim.x * NWAVES;
    LAS float* scr = (LAS float*)lds + wave * (64 * 33);
    bf16_t* WT = (bf16_t*)(P.ws + WS_WT);
    const float* win = P.in[I_WIN] + (size_t)l * 1024 * NIN;
    TJob j;
    j = TJob{win, 1024, NIN, WT + WT_IN, 512, 1, nullptr}; transpose_job(j, scr, gw, ngw, lane);
    j = TJob{win, 1024, NIN, WT + WT_IN + (size_t)512 * 1024, 3072, 2, nullptr}; transpose_job(j, scr, gw, ngw, lane);
    j = TJob{win, 1024, NIN, WT + WT_IN + (size_t)3584 * 1024, 4096, 3, nullptr}; transpose_job(j, scr, gw, ngw, lane);
    j = TJob{P.in[I_WQB] + (size_t)l * 256 * 768, 256, 768, WT + WT_QB, 768, 4, P.in[I_QNA] + l * 256}; transpose_job(j, scr, gw, ngw, lane);
    j = TJob{P.in[I_WKVB] + (size_t)l * 128 * 1024, 128, 1024, WT + WT_KVB, 1024, 5, P.in[I_KVNA] + l * 128}; transpose_job(j, scr, gw, ngw, lane);
    for (int n = 0; n < 3; ++n) { j = TJob{P.in[I_WBR] + ((size_t)l * 3 + n) * 512 * 1024, 512, 1024, WT + WT_BR + (size_t)n * 1024 * 512, 1024, 0, nullptr}; transpose_job(j, scr, gw, ngw, lane); }
    j = TJob{P.in[I_WOUT] + (size_t)l * 1024 * 1024, 1024, 1024, WT + WT_OUT, 1024, 0, nullptr}; transpose_job(j, scr, gw, ngw, lane);
}
DI void phase_wconv_ffn(const Params& P, int l, LAS unsigned char* lds) {
    const int tid = threadIdx.x, wave = tid >> 6, lane = tid & 63, gw = blockIdx.x * NWAVES + wave, ngw = gridDim.x * NWAVES;
    LAS float* scr = (LAS float*)lds + wave * (64 * 33);
    bf16_t* WT = (bf16_t*)(P.ws + WS_WT);
    TJob j;
    j = TJob{P.in[I_WF1] + (size_t)l * 1024 * 5632, 1024, 5632, WT + WT_F1, 5632, 0, nullptr}; transpose_job(j, scr, gw, ngw, lane);
    j = TJob{P.in[I_WF2] + (size_t)l * 2816 * 1024, 2816, 1024, WT + WT_F2, 1024, 0, nullptr}; transpose_job(j, scr, gw, ngw, lane);
}

DI void phase_norm(const float* __restrict__ hl, const float* __restrict__ hc, const float* __restrict__ nw, const float* __restrict__ MODl, int ishift, int iscale, bf16_t* __restrict__ A, int nrows) {
    const int tid = threadIdx.x, wave = tid >> 6, lane = tid & 63, gw = blockIdx.x * NWAVES + wave, ngw = gridDim.x * NWAVES;
    f32x4 nx[4];
#define NLOAD(dst, m_) do { const float* xr_ = (m_) >= TL ? hc + (size_t)((m_) - TL) * DM : hl + (size_t)(m_) * DM; \
        _Pragma("unroll") for (int j = 0; j < 4; ++j) dst[j] = *(const f32x4*)(xr_ + 4 * lane + 256 * j); } while (0)
    if (gw < nrows) NLOAD(nx, gw);
    for (int m = gw; m < nrows; m += ngw) {
        f32x4 v[4];
#pragma unroll
        for (int j = 0; j < 4; ++j) v[j] = nx[j];
        if (m + ngw < nrows) NLOAD(nx, m + ngw);
        int b, pos, isctx; rowinfo(m, b, pos, isctx);
        const float* mod = MODl + (size_t)(isctx ? 4 : b) * 6144;
        float ss = 0.f;
#pragma unroll
        for (int j = 0; j < 4; ++j) ss += (v[j].x * v[j].x + v[j].y * v[j].y) + (v[j].z * v[j].z + v[j].w * v[j].w);
        const float rstd = rsqrtf(wave_sum(ss) * (1.f / DM) + EPS);
#pragma unroll
        for (int j = 0; j < 4; ++j) { const int c = 4 * lane + 256 * j;
            const f32x4 w = *(const f32x4*)(nw + c), sh = *(const f32x4*)(mod + ishift * 1024 + c), sc = *(const f32x4*)(mod + iscale * 1024 + c);
            const f32x4 y = v[j] * rstd * w * (sc + 1.f) + sh;
            u32x2 o; o.x = pk2(y.x, y.y); o.y = pk2(y.z, y.w);
            *(u32x2*)(A + (size_t)m * DM + c) = o; }
    }
#undef NLOAD
}
#include <cstdlib>
#include <vector>

#define XB_TMO      128
#define XB_XCNT(j)  (256  + 64 * (j))
#define XB_XSUB(j)  (1280 + 64 * (j))
#define XB_XGEN(j)  (2304 + 64 * (j))
#define XB_TOP      3328
#define XB_TOPGEN   3392
#define XCD_BAR_WORDS 3456
#define XB_SPIN_CAP (1u << 18)

__device__ __forceinline__ unsigned xb_ld(unsigned* p)              { return __hip_atomic_load(p, __ATOMIC_RELAXED, __HIP_MEMORY_SCOPE_AGENT); }
__device__ __forceinline__ unsigned xb_add(unsigned* p, unsigned v) { return __hip_atomic_fetch_add(p, v, __ATOMIC_RELAXED, __HIP_MEMORY_SCOPE_AGENT); }
__device__ __forceinline__ unsigned xb_xcc_id() { return (unsigned)__builtin_amdgcn_s_getreg((3 << 11) | 20) & 0xFu; }
#define XB_SPIN(cond, bar) do { unsigned _sp = 0; while (cond) { __builtin_amdgcn_s_sleep(1); \
    if ((++_sp & 255u) == 0u) { if (xb_ld(&(bar)[XB_TMO])) break; if (_sp > XB_SPIN_CAP) { atomicAdd(&(bar)[XB_TMO], 1u); break; } } } } while (0)

struct XcdBarrier {
    unsigned* bar; unsigned x;
    volatile LAS unsigned* st;
};

__device__ __forceinline__ XcdBarrier xcd_barrier_post(unsigned* bar, volatile LAS unsigned* st) {
    XcdBarrier b; b.bar = bar; b.x = xb_xcc_id(); b.st = st;
    if (threadIdx.x == 0) (void)xb_add(&bar[XB_XCNT(b.x)], 1u);
    return b;
}
__device__ __forceinline__ void xcd_barrier_complete(unsigned* bar, unsigned x, unsigned& nloc, unsigned& nx) {
    const unsigned G = gridDim.x * gridDim.y * gridDim.z;
    unsigned sum, cnt, mine, sp = 0u;
    for (;;) {
        sum = 0u; cnt = 0u; mine = 0u;
#pragma unroll
        for (unsigned j = 0; j < 16; ++j) { const unsigned c = xb_ld(&bar[XB_XCNT(j)]); sum += c; cnt += (c > 0u) ? 1u : 0u; mine = (j == x) ? c : mine; }
        if (sum == G) break;
        __builtin_amdgcn_s_sleep(1);
        if ((++sp & 255u) == 0u) { if (xb_ld(&bar[XB_TMO])) break; if (sp > XB_SPIN_CAP) { atomicAdd(&bar[XB_TMO], 1u); break; } }
    }
    nloc = mine > 0u ? mine : 1u; nx = cnt > 0u ? cnt : 1u;
}

__device__ __forceinline__ void xcd_barrier(const XcdBarrier& b) {
    asm volatile("s_waitcnt vmcnt(0)" ::: "memory");
    __syncthreads();
    if (threadIdx.x == 0) {
        unsigned* bar = b.bar;
        __builtin_amdgcn_s_waitcnt(0);
        unsigned nloc = b.st[0], nx = b.st[1];
        if (nloc == 0u) { xcd_barrier_complete(bar, b.x, nloc, nx); b.st[0] = nloc; b.st[1] = nx; }
        const unsigned old = xb_add(&bar[XB_XSUB(b.x)], 1u);
        const unsigned gen = old / nloc;
        if (old + 1u == (gen + 1u) * nloc) {
            __builtin_amdgcn_fence(__ATOMIC_RELEASE, "agent");
            asm volatile("s_waitcnt vmcnt(0)" ::: "memory");
            const unsigned og = xb_add(&bar[XB_TOP], 1u);
            const unsigned tg = og / nx;
            if (og + 1u == (tg + 1u) * nx) xb_add(&bar[XB_TOPGEN], 1u);
            else XB_SPIN(xb_ld(&bar[XB_TOPGEN]) == tg, bar);
            __builtin_amdgcn_fence(__ATOMIC_ACQUIRE, "agent");
            xb_add(&bar[XB_XGEN(b.x)], 1u);
            asm volatile("s_waitcnt vmcnt(0)" ::: "memory");
        } else {
            XB_SPIN(xb_ld(&bar[XB_XGEN(b.x)]) == gen, bar);
            __builtin_amdgcn_fence(__ATOMIC_ACQUIRE, "agent");
            asm volatile("s_waitcnt vmcnt(0)" ::: "memory");
        }
    }
    __syncthreads();
}

enum { EM_PLAIN = 0, EM_KV, EM_BIG, EM_GATES, EM_BRANCH, EM_RES, EM_FFNIN };
template <int MODE> struct Epi {
    static constexpr bool PERM = true, AFTER_DRAIN = false;
    bf16_t* O0; int ld0; bf16_t* O1; int ld1;
    const bf16_t* Gsrc;
    const float* fa;
    const float* hin_l; const float* hin_c; float* hout_l; float* hout_c;
    int ipar;
    DI void emit(int row, int col, f32x4 v0, f32x4 v1) const {
        float f[8] = {v0[0], v0[1], v0[2], v0[3], v1[0], v1[1], v1[2], v1[3]};
        if (MODE == EM_PLAIN) {
            *(u32x4*)(O0 + (size_t)row * ld0 + col) = pack8(f);
        } else if (MODE == EM_KV) {
            if (col < 512) *(u32x4*)(O0 + (size_t)row * 768 + col) = pack8(f);
            else           *(u32x4*)(O1 + (size_t)row * 512 + (col - 512)) = pack8(f);
        } else if (MODE == EM_FFNIN) {
            if (col < DFF) *(u32x4*)(O0 + (size_t)row * DFF + col) = pack8(f);
            else           *(u32x4*)(O1 + (size_t)row * DFF + (col - DFF)) = pack8(f);
        } else if (MODE == EM_BIG) {
            const float QS = 0.08838834764831845f;
            if (col < 512) { for (int i = 0; i < 8; ++i) f[i] *= QS; }
            else if (col >= 1536 && col < 2560) {
                int b, pos, isctx; rowinfo(row, b, pos, isctx);
                const int sp = isctx ? pos : CTX + pos;
                const int g = ((col - 1536) & 127) >> 3;
                const f32x2* rot = (const f32x2*)fa + (size_t)sp * 64 + 4 * g;
                const float sc = col >= 2048 ? QS : 1.f;
#pragma unroll
                for (int e = 0; e < 4; ++e) { const f32x2 cs = rot[e]; const float x1 = f[e], x2 = f[4 + e];
                    f[e] = (x1 * cs.x - x2 * cs.y) * sc; f[4 + e] = (x1 * cs.y + x2 * cs.x) * sc; }
            }
            *(u32x4*)(O0 + (size_t)row * 3072 + col) = pack8(f);
        } else if (MODE == EM_GATES) {
            if (col < 1024) {
                bf16_t* p = O1 + (size_t)row * 1024 + col; float on[8]; unpack8(*(const u32x4*)p, on);
#pragma unroll
                for (int i = 0; i < 8; ++i) f[i] = on[i] * f[i] * sigmoidf_(f[i]);
                *(u32x4*)p = pack8(f);
            } else {
                const int cc = col - 1024; const f32x4 b0 = *(const f32x4*)(fa + cc), b1 = *(const f32x4*)(fa + cc + 4);
                const float bb[8] = {b0[0], b0[1], b0[2], b0[3], b1[0], b1[1], b1[2], b1[3]};
#pragma unroll
                for (int i = 0; i < 8; ++i) f[i] = sigmoidf_(f[i] + bb[i]);
                *(u32x4*)(O0 + (size_t)row * 3072 + cc) = pack8(f);
            }
        } else if (MODE == EM_BRANCH) {
            float g[8]; unpack8(*(const u32x4*)(Gsrc + (size_t)row * 3072 + col), g);
            bf16_t* p = O0 + (size_t)row * 1024 + col;
            if (ipar > 0) { float pr[8]; unpack8(*(const u32x4*)p, pr);
#pragma unroll
                for (int i = 0; i < 8; ++i) f[i] = pr[i] + g[i] * f[i]; }
            else {
#pragma unroll
                for (int i = 0; i < 8; ++i) f[i] = g[i] * f[i]; }
            *(u32x4*)p = pack8(f);
        } else if (MODE == EM_RES) {
            int b, pos, isctx; rowinfo(row, b, pos, isctx);
            const float* hi_ = isctx ? hin_c + (size_t)(row - TL) * DM : hin_l + (size_t)row * DM;
            float* ho_ = isctx ? hout_c + (size_t)(row - TL) * DM : hout_l + (size_t)row * DM;
            const float* mod = fa + (size_t)(isctx ? 4 : b) * 6144 + ipar * 1024 + col;
            const f32x4 m0 = *(const f32x4*)mod, m1 = *(const f32x4*)(mod + 4);
            const f32x4 h0 = *(const f32x4*)(hi_ + col), h1 = *(const f32x4*)(hi_ + col + 4);
            *(f32x4*)(ho_ + col) = h0 + m0 * v0; *(f32x4*)(ho_ + col + 4) = h1 + m1 * v1;
        }
    }
    DI void operator()(const pg8::f32x4 (&acc)[2][2][4][2], const pg8::Unit& u, int wr, int wc, int fr, int fq) const {
#pragma unroll
        for (int ai = 0; ai < 2; ++ai)
#pragma unroll
            for (int m = 0; m < 4; ++m) { const int row = u.pm * 256 + ai * 128 + wr * 64 + m * 16 + fr;
#pragma unroll
                for (int bj = 0; bj < 2; ++bj) { const int col = u.pn * 256 + bj * 128 + wc * 32 + 8 * fq;
                    emit(row, col, acc[ai][bj][m][0], acc[ai][bj][m][1]); } }
    }
};
template <int MODE>
DI void run_gemm(LAS unsigned char* lds, const bf16_t* A, int lda, const bf16_t* Bt, int M, int N, int K, const Epi<MODE>& E) {
    int Kop = K; if (K < 512) asm volatile("" : "+s"(Kop));
    pg8::Gemm g{A, Bt, M, N, Kop, lda}; pg8::StaticOrder S; S.init(M, N, (int)gridDim.x, (int)blockIdx.x);
    pg8::gemm_phase<Epi<MODE>, pg8::StaticOrder, true, true>((PG8_LAS unsigned char*)lds, g, S, E);
}

DI void phase_qkpost(const Params& P, int l) {
    const int tid = threadIdx.x, wave = tid >> 6, lane = tid & 63, gw = blockIdx.x * NWAVES + wave, ngw = gridDim.x * NWAVES;
    const bf16_t* __restrict__ SM = (const bf16_t*)(P.ws + WS_SM); bf16_t* __restrict__ Q = (bf16_t*)(P.ws + WS_Q); bf16_t* __restrict__ K = (bf16_t*)(P.ws + WS_K); bf16_t* __restrict__ V = (bf16_t*)(P.ws + WS_V);
    const f32x2* __restrict__ ROPE = (const f32x2*)(P.ws + WS_ROPE);
    const float* qn = P.in[I_QN] + l * 96; const float* kn = P.in[I_KN] + l * 96;
    const int s = lane & 7, h = lane >> 3;
    float qnw[12], knw[12];
#pragma unroll
    for (int i = 0; i < 8; ++i) { qnw[i] = qn[8 * s + i]; knw[i] = kn[8 * s + i]; }
#pragma unroll
    for (int i = 0; i < 4; ++i) { qnw[8 + i] = qn[64 + 4 * s + i]; knw[8 + i] = kn[64 + 4 * s + i]; }
    const bool second = (s & 2) != 0;
    u32x2 n_cq, n_kr, n_qr; unsigned n_ckv; u32x4 n_qn, n_kn, n_v;
#define QLOAD(m_) do { const bf16_t* sm_ = SM + (size_t)(m_) * 512; n_cq = *(const u32x2*)(sm_ + 4 * lane); n_ckv = *(const unsigned*)(sm_ + 256 + 2 * lane); n_kr = *(const u32x2*)(sm_ + 384 + 4 * s); \
        n_qn = *(const u32x4*)(Q + (size_t)(m_) * 768 + 64 * h + 8 * s); n_qr = *(const u32x2*)(Q + (size_t)(m_) * 768 + 512 + 32 * h + 4 * s); \
        n_kn = *(const u32x4*)(K + (size_t)(m_) * 768 + 64 * h + 8 * s); n_v = *(const u32x4*)(V + (size_t)(m_) * 512 + 8 * lane); } while (0)
    if (gw < TA) QLOAD(gw);
    for (int m = gw; m < TA; m += ngw) {
        const u32x2 cq = n_cq, krr = n_kr, qrr = n_qr; const unsigned ckv = n_ckv; const u32x4 qnn = n_qn, knn = n_kn, vraw = n_v;
        if (m + ngw < TA) QLOAD(m + ngw);
        int b, pos, isctx; rowinfo(m, b, pos, isctx);
        float a0 = bflo(cq.x), a1 = bfhi(cq.x), a2 = bflo(cq.y), a3 = bfhi(cq.y), c0 = bflo(ckv), c1 = bfhi(ckv);
        const float s_q = rsqrtf(wave_sum(a0 * a0 + a1 * a1 + a2 * a2 + a3 * a3) * (1.f / 256.f) + EPS);
        const float s_kv = rsqrtf(wave_sum(c0 * c0 + c1 * c1) * (1.f / 128.f) + EPS);
        float cs[4], sn[4];
        if (!isctx) { const f32x2* rp = ROPE + ((s < 4) ? (pos >> 6) : 128 + (pos & 63)) * 8 + 4 * (s & 1);
#pragma unroll
            for (int e = 0; e < 4; ++e) { const f32x2 t = rp[e]; cs[e] = t.x; sn[e] = t.y; } }
        else {
#pragma unroll
            for (int e = 0; e < 4; ++e) { cs[e] = 1.f; sn[e] = 0.f; } }
        {
            bf16_t* qp = Q + (size_t)m * 768;
            float z[12]; unpack8(qnn, z);
            z[8] = bflo(qrr.x); z[9] = bfhi(qrr.x); z[10] = bflo(qrr.y); z[11] = bfhi(qrr.y);
            float ss = 0.f;
#pragma unroll
            for (int i = 0; i < 12; ++i) { z[i] *= s_q; ss += z[i] * z[i]; }
            ss += __shfl_xor(ss, 1); ss += __shfl_xor(ss, 2); ss += __shfl_xor(ss, 4);
            const float r = rsqrtf(ss * (1.f / 96.f) + EPS);
#pragma unroll
            for (int i = 0; i < 12; ++i) z[i] *= r * qnw[i];
#pragma unroll
            for (int e = 0; e < 4; ++e) { const float mine = z[8 + e], other = __shfl_xor(mine, 2);
                z[8 + e] = second ? (other * sn[e] + mine * cs[e]) : (mine * cs[e] - other * sn[e]); }
            *(u32x4*)(qp + 64 * h + 8 * s) = pack8(z);
            u32x2 o; o.x = pk2(z[8], z[9]); o.y = pk2(z[10], z[11]); *(u32x2*)(qp + 512 + 32 * h + 4 * s) = o;
        }
        {
            bf16_t* kp = K + (size_t)m * 768;
            float z[12]; unpack8(knn, z);
#pragma unroll
            for (int i = 0; i < 8; ++i) z[i] *= s_kv;
            z[8] = bflo(krr.x); z[9] = bfhi(krr.x); z[10] = bflo(krr.y); z[11] = bfhi(krr.y);
            float ss = 0.f;
#pragma unroll
            for (int i = 0; i < 12; ++i) ss += z[i] * z[i];
            ss += __shfl_xor(ss, 1); ss += __shfl_xor(ss, 2); ss += __shfl_xor(ss, 4);
            const float r = rsqrtf(ss * (1.f / 96.f) + EPS);
#pragma unroll
            for (int i = 0; i < 12; ++i) z[i] *= r * knw[i];
#pragma unroll
            for (int e = 0; e < 4; ++e) { const float mine = z[8 + e], other = __shfl_xor(mine, 2);
                z[8 + e] = second ? (other * sn[e] + mine * cs[e]) : (mine * cs[e] - other * sn[e]); }
            *(u32x4*)(kp + 64 * h + 8 * s) = pack8(z);
            u32x2 o; o.x = pk2(z[8], z[9]); o.y = pk2(z[10], z[11]); *(u32x2*)(kp + 512 + 32 * h + 4 * s) = o;
            float vv[8]; unpack8(vraw, vv);
#pragma unroll
            for (int i = 0; i < 8; ++i) vv[i] *= s_kv;
            *(u32x4*)(V + (size_t)m * 512 + 8 * lane) = pack8(vv);
        }
    }
#undef QLOAD
}

DI void phase_scanpost(const Params& P, int l, int nrows) {
    const int tid = threadIdx.x, wave = tid >> 6, lane = tid & 63, gw = blockIdx.x * NWAVES + wave, ngw = gridDim.x * NWAVES;
    bf16_t* __restrict__ OF = (bf16_t*)(P.ws + WS_OF); const bf16_t* __restrict__ OB = (const bf16_t*)(P.ws + WS_OB);
    const float* gw_ = P.in[I_GON] + l * 128;
    const int sub = lane & 7, hd = lane >> 3;
    float w[16];
#pragma unroll
    for (int i = 0; i < 16; ++i) w[i] = hd < 4 ? gw_[16 * sub + i] : 1.f;
    u32x4 nf0, nf1, nb0, nb1;
#define PLOAD(m_) do { const bf16_t* pf_ = OF + (size_t)(m_) * 1024 + 16 * lane; const bf16_t* pb_ = OB + (size_t)(m_) * 1024 + 16 * lane; \
        nf0 = *(const u32x4*)pf_; nf1 = *(const u32x4*)(pf_ + 8); nb0 = *(const u32x4*)pb_; nb1 = *(const u32x4*)(pb_ + 8); } while (0)
    if (gw < nrows) PLOAD(gw);
    for (int m = gw; m < nrows; m += ngw) {
        float a[16], bq[16];
        unpack8(nf0, a); unpack8(nf1, a + 8); unpack8(nb0, bq); unpack8(nb1, bq + 8);
        if (m + ngw < nrows) PLOAD(m + ngw);
        float ss = 0.f;
#pragma unroll
        for (int i = 0; i < 16; ++i) { a[i] += bq[i]; ss += a[i] * a[i]; }
        ss += __shfl_xor(ss, 1); ss += __shfl_xor(ss, 2); ss += __shfl_xor(ss, 4);
        const float r = rsqrtf(ss * (1.f / 128.f) + EPS);
#pragma unroll
        for (int i = 0; i < 16; ++i) a[i] *= r * w[i];
        bf16_t* pf = OF + (size_t)m * 1024 + 16 * lane;
        *(u32x4*)pf = pack8(a); *(u32x4*)(pf + 8) = pack8(a + 8);
    }
#undef PLOAD
}

DI void phase_conv(const Params& P, int l, int nrows) {
    const bf16_t* __restrict__ G = (const bf16_t*)(P.ws + WS_G); bf16_t* __restrict__ U = (bf16_t*)(P.ws + WS_U);
    const float* __restrict__ wdw = P.in[I_WDW] + (size_t)l * 3 * DFF; const float* __restrict__ bdw = P.in[I_BDW] + (size_t)l * DFF;
    const int total = (nrows / 4) * 352;
    for (int i = blockIdx.x * NTHREADS + threadIdx.x; i < total; i += gridDim.x * NTHREADS) {
        const int quad = i / 352, c = (i - quad * 352) * 8, m0 = quad * 4;
        int b, pos, isctx; rowinfo(m0, b, pos, isctx);
        const int last = isctx ? CTX - 1 : SEQ - 1;
        u32x4 g[6], u[4];
#pragma unroll
        for (int r = 0; r < 4; ++r) { g[r + 1] = *(const u32x4*)(G + (size_t)(m0 + r) * DFF + c); u[r] = *(const u32x4*)(U + (size_t)(m0 + r) * DFF + c); }
        g[0] = pos > 0 ? *(const u32x4*)(G + (size_t)(m0 - 1) * DFF + c) : (u32x4){0u, 0u, 0u, 0u};
        g[5] = pos + 3 < last ? *(const u32x4*)(G + (size_t)(m0 + 4) * DFF + c) : (u32x4){0u, 0u, 0u, 0u};
        float w0[8], w1[8], w2[8], bb[8];
#pragma unroll
        for (int k = 0; k < 8; ++k) { w0[k] = wdw[c + k]; w1[k] = wdw[DFF + c + k]; w2[k] = wdw[2 * DFF + c + k]; bb[k] = bdw[c + k]; }
#pragma unroll
        for (int r = 0; r < 4; ++r) {
            float a0[8], a1[8], a2[8], uu[8], o[8];
            unpack8(g[r], a0); unpack8(g[r + 1], a1); unpack8(g[r + 2], a2); unpack8(u[r], uu);
#pragma unroll
            for (int k = 0; k < 8; ++k) {
                const float x = w0[k] * a0[k] + w1[k] * a1[k] + w2[k] * a2[k] + bb[k];
                const float t2 = 1.5957691216057308f * (x + 0.044715f * x * x * x);
                o[k] = x / (1.f + __expf(-t2)) * uu[k];
            }
            *(u32x4*)(U + (size_t)(m0 + r) * DFF + c) = pack8(o);
        }
    }
}

namespace att {
constexpr int NW = 8, QBLK = 32, KVBLK = 64;
constexpr float SCALE = 0.10206207261596575f;
constexpr float THR = 8.f;
constexpr int SHM_V = 64 * 128 * 2, SHM_K = 64 * 256, SHM_ATTN = 2 * SHM_V + 2 * SHM_K + NW * 64 * 4;
#define KSWZ(row, colB) ((row) * 256 + ((colB) ^ (((row) & 7) << 4)))
#define SBAR() __builtin_amdgcn_sched_barrier(0)
DI int crow(int r, int hi) { return (r & 3) + 8 * (r >> 2) + 4 * hi; }
DI unsigned cvtpk(float lo, float hi) { unsigned r; asm volatile("v_cvt_pk_bf16_f32 %0, %1, %2" : "=v"(r) : "v"(lo), "v"(hi)); return r; }
DI bf16x8 ld8(const bf16_t* p) { return *reinterpret_cast<const bf16x8*>(p); }

DI void partialSM(f32x16& p0, f32x16& p1, float& m_reg, float& mn, float& alpha) {
  constexpr float C = SCALE * 1.4426950408889634f;
  float pmax = p0[0]; for (int r = 1; r < 16; ++r) pmax = fmaxf(pmax, p0[r]); for (int r = 0; r < 16; ++r) pmax = fmaxf(pmax, p1[r]);
  { auto rr = __builtin_amdgcn_permlane32_swap(__float_as_uint(pmax), __float_as_uint(pmax), false, false);
    pmax = fmaxf(__uint_as_float(rr[0]), __uint_as_float(rr[1])); }
  if (__builtin_expect(__all(pmax - m_reg <= THR / SCALE), 1)) { mn = m_reg; alpha = 1.f; }
  else { mn = fmaxf(m_reg, pmax); alpha = __builtin_amdgcn_exp2f((m_reg - mn) * C); m_reg = mn; }
  float mnC = -mn * C;
  for (int r = 0; r < 16; ++r) p0[r] = fmaf(p0[r], C, mnC); for (int r = 0; r < 16; ++r) p1[r] = fmaf(p1[r], C, mnC);
  for (int r = 0; r < 16; ++r) p0[r] = __builtin_amdgcn_exp2f(p0[r]);
}
DI void finishSM(f32x16& p0, f32x16& p1, float alpha, float& l_reg, bf16x8& pa0, bf16x8& pa1, bf16x8& pa2, bf16x8& pa3) {
  for (int r = 0; r < 16; ++r) p1[r] = __builtin_amdgcn_exp2f(p1[r]);
  float ps = 0; for (int r = 0; r < 16; ++r) ps += p0[r]; for (int r = 0; r < 16; ++r) ps += p1[r];
  { auto rr = __builtin_amdgcn_permlane32_swap(__float_as_uint(ps), __float_as_uint(ps), false, false);
    ps = __uint_as_float(rr[0]) + __uint_as_float(rr[1]); }
  l_reg = l_reg * alpha + ps;
#define PK4(P, BASE, OUT) do { unsigned a0 = cvtpk(P[BASE + 0], P[BASE + 1]), a1 = cvtpk(P[BASE + 2], P[BASE + 3]);   \
    unsigned b0 = cvtpk(P[BASE + 4], P[BASE + 5]), b1 = cvtpk(P[BASE + 6], P[BASE + 7]);                              \
    auto r0 = __builtin_amdgcn_permlane32_swap(a0, b0, false, false); auto r1 = __builtin_amdgcn_permlane32_swap(a1, b1, false, false); \
    u32x4 w = {r0[0], r1[0], r0[1], r1[1]}; OUT = *reinterpret_cast<bf16x8*>(&w); } while (0)
  PK4(p0, 0, pa0); PK4(p0, 8, pa1); PK4(p1, 0, pa2); PK4(p1, 8, pa3);
#undef PK4
}
DI void qkt(f32x16& p0, f32x16& p1, const char* Ks, const bf16x8* qr, int r32, int hi) {
  p0 = f32x16{}; p1 = f32x16{};
#pragma unroll
  for (int d0 = 0; d0 < 6; ++d0) { int cb = (d0 * 16 + hi * 8) * 2;
    bf16x8 b0 = *reinterpret_cast<const bf16x8*>(Ks + KSWZ(r32, cb));
    bf16x8 b1 = *reinterpret_cast<const bf16x8*>(Ks + KSWZ(32 + r32, cb));
    p0 = __builtin_amdgcn_mfma_f32_32x32x16_bf16(b0, qr[d0], p0, 0, 0, 0);
    p1 = __builtin_amdgcn_mfma_f32_32x32x16_bf16(b1, qr[d0], p1, 0, 0, 0); }
}
DI int v_st(int k, int c) { const int kk = (k & ~0xC) | ((k & 4) << 1) | ((k & 8) >> 1); return ((kk >> 3) * 4 + (c >> 5)) * 512 + ((kk & 7) * 32 + (c & 31)) * 2; }
DI int v_rd_base(int lane) { return ((lane & 3) << 3) | (((lane >> 2) & 3) << 6) | (((lane >> 4) & 1) << 5) | (((lane >> 5) & 1) << 8); }
constexpr int v_rd_off(int d0, int ks, int half) { return d0 * 512 + ks * 4096 + half * 2048; }
template <int OFF> DI s16x4 tr_read(int vb) {
  s16x4 r; asm volatile("ds_read_b64_tr_b16 %0, %1 offset:%2" : "=&v"(r) : "v"(vb), "i"(OFF) : "memory"); return r;
}
template <int D0> DI void pv_one(f32x16& od, int vb, bf16x8 pa0, bf16x8 pa1, bf16x8 pa2, bf16x8 pa3) {
  const s16x4 l0 = tr_read<v_rd_off(D0, 0, 0)>(vb), h0 = tr_read<v_rd_off(D0, 0, 1)>(vb), l1 = tr_read<v_rd_off(D0, 1, 0)>(vb), h1 = tr_read<v_rd_off(D0, 1, 1)>(vb);
  const s16x4 l2 = tr_read<v_rd_off(D0, 2, 0)>(vb), h2 = tr_read<v_rd_off(D0, 2, 1)>(vb), l3 = tr_read<v_rd_off(D0, 3, 0)>(vb), h3 = tr_read<v_rd_off(D0, 3, 1)>(vb);
  asm volatile("s_waitcnt lgkmcnt(0)" ::: "memory"); SBAR();
#define PK(L, H) (bf16x8){L[0], L[1], L[2], L[3], H[0], H[1], H[2], H[3]}
  od = __builtin_amdgcn_mfma_f32_32x32x16_bf16(pa0, PK(l0, h0), od, 0, 0, 0);
  od = __builtin_amdgcn_mfma_f32_32x32x16_bf16(pa1, PK(l1, h1), od, 0, 0, 0);
  od = __builtin_amdgcn_mfma_f32_32x32x16_bf16(pa2, PK(l2, h2), od, 0, 0, 0);
  od = __builtin_amdgcn_mfma_f32_32x32x16_bf16(pa3, PK(l3, h3), od, 0, 0, 0);
#undef PK
}
DI void pv_d0(f32x16* o, int vb, bf16x8 pa0, bf16x8 pa1, bf16x8 pa2, bf16x8 pa3) {
  pv_one<0>(o[0], vb, pa0, pa1, pa2, pa3); pv_one<1>(o[1], vb, pa0, pa1, pa2, pa3);
}

DI void attn_unit(const bf16_t* Qg, bf16_t* Og, int ldo, const bf16_t* Kg, const bf16_t* Vg, int qrow0, int h, int ctxrow0, int latrow0, int NT, char* lds) {
  const int tid = threadIdx.x, wid = tid >> 6, lane = tid & 63, r32 = lane & 31, hi = lane >> 5;
  char* V_lds = lds; char* K_lds = lds + 2 * SHM_V;
  float* ws = (float*)(lds + 2 * SHM_V + 2 * SHM_K) + wid * 64; float* li_l = ws; float* al_l = ws + 32;
  float m_reg = -1e30f, l_reg = 0; f32x16 o[2] = {}; bf16x8 qr[6];
  const bf16_t* Qw = Qg + (size_t)(qrow0 + wid * QBLK + r32) * 768;
#pragma unroll
  for (int d0 = 0; d0 < 6; ++d0) qr[d0] = ld8(Qw + (d0 < 4 ? 64 * h + 16 * d0 + 8 * hi : 512 + 32 * h + 16 * (d0 - 4) + 8 * hi));
  const int vr = tid >> 3, vc = tid & 7, vst = v_st(vr, 8 * vc), vcol = 64 * h + 8 * vc;
  const int c0 = tid, c1 = 512 + (tid & 255);
  const int kr0 = c0 / 12, kc0 = c0 % 12, kr1 = c1 / 12, kc1 = c1 % 12;
  const int kcol0 = kc0 < 8 ? 64 * h + 8 * kc0 : 512 + 32 * h + 8 * (kc0 - 8), kcol1 = kc1 < 8 ? 64 * h + 8 * kc1 : 512 + 32 * h + 8 * (kc1 - 8);
  const int kst0 = KSWZ(kr0, kc0 * 16), kst1 = KSWZ(kr1, kc1 * 16);
  const int vb0 = (int)(uintptr_t)V_lds + v_rd_base(lane);
  struct { bf16x8 vs0, ks0, ks1; } sr_[2];
#define TROW(j) ((j) < 4 ? ctxrow0 + 64 * (j) : latrow0 + 64 * ((j) - 4))
#define SLOAD(i, j) do { const int rb_ = TROW(j); sr_[i].vs0 = ld8(Vg + (size_t)(rb_ + vr) * 512 + vcol); \
    sr_[i].ks0 = ld8(Kg + (size_t)(rb_ + kr0) * 768 + kcol0); sr_[i].ks1 = ld8(Kg + (size_t)(rb_ + kr1) * 768 + kcol1); } while (0)
#define SWRITE(b, i) do { *(bf16x8*)(V_lds + (b) * SHM_V + vst) = sr_[i].vs0; \
    *(bf16x8*)(K_lds + (b) * SHM_K + kst0) = sr_[i].ks0; *(bf16x8*)(K_lds + (b) * SHM_K + kst1) = sr_[i].ks1; } while (0)
#define SWAIT() asm volatile("s_waitcnt vmcnt(3)" ::: "memory")
#define RESC(a) do { if (__any((a) < 1.f)) { if (hi == 0) al_l[r32] = (a); asm volatile("s_waitcnt lgkmcnt(0)" ::: "memory"); \
    for (int d = 0; d < 2; ++d) for (int r = 0; r < 16; ++r) o[d][r] *= al_l[crow(r, hi)]; } } while (0)
  f32x16 pA0, pA1, pB0, pB1; float mnA, mnB, alA, alB; bf16x8 pa0, pa1, pa2, pa3;
  constexpr int SE = 0, SO = 1;
  SLOAD(SE, 0); asm volatile("s_waitcnt vmcnt(0)" ::: "memory"); SWRITE(0, SE); __syncthreads();
  qkt(pA0, pA1, K_lds, qr, r32, hi); partialSM(pA0, pA1, m_reg, mnA, alA);
  SLOAD(SO, 1); if (2 < NT) SLOAD(SE, 2);
  SWAIT(); SWRITE(1, SO); __syncthreads();
  for (int j = 1; j + 1 < NT; j += 2) {
    SBAR(); qkt(pB0, pB1, K_lds + SHM_K, qr, r32, hi);
    finishSM(pA0, pA1, alA, l_reg, pa0, pa1, pa2, pa3); SBAR();
    SLOAD(SO, j + 2); SBAR();
    pv_d0(o, vb0, pa0, pa1, pa2, pa3); partialSM(pB0, pB1, m_reg, mnB, alB);
    __syncthreads(); SWAIT(); SWRITE(0, SE);
    RESC(alB); __syncthreads();
    SBAR(); qkt(pA0, pA1, K_lds, qr, r32, hi);
    finishSM(pB0, pB1, alB, l_reg, pa0, pa1, pa2, pa3); SBAR();
    if (j + 3 < NT) SLOAD(SE, j + 3); SBAR();
    pv_d0(o, vb0 + SHM_V, pa0, pa1, pa2, pa3); partialSM(pA0, pA1, m_reg, mnA, alA);
    __syncthreads(); SWAIT(); SWRITE(1, SO);
    RESC(alA); __syncthreads();
  }
  SBAR(); qkt(pB0, pB1, K_lds + SHM_K, qr, r32, hi);
  finishSM(pA0, pA1, alA, l_reg, pa0, pa1, pa2, pa3); SBAR();
  pv_d0(o, vb0, pa0, pa1, pa2, pa3); partialSM(pB0, pB1, m_reg, mnB, alB);
  __syncthreads(); RESC(alB);
  finishSM(pB0, pB1, alB, l_reg, pa0, pa1, pa2, pa3); SBAR();
  pv_d0(o, vb0 + SHM_V, pa0, pa1, pa2, pa3);
  if (hi == 0) li_l[r32] = l_reg; asm volatile("s_waitcnt lgkmcnt(0)" ::: "memory");
  float rli[16];
#pragma unroll
  for (int r = 0; r < 16; ++r) rli[r] = __builtin_amdgcn_rcpf(li_l[crow(r, hi)]);
  bf16_t* Ow = Og + (size_t)(qrow0 + wid * QBLK) * ldo + 64 * h;
#pragma unroll
  for (int r = 0; r < 16; ++r) { const int orow = crow(r, hi);
#pragma unroll
    for (int d0 = 0; d0 < 2; ++d0) Ow[(size_t)orow * ldo + d0 * 32 + r32] = f2bf(o[d0][r] * rli[r]); }
#undef TROW
#undef SLOAD
#undef SWRITE
#undef SWAIT
#undef RESC
}
}

DI void phase_attention(const Params& P, int l, char* lds, bf16_t* Og, int ldo) {
    bf16_t* Q = (bf16_t*)(P.ws + WS_Q); const bf16_t* K = (const bf16_t*)(P.ws + WS_K); const bf16_t* V = (const bf16_t*)(P.ws + WS_V);
    for (int u = blockIdx.x; u < 1024; u += gridDim.x) {
        const int bh = (u >> 8) * 8 + (u & 7), qb = (u >> 3) & 31, b = bh >> 3, h = bh & 7;
        __syncthreads();
        att::attn_unit(Q, Og, ldo, K, V, b * SEQ + 256 * qb, h, TL + b * CTX, b * SEQ, 132, lds);
    }
    if (l == 0) {
        for (int u = blockIdx.x; u < 32; u += gridDim.x) {
            const int b = u >> 3, h = u & 7;
            __syncthreads();
            att::attn_unit(Q, Og, ldo, K, V, TL + b * CTX, h, TL + b * CTX, 0, 4, lds);
        }
    }
    __syncthreads();
}

namespace scn {
constexpr int RQ = 0, RK = 16384, RR = 32768;
constexpr int QD = 34816;
constexpr int KN = QD + 64 * 272;
constexpr int KET = KN + 64 * 272;
constexpr int VT = KET + 128 * 144;
constexpr int ST = VT + 128 * 144;
constexpr int PM = ST + 128 * 272;
constexpr int DEC = PM + 64 * 144;
constexpr int END = DEC + 512;
static_assert(END <= LDS_BYTES - 16, "scan LDS");
constexpr size_t US_OFF = 0, DL_OFF = (size_t)64 * 3 * 16384 * 2;
static_assert(DL_OFF + (size_t)64 * 3 * 128 * 4 <= (size_t)3584 * 1024 * 2, "scan hand-off must fit in the dead part of the weight region");
DI int crow(int r, int hi) { return (r & 3) + 8 * (r >> 2) + 4 * hi; }
#define SC_BAR() do { asm volatile("s_waitcnt lgkmcnt(0)" ::: "memory"); __builtin_amdgcn_s_barrier(); asm volatile("" ::: "memory"); } while (0)
#define SMFMA(a, b, c) __builtin_amdgcn_mfma_f32_32x32x16_bf16((a), (b), (c), 0, 0, 0)
}
DI void phase_scan(const Params& P, int l, char* lds, const int pass) {
    using namespace scn;
    const int tid = threadIdx.x, wid = tid >> 6, lane = tid & 63, r32 = lane & 31, hi = lane >> 5;
    const bf16_t* R4 = (const bf16_t*)(P.ws + WS_R4); const bf16_t* SM = (const bf16_t*)(P.ws + WS_SM);
    bf16_t* UST = (bf16_t*)(P.ws + WS_WT + US_OFF); float* DLG = (float*)(P.ws + WS_WT + DL_OFF);
    const int nitems = pass == 1 ? 192 : 256;
    for (int item = blockIdx.x; item < nitems; item += gridDim.x) {
        int seg, scan; if (pass == 1) { seg = item % 3; scan = item / 3; } else { seg = item & 3; scan = item >> 2; }
        const int dir = scan & 1, hd = (scan >> 1) & 7, b = scan >> 4;
        const bool gla = hd < 4; const int hh = hd & 3;
        const int qcol = gla ? hh * 128 : 1536 + hh * 128, kcol = gla ? 512 + hh * 128 : 2048 + hh * 128, vcol = (gla ? 1024 : 2560) + hh * 128;
        bf16_t* Od = (bf16_t*)(P.ws + (dir ? WS_OB : WS_OF)); const int ocol = hd * 128;
        const int pti = wid >> 2, pdj = wid & 3, pd = 32 * pdj + r32;
        const int vt = wid >> 1, dt0 = 2 * (wid & 1);
        bf16x8 w2h = {0, 0, 0, 0, 0, 0, 0, 0}, w2l = {0, 0, 0, 0, 0, 0, 0, 0}; float bias = 0.f, lg = 0.f;
        if (gla) { const float* W2 = P.in[I_GK2] + (size_t)(l * 2 + dir) * 16 * 512 + hh * 128 + pd;
#pragma unroll
            for (int j = 0; j < 8; ++j) { const float w = W2[(8 * hi + j) * 512]; const unsigned u = __float_as_uint(w) & 0xffff0000u; const float res = w - __uint_as_float(u);
                w2h[j] = (short)(u >> 16); w2l[j] = (short)(__float_as_uint(res) >> 16); }
            bias = P.in[I_BGK][(l * 2 + dir) * 512 + hh * 128 + pd]; }
        else lg = -expf(P.in[I_RDEC][(l * 2 + dir) * 4 + hh]);
        f32x16 S0 = {}, S1 = {}; float clsum = 0.f;
        __syncthreads();
        if (pass == 2) {
            for (int sp = 0; sp < seg; ++sp) {
                const bf16_t* U = UST + (size_t)(scan * 3 + sp) * 16384; const float* DL = DLG + (size_t)(scan * 3 + sp) * 128;
                const float e0 = __expf(DL[32 * dt0 + r32]), e1 = __expf(DL[32 * (dt0 + 1) + r32]);
#pragma unroll
                for (int r = 0; r < 16; ++r) { const int v = 32 * vt + crow(r, hi);
                    S0[r] = S0[r] * e0 + bf2f(U[v * 128 + 32 * dt0 + r32]); S1[r] = S1[r] * e1 + bf2f(U[v * 128 + 32 * (dt0 + 1) + r32]); }
            }
#pragma unroll
            for (int r = 0; r < 16; ++r) { const int v = 32 * vt + crow(r, hi);
                *(bf16_t*)(lds + ST + v * 272 + (32 * dt0 + r32) * 2) = f2bf(S0[r]); *(bf16_t*)(lds + ST + v * 272 + (32 * (dt0 + 1) + r32) * 2) = f2bf(S1[r]); }
            { const int i = tid >> 4, j = 32 + (tid & 15) * 2; *(unsigned*)(lds + PM + i * 144 + j * 2) = 0u; }
        }
        u32x4 pq0 = {0u, 0u, 0u, 0u}, pq1 = pq0, pk0, pk1, pr = pq0, pv0, pv1;
#define ROWBASE(n) (dir == 0 ? ((n) < 4 ? TL + b * CTX + 64 * (n) : b * SEQ + 64 * ((n) - 4)) : ((n) < 4 ? TL + b * CTX + 64 * (3 - (n)) : b * SEQ + 64 * (127 - ((n) - 4))))
#define SC_LOADQK(n) do { const int rb_ = ROWBASE(n); \
        if (pass == 2) { pq0 = *(const u32x4*)(R4 + (size_t)(rb_ + (tid >> 4)) * 3072 + qcol + 8 * (tid & 15)); pq1 = *(const u32x4*)(R4 + (size_t)(rb_ + 32 + (tid >> 4)) * 3072 + qcol + 8 * (tid & 15)); } \
        pk0 = *(const u32x4*)(R4 + (size_t)(rb_ + (tid >> 4)) * 3072 + kcol + 8 * (tid & 15)); pk1 = *(const u32x4*)(R4 + (size_t)(rb_ + 32 + (tid >> 4)) * 3072 + kcol + 8 * (tid & 15)); \
        if (tid < 128) pr = *(const u32x4*)(SM + (size_t)(rb_ + (tid >> 1)) * 512 + 416 + dir * 16 + 8 * (tid & 1)); } while (0)
#define SC_LOADV(n) do { const int rb_ = ROWBASE(n); \
        pv0 = *(const u32x4*)(R4 + (size_t)(rb_ + lane) * 3072 + vcol + 8 * wid); pv1 = *(const u32x4*)(R4 + (size_t)(rb_ + lane) * 3072 + vcol + 64 + 8 * wid); } while (0)
#define SC_STOREQK() do { if (pass == 2) { *(u32x4*)(lds + RQ + sr0 * 256 + (tid & 15) * 16) = pq0; *(u32x4*)(lds + RQ + sr1 * 256 + (tid & 15) * 16) = pq1; } \
        *(u32x4*)(lds + RK + sr0 * 256 + (tid & 15) * 16) = pk0; *(u32x4*)(lds + RK + sr1 * 256 + (tid & 15) * 16) = pk1; \
        if (tid < 128) *(u32x4*)(lds + RR + srr * 32 + (tid & 1) * 16) = pr; } while (0)
        const int sr0 = dir ? 63 - (tid >> 4) : (tid >> 4), sr1 = dir ? 31 - (tid >> 4) : 32 + (tid >> 4);
        const int srr = dir ? 63 - (tid >> 1) : (tid >> 1), svi = dir ? 63 - lane : lane;
        const int n0 = 33 * seg;
        SC_LOADQK(n0); SC_STOREQK(); SC_LOADQK(n0 + 1); SC_LOADV(n0);
        for (int n = n0; n < n0 + 33; ++n) {
            int r32v = r32, hiv = hi; asm volatile("" : "+v"(r32v), "+v"(hiv));
            SC_BAR();
            { char* vb = lds + VT + (8 * wid) * 144 + svi * 2;
              const unsigned w0[4] = {pv0.x, pv0.y, pv0.z, pv0.w}, w1[4] = {pv1.x, pv1.y, pv1.z, pv1.w};
#pragma unroll
              for (int e = 0; e < 4; ++e) { *(bf16_t*)(vb + (2 * e) * 144) = (bf16_t)(w0[e] & 0xffffu); *(bf16_t*)(vb + (2 * e + 1) * 144) = (bf16_t)(w0[e] >> 16);
                  *(bf16_t*)(vb + (64 + 2 * e) * 144) = (bf16_t)(w1[e] & 0xffffu); *(bf16_t*)(vb + (64 + 2 * e + 1) * 144) = (bf16_t)(w1[e] >> 16); }
              if (n + 1 < n0 + 33) SC_LOADV(n + 1); }
            {
                f32x16 cum; float cl;
                if (gla) {
                    f32x16 la0, la1;
                    { const bf16x8 a0 = *(const bf16x8*)(lds + RR + r32v * 32 + hiv * 16), a1 = *(const bf16x8*)(lds + RR + (32 + r32v) * 32 + hiv * 16);
                      la0 = SMFMA(a0, w2h, (f32x16{})); la0 = SMFMA(a0, w2l, la0); la1 = SMFMA(a1, w2h, (f32x16{})); la1 = SMFMA(a1, w2l, la1); }
                    float ssum = 0.f;
#pragma unroll
                    for (int r = 0; r < 16; ++r) { const float x0 = la0[r] + bias, x1 = la1[r] + bias;
                        la0[r] = (fminf(x0, 0.f) - __logf(1.f + __expf(-fabsf(x0)))) * (1.f / 16.f);
                        la1[r] = (fminf(x1, 0.f) - __logf(1.f + __expf(-fabsf(x1)))) * (1.f / 16.f);
                        ssum += la0[r] + la1[r]; }
                    cl = ssum + __shfl_xor(ssum, 32);
                    __builtin_amdgcn_sched_barrier(0);
                    cum = f32x16{};
                    bf16x8 tri0, tri1;
#pragma unroll
                    for (int j = 0; j < 8; ++j) { const int k0 = 8 * (j >> 2) + 4 * hiv + (j & 3);
                        tri0[j] = (short)(r32v >= k0 ? 0x3F80 : 0); tri1[j] = (short)(r32v >= k0 + 16 ? 0x3F80 : 0); }
                    const bf16x8 ones = {0x3F80, 0x3F80, 0x3F80, 0x3F80, 0x3F80, 0x3F80, 0x3F80, 0x3F80};
                    const bf16x8 atk0_0 = pti ? ones : tri0, atk0_1 = pti ? ones : tri1;
#pragma unroll
                    for (int st = 0; st < 2; ++st) { bf16x8 h8, l8;
#pragma unroll
                        for (int j = 0; j < 8; ++j) { const float v = la0[8 * st + j]; const unsigned u = __float_as_uint(v) & 0xffff0000u; const float res = v - __uint_as_float(u);
                            h8[j] = (short)(u >> 16); l8[j] = (short)(__float_as_uint(res) >> 16); }
                        const bf16x8 am = st ? atk0_1 : atk0_0; cum = SMFMA(am, h8, cum); cum = SMFMA(am, l8, cum); }
                    if (pti) {
#pragma unroll
                        for (int st = 0; st < 2; ++st) { bf16x8 h8, l8;
#pragma unroll
                            for (int j = 0; j < 8; ++j) { const float v = la1[8 * st + j]; const unsigned u = __float_as_uint(v) & 0xffff0000u; const float res = v - __uint_as_float(u);
                                h8[j] = (short)(u >> 16); l8[j] = (short)(__float_as_uint(res) >> 16); }
                            const bf16x8 am = st ? tri1 : tri0; cum = SMFMA(am, h8, cum); cum = SMFMA(am, l8, cum); } }
                    __builtin_amdgcn_sched_barrier(0);
                } else {
#pragma unroll
                    for (int r = 0; r < 16; ++r) cum[r] = (float)(32 * pti + crow(r, hiv) + 1) * lg;
                    cl = 64.f * lg;
                }
                clsum += cl;
                {
                    const int ibase = 32 * pti + 4 * hiv; const float ecl = __expf(cl);
                    const char* rqb = lds + RQ + ibase * 256 + pd * 2; const char* rkb = lds + RK + ibase * 256 + pd * 2;
                    char* qdb = lds + QD + ibase * 272 + pd * 2; char* knb = lds + KN + ibase * 272 + pd * 2; char* keb = lds + KET + pd * 144 + ibase * 2;
                    if (pass == 2) {
#pragma unroll
                        for (int r = 0; r < 16; ++r) { const int cr = (r & 3) + 8 * (r >> 2);
                            const float c = cum[r]; const float e1 = __expf(c), e2 = __expf(-c);
                            const float q = bf2f(*(const bf16_t*)(rqb + cr * 256)), k = bf2f(*(const bf16_t*)(rkb + cr * 256));
                            const float kn = k * e2;
                            *(bf16_t*)(qdb + cr * 272) = f2bf(q * e1);
                            *(bf16_t*)(knb + cr * 272) = f2bf(kn);
                            *(bf16_t*)(keb + cr * 2) = f2bf(kn * ecl);
                            if ((r & 3) == 3) { asm volatile("" ::: "memory"); } }
                    } else {
#pragma unroll
                        for (int r = 0; r < 16; ++r) { const int cr = (r & 3) + 8 * (r >> 2);
                            const float k = bf2f(*(const bf16_t*)(rkb + cr * 256));
                            *(bf16_t*)(keb + cr * 2) = f2bf(k * __expf(cl - cum[r]));
                            if ((r & 3) == 3) { asm volatile("" ::: "memory"); } }
                    }
                    if (pti == 0 && hiv == 0) *(float*)(lds + DEC + pd * 4) = ecl;
                }
            }
            SC_BAR();
            if (n + 1 < n0 + 33) { SC_STOREQK(); if (n + 2 < n0 + 33) SC_LOADQK(n + 2); }
            f32x16 oacc = {};
            if (pass == 2) {
                if (wid < 3) {
                    const int ti = (wid + 1) >> 1, tj = wid >> 1; f32x16 T0 = {};
#pragma unroll
                    for (int kk = 0; kk < 8; ++kk) { const bf16x8 a = *(const bf16x8*)(lds + QD + (32 * ti + r32v) * 272 + (16 * kk + 8 * hiv) * 2), bb = *(const bf16x8*)(lds + KN + (32 * tj + r32v) * 272 + (16 * kk + 8 * hiv) * 2);
                        T0 = SMFMA(a, bb, T0); }
#pragma unroll
                    for (int r = 0; r < 16; ++r) { const int cr = (r & 3) + 8 * (r >> 2); const int ib = 32 * ti + 4 * hiv, j = 32 * tj + r32v; int jm = j - (dir ? 0 : 1) - ib; asm volatile("" : "+v"(jm));
                        *(bf16_t*)(lds + PM + ib * 144 + j * 2 + cr * 144) = f2bf(cr > jm ? T0[r] : 0.f); }
                }
                { const int ti = wid >> 2, vj = wid & 3;
#pragma unroll
                  for (int kk = 0; kk < 8; ++kk) { const bf16x8 a = *(const bf16x8*)(lds + QD + (32 * ti + r32v) * 272 + (16 * kk + 8 * hiv) * 2), bb = *(const bf16x8*)(lds + ST + (32 * vj + r32v) * 272 + (16 * kk + 8 * hiv) * 2);
                      oacc = SMFMA(a, bb, oacc); } }
            }
            {
                const float dc0 = *(const float*)(lds + DEC + (32 * dt0 + r32v) * 4), dc1 = *(const float*)(lds + DEC + (32 * (dt0 + 1) + r32v) * 4);
#pragma unroll
                for (int r = 0; r < 16; ++r) { S0[r] *= dc0; S1[r] *= dc1; }
#pragma unroll
                for (int kk = 0; kk < 4; ++kk) { const bf16x8 a = *(const bf16x8*)(lds + VT + (32 * vt + r32v) * 144 + (16 * kk + 8 * hiv) * 2);
                    const bf16x8 b0 = *(const bf16x8*)(lds + KET + (32 * dt0 + r32v) * 144 + (16 * kk + 8 * hiv) * 2), b1 = *(const bf16x8*)(lds + KET + (32 * (dt0 + 1) + r32v) * 144 + (16 * kk + 8 * hiv) * 2);
                    S0 = SMFMA(a, b0, S0); S1 = SMFMA(a, b1, S1); }
            }
            if (pass == 2) {
                SC_BAR();
                { const int ti = wid >> 2, vj = wid & 3;
#pragma unroll
                  for (int kk = 0; kk < 4; ++kk) { const bf16x8 a = *(const bf16x8*)(lds + PM + (32 * ti + r32v) * 144 + (16 * kk + 8 * hiv) * 2), bb = *(const bf16x8*)(lds + VT + (32 * vj + r32v) * 144 + (16 * kk + 8 * hiv) * 2);
                      oacc = SMFMA(a, bb, oacc); }
                  const int rb = ROWBASE(n);
#pragma unroll
                  for (int r = 0; r < 16; ++r) { const int i = 32 * ti + crow(r, hiv), row = rb + (dir ? 63 - i : i);
                      Od[(size_t)row * 1024 + ocol + 32 * vj + r32v] = f2bf(oacc[r]); } }
#pragma unroll
                for (int r = 0; r < 16; ++r) { const int cr = (r & 3) + 8 * (r >> 2); char* stb = lds + ST + (32 * vt + 4 * hiv) * 272 + (32 * dt0 + r32v) * 2;
                    *(bf16_t*)(stb + cr * 272) = f2bf(S0[r]); *(bf16_t*)(stb + cr * 272 + 64) = f2bf(S1[r]); }
            }
        }
        if (pass == 1) {
            bf16_t* U = UST + (size_t)(scan * 3 + seg) * 16384;
#pragma unroll
            for (int r = 0; r < 16; ++r) { const int v = 32 * vt + crow(r, hi);
                U[v * 128 + 32 * dt0 + r32] = f2bf(S0[r]); U[v * 128 + 32 * (dt0 + 1) + r32] = f2bf(S1[r]); }
            if (pti == 0 && hi == 0) DLG[(size_t)(scan * 3 + seg) * 128 + pd] = clsum;
        }
#undef ROWBASE
#undef SC_LOADQK
#undef SC_LOADV
#undef SC_STOREQK
    }
    __syncthreads();
}

constexpr int PH_PER_LAYER = 16, N_PHASES = 1 + 2 * PH_PER_LAYER;
#ifndef PHEN
#define PHEN(q) 1
#endif
#ifdef PROBE_GEMM
#define REPG for (int rep_ = 0; rep_ < 2; ++rep_)
#else
#define REPG
#endif
#ifdef PROBE_EW
#define REPE for (int rep_ = 0; rep_ < 2; ++rep_)
#else
#define REPE
#endif
#define PH(k) if (lo <= (k) && (k) < hi && ((k) == lo || (xcd_barrier(xbar), true)))
template <int l>
DI void layer_program(const Params& P, int lo, int hi, LAS unsigned char* lds, unsigned char* lds_raw, const XcdBarrier& xbar) {
    constexpr int base = 1 + PH_PER_LAYER * l;
    constexpr int Mlat = (l == 0) ? TA : TL;
#define WSP(T, off) ((T*)(P.ws + (off)))
#define MODL (WSP(const float, WS_MOD) + (size_t)l * 5 * 6144)
#define HIN_L ((l == 0) ? P.in[I_X] : (const float*)P.out)
#define HIN_C ((l == 0) ? P.in[I_CTX] : WSP(const float, WS_HC))
    PH(base + 0) if (PHEN(0)) REPE { phase_norm(HIN_L, HIN_C, P.in[I_N1W] + l * DM, MODL, 0, 1, WSP(bf16_t, WS_A), TA); phase_wconv_mixer(P, l, lds); }
    PH(base + 1) if (PHEN(1)) REPG { Epi<EM_PLAIN> E{}; E.O0 = WSP(bf16_t, WS_SM); E.ld0 = 512; run_gemm<EM_PLAIN>(lds, WSP(bf16_t, WS_A), 1024, WSP(bf16_t, WS_WT) + WT_IN, TA, 512, 1024, E); }
    PH(base + 2) if (PHEN(2)) REPG { { Epi<EM_PLAIN> E{}; E.O0 = WSP(bf16_t, WS_Q); E.ld0 = 768; run_gemm<EM_PLAIN>(lds, WSP(bf16_t, WS_SM), 512, WSP(bf16_t, WS_WT) + WT_QB, TA, 768, 256, E); }
                  { Epi<EM_KV> E2{}; E2.O0 = WSP(bf16_t, WS_K); E2.O1 = WSP(bf16_t, WS_V); run_gemm<EM_KV>(lds, WSP(bf16_t, WS_SM) + 256, 512, WSP(bf16_t, WS_WT) + WT_KVB, TA, 1024, 128, E2); } }
    PH(base + 3) if (PHEN(3)) phase_qkpost(P, l);
    PH(base + 4) if (PHEN(4)) {
#ifdef PROBE_ATTN
        phase_attention(P, l, (char*)lds_raw, WSP(bf16_t, WS_OF), 1024);
#endif
        phase_attention(P, l, (char*)lds_raw, WSP(bf16_t, WS_Q), 768); }
    PH(base + 5) if (PHEN(5)) REPG { Epi<EM_BIG> E{}; E.O0 = WSP(bf16_t, WS_R4); E.fa = WSP(const float, WS_ROT); run_gemm<EM_BIG>(lds, WSP(bf16_t, WS_A), 1024, WSP(bf16_t, WS_WT) + WT_IN + (size_t)512 * 1024, TA, 3072, 1024, E); }
    PH(base + 6) if (PHEN(6)) phase_scan(P, l, (char*)lds_raw, 1);
    PH(base + 7) if (PHEN(6)) phase_scan(P, l, (char*)lds_raw, 2);
    PH(base + 8) if (PHEN(7)) phase_scanpost(P, l, Mlat);
    PH(base + 9) if (PHEN(8)) { Epi<EM_GATES> E{}; E.O0 = WSP(bf16_t, WS_R4); E.O1 = WSP(bf16_t, WS_OF); E.fa = P.in[I_BGATE] + (size_t)l * 3072; run_gemm<EM_GATES>(lds, WSP(bf16_t, WS_A), 1024, WSP(bf16_t, WS_WT) + WT_IN + (size_t)3584 * 1024, Mlat, 4096, 1024, E); }
    PH(base + 10) if (PHEN(9)) REPG {
        { Epi<EM_BRANCH> E{}; E.O0 = WSP(bf16_t, WS_OB); E.Gsrc = WSP(bf16_t, WS_R4); E.ipar = 0; run_gemm<EM_BRANCH>(lds, WSP(bf16_t, WS_Q), 768, WSP(bf16_t, WS_WT) + WT_BR, Mlat, 1024, 512, E); }
        { Epi<EM_BRANCH> E{}; E.O0 = WSP(bf16_t, WS_OB); E.Gsrc = WSP(bf16_t, WS_R4) + 1024; E.ipar = 1; run_gemm<EM_BRANCH>(lds, WSP(bf16_t, WS_OF), 1024, WSP(bf16_t, WS_WT) + WT_BR + (size_t)1024 * 512, Mlat, 1024, 512, E); }
        { Epi<EM_BRANCH> E{}; E.O0 = WSP(bf16_t, WS_OB); E.Gsrc = WSP(bf16_t, WS_R4) + 2048; E.ipar = 2; run_gemm<EM_BRANCH>(lds, WSP(bf16_t, WS_OF) + 512, 1024, WSP(bf16_t, WS_WT) + WT_BR + (size_t)2048 * 512, Mlat, 1024, 512, E); } }
    PH(base + 11) if (PHEN(10)) { Epi<EM_RES> E{}; E.fa = MODL; E.ipar = 2; E.hin_l = HIN_L; E.hin_c = HIN_C; E.hout_l = P.out; E.hout_c = WSP(float, WS_HC);
                   run_gemm<EM_RES>(lds, WSP(bf16_t, WS_OB), 1024, WSP(bf16_t, WS_WT) + WT_OUT, Mlat, 1024, 1024, E); }
    PH(base + 12) if (PHEN(11)) REPE { phase_norm(P.out, WSP(const float, WS_HC), P.in[I_N2W] + l * DM, MODL, 3, 4, WSP(bf16_t, WS_A), Mlat); phase_wconv_ffn(P, l, lds); }
    PH(base + 13) if (PHEN(12)) REPG { Epi<EM_FFNIN> E{}; E.O0 = WSP(bf16_t, WS_G); E.O1 = WSP(bf16_t, WS_U); run_gemm<EM_FFNIN>(lds, WSP(bf16_t, WS_A), 1024, WSP(bf16_t, WS_WT) + WT_F1, Mlat, 5632, 1024, E); }
    PH(base + 14) if (PHEN(13)) phase_conv(P, l, Mlat);
    PH(base + 15) if (PHEN(14)) { Epi<EM_RES> E{}; E.fa = MODL; E.ipar = 5; E.hin_l = P.out; E.hin_c = WSP(const float, WS_HC); E.hout_l = P.out; E.hout_c = WSP(float, WS_HC);
                   run_gemm<EM_RES>(lds, WSP(bf16_t, WS_U), DFF, WSP(bf16_t, WS_WT) + WT_F2, Mlat, 1024, DFF, E); }
}
__global__ void __launch_bounds__(NTHREADS, 2) fwd_kernel(Params P) {
    extern __shared__ __attribute__((aligned(16))) unsigned char lds_raw[];
    LAS unsigned char* lds = (LAS unsigned char*)lds_raw;
    cg::grid_group grid = cg::this_grid();
    const int lo = P.ph_lo, hi = P.ph_hi;
    Params* G = (Params*)(P.ws + WS_PAR + (size_t)blockIdx.x * 256);
    if (threadIdx.x == 0) {
#pragma unroll
        for (int i = 0; i < 26; ++i) G->in[i] = P.in[i];
        G->out = P.out; G->ws = P.ws; G->ph_lo = lo; G->ph_hi = hi;
    }
    __syncthreads();
    asm volatile("" ::: "memory");
    const Params& Q = *G;
    if (threadIdx.x < 4) ((LAS unsigned*)(lds + LDS_BARW))[threadIdx.x] = 0u;
    __syncthreads();
    const XcdBarrier xbar = xcd_barrier_post((unsigned*)(P.ws + WS_BAR), (volatile LAS unsigned*)(lds + LDS_BARW));
    if (lo < 0) grid.sync();
    PH(0) REPE phase_prologue(Q, lds);
    layer_program<0>(Q, lo, hi, lds, lds_raw, xbar);
    layer_program<1>(Q, lo, hi, lds, lds_raw, xbar);
#ifdef PROBE_SYNC
    for (int i = 0; i < 20; ++i) xcd_barrier(xbar);
#endif
}

#ifndef N_LAUNCH_MODE
#define N_LAUNCH_MODE 1
#endif
extern "C" void kernel_launch(void* const* d_in, const int* in_sizes, int n_in, void* d_out, int out_size, void* d_ws, size_t ws_size, hipStream_t stream) {
    static int grid_blocks = 0;
    if (!grid_blocks) {
        if (n_in != 26 || ws_size < WS_NEED) { fprintf(stderr, "kernel_launch: bad inputs (n_in %d, ws %zu < %zu)\n", n_in, ws_size, (size_t)WS_NEED); return; }
        if (hipFuncSetAttribute((const void*)fwd_kernel, hipFuncAttributeMaxDynamicSharedMemorySize, LDS_BYTES) != hipSuccess) { fprintf(stderr, "kernel_launch: hipFuncSetAttribute failed\n"); return; }
        int dev = 0, cus = 0, per_cu = 0;
        hipGetDevice(&dev);
        hipDeviceGetAttribute(&cus, hipDeviceAttributeMultiprocessorCount, dev);
        hipOccupancyMaxActiveBlocksPerMultiprocessor(&per_cu, fwd_kernel, NTHREADS, LDS_BYTES);
        if (per_cu < 1) { fprintf(stderr, "kernel_launch: occupancy query returned %d\n", per_cu); return; }
        grid_blocks = cus * 1;
    }
    Params p{};
    for (int i = 0; i < 26; ++i) p.in[i] = (const float*)d_in[i];
    p.out = (float*)d_out; p.ws = (unsigned char*)d_ws;
#if N_LAUNCH_MODE == 1
    p.ph_lo = 0; p.ph_hi = N_PHASES;
    if (hipMemsetAsync((unsigned char*)d_ws + WS_BAR, 0, XCD_BAR_WORDS * 4, stream) != hipSuccess) { fprintf(stderr, "kernel_launch: memset of the barrier words failed\n"); return; }
    void* args[] = {&p};
    hipError_t e = hipLaunchCooperativeKernel((const void*)fwd_kernel, dim3(grid_blocks), dim3(NTHREADS), args, LDS_BYTES, stream);
    if (e != hipSuccess) fprintf(stderr, "cooperative launch failed: %s (grid %d)\n", hipGetErrorString(e), grid_blocks);
#else
    for (int ph = 0; ph < N_PHASES; ++ph) {
        p.ph_lo = ph; p.ph_hi = ph + 1;
        hipLaunchKernelGGL(fwd_kernel, dim3(grid_blocks), dim3(NTHREADS), LDS_BYTES, stream, p);
    }
#endif
}
```

```cpp
#include <hip/hip_runtime.h>
#include <hip/hip_bf16.h>
#include <hip/hip_cooperative_groups.h>
#include <cstdio>
#include <cstdint>
namespace cg = cooperative_groups;
#define DI __device__ __forceinline__
#define LAS __attribute__((address_space(3)))
namespace pg8 {
#define PG8_LAS __attribute__((address_space(3)))
typedef unsigned short bf16_t;
typedef short bf16x8 __attribute__((ext_vector_type(8)));
typedef float f32x4 __attribute__((ext_vector_type(4)));
typedef unsigned u32x4 __attribute__((ext_vector_type(4)));
constexpr int BM = 256, BK = 64, HALF = 128, HTB = HALF * BK * 2  , STAGE_BYTES = 8 * HTB, NXCD = 8, WGM = 8;

__host__ __device__ __forceinline__ int lds_byte(int r, int c) { const int st = (r >> 4) * 2 + (c >> 5), rr = r & 15, cc = c & 31, ob = rr * 64 + cc * 2; return st * 1024 + (ob ^ (((ob >> 9) & 1) << 5)); }
__host__ __device__ __forceinline__ void stage_rc(int b, int& R, int& C) { const int st = b / 1024, sb = b % 1024, swz = sb ^ (((sb >> 9) & 1) << 5); R = (st >> 1) * 16 + swz / 64; C = (st & 1) * 32 + (swz % 64) / 2; }
__host__ __device__ __forceinline__ int perm32(int rho) { const int n = rho >> 4, i = rho & 15; return 8 * (i >> 2) + 4 * n + (i & 3); }

struct Unit { int pm, pn; };
struct Gemm { const bf16_t* A; const bf16_t* Bt; int M, N, K, lda; };

struct StaticOrder {
    int nM, nN, nwg, G, c;
    __host__ __device__ void init(int M, int N, int G_, int c_) { nM = M / BM; nN = N / BM; nwg = nM * nN; G = G_; c = c_; }
    __host__ __device__ bool next(int i, Unit& u) const {
        const long L = (long)i * G + c; if (L >= nwg) return false;
        int wgid = (int)L; { const int q = nwg / NXCD, r = nwg % NXCD, xcd = wgid % NXCD, off = wgid / NXCD; wgid = (xcd < r ? xcd * (q + 1) : r * (q + 1) + (xcd - r) * q) + off; }
        const int nig = WGM * nN, gid = wgid / nig, fm = gid * WGM, gsz = (nM - fm) < WGM ? (nM - fm) : WGM;
        u.pm = fm + ((wgid % nig) % gsz); u.pn = (wgid % nig) / gsz; return true;
    }
    __device__ __forceinline__ void a_ready(const Unit&) const {}
    __device__ __forceinline__ void done(const Unit&) const {}
};

__device__ __forceinline__ unsigned cvt_pk_bf16(float lo, float hi) { unsigned r; asm volatile("v_cvt_pk_bf16_f32 %0, %1, %2" : "=v"(r) : "v"(lo), "v"(hi)); return r; }
template <class Epi, class Sched, bool ALIGN_EPI = false, bool SP2 = false>
__device__ __forceinline__ void gemm_phase(PG8_LAS unsigned char* lds, const Gemm g, const Sched& S, const Epi& E) {
    const int tid = threadIdx.x, wid = __builtin_amdgcn_readfirstlane(tid >> 6), lane = tid & 63, wr = wid >> 2, wc = wid & 3, fr = lane & 15, fq = lane >> 4;
    const int K = g.K, nt = K / BK;
    unsigned voffA[2], voffB[2];
#pragma unroll
    for (int i = 0; i < 2; ++i) { int R, C; stage_rc(tid * 16 + i * 8192, R, C); const int Rb = Epi::PERM ? ((R & ~31) + perm32(R & 31)) : R;
        voffA[i] = (unsigned)(R * g.lda + C) * 2u; voffB[i] = (unsigned)(Rb * K + C) * 2u; }
    const size_t kstep = (size_t)(BK * 2);
    const size_t hstep = (size_t)HALF * K * 2;
    const size_t tstep = 2 * hstep; const size_t hstepA = (size_t)HALF * g.lda * 2; const size_t tstepA = 2 * hstepA;
    const unsigned ldsw = (unsigned)wid * 1024u;
    const int aoff = lds_byte(wr * 64 + fr, fq * 8), boff = lds_byte(wc * 32 + fr, fq * 8);
#define PG8_SA(b, h) (((b) * 2 + (h)) * HTB)
#define PG8_SB(b, h) ((4 + (b) * 2 + (h)) * HTB)
#define PG8_STAGE(bufoff, gbase, voff) do { _Pragma("unroll") for (int _i = 0; _i < 2; ++_i) \
        __builtin_amdgcn_global_load_lds((const unsigned*)((const char*)(gbase) + (voff)[_i]), (PG8_LAS unsigned*)(lds + (bufoff) + ldsw + _i * 8192), 16, 0, 0); } while (0)
#define PG8_LDA(dst, b, h) do { _Pragma("unroll") for (int m = 0; m < 4; ++m) _Pragma("unroll") for (int k = 0; k < 2; ++k) dst[m][k] = *(const PG8_LAS bf16x8*)(lds + PG8_SA(b, h) + aoff + m * 2048 + k * 1024); } while (0)
#define PG8_LDB(dst, b, h) do { _Pragma("unroll") for (int n = 0; n < 2; ++n) _Pragma("unroll") for (int k = 0; k < 2; ++k) dst[n][k] = *(const PG8_LAS bf16x8*)(lds + PG8_SB(b, h) + boff + n * 2048 + k * 1024); } while (0)
#define PG8_MMA(ai, bj, At, Bt) do { __builtin_amdgcn_s_setprio(1); _Pragma("unroll") for (int m = 0; m < 4; ++m) _Pragma("unroll") for (int n = 0; n < 2; ++n) _Pragma("unroll") for (int k = 0; k < 2; ++k) \
        acc[ai][bj][m][n] = __builtin_amdgcn_mfma_f32_16x16x32_bf16(Bt[n][k], At[m][k], acc[ai][bj][m][n], 0, 0, 0); __builtin_amdgcn_s_setprio(0); } while (0)
#define PG8_WAIT_V(n) asm volatile("s_waitcnt vmcnt(" #n ")" ::: "memory")
#define PG8_WAIT_L(n) asm volatile("s_waitcnt lgkmcnt(" #n ")" ::: "memory")
#define PG8_BAR __builtin_amdgcn_s_barrier()
#define PG8_SCHED __builtin_amdgcn_sched_barrier(0)
    Unit cur, nxt; int ui = 0;
    if (!S.next(0, cur)) return;
    f32x4 acc[2][2][4][2];
#pragma unroll
    for (int a = 0; a < 2; ++a)
#pragma unroll
        for (int b = 0; b < 2; ++b)
#pragma unroll
            for (int m = 0; m < 4; ++m)
#pragma unroll
                for (int n = 0; n < 2; ++n) acc[a][b][m][n] = (f32x4){0.f, 0.f, 0.f, 0.f};
    bf16x8 At[4][2], B0[2][2], B1[2][2];
    const char* cA = (const char*)g.A + (size_t)cur.pm * tstepA; const char* cB = (const char*)g.Bt + (size_t)cur.pn * tstep;
    S.a_ready(cur);
    if constexpr (SP2) {
        PG8_STAGE(PG8_SB(0, 0), cB, voffB); PG8_STAGE(PG8_SB(0, 1), cB + hstep, voffB); PG8_STAGE(PG8_SA(0, 0), cA, voffA); PG8_STAGE(PG8_SA(0, 1), cA + hstepA, voffA);
        if (wr == 1) PG8_BAR;
        PG8_WAIT_V(2); PG8_BAR;
        PG8_STAGE(PG8_SB(1, 0), cB + kstep, voffB); PG8_STAGE(PG8_SA(1, 0), cA + kstep, voffA); PG8_STAGE(PG8_SB(1, 1), cB + hstep + kstep, voffB);
        PG8_WAIT_V(6); PG8_BAR;
    } else {
        PG8_STAGE(PG8_SB(0, 0), cB, voffB); PG8_STAGE(PG8_SA(0, 0), cA, voffA); PG8_STAGE(PG8_SB(0, 1), cB + hstep, voffB); PG8_STAGE(PG8_SA(0, 1), cA + hstepA, voffA);
        if (wr == 1) PG8_BAR;
        PG8_WAIT_V(4); PG8_BAR;
        PG8_STAGE(PG8_SB(1, 0), cB + kstep, voffB); PG8_STAGE(PG8_SA(1, 0), cA + kstep, voffA); PG8_STAGE(PG8_SB(1, 1), cB + hstep + kstep, voffB);
        PG8_WAIT_V(6); PG8_BAR;
    }
    for (;;) {
        const bool has_next = S.next(ui + 1, nxt);
        const char* nA = has_next ? (const char*)g.A + (size_t)nxt.pm * tstepA : cA; const char* nB = has_next ? (const char*)g.Bt + (size_t)nxt.pn * tstep : cB;
        for (int t = 0; t < nt; t += 2) {
            const bool last = (t == nt - 2);
            const char* a1 = cA + (size_t)(t + 1) * kstep;
            const char* a2 = last ? nA : cA + (size_t)(t + 2) * kstep; const char* b2 = last ? nB : cB + (size_t)(t + 2) * kstep;
            const char* a3 = a2 + kstep; const char* b3 = b2 + kstep;
            if (last && has_next) S.a_ready(nxt);
            if constexpr (SP2) {
            PG8_LDB(B0, 0, 0); PG8_LDB(B1, 0, 1); PG8_SCHED; PG8_LDA(At, 0, 0); PG8_STAGE(PG8_SA(1, 1), a1 + hstepA, voffA);
            PG8_WAIT_V(8); PG8_WAIT_L(0); PG8_BAR; PG8_MMA(0, 0, At, B0); PG8_MMA(0, 1, At, B1); PG8_BAR; PG8_SCHED;
            PG8_LDA(At, 0, 1); PG8_STAGE(PG8_SB(0, 0), b2, voffB); PG8_STAGE(PG8_SB(0, 1), b2 + hstep, voffB); PG8_STAGE(PG8_SA(0, 0), a2, voffA);
            PG8_WAIT_V(8); PG8_WAIT_L(0); PG8_BAR; PG8_MMA(1, 0, At, B0); PG8_MMA(1, 1, At, B1); PG8_BAR; PG8_SCHED;
            PG8_LDB(B0, 1, 0); PG8_LDB(B1, 1, 1); PG8_SCHED; PG8_LDA(At, 1, 0); PG8_STAGE(PG8_SA(0, 1), a2 + hstepA, voffA);
            PG8_WAIT_V(8); PG8_WAIT_L(0); PG8_BAR; PG8_MMA(0, 0, At, B0); PG8_MMA(0, 1, At, B1); PG8_BAR; PG8_SCHED;
            PG8_LDA(At, 1, 1); PG8_STAGE(PG8_SB(1, 0), b3, voffB); PG8_STAGE(PG8_SB(1, 1), b3 + hstep, voffB); PG8_STAGE(PG8_SA(1, 0), a3, voffA);
            PG8_WAIT_V(8); PG8_WAIT_L(0); PG8_BAR; PG8_MMA(1, 0, At, B0); PG8_MMA(1, 1, At, B1); PG8_BAR; PG8_SCHED;
            } else {
            PG8_LDB(B0, 0, 0); PG8_SCHED; PG8_LDA(At, 0, 0); PG8_STAGE(PG8_SA(1, 1), a1 + hstepA, voffA);
            PG8_WAIT_L(8); PG8_BAR; PG8_WAIT_L(0); PG8_MMA(0, 0, At, B0); PG8_BAR; PG8_SCHED;
            PG8_LDB(B1, 0, 1); PG8_STAGE(PG8_SB(0, 0), b2, voffB);
            PG8_BAR; PG8_WAIT_L(0); PG8_MMA(0, 1, At, B1); PG8_BAR;
            PG8_LDA(At, 0, 1); PG8_STAGE(PG8_SA(0, 0), a2, voffA);
            PG8_BAR; PG8_WAIT_L(0); PG8_MMA(1, 0, At, B0); PG8_BAR; PG8_SCHED;
            PG8_STAGE(PG8_SB(0, 1), b2 + hstep, voffB);
            PG8_WAIT_V(6); PG8_BAR; PG8_MMA(1, 1, At, B1); PG8_BAR;
            PG8_LDB(B0, 1, 0); PG8_SCHED; PG8_LDA(At, 1, 0); PG8_STAGE(PG8_SA(0, 1), a2 + hstepA, voffA);
            PG8_WAIT_L(8); PG8_BAR; PG8_WAIT_L(0); PG8_MMA(0, 0, At, B0); PG8_BAR; PG8_SCHED;
            PG8_LDB(B1, 1, 1); PG8_STAGE(PG8_SB(1, 0), b3, voffB);
            PG8_BAR; PG8_WAIT_L(0); PG8_MMA(0, 1, At, B1); PG8_BAR;
            PG8_LDA(At, 1, 1); PG8_STAGE(PG8_SA(1, 0), a3, voffA);
            PG8_BAR; PG8_WAIT_L(0); PG8_MMA(1, 0, At, B0); PG8_BAR; PG8_SCHED;
            PG8_STAGE(PG8_SB(1, 1), b3 + hstep, voffB);
            PG8_WAIT_V(6); PG8_BAR; PG8_MMA(1, 1, At, B1); PG8_BAR;
            }
        }
        if constexpr (ALIGN_EPI) { if (wr == 0) PG8_BAR; }
        if constexpr (!Epi::AFTER_DRAIN) { E(acc, cur, wr, wc, fr, fq); S.done(cur); }
        if (!has_next) break;
#pragma unroll
        for (int a = 0; a < 2; ++a)
#pragma unroll
            for (int b = 0; b < 2; ++b)
#pragma unroll
                for (int m = 0; m < 4; ++m)
#pragma unroll
                    for (int n = 0; n < 2; ++n) acc[a][b][m][n] = (f32x4){0.f, 0.f, 0.f, 0.f};
        cur = nxt; cA = nA; cB = nB; ++ui;
        if constexpr (ALIGN_EPI) { if (wr == 1) PG8_BAR; }
    }
    PG8_WAIT_V(0);
    if constexpr (!ALIGN_EPI) { if (wr == 0) PG8_BAR; }
    PG8_BAR;
    if constexpr (Epi::AFTER_DRAIN) { E.fused(acc, cur, wr, wc, fr, fq, lds, wid, lane); S.done(cur); }
#undef PG8_SA
#undef PG8_SB
#undef PG8_STAGE
#undef PG8_LDA
#undef PG8_LDB
#undef PG8_MMA
#undef PG8_WAIT_V
#undef PG8_WAIT_L
#undef PG8_BAR
#undef PG8_SCHED
}
}

typedef unsigned short bf16_t;
typedef short bf16x8 __attribute__((ext_vector_type(8)));
typedef short s16x4 __attribute__((ext_vector_type(4)));
typedef float f32x4 __attribute__((ext_vector_type(4)));
typedef float f32x2 __attribute__((ext_vector_type(2)));
typedef float f32x16 __attribute__((ext_vector_type(16)));
typedef unsigned u32x4 __attribute__((ext_vector_type(4)));
typedef unsigned u32x2 __attribute__((ext_vector_type(2)));

constexpr int DM = 1024, NB = 4, SEQ = 8192, CTX = 256, TL = NB * SEQ, TC = NB * CTX, TA = TL + TC;
constexpr int DFF = 2816, NIN = 7616;
constexpr float EPS = 1e-6f;
constexpr int NTHREADS = 512, NWAVES = 8;

constexpr size_t al256(size_t x) { return (x + 255) / 256 * 256; }
constexpr size_t WS_MOD = 0;
constexpr size_t WS_PAR = al256(WS_MOD + (size_t)2 * 5 * 6144 * 4);
constexpr size_t WS_BAR = al256(WS_PAR + (size_t)1024 * 256);
constexpr size_t WS_ROPE = al256(WS_BAR + (size_t)3456 * 4);
constexpr size_t WS_ROT = al256(WS_ROPE + (size_t)192 * 8 * 8);
constexpr size_t WS_HC  = al256(WS_ROT + (size_t)8448 * 64 * 8);
constexpr size_t WS_WT  = al256(WS_HC + (size_t)TC * DM * 4);
constexpr size_t WT_IN = 0, WT_QB = WT_IN + (size_t)7680 * 1024, WT_KVB = WT_QB + (size_t)768 * 256, WT_BR = WT_KVB + (size_t)1024 * 128,
                 WT_OUT = WT_BR + (size_t)3 * 1024 * 512, WT_MIX_END = WT_OUT + (size_t)1024 * 1024;
constexpr size_t WT_F1 = 0, WT_F2 = (size_t)5632 * 1024, WT_FFN_END = WT_F2 + (size_t)1024 * 2816;
constexpr size_t WT_ELEMS = WT_MIX_END > WT_FFN_END ? WT_MIX_END : WT_FFN_END;
constexpr size_t WS_A   = al256(WS_WT + WT_ELEMS * 2);
constexpr size_t WS_SM  = al256(WS_A + (size_t)TA * 1024 * 2);
constexpr size_t WS_Q   = al256(WS_SM + (size_t)TA * 512 * 2);
constexpr size_t WS_R4  = al256(WS_Q + (size_t)TA * 768 * 2);
constexpr size_t WS_K   = WS_R4;
constexpr size_t WS_V   = al256(WS_K + (size_t)TA * 768 * 2);
constexpr size_t WS_OF  = al256(WS_R4 + (size_t)TA * 3072 * 2);
constexpr size_t WS_OB  = al256(WS_OF + (size_t)TA * 1024 * 2);
constexpr size_t WS_END_MIX = al256(WS_OB + (size_t)TA * 1024 * 2);
constexpr size_t WS_G   = WS_SM;
constexpr size_t WS_U   = al256(WS_G + (size_t)TA * DFF * 2);
constexpr size_t WS_END_FFN = al256(WS_U + (size_t)132 * 6 * DFF * 4);
constexpr size_t WS_NEED = WS_END_MIX > WS_END_FFN ? WS_END_MIX : WS_END_FFN;
static_assert(WS_V + (size_t)TA * 512 * 2 <= WS_OF, "K/V overlay must fit in R4");

constexpr int LDS_BYTES = 148 * 1024;
constexpr int LDS_BARW = LDS_BYTES - 16;

struct Params { const float* in[26]; float* out; unsigned char* ws; int ph_lo, ph_hi; };
enum { I_X = 0, I_C, I_CTX, I_CCTX, I_WADA, I_BADA, I_N1W, I_N2W, I_WIN, I_BGATE, I_QNA, I_WQB, I_KVNA, I_WKVB, I_QN, I_KN, I_GK2, I_BGK, I_GON, I_RDEC, I_WBR, I_WOUT, I_WF1, I_WDW, I_BDW, I_WF2 };

DI float bflo(unsigned w) { return __uint_as_float(w << 16); }
DI float bfhi(unsigned w) { return __uint_as_float(w & 0xffff0000u); }
DI float bf2f(bf16_t x) { return __uint_as_float((unsigned)x << 16); }
DI unsigned pk2(float lo, float hi) { unsigned r; asm volatile("v_cvt_pk_bf16_f32 %0, %1, %2" : "=v"(r) : "v"(lo), "v"(hi)); return r; }
DI bf16_t f2bf(float x) { return (bf16_t)(pk2(x, 0.f) & 0xffffu); }
DI float wave_sum(float v) {
#pragma unroll
    for (int o = 1; o < 64; o <<= 1) v += __shfl_xor(v, o);
    return v;
}
DI float sigmoidf_(float x) { return 1.f / (1.f + __expf(-x)); }
DI void unpack8(u32x4 w, float* f) { f[0] = bflo(w.x); f[1] = bfhi(w.x); f[2] = bflo(w.y); f[3] = bfhi(w.y); f[4] = bflo(w.z); f[5] = bfhi(w.z); f[6] = bflo(w.w); f[7] = bfhi(w.w); }
DI u32x4 pack8(const float* f) { u32x4 w; w.x = pk2(f[0], f[1]); w.y = pk2(f[2], f[3]); w.z = pk2(f[4], f[5]); w.w = pk2(f[6], f[7]); return w; }

DI void rowinfo(int m, int& b, int& pos, int& isctx) {
    if (m < TL) { b = m >> 13; pos = m & 8191; isctx = 0; } else { const int j = m - TL; b = j >> 8; pos = j & 255; isctx = 1; }
}

DI void phase_prologue(const Params& P, LAS unsigned char* lds) {
    const int tid = threadIdx.x, wave = tid >> 6, lane = tid & 63;
    LAS float* cond = (LAS float*)lds;
    LAS float* part = cond + 5 * 1024;
    const float* c = P.in[I_C]; const float* cc = P.in[I_CCTX];
    for (int i = tid; i < 5 * 1024; i += NTHREADS) { const int r = i >> 10, k = i & 1023; const float v = r < 4 ? c[r * 1024 + k] : cc[k]; cond[i] = v / (1.f + expf(-v)); }
    __syncthreads();
    float* MOD = (float*)(P.ws + WS_MOD);
    for (int item = blockIdx.x; item < 192; item += gridDim.x) {
        const int l = item / 96, j0 = (item % 96) * 64;
        const float* W = P.in[I_WADA] + (size_t)l * 1024 * 6144 + j0 + lane;
        float a0 = 0.f, a1 = 0.f, a2 = 0.f, a3 = 0.f, a4 = 0.f;
#pragma unroll 16
        for (int k = wave * 128; k < wave * 128 + 128; ++k) {
            const float w = W[(size_t)k * 6144];
            a0 += cond[k] * w; a1 += cond[1024 + k] * w; a2 += cond[2048 + k] * w; a3 += cond[3072 + k] * w; a4 += cond[4096 + k] * w;
        }
        part[(wave * 5 + 0) * 64 + lane] = a0; part[(wave * 5 + 1) * 64 + lane] = a1; part[(wave * 5 + 2) * 64 + lane] = a2;
        part[(wave * 5 + 3) * 64 + lane] = a3; part[(wave * 5 + 4) * 64 + lane] = a4;
        __syncthreads();
        if (tid < 320) { const int r = tid >> 6; float s = 0.f;
            for (int w = 0; w < 8; ++w) s += part[(w * 5 + r) * 64 + lane];
            MOD[(size_t)(l * 5 + r) * 6144 + j0 + lane] = s + P.in[I_BADA][l * 6144 + j0 + lane]; }
        __syncthreads();
    }
    { f32x2* ROPE = (f32x2*)(P.ws + WS_ROPE);
      for (int i = blockIdx.x * NTHREADS + tid; i < 192 * 8; i += gridDim.x * NTHREADS) { const int p = i >> 3, f = i & 7; const float pos = (float)(p < 128 ? p : p - 128);
          const float inv = powf(10000.0f, -(float)f * 0.125f); float s, co; sincosf(pos * inv, &s, &co); ROPE[i] = (f32x2){co, s}; } }
    f32x2* ROT = (f32x2*)(P.ws + WS_ROT);
    for (int i = blockIdx.x * NTHREADS + tid; i < 8448 * 64; i += gridDim.x * NTHREADS) {
        const int pos = i >> 6, j = i & 63;
        const float inv = 1.0f / powf(10000.0f, (float)j / 63.0f);
        const float ang = (float)pos * inv; float s, co; sincosf(ang, &s, &co);
        ROT[i] = (f32x2){co, s};
    }
}

DI int wmap(int id, int n) {
    switch (id) {
    case 1: if (n < 416) return n; if (n < 448) return 2464 + (n - 416); return -1;
    case 2: { if (n < 1536) return 416 + n;
              if (n < 2560) { const int base = n < 2048 ? 2496 : 3008; const int j = (n - 1536) & 511; const int hh = j >> 7, v = j & 127, g = v >> 3, e = v & 7;
                              const int d = e < 4 ? 4 * g + e : 64 + 4 * g + (e - 4); return base + hh * 128 + d; }
              return 3520 + (n - 2560); }
    case 3: if (n < 512) return 1952 + n; if (n < 1024) return 4032 + (n - 512); return 4544 + (n - 1024);
    case 4: if (n < 512) return (n >> 6) * 96 + (n & 63); { const int j = n - 512; return (j >> 5) * 96 + 64 + (j & 31); }
    case 5: if (n < 512) return (n >> 6) * 128 + (n & 63); { const int j = n - 512; return (j >> 6) * 128 + 64 + (j & 63); }
    case 6: { const int pn = n >> 8, bj = (n >> 7) & 1, j = n & 127; return bj * 2816 + 128 * pn + j; }
    default: return n;
    }
}
struct TJob { const float* W; int K, Nsrc; bf16_t* WT; int ndst, map_id; const float* kscale; };
DI void transpose_job(const TJob& J, LAS float* scr, int gw, int ngw, int lane) {
    const int nblk = J.ndst / 32, nitems = (J.K / 64) * nblk;
    for (int item = gw; item < nitems; item += ngw) {
        const int kb = item / nblk, nb = item % nblk, k0 = 64 * kb, n0 = 32 * nb;
        const int src = wmap(J.map_id, n0 + (lane & 31));
        float tv[32];
#pragma unroll
        for (int i = 0; i < 32; ++i) { const int kk = 2 * i + (lane >> 5); tv[i] = src >= 0 ? J.W[(size_t)(k0 + kk) * J.Nsrc + src] : 0.f; }
        if (J.kscale) {
#pragma unroll
            for (int i = 0; i < 32; ++i) tv[i] *= J.kscale[k0 + 2 * i + (lane >> 5)]; }
#pragma unroll
        for (int i = 0; i < 32; ++i) scr[(2 * i + (lane >> 5)) * 33 + (lane & 31)] = tv[i];
        asm volatile("s_waitcnt lgkmcnt(0)" ::: "memory");
        const int c = lane & 7;
#pragma unroll
        for (int j = 0; j < 4; ++j) { const int n = (lane >> 3) + 8 * j; const LAS float* s = scr + (8 * c) * 33 + n;
            u32x4 o; o.x = pk2(s[0 * 33], s[1 * 33]); o.y = pk2(s[2 * 33], s[3 * 33]); o.z = pk2(s[4 * 33], s[5 * 33]); o.w = pk2(s[6 * 33], s[7 * 33]);
            *(u32x4*)(J.WT + (size_t)(n0 + n) * J.K + k0 + 8 * c) = o; }
        asm volatile("s_waitcnt lgkmcnt(0)" ::: "memory");
    }
}
DI void phase_wconv_mixer(const Params& P, int l, LAS unsigned char* lds) {
    const int tid = threadIdx.x, wave = tid >> 6, lane = tid & 63, gw = blockIdx.x * NWAVES + wave, ngw = gridDim.x * NWAVES;
    LAS float* scr = (LAS float*)lds + wave * (64 * 33);
    bf16_t* WT = (bf16_t*)(P.ws + WS_WT);
    const float* win = P.in[I_WIN] + (size_t)l * 1024 * NIN;
    TJob j;
    j = TJob{win, 1024, NIN, WT + WT_IN, 512, 1, nullptr}; transpose_job(j, scr, gw, ngw, lane);
    j = TJob{win, 1024, NIN, WT + WT_IN + (size_t)512 * 1024, 3072, 2, nullptr}; transpose_job(j, scr, gw, ngw, lane);
    j = TJob{win, 1024, NIN, WT + WT_IN + (size_t)3584 * 1024, 4096, 3, nullptr}; transpose_job(j, scr, gw, ngw, lane);
    j = TJob{P.in[I_WQB] + (size_t)l * 256 * 768, 256, 768, WT + WT_QB, 768, 4, P.in[I_QNA] + l * 256}; transpose_job(j, scr, gw, ngw, lane);
    j = TJob{P.in[I_WKVB] + (size_t)l * 128 * 1024, 128, 1024, WT + WT_KVB, 1024, 5, P.in[I_KVNA] + l * 128}; transpose_job(j, scr, gw, ngw, lane);
    for (int n = 0; n < 3; ++n) { j = TJob{P.in[I_WBR] + ((size_t)l * 3 + n) * 512 * 1024, 512, 1024, WT + WT_BR + (size_t)n * 1024 * 512, 1024, 0, nullptr}; transpose_job(j, scr, gw, ngw, lane); }
    j = TJob{P.in[I_WOUT] + (size_t)l * 1024 * 1024, 1024, 1024, WT + WT_OUT, 1024, 0, nullptr}; transpose_job(j, scr, gw, ngw, lane);
}
DI void phase_wconv_ffn(const Params& P, int l, LAS unsigned char* lds) {
    const int tid = threadIdx.x, wave = tid >> 6, lane = tid & 63, gw = blockIdx.x * NWAVES + wave, ngw = gridDim.x * NWAVES;
    LAS float* scr = (LAS float*)lds + wave * (64 * 33);
    bf16_t* WT = (bf16_t*)(P.ws + WS_WT);
    TJob j;
    j = TJob{P.in[I_WF1] + (size_t)l * 1024 * 5632, 1024, 5632, WT + WT_F1, 5632, 6, nullptr}; transpose_job(j, scr, gw, ngw, lane);
    j = TJob{P.in[I_WF2] + (size_t)l * 2816 * 1024, 2816, 1024, WT + WT_F2, 1024, 0, nullptr}; transpose_job(j, scr, gw, ngw, lane);
}

DI void phase_norm(const float* __restrict__ hl, const float* __restrict__ hc, const float* __restrict__ nw, const float* __restrict__ MODl, int ishift, int iscale, bf16_t* __restrict__ A, int nrows) {
    const int tid = threadIdx.x, wave = tid >> 6, lane = tid & 63, gw = blockIdx.x * NWAVES + wave, ngw = gridDim.x * NWAVES;
    f32x4 nx[4];
#define NLOAD(dst, m_) do { const float* xr_ = (m_) >= TL ? hc + (size_t)((m_) - TL) * DM : hl + (size_t)(m_) * DM; \
        _Pragma("unroll") for (int j = 0; j < 4; ++j) dst[j] = *(const f32x4*)(xr_ + 4 * lane + 256 * j); } while (0)
    if (gw < nrows) NLOAD(nx, gw);
    for (int m = gw; m < nrows; m += ngw) {
        f32x4 v[4];
#pragma unroll
        for (int j = 0; j < 4; ++j) v[j] = nx[j];
        if (m + ngw < nrows) NLOAD(nx, m + ngw);
        int b, pos, isctx; rowinfo(m, b, pos, isctx);
        const float* mod = MODl + (size_t)(isctx ? 4 : b) * 6144;
        float ss = 0.f;
#pragma unroll
        for (int j = 0; j < 4; ++j) ss += (v[j].x * v[j].x + v[j].y * v[j].y) + (v[j].z * v[j].z + v[j].w * v[j].w);
        const float rstd = rsqrtf(wave_sum(ss) * (1.f / DM) + EPS);
#pragma unroll
        for (int j = 0; j < 4; ++j) { const int c = 4 * lane + 256 * j;
            const f32x4 w = *(const f32x4*)(nw + c), sh = *(const f32x4*)(mod + ishift * 1024 + c), sc = *(const f32x4*)(mod + iscale * 1024 + c);
            const f32x4 y = v[j] * rstd * w * (sc + 1.f) + sh;
            u32x2 o; o.x = pk2(y.x, y.y); o.y = pk2(y.z, y.w);
            *(u32x2*)(A + (size_t)m * DM + c) = o; }
    }
#undef NLOAD
}
#include <cstdlib>
#include <vector>

#define XB_TMO      128
#define XB_XCNT(j)  (256  + 64 * (j))
#define XB_XSUB(j)  (1280 + 64 * (j))
#define XB_XGEN(j)  (2304 + 64 * (j))
#define XB_TOP      3328
#define XB_TOPGEN   3392
#define XCD_BAR_WORDS 3456
#define XB_SPIN_CAP (1u << 18)

__device__ __forceinline__ unsigned xb_ld(unsigned* p)              { return __hip_atomic_load(p, __ATOMIC_RELAXED, __HIP_MEMORY_SCOPE_AGENT); }
__device__ __forceinline__ unsigned xb_add(unsigned* p, unsigned v) { return __hip_atomic_fetch_add(p, v, __ATOMIC_RELAXED, __HIP_MEMORY_SCOPE_AGENT); }
__device__ __forceinline__ unsigned xb_xcc_id() { return (unsigned)__builtin_amdgcn_s_getreg((3 << 11) | 20) & 0xFu; }
#define XB_SPIN(cond, bar) do { unsigned _sp = 0; while (cond) { __builtin_amdgcn_s_sleep(1); \
    if ((++_sp & 255u) == 0u) { if (xb_ld(&(bar)[XB_TMO])) break; if (_sp > XB_SPIN_CAP) { atomicAdd(&(bar)[XB_TMO], 1u); break; } } } } while (0)

struct XcdBarrier {
    unsigned* bar; unsigned x;
    volatile LAS unsigned* st;
};

__device__ __forceinline__ XcdBarrier xcd_barrier_post(unsigned* bar, volatile LAS unsigned* st) {
    XcdBarrier b; b.bar = bar; b.x = xb_xcc_id(); b.st = st;
    if (threadIdx.x == 0) (void)xb_add(&bar[XB_XCNT(b.x)], 1u);
    return b;
}
__device__ __forceinline__ void xcd_barrier_complete(unsigned* bar, unsigned x, unsigned& nloc, unsigned& nx) {
    const unsigned G = gridDim.x * gridDim.y * gridDim.z;
    unsigned sum, cnt, mine, sp = 0u;
    for (;;) {
        sum = 0u; cnt = 0u; mine = 0u;
#pragma unroll
        for (unsigned j = 0; j < 16; ++j) { const unsigned c = xb_ld(&bar[XB_XCNT(j)]); sum += c; cnt += (c > 0u) ? 1u : 0u; mine = (j == x) ? c : mine; }
        if (sum == G) break;
        __builtin_amdgcn_s_sleep(1);
        if ((++sp & 255u) == 0u) { if (xb_ld(&bar[XB_TMO])) break; if (sp > XB_SPIN_CAP) { atomicAdd(&bar[XB_TMO], 1u); break; } }
    }
    nloc = mine > 0u ? mine : 1u; nx = cnt > 0u ? cnt : 1u;
}

__device__ __forceinline__ void xcd_barrier(const XcdBarrier& b) {
    asm volatile("s_waitcnt vmcnt(0)" ::: "memory");
    __syncthreads();
    if (threadIdx.x == 0) {
        unsigned* bar = b.bar;
        __builtin_amdgcn_s_waitcnt(0);
        unsigned nloc = b.st[0], nx = b.st[1];
        if (nloc == 0u) { xcd_barrier_complete(bar, b.x, nloc, nx); b.st[0] = nloc; b.st[1] = nx; }
        const unsigned old = xb_add(&bar[XB_XSUB(b.x)], 1u);
        const unsigned gen = old / nloc;
        if (old + 1u == (gen + 1u) * nloc) {
            __builtin_amdgcn_fence(__ATOMIC_RELEASE, "agent");
            asm volatile("s_waitcnt vmcnt(0)" ::: "memory");
            const unsigned og = xb_add(&bar[XB_TOP], 1u);
            const unsigned tg = og / nx;
            if (og + 1u == (tg + 1u) * nx) xb_add(&bar[XB_TOPGEN], 1u);
            else XB_SPIN(xb_ld(&bar[XB_TOPGEN]) == tg, bar);
            __builtin_amdgcn_fence(__ATOMIC_ACQUIRE, "agent");
            xb_add(&bar[XB_XGEN(b.x)], 1u);
            asm volatile("s_waitcnt vmcnt(0)" ::: "memory");
        } else {
            XB_SPIN(xb_ld(&bar[XB_XGEN(b.x)]) == gen, bar);
            __builtin_amdgcn_fence(__ATOMIC_ACQUIRE, "agent");
            asm volatile("s_waitcnt vmcnt(0)" ::: "memory");
        }
    }
    __syncthreads();
}

enum { EM_PLAIN = 0, EM_KV, EM_BIG, EM_GATES, EM_BRANCH, EM_RES, EM_FFNIN };
template <int MODE> struct Epi {
    static constexpr bool PERM = true, AFTER_DRAIN = false;
    bf16_t* O0; int ld0; bf16_t* O1; int ld1;
    const bf16_t* Gsrc;
    const float* fa;
    const float* hin_l; const float* hin_c; float* hout_l; float* hout_c;
    int ipar;
    DI void emit(int row, int col, f32x4 v0, f32x4 v1) const {
        float f[8] = {v0[0], v0[1], v0[2], v0[3], v1[0], v1[1], v1[2], v1[3]};
        if (MODE == EM_PLAIN) {
            *(u32x4*)(O0 + (size_t)row * ld0 + col) = pack8(f);
        } else if (MODE == EM_KV) {
            if (col < 512) *(u32x4*)(O0 + (size_t)row * 768 + col) = pack8(f);
            else           *(u32x4*)(O1 + (size_t)row * 512 + (col - 512)) = pack8(f);
        } else if (MODE == EM_FFNIN) {
            if (col < DFF) *(u32x4*)(O0 + (size_t)row * DFF + col) = pack8(f);
            else           *(u32x4*)(O1 + (size_t)row * DFF + (col - DFF)) = pack8(f);
        } else if (MODE == EM_BIG) {
            const float QS = 0.08838834764831845f;
            if (col < 512) { for (int i = 0; i < 8; ++i) f[i] *= QS; }
            else if (col >= 1536 && col < 2560) {
                int b, pos, isctx; rowinfo(row, b, pos, isctx);
                const int sp = isctx ? pos : CTX + pos;
                const int g = ((col - 1536) & 127) >> 3;
                const f32x2* rot = (const f32x2*)fa + (size_t)sp * 64 + 4 * g;
                const float sc = col >= 2048 ? QS : 1.f;
#pragma unroll
                for (int e = 0; e < 4; ++e) { const f32x2 cs = rot[e]; const float x1 = f[e], x2 = f[4 + e];
                    f[e] = (x1 * cs.x - x2 * cs.y) * sc; f[4 + e] = (x1 * cs.y + x2 * cs.x) * sc; }
            }
            *(u32x4*)(O0 + (size_t)row * 3072 + col) = pack8(f);
        } else if (MODE == EM_GATES) {
            if (col < 1024) {
                bf16_t* p = O1 + (size_t)row * 1024 + col; float on[8]; unpack8(*(const u32x4*)p, on);
#pragma unroll
                for (int i = 0; i < 8; ++i) f[i] = on[i] * f[i] * sigmoidf_(f[i]);
                *(u32x4*)p = pack8(f);
            } else {
                const int cc = col - 1024; const f32x4 b0 = *(const f32x4*)(fa + cc), b1 = *(const f32x4*)(fa + cc + 4);
                const float bb[8] = {b0[0], b0[1], b0[2], b0[3], b1[0], b1[1], b1[2], b1[3]};
#pragma unroll
                for (int i = 0; i < 8; ++i) f[i] = sigmoidf_(f[i] + bb[i]);
                *(u32x4*)(O0 + (size_t)row * 3072 + cc) = pack8(f);
            }
        } else if (MODE == EM_BRANCH) {
            float g[8]; unpack8(*(const u32x4*)(Gsrc + (size_t)row * 3072 + col), g);
            bf16_t* p = O0 + (size_t)row * 1024 + col;
            if (ipar > 0) { float pr[8]; unpack8(*(const u32x4*)p, pr);
#pragma unroll
                for (int i = 0; i < 8; ++i) f[i] = pr[i] + g[i] * f[i]; }
            else {
#pragma unroll
                for (int i = 0; i < 8; ++i) f[i] = g[i] * f[i]; }
            *(u32x4*)p = pack8(f);
        } else if (MODE == EM_RES) {
            int b, pos, isctx; rowinfo(row, b, pos, isctx);
            const float* hi_ = isctx ? hin_c + (size_t)(row - TL) * DM : hin_l + (size_t)row * DM;
            float* ho_ = isctx ? hout_c + (size_t)(row - TL) * DM : hout_l + (size_t)row * DM;
            const float* mod = fa + (size_t)(isctx ? 4 : b) * 6144 + ipar * 1024 + col;
            const f32x4 m0 = *(const f32x4*)mod, m1 = *(const f32x4*)(mod + 4);
            const f32x4 h0 = *(const f32x4*)(hi_ + col), h1 = *(const f32x4*)(hi_ + col + 4);
            *(f32x4*)(ho_ + col) = h0 + m0 * v0; *(f32x4*)(ho_ + col + 4) = h1 + m1 * v1;
        }
    }
    DI void operator()(const pg8::f32x4 (&acc)[2][2][4][2], const pg8::Unit& u, int wr, int wc, int fr, int fq) const {
#pragma unroll
        for (int ai = 0; ai < 2; ++ai)
#pragma unroll
            for (int m = 0; m < 4; ++m) { const int row = u.pm * 256 + ai * 128 + wr * 64 + m * 16 + fr;
#pragma unroll
                for (int bj = 0; bj < 2; ++bj) { const int col = u.pn * 256 + bj * 128 + wc * 32 + 8 * fq;
                    emit(row, col, acc[ai][bj][m][0], acc[ai][bj][m][1]); } }
    }
};

DI float dpp_ror1(float x) { return __int_as_float(__builtin_amdgcn_update_dpp(0, __float_as_int(x), 0x121, 0xf, 0xf, false)); }
DI float dpp_ror15(float x) { return __int_as_float(__builtin_amdgcn_update_dpp(0, __float_as_int(x), 0x12F, 0xf, 0xf, false)); }
DI float gelu_gate(float x, float u) { const float t2 = 1.5957691216057308f * (x + 0.044715f * x * x * x); return x / (1.f + __expf(-t2)) * u; }
struct EpiFfnConv {
    static constexpr bool PERM = true, AFTER_DRAIN = false;
    bf16_t* ACT; float* HALO; const float* wdw; const float* bdw; LAS float* X;
    DI void operator()(const pg8::f32x4 (&acc)[2][2][4][2], const pg8::Unit& u, int wr, int wc, int fr, int fq) const {
        const int ch = 128 * u.pn + 32 * wc + 8 * fq, xc = 32 * wc + 8 * fq;
        float w0[8], w1[8], w2[8], bb[8];
#pragma unroll
        for (int k = 0; k < 8; ++k) { w0[k] = wdw[ch + k]; w1[k] = wdw[DFF + ch + k]; w2[k] = wdw[2 * DFF + ch + k]; bb[k] = bdw[ch + k]; }
#pragma unroll
        for (int ai = 0; ai < 2; ++ai) {
            if (fr == 0) {
#pragma unroll
                for (int k = 0; k < 8; ++k) X[((ai * 2 + wr) * 2 + 0) * 128 + xc + k] = acc[ai][0][0][k >> 2][k & 3]; }
            if (fr == 15) {
#pragma unroll
                for (int k = 0; k < 8; ++k) X[((ai * 2 + wr) * 2 + 1) * 128 + xc + k] = acc[ai][0][3][k >> 2][k & 3]; }
        }
        asm volatile("s_waitcnt lgkmcnt(0)" ::: "memory"); __builtin_amdgcn_s_barrier(); asm volatile("" ::: "memory");
        const bool first_tile_row_is_seq_start = (u.pm >= TL / 256) || ((u.pm & 31) == 0);
        const bool last_tile_row_is_seq_end = (u.pm >= TL / 256) || ((u.pm & 31) == 31);
#pragma unroll
        for (int ai = 0; ai < 2; ++ai) {
            float top[8], bot[8];
            { const int tsel = wr == 1 ? ((ai * 2 + 0) * 2 + 1) : ((0 * 2 + 1) * 2 + 1);
              const bool tval = (wr == 1) || (ai == 1);
              const int bsel = wr == 0 ? ((ai * 2 + 1) * 2 + 0) : ((1 * 2 + 0) * 2 + 0);
              const bool bval = (wr == 0) || (ai == 0);
#pragma unroll
              for (int k = 0; k < 8; ++k) { top[k] = tval ? X[tsel * 128 + xc + k] : 0.f; bot[k] = bval ? X[bsel * 128 + xc + k] : 0.f; } }
#pragma unroll
            for (int m = 0; m < 4; ++m) {
                const int row = u.pm * 256 + ai * 128 + wr * 64 + m * 16 + fr;
                float o[8], xs[8];
#pragma unroll
                for (int k = 0; k < 8; ++k) {
                    const float g = acc[ai][0][m][k >> 2][k & 3], up = acc[ai][1][m][k >> 2][k & 3];
                    const float pa = dpp_ror1(g);
                    const float pb = m > 0 ? dpp_ror1(acc[ai][0][m > 0 ? m - 1 : 0][k >> 2][k & 3]) : top[k];
                    const float na = dpp_ror15(g);
                    const float nb = m < 3 ? dpp_ror15(acc[ai][0][m < 3 ? m + 1 : 3][k >> 2][k & 3]) : bot[k];
                    const float gp = fr > 0 ? pa : pb, gn = fr < 15 ? na : nb;
                    const float x = w0[k] * gp + w1[k] * g + w2[k] * gn + bb[k];
                    xs[k] = x; o[k] = gelu_gate(x, up);
                }
                *(u32x4*)(ACT + (size_t)row * DFF + ch) = pack8(o);
                if (ai == 0 && m == 0 && wr == 0 && fr == 0 && !first_tile_row_is_seq_start) { float* h = HALO + ((size_t)u.pm * 6 + 0) * DFF + ch;
#pragma unroll
                    for (int k = 0; k < 8; ++k) { h[k] = acc[0][0][0][k >> 2][k & 3]; h[DFF + k] = xs[k]; h[2 * DFF + k] = acc[0][1][0][k >> 2][k & 3]; } }
                if (ai == 1 && m == 3 && wr == 1 && fr == 15 && !last_tile_row_is_seq_end) { float* h = HALO + ((size_t)u.pm * 6 + 3) * DFF + ch;
#pragma unroll
                    for (int k = 0; k < 8; ++k) { h[k] = acc[1][0][3][k >> 2][k & 3]; h[DFF + k] = xs[k]; h[2 * DFF + k] = acc[1][1][3][k >> 2][k & 3]; } }
            }
        }
    }
};
DI void phase_convfix(const Params& P, int l) {
    bf16_t* ACT = (bf16_t*)(P.ws + WS_G); const float* HALO = (const float*)(P.ws + WS_U);
    const float* wdw = P.in[I_WDW] + (size_t)l * 3 * DFF; const float* bdw = P.in[I_BDW] + (size_t)l * DFF; (void)bdw;
    const int total = 127 * DFF;
    for (int i = blockIdx.x * NTHREADS + threadIdx.x; i < total; i += gridDim.x * NTHREADS) {
        const int pm = i / DFF, c = i - pm * DFF;
        if ((pm & 31) == 31) continue;
        const float* hl = HALO + ((size_t)pm * 6 + 3) * DFF + c; const float* hf = HALO + ((size_t)(pm + 1) * 6 + 0) * DFF + c;
        const float g_last = hl[0], x_last = hl[DFF], u_last = hl[2 * DFF], g_first = hf[0], x_first = hf[DFF], u_first = hf[2 * DFF];
        ACT[(size_t)(pm * 256 + 255) * DFF + c] = f2bf(gelu_gate(x_last + wdw[2 * DFF + c] * g_first, u_last));
        ACT[(size_t)(pm * 256 + 256) * DFF + c] = f2bf(gelu_gate(x_first + wdw[c] * g_last, u_first));
    }
}
template <int MODE>
DI void run_gemm(LAS unsigned char* lds, const bf16_t* A, int lda, const bf16_t* Bt, int M, int N, int K, const Epi<MODE>& E) {
    int Kop = K; if (K < 512) asm volatile("" : "+s"(Kop));
    pg8::Gemm g{A, Bt, M, N, Kop, lda}; pg8::StaticOrder S; S.init(M, N, (int)gridDim.x, (int)blockIdx.x);
    pg8::gemm_phase<Epi<MODE>, pg8::StaticOrder, true, true>((PG8_LAS unsigned char*)lds, g, S, E);
}
DI void run_gemm_ffnconv(LAS unsigned char* lds, const bf16_t* A, const bf16_t* Bt, int M, const EpiFfnConv& E) {
    pg8::Gemm g{A, Bt, M, 5632, 1024, 1024}; pg8::StaticOrder S; S.init(M, 5632, (int)gridDim.x, (int)blockIdx.x);
    pg8::gemm_phase<EpiFfnConv, pg8::StaticOrder, true, true>((PG8_LAS unsigned char*)lds, g, S, E);
}

DI void phase_qkpost(const Params& P, int l) {
    const int tid = threadIdx.x, wave = tid >> 6, lane = tid & 63, gw = blockIdx.x * NWAVES + wave, ngw = gridDim.x * NWAVES;
    const bf16_t* __restrict__ SM = (const bf16_t*)(P.ws + WS_SM); bf16_t* __restrict__ Q = (bf16_t*)(P.ws + WS_Q); bf16_t* __restrict__ K = (bf16_t*)(P.ws + WS_K); bf16_t* __restrict__ V = (bf16_t*)(P.ws + WS_V);
    const f32x2* __restrict__ ROPE = (const f32x2*)(P.ws + WS_ROPE);
    const float* qn = P.in[I_QN] + l * 96; const float* kn = P.in[I_KN] + l * 96;
    const int s = lane & 7, h = lane >> 3;
    float qnw[12], knw[12];
#pragma unroll
    for (int i = 0; i < 8; ++i) { qnw[i] = qn[8 * s + i]; knw[i] = kn[8 * s + i]; }
#pragma unroll
    for (int i = 0; i < 4; ++i) { qnw[8 + i] = qn[64 + 4 * s + i]; knw[8 + i] = kn[64 + 4 * s + i]; }
    const bool second = (s & 2) != 0;
    u32x2 n_cq, n_kr, n_qr; unsigned n_ckv; u32x4 n_qn, n_kn, n_v;
#define QLOAD(m_) do { const bf16_t* sm_ = SM + (size_t)(m_) * 512; n_cq = *(const u32x2*)(sm_ + 4 * lane); n_ckv = *(const unsigned*)(sm_ + 256 + 2 * lane); n_kr = *(const u32x2*)(sm_ + 384 + 4 * s); \
        n_qn = *(const u32x4*)(Q + (size_t)(m_) * 768 + 64 * h + 8 * s); n_qr = *(const u32x2*)(Q + (size_t)(m_) * 768 + 512 + 32 * h + 4 * s); \
        n_kn = *(const u32x4*)(K + (size_t)(m_) * 768 + 64 * h + 8 * s); n_v = *(const u32x4*)(V + (size_t)(m_) * 512 + 8 * lane); } while (0)
    if (gw < TA) QLOAD(gw);
    for (int m = gw; m < TA; m += ngw) {
        const u32x2 cq = n_cq, krr = n_kr, qrr = n_qr; const unsigned ckv = n_ckv; const u32x4 qnn = n_qn, knn = n_kn, vraw = n_v;
        if (m + ngw < TA) QLOAD(m + ngw);
        int b, pos, isctx; rowinfo(m, b, pos, isctx);
        float a0 = bflo(cq.x), a1 = bfhi(cq.x), a2 = bflo(cq.y), a3 = bfhi(cq.y), c0 = bflo(ckv), c1 = bfhi(ckv);
        const float s_q = rsqrtf(wave_sum(a0 * a0 + a1 * a1 + a2 * a2 + a3 * a3) * (1.f / 256.f) + EPS);
        const float s_kv = rsqrtf(wave_sum(c0 * c0 + c1 * c1) * (1.f / 128.f) + EPS);
        float cs[4], sn[4];
        if (!isctx) { const f32x2* rp = ROPE + ((s < 4) ? (pos >> 6) : 128 + (pos & 63)) * 8 + 4 * (s & 1);
#pragma unroll
            for (int e = 0; e < 4; ++e) { const f32x2 t = rp[e]; cs[e] = t.x; sn[e] = t.y; } }
        else {
#pragma unroll
            for (int e = 0; e < 4; ++e) { cs[e] = 1.f; sn[e] = 0.f; } }
        {
            bf16_t* qp = Q + (size_t)m * 768;
            float z[12]; unpack8(qnn, z);
            z[8] = bflo(qrr.x); z[9] = bfhi(qrr.x); z[10] = bflo(qrr.y); z[11] = bfhi(qrr.y);
            float ss = 0.f;
#pragma unroll
            for (int i = 0; i < 12; ++i) { z[i] *= s_q; ss += z[i] * z[i]; }
            ss += __shfl_xor(ss, 1); ss += __shfl_xor(ss, 2); ss += __shfl_xor(ss, 4);
            const float r = rsqrtf(ss * (1.f / 96.f) + EPS);
#pragma unroll
            for (int i = 0; i < 12; ++i) z[i] *= r * qnw[i];
#pragma unroll
            for (int e = 0; e < 4; ++e) { const float mine = z[8 + e], other = __shfl_xor(mine, 2);
                z[8 + e] = second ? (other * sn[e] + mine * cs[e]) : (mine * cs[e] - other * sn[e]); }
            *(u32x4*)(qp + 64 * h + 8 * s) = pack8(z);
            u32x2 o; o.x = pk2(z[8], z[9]); o.y = pk2(z[10], z[11]); *(u32x2*)(qp + 512 + 32 * h + 4 * s) = o;
        }
        {
            bf16_t* kp = K + (size_t)m * 768;
            float z[12]; unpack8(knn, z);
#pragma unroll
            for (int i = 0; i < 8; ++i) z[i] *= s_kv;
            z[8] = bflo(krr.x); z[9] = bfhi(krr.x); z[10] = bflo(krr.y); z[11] = bfhi(krr.y);
            float ss = 0.f;
#pragma unroll
            for (int i = 0; i < 12; ++i) ss += z[i] * z[i];
            ss += __shfl_xor(ss, 1); ss += __shfl_xor(ss, 2); ss += __shfl_xor(ss, 4);
            const float r = rsqrtf(ss * (1.f / 96.f) + EPS);
#pragma unroll
            for (int i = 0; i < 12; ++i) z[i] *= r * knw[i];
#pragma unroll
            for (int e = 0; e < 4; ++e) { const float mine = z[8 + e], other = __shfl_xor(mine, 2);
                z[8 + e] = second ? (other * sn[e] + mine * cs[e]) : (mine * cs[e] - other * sn[e]); }
            *(u32x4*)(kp + 64 * h + 8 * s) = pack8(z);
            u32x2 o; o.x = pk2(z[8], z[9]); o.y = pk2(z[10], z[11]); *(u32x2*)(kp + 512 + 32 * h + 4 * s) = o;
            float vv[8]; unpack8(vraw, vv);
#pragma unroll
            for (int i = 0; i < 8; ++i) vv[i] *= s_kv;
            *(u32x4*)(V + (size_t)m * 512 + 8 * lane) = pack8(vv);
        }
    }
#undef QLOAD
}

DI void phase_scanpost(const Params& P, int l, int nrows) {
    const int tid = threadIdx.x, wave = tid >> 6, lane = tid & 63, gw = blockIdx.x * NWAVES + wave, ngw = gridDim.x * NWAVES;
    bf16_t* __restrict__ OF = (bf16_t*)(P.ws + WS_OF); const bf16_t* __restrict__ OB = (const bf16_t*)(P.ws + WS_OB);
    const float* gw_ = P.in[I_GON] + l * 128;
    const int sub = lane & 7, hd = lane >> 3;
    float w[16];
#pragma unroll
    for (int i = 0; i < 16; ++i) w[i] = hd < 4 ? gw_[16 * sub + i] : 1.f;
    u32x4 nf0, nf1, nb0, nb1;
#define PLOAD(m_) do { const bf16_t* pf_ = OF + (size_t)(m_) * 1024 + 16 * lane; const bf16_t* pb_ = OB + (size_t)(m_) * 1024 + 16 * lane; \
        nf0 = *(const u32x4*)pf_; nf1 = *(const u32x4*)(pf_ + 8); nb0 = *(const u32x4*)pb_; nb1 = *(const u32x4*)(pb_ + 8); } while (0)
    if (gw < nrows) PLOAD(gw);
    for (int m = gw; m < nrows; m += ngw) {
        float a[16], bq[16];
        unpack8(nf0, a); unpack8(nf1, a + 8); unpack8(nb0, bq); unpack8(nb1, bq + 8);
        if (m + ngw < nrows) PLOAD(m + ngw);
        float ss = 0.f;
#pragma unroll
        for (int i = 0; i < 16; ++i) { a[i] += bq[i]; ss += a[i] * a[i]; }
        ss += __shfl_xor(ss, 1); ss += __shfl_xor(ss, 2); ss += __shfl_xor(ss, 4);
        const float r = rsqrtf(ss * (1.f / 128.f) + EPS);
#pragma unroll
        for (int i = 0; i < 16; ++i) a[i] *= r * w[i];
        bf16_t* pf = OF + (size_t)m * 1024 + 16 * lane;
        *(u32x4*)pf = pack8(a); *(u32x4*)(pf + 8) = pack8(a + 8);
    }
#undef PLOAD
}

DI void phase_conv(const Params& P, int l, int nrows) {
    const bf16_t* __restrict__ G = (const bf16_t*)(P.ws + WS_G); bf16_t* __restrict__ U = (bf16_t*)(P.ws + WS_U);
    const float* __restrict__ wdw = P.in[I_WDW] + (size_t)l * 3 * DFF; const float* __restrict__ bdw = P.in[I_BDW] + (size_t)l * DFF;
    const int total = (nrows / 4) * 352;
    for (int i = blockIdx.x * NTHREADS + threadIdx.x; i < total; i += gridDim.x * NTHREADS) {
        const int quad = i / 352, c = (i - quad * 352) * 8, m0 = quad * 4;
        int b, pos, isctx; rowinfo(m0, b, pos, isctx);
        const int last = isctx ? CTX - 1 : SEQ - 1;
        u32x4 g[6], u[4];
#pragma unroll
        for (int r = 0; r < 4; ++r) { g[r + 1] = *(const u32x4*)(G + (size_t)(m0 + r) * DFF + c); u[r] = *(const u32x4*)(U + (size_t)(m0 + r) * DFF + c); }
        g[0] = pos > 0 ? *(const u32x4*)(G + (size_t)(m0 - 1) * DFF + c) : (u32x4){0u, 0u, 0u, 0u};
        g[5] = pos + 3 < last ? *(const u32x4*)(G + (size_t)(m0 + 4) * DFF + c) : (u32x4){0u, 0u, 0u, 0u};
        float w0[8], w1[8], w2[8], bb[8];
#pragma unroll
        for (int k = 0; k < 8; ++k) { w0[k] = wdw[c + k]; w1[k] = wdw[DFF + c + k]; w2[k] = wdw[2 * DFF + c + k]; bb[k] = bdw[c + k]; }
#pragma unroll
        for (int r = 0; r < 4; ++r) {
            float a0[8], a1[8], a2[8], uu[8], o[8];
            unpack8(g[r], a0); unpack8(g[r + 1], a1); unpack8(g[r + 2], a2); unpack8(u[r], uu);
#pragma unroll
            for (int k = 0; k < 8; ++k) {
                const float x = w0[k] * a0[k] + w1[k] * a1[k] + w2[k] * a2[k] + bb[k];
                const float t2 = 1.5957691216057308f * (x + 0.044715f * x * x * x);
                o[k] = x / (1.f + __expf(-t2)) * uu[k];
            }
            *(u32x4*)(U + (size_t)(m0 + r) * DFF + c) = pack8(o);
        }
    }
}

namespace att {
constexpr int NW = 8, QBLK = 32, KVBLK = 64;
constexpr float SCALE = 0.10206207261596575f;
constexpr float THR = 8.f;
constexpr int SHM_V = 64 * 128 * 2, SHM_K = 64 * 256, SHM_ATTN = 2 * SHM_V + 2 * SHM_K + NW * 64 * 4;
#define KSWZ(row, colB) ((row) * 256 + ((colB) ^ (((row) & 7) << 4)))
#define SBAR() __builtin_amdgcn_sched_barrier(0)
DI int crow(int r, int hi) { return (r & 3) + 8 * (r >> 2) + 4 * hi; }
DI unsigned cvtpk(float lo, float hi) { unsigned r; asm volatile("v_cvt_pk_bf16_f32 %0, %1, %2" : "=v"(r) : "v"(lo), "v"(hi)); return r; }
DI bf16x8 ld8(const bf16_t* p) { return *reinterpret_cast<const bf16x8*>(p); }

DI void partialSM(f32x16& p0, f32x16& p1, float& m_reg, float& mn, float& alpha) {
  constexpr float C = SCALE * 1.4426950408889634f;
  float pmax = p0[0]; for (int r = 1; r < 16; ++r) pmax = fmaxf(pmax, p0[r]); for (int r = 0; r < 16; ++r) pmax = fmaxf(pmax, p1[r]);
  { auto rr = __builtin_amdgcn_permlane32_swap(__float_as_uint(pmax), __float_as_uint(pmax), false, false);
    pmax = fmaxf(__uint_as_float(rr[0]), __uint_as_float(rr[1])); }
  if (__builtin_expect(__all(pmax - m_reg <= THR / SCALE), 1)) { mn = m_reg; alpha = 1.f; }
  else { mn = fmaxf(m_reg, pmax); alpha = __builtin_amdgcn_exp2f((m_reg - mn) * C); m_reg = mn; }
  float mnC = -mn * C;
  for (int r = 0; r < 16; ++r) p0[r] = fmaf(p0[r], C, mnC); for (int r = 0; r < 16; ++r) p1[r] = fmaf(p1[r], C, mnC);
  for (int r = 0; r < 16; ++r) p0[r] = __builtin_amdgcn_exp2f(p0[r]);
}
DI void finishSM(f32x16& p0, f32x16& p1, float alpha, float& l_reg, bf16x8& pa0, bf16x8& pa1, bf16x8& pa2, bf16x8& pa3) {
  for (int r = 0; r < 16; ++r) p1[r] = __builtin_amdgcn_exp2f(p1[r]);
  float ps = 0; for (int r = 0; r < 16; ++r) ps += p0[r]; for (int r = 0; r < 16; ++r) ps += p1[r];
  { auto rr = __builtin_amdgcn_permlane32_swap(__float_as_uint(ps), __float_as_uint(ps), false, false);
    ps = __uint_as_float(rr[0]) + __uint_as_float(rr[1]); }
  l_reg = l_reg * alpha + ps;
#define PK4(P, BASE, OUT) do { unsigned a0 = cvtpk(P[BASE + 0], P[BASE + 1]), a1 = cvtpk(P[BASE + 2], P[BASE + 3]);   \
    unsigned b0 = cvtpk(P[BASE + 4], P[BASE + 5]), b1 = cvtpk(P[BASE + 6], P[BASE + 7]);                              \
    auto r0 = __builtin_amdgcn_permlane32_swap(a0, b0, false, false); auto r1 = __builtin_amdgcn_permlane32_swap(a1, b1, false, false); \
    u32x4 w = {r0[0], r1[0], r0[1], r1[1]}; OUT = *reinterpret_cast<bf16x8*>(&w); } while (0)
  PK4(p0, 0, pa0); PK4(p0, 8, pa1); PK4(p1, 0, pa2); PK4(p1, 8, pa3);
#undef PK4
}
DI void qkt(f32x16& p0, f32x16& p1, const char* Ks, const bf16x8* qr, int r32, int hi) {
  p0 = f32x16{}; p1 = f32x16{};
#pragma unroll
  for (int d0 = 0; d0 < 6; ++d0) { int cb = (d0 * 16 + hi * 8) * 2;
    bf16x8 b0 = *reinterpret_cast<const bf16x8*>(Ks + KSWZ(r32, cb));
    bf16x8 b1 = *reinterpret_cast<const bf16x8*>(Ks + KSWZ(32 + r32, cb));
    p0 = __builtin_amdgcn_mfma_f32_32x32x16_bf16(b0, qr[d0], p0, 0, 0, 0);
    p1 = __builtin_amdgcn_mfma_f32_32x32x16_bf16(b1, qr[d0], p1, 0, 0, 0); }
}
DI int v_st(int k, int c) { const int kk = (k & ~0xC) | ((k & 4) << 1) | ((k & 8) >> 1); return ((kk >> 3) * 4 + (c >> 5)) * 512 + ((kk & 7) * 32 + (c & 31)) * 2; }
DI int v_rd_base(int lane) { return ((lane & 3) << 3) | (((lane >> 2) & 3) << 6) | (((lane >> 4) & 1) << 5) | (((lane >> 5) & 1) << 8); }
constexpr int v_rd_off(int d0, int ks, int half) { return d0 * 512 + ks * 4096 + half * 2048; }
template <int OFF> DI s16x4 tr_read(int vb) {
  s16x4 r; asm volatile("ds_read_b64_tr_b16 %0, %1 offset:%2" : "=&v"(r) : "v"(vb), "i"(OFF) : "memory"); return r;
}
template <int D0> DI void pv_one(f32x16& od, int vb, bf16x8 pa0, bf16x8 pa1, bf16x8 pa2, bf16x8 pa3) {
  const s16x4 l0 = tr_read<v_rd_off(D0, 0, 0)>(vb), h0 = tr_read<v_rd_off(D0, 0, 1)>(vb), l1 = tr_read<v_rd_off(D0, 1, 0)>(vb), h1 = tr_read<v_rd_off(D0, 1, 1)>(vb);
  const s16x4 l2 = tr_read<v_rd_off(D0, 2, 0)>(vb), h2 = tr_read<v_rd_off(D0, 2, 1)>(vb), l3 = tr_read<v_rd_off(D0, 3, 0)>(vb), h3 = tr_read<v_rd_off(D0, 3, 1)>(vb);
  asm volatile("s_waitcnt lgkmcnt(0)" ::: "memory"); SBAR();
#define PK(L, H) (bf16x8){L[0], L[1], L[2], L[3], H[0], H[1], H[2], H[3]}
  od = __builtin_amdgcn_mfma_f32_32x32x16_bf16(pa0, PK(l0, h0), od, 0, 0, 0);
  od = __builtin_amdgcn_mfma_f32_32x32x16_bf16(pa1, PK(l1, h1), od, 0, 0, 0);
  od = __builtin_amdgcn_mfma_f32_32x32x16_bf16(pa2, PK(l2, h2), od, 0, 0, 0);
  od = __builtin_amdgcn_mfma_f32_32x32x16_bf16(pa3, PK(l3, h3), od, 0, 0, 0);
#undef PK
}
DI void pv_d0(f32x16* o, int vb, bf16x8 pa0, bf16x8 pa1, bf16x8 pa2, bf16x8 pa3) {
  pv_one<0>(o[0], vb, pa0, pa1, pa2, pa3); pv_one<1>(o[1], vb, pa0, pa1, pa2, pa3);
}

DI void attn_unit(const bf16_t* Qg, bf16_t* Og, int ldo, const bf16_t* Kg, const bf16_t* Vg, int qrow0, int h, int ctxrow0, int latrow0, int NT, char* lds) {
  const int tid = threadIdx.x, wid = tid >> 6, lane = tid & 63, r32 = lane & 31, hi = lane >> 5;
  char* V_lds = lds; char* K_lds = lds + 2 * SHM_V;
  float* ws = (float*)(lds + 2 * SHM_V + 2 * SHM_K) + wid * 64; float* li_l = ws; float* al_l = ws + 32;
  float m_reg = -1e30f, l_reg = 0; f32x16 o[2] = {}; bf16x8 qr[6];
  const bf16_t* Qw = Qg + (size_t)(qrow0 + wid * QBLK + r32) * 768;
#pragma unroll
  for (int d0 = 0; d0 < 6; ++d0) qr[d0] = ld8(Qw + (d0 < 4 ? 64 * h + 16 * d0 + 8 * hi : 512 + 32 * h + 16 * (d0 - 4) + 8 * hi));
  const int vr = tid >> 3, vc = tid & 7, vst = v_st(vr, 8 * vc), vcol = 64 * h + 8 * vc;
  const int c0 = tid, c1 = 512 + (tid & 255);
  const int kr0 = c0 / 12, kc0 = c0 % 12, kr1 = c1 / 12, kc1 = c1 % 12;
  const int kcol0 = kc0 < 8 ? 64 * h + 8 * kc0 : 512 + 32 * h + 8 * (kc0 - 8), kcol1 = kc1 < 8 ? 64 * h + 8 * kc1 : 512 + 32 * h + 8 * (kc1 - 8);
  const int kst0 = KSWZ(kr0, kc0 * 16), kst1 = KSWZ(kr1, kc1 * 16);
  const int vb0 = (int)(uintptr_t)V_lds + v_rd_base(lane);
  struct { bf16x8 vs0, ks0, ks1; } sr_[2];
#define TROW(j) ((j) < 4 ? ctxrow0 + 64 * (j) : latrow0 + 64 * ((j) - 4))
#define SLOAD(i, j) do { const int rb_ = TROW(j); sr_[i].vs0 = ld8(Vg + (size_t)(rb_ + vr) * 512 + vcol); \
    sr_[i].ks0 = ld8(Kg + (size_t)(rb_ + kr0) * 768 + kcol0); sr_[i].ks1 = ld8(Kg + (size_t)(rb_ + kr1) * 768 + kcol1); } while (0)
#define SWRITE(b, i) do { *(bf16x8*)(V_lds + (b) * SHM_V + vst) = sr_[i].vs0; \
    *(bf16x8*)(K_lds + (b) * SHM_K + kst0) = sr_[i].ks0; *(bf16x8*)(K_lds + (b) * SHM_K + kst1) = sr_[i].ks1; } while (0)
#define SWAIT() asm volatile("s_waitcnt vmcnt(3)" ::: "memory")
#define RESC(a) do { if (__any((a) < 1.f)) { if (hi == 0) al_l[r32] = (a); asm volatile("s_waitcnt lgkmcnt(0)" ::: "memory"); \
    for (int d = 0; d < 2; ++d) for (int r = 0; r < 16; ++r) o[d][r] *= al_l[crow(r, hi)]; } } while (0)
  f32x16 pA0, pA1, pB0, pB1; float mnA, mnB, alA, alB; bf16x8 pa0, pa1, pa2, pa3;
  constexpr int SE = 0, SO = 1;
  SLOAD(SE, 0); asm volatile("s_waitcnt vmcnt(0)" ::: "memory"); SWRITE(0, SE); __syncthreads();
  qkt(pA0, pA1, K_lds, qr, r32, hi); partialSM(pA0, pA1, m_reg, mnA, alA);
  SLOAD(SO, 1); if (2 < NT) SLOAD(SE, 2);
  SWAIT(); SWRITE(1, SO); __syncthreads();
  for (int j = 1; j + 1 < NT; j += 2) {
    SBAR(); qkt(pB0, pB1, K_lds + SHM_K, qr, r32, hi);
    finishSM(pA0, pA1, alA, l_reg, pa0, pa1, pa2, pa3); SBAR();
    SLOAD(SO, j + 2); SBAR();
    pv_d0(o, vb0, pa0, pa1, pa2, pa3); partialSM(pB0, pB1, m_reg, mnB, alB);
    __syncthreads(); SWAIT(); SWRITE(0, SE);
    RESC(alB); __syncthreads();
    SBAR(); qkt(pA0, pA1, K_lds, qr, r32, hi);
    finishSM(pB0, pB1, alB, l_reg, pa0, pa1, pa2, pa3); SBAR();
    if (j + 3 < NT) SLOAD(SE, j + 3); SBAR();
    pv_d0(o, vb0 + SHM_V, pa0, pa1, pa2, pa3); partialSM(pA0, pA1, m_reg, mnA, alA);
    __syncthreads(); SWAIT(); SWRITE(1, SO);
    RESC(alA); __syncthreads();
  }
  SBAR(); qkt(pB0, pB1, K_lds + SHM_K, qr, r32, hi);
  finishSM(pA0, pA1, alA, l_reg, pa0, pa1, pa2, pa3); SBAR();
  pv_d0(o, vb0, pa0, pa1, pa2, pa3); partialSM(pB0, pB1, m_reg, mnB, alB);
  __syncthreads(); RESC(alB);
  finishSM(pB0, pB1, alB, l_reg, pa0, pa1, pa2, pa3); SBAR();
  pv_d0(o, vb0 + SHM_V, pa0, pa1, pa2, pa3);
  if (hi == 0) li_l[r32] = l_reg; asm volatile("s_waitcnt lgkmcnt(0)" ::: "memory");
  float rli[16];
#pragma unroll
  for (int r = 0; r < 16; ++r) rli[r] = __builtin_amdgcn_rcpf(li_l[crow(r, hi)]);
  bf16_t* Ow = Og + (size_t)(qrow0 + wid * QBLK) * ldo + 64 * h;
#pragma unroll
  for (int r = 0; r < 16; ++r) { const int orow = crow(r, hi);
#pragma unroll
    for (int d0 = 0; d0 < 2; ++d0) Ow[(size_t)orow * ldo + d0 * 32 + r32] = f2bf(o[d0][r] * rli[r]); }
#undef TROW
#undef SLOAD
#undef SWRITE
#undef SWAIT
#undef RESC
}
}

DI void phase_attention(const Params& P, int l, char* lds, bf16_t* Og, int ldo) {
    bf16_t* Q = (bf16_t*)(P.ws + WS_Q); const bf16_t* K = (const bf16_t*)(P.ws + WS_K); const bf16_t* V = (const bf16_t*)(P.ws + WS_V);
    for (int u = blockIdx.x; u < 1024; u += gridDim.x) {
        const int bh = (u >> 8) * 8 + (u & 7), qb = (u >> 3) & 31, b = bh >> 3, h = bh & 7;
        __syncthreads();
        att::attn_unit(Q, Og, ldo, K, V, b * SEQ + 256 * qb, h, TL + b * CTX, b * SEQ, 132, lds);
    }
    if (l == 0) {
        for (int u = blockIdx.x; u < 32; u += gridDim.x) {
            const int b = u >> 3, h = u & 7;
            __syncthreads();
            att::attn_unit(Q, Og, ldo, K, V, TL + b * CTX, h, TL + b * CTX, 0, 4, lds);
        }
    }
    __syncthreads();
}

namespace scn {
constexpr int RQ = 0, RK = 16384, RR = 32768;
constexpr int QD = 34816;
constexpr int KN = QD + 64 * 272;
constexpr int KET = KN + 64 * 272;
constexpr int VT = KET + 128 * 144;
constexpr int ST = VT + 128 * 144;
constexpr int PM = ST + 128 * 272;
constexpr int DEC = PM + 64 * 144;
constexpr int END = DEC + 512;
static_assert(END <= LDS_BYTES - 16, "scan LDS");
constexpr size_t US_OFF = 0, DL_OFF = (size_t)64 * 3 * 16384 * 2;
static_assert(DL_OFF + (size_t)64 * 3 * 128 * 4 <= (size_t)3584 * 1024 * 2, "scan hand-off must fit in the dead part of the weight region");
DI int crow(int r, int hi) { return (r & 3) + 8 * (r >> 2) + 4 * hi; }
#define SC_BAR() do { asm volatile("s_waitcnt lgkmcnt(0)" ::: "memory"); __builtin_amdgcn_s_barrier(); asm volatile("" ::: "memory"); } while (0)
#define SMFMA(a, b, c) __builtin_amdgcn_mfma_f32_32x32x16_bf16((a), (b), (c), 0, 0, 0)
}
DI void phase_scan(const Params& P, int l, char* lds, const int pass) {
    using namespace scn;
    const int tid = threadIdx.x, wid = tid >> 6, lane = tid & 63, r32 = lane & 31, hi = lane >> 5;
    const bf16_t* R4 = (const bf16_t*)(P.ws + WS_R4); const bf16_t* SM = (const bf16_t*)(P.ws + WS_SM);
    bf16_t* UST = (bf16_t*)(P.ws + WS_WT + US_OFF); float* DLG = (float*)(P.ws + WS_WT + DL_OFF);
    const int nitems = pass == 1 ? 192 : 256;
    for (int item = blockIdx.x; item < nitems; item += gridDim.x) {
        int seg, scan; if (pass == 1) { seg = item % 3; scan = item / 3; } else { seg = item & 3; scan = item >> 2; }
        const int dir = scan & 1, hd = (scan >> 1) & 7, b = scan >> 4;
        const bool gla = hd < 4; const int hh = hd & 3;
        const int qcol = gla ? hh * 128 : 1536 + hh * 128, kcol = gla ? 512 + hh * 128 : 2048 + hh * 128, vcol = (gla ? 1024 : 2560) + hh * 128;
        bf16_t* Od = (bf16_t*)(P.ws + (dir ? WS_OB : WS_OF)); const int ocol = hd * 128;
        const int pti = wid >> 2, pdj = wid & 3, pd = 32 * pdj + r32;
        const int vt = wid >> 1, dt0 = 2 * (wid & 1);
        bf16x8 w2h = {0, 0, 0, 0, 0, 0, 0, 0}, w2l = {0, 0, 0, 0, 0, 0, 0, 0}; float bias = 0.f, lg = 0.f;
        if (gla) { const float* W2 = P.in[I_GK2] + (size_t)(l * 2 + dir) * 16 * 512 + hh * 128 + pd;
#pragma unroll
            for (int j = 0; j < 8; ++j) { const float w = W2[(8 * hi + j) * 512]; const unsigned u = __float_as_uint(w) & 0xffff0000u; const float res = w - __uint_as_float(u);
                w2h[j] = (short)(u >> 16); w2l[j] = (short)(__float_as_uint(res) >> 16); }
            bias = P.in[I_BGK][(l * 2 + dir) * 512 + hh * 128 + pd]; }
        else lg = -expf(P.in[I_RDEC][(l * 2 + dir) * 4 + hh]);
        f32x16 S0 = {}, S1 = {}; float clsum = 0.f;
        __syncthreads();
        if (pass == 2) {
            for (int sp = 0; sp < seg; ++sp) {
                const bf16_t* U = UST + (size_t)(scan * 3 + sp) * 16384; const float* DL = DLG + (size_t)(scan * 3 + sp) * 128;
                const float e0 = __expf(DL[32 * dt0 + r32]), e1 = __expf(DL[32 * (dt0 + 1) + r32]);
#pragma unroll
                for (int r = 0; r < 16; ++r) { const int v = 32 * vt + crow(r, hi);
                    S0[r] = S0[r] * e0 + bf2f(U[v * 128 + 32 * dt0 + r32]); S1[r] = S1[r] * e1 + bf2f(U[v * 128 + 32 * (dt0 + 1) + r32]); }
            }
#pragma unroll
            for (int r = 0; r < 16; ++r) { const int v = 32 * vt + crow(r, hi);
                *(bf16_t*)(lds + ST + v * 272 + (32 * dt0 + r32) * 2) = f2bf(S0[r]); *(bf16_t*)(lds + ST + v * 272 + (32 * (dt0 + 1) + r32) * 2) = f2bf(S1[r]); }
            { const int i = tid >> 4, j = 32 + (tid & 15) * 2; *(unsigned*)(lds + PM + i * 144 + j * 2) = 0u; }
        }
        u32x4 pq0 = {0u, 0u, 0u, 0u}, pq1 = pq0, pk0, pk1, pr = pq0, pv0, pv1;
#define ROWBASE(n) (dir == 0 ? ((n) < 4 ? TL + b * CTX + 64 * (n) : b * SEQ + 64 * ((n) - 4)) : ((n) < 4 ? TL + b * CTX + 64 * (3 - (n)) : b * SEQ + 64 * (127 - ((n) - 4))))
#define SC_LOADQK(n) do { const int rb_ = ROWBASE(n); \
        if (pass == 2) { pq0 = *(const u32x4*)(R4 + (size_t)(rb_ + (tid >> 4)) * 3072 + qcol + 8 * (tid & 15)); pq1 = *(const u32x4*)(R4 + (size_t)(rb_ + 32 + (tid >> 4)) * 3072 + qcol + 8 * (tid & 15)); } \
        pk0 = *(const u32x4*)(R4 + (size_t)(rb_ + (tid >> 4)) * 3072 + kcol + 8 * (tid & 15)); pk1 = *(const u32x4*)(R4 + (size_t)(rb_ + 32 + (tid >> 4)) * 3072 + kcol + 8 * (tid & 15)); \
        if (tid < 128) pr = *(const u32x4*)(SM + (size_t)(rb_ + (tid >> 1)) * 512 + 416 + dir * 16 + 8 * (tid & 1)); } while (0)
#define SC_LOADV(n) do { const int rb_ = ROWBASE(n); \
        pv0 = *(const u32x4*)(R4 + (size_t)(rb_ + lane) * 3072 + vcol + 8 * wid); pv1 = *(const u32x4*)(R4 + (size_t)(rb_ + lane) * 3072 + vcol + 64 + 8 * wid); } while (0)
#define SC_STOREQK() do { if (pass == 2) { *(u32x4*)(lds + RQ + sr0 * 256 + (tid & 15) * 16) = pq0; *(u32x4*)(lds + RQ + sr1 * 256 + (tid & 15) * 16) = pq1; } \
        *(u32x4*)(lds + RK + sr0 * 256 + (tid & 15) * 16) = pk0; *(u32x4*)(lds + RK + sr1 * 256 + (tid & 15) * 16) = pk1; \
        if (tid < 128) *(u32x4*)(lds + RR + srr * 32 + (tid & 1) * 16) = pr; } while (0)
        const int sr0 = dir ? 63 - (tid >> 4) : (tid >> 4), sr1 = dir ? 31 - (tid >> 4) : 32 + (tid >> 4);
        const int srr = dir ? 63 - (tid >> 1) : (tid >> 1), svi = dir ? 63 - lane : lane;
        const int n0 = 33 * seg;
        SC_LOADQK(n0); SC_STOREQK(); SC_LOADQK(n0 + 1); SC_LOADV(n0);
        for (int n = n0; n < n0 + 33; ++n) {
            int r32v = r32, hiv = hi; asm volatile("" : "+v"(r32v), "+v"(hiv));
            SC_BAR();
            { char* vb = lds + VT + (8 * wid) * 144 + svi * 2;
              const unsigned w0[4] = {pv0.x, pv0.y, pv0.z, pv0.w}, w1[4] = {pv1.x, pv1.y, pv1.z, pv1.w};
#pragma unroll
              for (int e = 0; e < 4; ++e) { *(bf16_t*)(vb + (2 * e) * 144) = (bf16_t)(w0[e] & 0xffffu); *(bf16_t*)(vb + (2 * e + 1) * 144) = (bf16_t)(w0[e] >> 16);
                  *(bf16_t*)(vb + (64 + 2 * e) * 144) = (bf16_t)(w1[e] & 0xffffu); *(bf16_t*)(vb + (64 + 2 * e + 1) * 144) = (bf16_t)(w1[e] >> 16); }
              if (n + 1 < n0 + 33) SC_LOADV(n + 1); }
            {
                f32x16 cum; float cl;
                if (gla) {
                    f32x16 la0, la1;
                    { const bf16x8 a0 = *(const bf16x8*)(lds + RR + r32v * 32 + hiv * 16), a1 = *(const bf16x8*)(lds + RR + (32 + r32v) * 32 + hiv * 16);
                      la0 = SMFMA(a0, w2h, (f32x16{})); la0 = SMFMA(a0, w2l, la0); la1 = SMFMA(a1, w2h, (f32x16{})); la1 = SMFMA(a1, w2l, la1); }
                    float ssum = 0.f;
#pragma unroll
                    for (int r = 0; r < 16; ++r) { const float x0 = la0[r] + bias, x1 = la1[r] + bias;
                        la0[r] = (fminf(x0, 0.f) - __logf(1.f + __expf(-fabsf(x0)))) * (1.f / 16.f);
                        la1[r] = (fminf(x1, 0.f) - __logf(1.f + __expf(-fabsf(x1)))) * (1.f / 16.f);
                        ssum += la0[r] + la1[r]; }
                    cl = ssum + __shfl_xor(ssum, 32);
                    __builtin_amdgcn_sched_barrier(0);
                    cum = f32x16{};
                    bf16x8 tri0, tri1;
#pragma unroll
                    for (int j = 0; j < 8; ++j) { const int k0 = 8 * (j >> 2) + 4 * hiv + (j & 3);
                        tri0[j] = (short)(r32v >= k0 ? 0x3F80 : 0); tri1[j] = (short)(r32v >= k0 + 16 ? 0x3F80 : 0); }
                    const bf16x8 ones = {0x3F80, 0x3F80, 0x3F80, 0x3F80, 0x3F80, 0x3F80, 0x3F80, 0x3F80};
                    const bf16x8 atk0_0 = pti ? ones : tri0, atk0_1 = pti ? ones : tri1;
#pragma unroll
                    for (int st = 0; st < 2; ++st) { bf16x8 h8, l8;
#pragma unroll
                        for (int j = 0; j < 8; ++j) { const float v = la0[8 * st + j]; const unsigned u = __float_as_uint(v) & 0xffff0000u; const float res = v - __uint_as_float(u);
                            h8[j] = (short)(u >> 16); l8[j] = (short)(__float_as_uint(res) >> 16); }
                        const bf16x8 am = st ? atk0_1 : atk0_0; cum = SMFMA(am, h8, cum); cum = SMFMA(am, l8, cum); }
                    if (pti) {
#pragma unroll
                        for (int st = 0; st < 2; ++st) { bf16x8 h8, l8;
#pragma unroll
                            for (int j = 0; j < 8; ++j) { const float v = la1[8 * st + j]; const unsigned u = __float_as_uint(v) & 0xffff0000u; const float res = v - __uint_as_float(u);
                                h8[j] = (short)(u >> 16); l8[j] = (short)(__float_as_uint(res) >> 16); }
                            const bf16x8 am = st ? tri1 : tri0; cum = SMFMA(am, h8, cum); cum = SMFMA(am, l8, cum); } }
                    __builtin_amdgcn_sched_barrier(0);
                } else {
#pragma unroll
                    for (int r = 0; r < 16; ++r) cum[r] = (float)(32 * pti + crow(r, hiv) + 1) * lg;
                    cl = 64.f * lg;
                }
                clsum += cl;
                {
                    const int ibase = 32 * pti + 4 * hiv; const float ecl = __expf(cl);
                    const char* rqb = lds + RQ + ibase * 256 + pd * 2; const char* rkb = lds + RK + ibase * 256 + pd * 2;
                    char* qdb = lds + QD + ibase * 272 + pd * 2; char* knb = lds + KN + ibase * 272 + pd * 2; char* keb = lds + KET + pd * 144 + ibase * 2;
                    if (pass == 2) {
#pragma unroll
                        for (int r = 0; r < 16; ++r) { const int cr = (r & 3) + 8 * (r >> 2);
                            const float c = cum[r]; const float e1 = __expf(c), e2 = __expf(-c);
                            const float q = bf2f(*(const bf16_t*)(rqb + cr * 256)), k = bf2f(*(const bf16_t*)(rkb + cr * 256));
                            const float kn = k * e2;
                            *(bf16_t*)(qdb + cr * 272) = f2bf(q * e1);
                            *(bf16_t*)(knb + cr * 272) = f2bf(kn);
                            *(bf16_t*)(keb + cr * 2) = f2bf(kn * ecl);
                            if ((r & 3) == 3) { asm volatile("" ::: "memory"); } }
                    } else {
#pragma unroll
                        for (int r = 0; r < 16; ++r) { const int cr = (r & 3) + 8 * (r >> 2);
                            const float k = bf2f(*(const bf16_t*)(rkb + cr * 256));
                            *(bf16_t*)(keb + cr * 2) = f2bf(k * __expf(cl - cum[r]));
                            if ((r & 3) == 3) { asm volatile("" ::: "memory"); } }
                    }
                    if (pti == 0 && hiv == 0) *(float*)(lds + DEC + pd * 4) = ecl;
                }
            }
            SC_BAR();
            if (n + 1 < n0 + 33) { SC_STOREQK(); if (n + 2 < n0 + 33) SC_LOADQK(n + 2); }
            f32x16 oacc = {};
            if (pass == 2) {
                if (wid < 3) {
                    const int ti = (wid + 1) >> 1, tj = wid >> 1; f32x16 T0 = {};
#pragma unroll
                    for (int kk = 0; kk < 8; ++kk) { const bf16x8 a = *(const bf16x8*)(lds + QD + (32 * ti + r32v) * 272 + (16 * kk + 8 * hiv) * 2), bb = *(const bf16x8*)(lds + KN + (32 * tj + r32v) * 272 + (16 * kk + 8 * hiv) * 2);
                        T0 = SMFMA(a, bb, T0); }
#pragma unroll
                    for (int r = 0; r < 16; ++r) { const int cr = (r & 3) + 8 * (r >> 2); const int ib = 32 * ti + 4 * hiv, j = 32 * tj + r32v; int jm = j - (dir ? 0 : 1) - ib; asm volatile("" : "+v"(jm));
                        *(bf16_t*)(lds + PM + ib * 144 + j * 2 + cr * 144) = f2bf(cr > jm ? T0[r] : 0.f); }
                }
                { const int ti = wid >> 2, vj = wid & 3;
#pragma unroll
                  for (int kk = 0; kk < 8; ++kk) { const bf16x8 a = *(const bf16x8*)(lds + QD + (32 * ti + r32v) * 272 + (16 * kk + 8 * hiv) * 2), bb = *(const bf16x8*)(lds + ST + (32 * vj + r32v) * 272 + (16 * kk + 8 * hiv) * 2);
                      oacc = SMFMA(a, bb, oacc); } }
            }
            {
                const float dc0 = *(const float*)(lds + DEC + (32 * dt0 + r32v) * 4), dc1 = *(const float*)(lds + DEC + (32 * (dt0 + 1) + r32v) * 4);
#pragma unroll
                for (int r = 0; r < 16; ++r) { S0[r] *= dc0; S1[r] *= dc1; }
#pragma unroll
                for (int kk = 0; kk < 4; ++kk) { const bf16x8 a = *(const bf16x8*)(lds + VT + (32 * vt + r32v) * 144 + (16 * kk + 8 * hiv) * 2);
                    const bf16x8 b0 = *(const bf16x8*)(lds + KET + (32 * dt0 + r32v) * 144 + (16 * kk + 8 * hiv) * 2), b1 = *(const bf16x8*)(lds + KET + (32 * (dt0 + 1) + r32v) * 144 + (16 * kk + 8 * hiv) * 2);
                    S0 = SMFMA(a, b0, S0); S1 = SMFMA(a, b1, S1); }
            }
            if (pass == 2) {
                SC_BAR();
                { const int ti = wid >> 2, vj = wid & 3;
#pragma unroll
                  for (int kk = 0; kk < 4; ++kk) { const bf16x8 a = *(const bf16x8*)(lds + PM + (32 * ti + r32v) * 144 + (16 * kk + 8 * hiv) * 2), bb = *(const bf16x8*)(lds + VT + (32 * vj + r32v) * 144 + (16 * kk + 8 * hiv) * 2);
                      oacc = SMFMA(a, bb, oacc); }
                  const int rb = ROWBASE(n);
#pragma unroll
                  for (int r = 0; r < 16; ++r) { const int i = 32 * ti + crow(r, hiv), row = rb + (dir ? 63 - i : i);
                      Od[(size_t)row * 1024 + ocol + 32 * vj + r32v] = f2bf(oacc[r]); } }
#pragma unroll
                for (int r = 0; r < 16; ++r) { const int cr = (r & 3) + 8 * (r >> 2); char* stb = lds + ST + (32 * vt + 4 * hiv) * 272 + (32 * dt0 + r32v) * 2;
                    *(bf16_t*)(stb + cr * 272) = f2bf(S0[r]); *(bf16_t*)(stb + cr * 272 + 64) = f2bf(S1[r]); }
            }
        }
        if (pass == 1) {
            bf16_t* U = UST + (size_t)(scan * 3 + seg) * 16384;
#pragma unroll
            for (int r = 0; r < 16; ++r) { const int v = 32 * vt + crow(r, hi);
                U[v * 128 + 32 * dt0 + r32] = f2bf(S0[r]); U[v * 128 + 32 * (dt0 + 1) + r32] = f2bf(S1[r]); }
            if (pti == 0 && hi == 0) DLG[(size_t)(scan * 3 + seg) * 128 + pd] = clsum;
        }
#undef ROWBASE
#undef SC_LOADQK
#undef SC_LOADV
#undef SC_STOREQK
    }
    __syncthreads();
}

constexpr int PH_PER_LAYER = 16, N_PHASES = 1 + 2 * PH_PER_LAYER;
#ifndef PHEN
#define PHEN(q) 1
#endif
#ifdef PROBE_GEMM
#define REPG for (int rep_ = 0; rep_ < 2; ++rep_)
#else
#define REPG
#endif
#ifdef PROBE_EW
#define REPE for (int rep_ = 0; rep_ < 2; ++rep_)
#else
#define REPE
#endif
#define PH(k) if (lo <= (k) && (k) < hi && ((k) == lo || (xcd_barrier(xbar), true)))
template <int l>
DI void layer_program(const Params& P, int lo, int hi, LAS unsigned char* lds, unsigned char* lds_raw, const XcdBarrier& xbar) {
    constexpr int base = 1 + PH_PER_LAYER * l;
    constexpr int Mlat = (l == 0) ? TA : TL;
#define WSP(T, off) ((T*)(P.ws + (off)))
#define MODL (WSP(const float, WS_MOD) + (size_t)l * 5 * 6144)
#define HIN_L ((l == 0) ? P.in[I_X] : (const float*)P.out)
#define HIN_C ((l == 0) ? P.in[I_CTX] : WSP(const float, WS_HC))
    PH(base + 0) if (PHEN(0)) REPE { phase_norm(HIN_L, HIN_C, P.in[I_N1W] + l * DM, MODL, 0, 1, WSP(bf16_t, WS_A), TA); if (l > 0) phase_wconv_mixer(P, l, lds); }
    PH(base + 1) if (PHEN(1)) REPG { Epi<EM_PLAIN> E{}; E.O0 = WSP(bf16_t, WS_SM); E.ld0 = 512; run_gemm<EM_PLAIN>(lds, WSP(bf16_t, WS_A), 1024, WSP(bf16_t, WS_WT) + WT_IN, TA, 512, 1024, E); }
    PH(base + 2) if (PHEN(2)) REPG { { Epi<EM_PLAIN> E{}; E.O0 = WSP(bf16_t, WS_Q); E.ld0 = 768; run_gemm<EM_PLAIN>(lds, WSP(bf16_t, WS_SM), 512, WSP(bf16_t, WS_WT) + WT_QB, TA, 768, 256, E); }
                  { Epi<EM_KV> E2{}; E2.O0 = WSP(bf16_t, WS_K); E2.O1 = WSP(bf16_t, WS_V); run_gemm<EM_KV>(lds, WSP(bf16_t, WS_SM) + 256, 512, WSP(bf16_t, WS_WT) + WT_KVB, TA, 1024, 128, E2); } }
    PH(base + 3) if (PHEN(3)) phase_qkpost(P, l);
    PH(base + 4) if (PHEN(4)) {
#ifdef PROBE_ATTN
        phase_attention(P, l, (char*)lds_raw, WSP(bf16_t, WS_OF), 1024);
#endif
        phase_attention(P, l, (char*)lds_raw, WSP(bf16_t, WS_Q), 768); }
    PH(base + 5) if (PHEN(5)) REPG { Epi<EM_BIG> E{}; E.O0 = WSP(bf16_t, WS_R4); E.fa = WSP(const float, WS_ROT); run_gemm<EM_BIG>(lds, WSP(bf16_t, WS_A), 1024, WSP(bf16_t, WS_WT) + WT_IN + (size_t)512 * 1024, TA, 3072, 1024, E); }
    PH(base + 6) if (PHEN(6)) phase_scan(P, l, (char*)lds_raw, 1);
    PH(base + 7) if (PHEN(6)) phase_scan(P, l, (char*)lds_raw, 2);
    PH(base + 8) if (PHEN(7)) phase_scanpost(P, l, Mlat);
    PH(base + 9) if (PHEN(8)) { Epi<EM_GATES> E{}; E.O0 = WSP(bf16_t, WS_R4); E.O1 = WSP(bf16_t, WS_OF); E.fa = P.in[I_BGATE] + (size_t)l * 3072; run_gemm<EM_GATES>(lds, WSP(bf16_t, WS_A), 1024, WSP(bf16_t, WS_WT) + WT_IN + (size_t)3584 * 1024, Mlat, 4096, 1024, E); }
    PH(base + 10) if (PHEN(9)) REPG {
        { Epi<EM_BRANCH> E{}; E.O0 = WSP(bf16_t, WS_OB); E.Gsrc = WSP(bf16_t, WS_R4); E.ipar = 0; run_gemm<EM_BRANCH>(lds, WSP(bf16_t, WS_Q), 768, WSP(bf16_t, WS_WT) + WT_BR, Mlat, 1024, 512, E); }
        { Epi<EM_BRANCH> E{}; E.O0 = WSP(bf16_t, WS_OB); E.Gsrc = WSP(bf16_t, WS_R4) + 1024; E.ipar = 1; run_gemm<EM_BRANCH>(lds, WSP(bf16_t, WS_OF), 1024, WSP(bf16_t, WS_WT) + WT_BR + (size_t)1024 * 512, Mlat, 1024, 512, E); }
        { Epi<EM_BRANCH> E{}; E.O0 = WSP(bf16_t, WS_OB); E.Gsrc = WSP(bf16_t, WS_R4) + 2048; E.ipar = 2; run_gemm<EM_BRANCH>(lds, WSP(bf16_t, WS_OF) + 512, 1024, WSP(bf16_t, WS_WT) + WT_BR + (size_t)2048 * 512, Mlat, 1024, 512, E); } }
    PH(base + 11) if (PHEN(10)) { Epi<EM_RES> E{}; E.fa = MODL; E.ipar = 2; E.hin_l = HIN_L; E.hin_c = HIN_C; E.hout_l = P.out; E.hout_c = WSP(float, WS_HC);
                   run_gemm<EM_RES>(lds, WSP(bf16_t, WS_OB), 1024, WSP(bf16_t, WS_WT) + WT_OUT, Mlat, 1024, 1024, E); }
    PH(base + 12) if (PHEN(11)) REPE { phase_norm(P.out, WSP(const float, WS_HC), P.in[I_N2W] + l * DM, MODL, 3, 4, WSP(bf16_t, WS_A), Mlat); phase_wconv_ffn(P, l, lds); }
    PH(base + 13) if (PHEN(12)) { EpiFfnConv E{}; E.ACT = WSP(bf16_t, WS_G); E.HALO = WSP(float, WS_U); E.wdw = P.in[I_WDW] + (size_t)l * 3 * DFF; E.bdw = P.in[I_BDW] + (size_t)l * DFF; E.X = (LAS float*)(lds + 131072);
                   run_gemm_ffnconv(lds, WSP(bf16_t, WS_A), WSP(bf16_t, WS_WT) + WT_F1, Mlat, E); }
    PH(base + 14) if (PHEN(13)) phase_convfix(P, l);
    PH(base + 15) if (PHEN(14)) { Epi<EM_RES> E{}; E.fa = MODL; E.ipar = 5; E.hin_l = P.out; E.hin_c = WSP(const float, WS_HC); E.hout_l = P.out; E.hout_c = WSP(float, WS_HC);
                   run_gemm<EM_RES>(lds, WSP(bf16_t, WS_G), DFF, WSP(bf16_t, WS_WT) + WT_F2, Mlat, 1024, DFF, E); }
}
__global__ void __launch_bounds__(NTHREADS, 2) fwd_kernel(Params P) {
    extern __shared__ __attribute__((aligned(16))) unsigned char lds_raw[];
    LAS unsigned char* lds = (LAS unsigned char*)lds_raw;
    cg::grid_group grid = cg::this_grid();
    const int lo = P.ph_lo, hi = P.ph_hi;
    Params* G = (Params*)(P.ws + WS_PAR + (size_t)blockIdx.x * 256);
    if (threadIdx.x == 0) {
#pragma unroll
        for (int i = 0; i < 26; ++i) G->in[i] = P.in[i];
        G->out = P.out; G->ws = P.ws; G->ph_lo = lo; G->ph_hi = hi;
    }
    __syncthreads();
    asm volatile("" ::: "memory");
    const Params& Q = *G;
    if (threadIdx.x < 4) ((LAS unsigned*)(lds + LDS_BARW))[threadIdx.x] = 0u;
    __syncthreads();
    const XcdBarrier xbar = xcd_barrier_post((unsigned*)(P.ws + WS_BAR), (volatile LAS unsigned*)(lds + LDS_BARW));
    if (lo < 0) grid.sync();
    PH(0) REPE { phase_prologue(Q, lds); __syncthreads(); phase_wconv_mixer(Q, 0, lds); }
    layer_program<0>(Q, lo, hi, lds, lds_raw, xbar);
    layer_program<1>(Q, lo, hi, lds, lds_raw, xbar);
#ifdef PROBE_SYNC
    for (int i = 0; i < 20; ++i) xcd_barrier(xbar);
#endif
}

#ifndef N_LAUNCH_MODE
#define N_LAUNCH_MODE 1
#endif
extern "C" void kernel_launch(void* const* d_in, const int* in_sizes, int n_in, void* d_out, int out_size, void* d_ws, size_t ws_size, hipStream_t stream) {
    static int grid_blocks = 0;
    if (!grid_blocks) {
        if (n_in != 26 || ws_size < WS_NEED) { fprintf(stderr, "kernel_launch: bad inputs (n_in %d, ws %zu < %zu)\n", n_in, ws_size, (size_t)WS_NEED); return; }
        if (hipFuncSetAttribute((const void*)fwd_kernel, hipFuncAttributeMaxDynamicSharedMemorySize, LDS_BYTES) != hipSuccess) { fprintf(stderr, "kernel_launch: hipFuncSetAttribute failed\n"); return; }
        int dev = 0, cus = 0, per_cu = 0;
        hipGetDevice(&dev);
        hipDeviceGetAttribute(&cus, hipDeviceAttributeMultiprocessorCount, dev);
        hipOccupancyMaxActiveBlocksPerMultiprocessor(&per_cu, fwd_kernel, NTHREADS, LDS_BYTES);
        if (per_cu < 1) { fprintf(stderr, "kernel_launch: occupancy query returned %d\n", per_cu); return; }
        grid_blocks = cus * 1;
    }
    Params p{};
    for (int i = 0; i < 26; ++i) p.in[i] = (const float*)d_in[i];
    p.out = (float*)d_out; p.ws = (unsigned char*)d_ws;
#if N_LAUNCH_MODE == 1
    p.ph_lo = 0; p.ph_hi = N_PHASES;
    if (hipMemsetAsync((unsigned char*)d_ws + WS_BAR, 0, XCD_BAR_WORDS * 4, stream) != hipSuccess) { fprintf(stderr, "kernel_launch: memset of the barrier words failed\n"); return; }
    void* args[] = {&p};
    hipError_t e = hipLaunchCooperativeKernel((const void*)fwd_kernel, dim3(grid_blocks), dim3(NTHREADS), args, LDS_BYTES, stream);
    if (e != hipSuccess) fprintf(stderr, "cooperative launch failed: %s (grid %d)\n", hipGetErrorString(e), grid_blocks);
#else
    for (int ph = 0; ph < N_PHASES; ++ph) {
        p.ph_lo = ph; p.ph_hi = ph + 1;
        hipLaunchKernelGGL(fwd_kernel, dim3(grid_blocks), dim3(NTHREADS), LDS_BYTES, stream, p);
    }
#endif
}
```

```cpp
#include <hip/hip_runtime.h>
#include <hip/hip_bf16.h>
#include <hip/hip_cooperative_groups.h>
#include <cstdio>
#include <cstdint>
namespace cg = cooperative_groups;
#define DI __device__ __forceinline__
#define LAS __attribute__((address_space(3)))
namespace pg8 {
#define PG8_LAS __attribute__((address_space(3)))
typedef unsigned short bf16_t;
typedef short bf16x8 __attribute__((ext_vector_type(8)));
typedef float f32x4 __attribute__((ext_vector_type(4)));
typedef unsigned u32x4 __attribute__((ext_vector_type(4)));
constexpr int BM = 256, BK = 64, HALF = 128, HTB = HALF * BK * 2  , STAGE_BYTES = 8 * HTB, NXCD = 8, WGM = 8;

__host__ __device__ __forceinline__ int lds_byte(int r, int c) { const int st = (r >> 4) * 2 + (c >> 5), rr = r & 15, cc = c & 31, ob = rr * 64 + cc * 2; return st * 1024 + (ob ^ (((ob >> 9) & 1) << 5)); }
__host__ __device__ __forceinline__ void stage_rc(int b, int& R, int& C) { const int st = b / 1024, sb = b % 1024, swz = sb ^ (((sb >> 9) & 1) << 5); R = (st >> 1) * 16 + swz / 64; C = (st & 1) * 32 + (swz % 64) / 2; }
__host__ __device__ __forceinline__ int perm32(int rho) { const int n = rho >> 4, i = rho & 15; return 8 * (i >> 2) + 4 * n + (i & 3); }

struct Unit { int pm, pn; };
struct Gemm { const bf16_t* A; const bf16_t* Bt; int M, N, K, lda; };

struct StaticOrder {
    int nM, nN, nwg, G, c;
    __host__ __device__ void init(int M, int N, int G_, int c_) { nM = M / BM; nN = N / BM; nwg = nM * nN; G = G_; c = c_; }
    __host__ __device__ bool next(int i, Unit& u) const {
        const long L = (long)i * G + c; if (L >= nwg) return false;
        int wgid = (int)L; { const int q = nwg / NXCD, r = nwg % NXCD, xcd = wgid % NXCD, off = wgid / NXCD; wgid = (xcd < r ? xcd * (q + 1) : r * (q + 1) + (xcd - r) * q) + off; }
        const int nig = WGM * nN, gid = wgid / nig, fm = gid * WGM, gsz = (nM - fm) < WGM ? (nM - fm) : WGM;
        u.pm = fm + ((wgid % nig) % gsz); u.pn = (wgid % nig) / gsz; return true;
    }
    __device__ __forceinline__ void a_ready(const Unit&) const {}
    __device__ __forceinline__ void done(const Unit&) const {}
};

__device__ __forceinline__ unsigned cvt_pk_bf16(float lo, float hi) { unsigned r; asm volatile("v_cvt_pk_bf16_f32 %0, %1, %2" : "=v"(r) : "v"(lo), "v"(hi)); return r; }
template <class Epi, class Sched, bool ALIGN_EPI = false, bool SP2 = false>
__device__ __forceinline__ void gemm_phase(PG8_LAS unsigned char* lds, const Gemm g, const Sched& S, const Epi& E) {
    const int tid = threadIdx.x, wid = __builtin_amdgcn_readfirstlane(tid >> 6), lane = tid & 63, wr = wid >> 2, wc = wid & 3, fr = lane & 15, fq = lane >> 4;
    const int K = g.K, nt = K / BK;
    unsigned voffA[2], voffB[2];
#pragma unroll
    for (int i = 0; i < 2; ++i) { int R, C; stage_rc(tid * 16 + i * 8192, R, C); const int Rb = Epi::PERM ? ((R & ~31) + perm32(R & 31)) : R;
        voffA[i] = (unsigned)(R * g.lda + C) * 2u; voffB[i] = (unsigned)(Rb * K + C) * 2u; }
    const size_t kstep = (size_t)(BK * 2);
    const size_t hstep = (size_t)HALF * K * 2;
    const size_t tstep = 2 * hstep; const size_t hstepA = (size_t)HALF * g.lda * 2; const size_t tstepA = 2 * hstepA;
    const unsigned ldsw = (unsigned)wid * 1024u;
    const int aoff = lds_byte(wr * 64 + fr, fq * 8), boff = lds_byte(wc * 32 + fr, fq * 8);
#define PG8_SA(b, h) (((b) * 2 + (h)) * HTB)
#define PG8_SB(b, h) ((4 + (b) * 2 + (h)) * HTB)
#define PG8_STAGE(bufoff, gbase, voff) do { _Pragma("unroll") for (int _i = 0; _i < 2; ++_i) \
        __builtin_amdgcn_global_load_lds((const unsigned*)((const char*)(gbase) + (voff)[_i]), (PG8_LAS unsigned*)(lds + (bufoff) + ldsw + _i * 8192), 16, 0, 0); } while (0)
#define PG8_LDA(dst, b, h) do { _Pragma("unroll") for (int m = 0; m < 4; ++m) _Pragma("unroll") for (int k = 0; k < 2; ++k) dst[m][k] = *(const PG8_LAS bf16x8*)(lds + PG8_SA(b, h) + aoff + m * 2048 + k * 1024); } while (0)
#define PG8_LDB(dst, b, h) do { _Pragma("unroll") for (int n = 0; n < 2; ++n) _Pragma("unroll") for (int k = 0; k < 2; ++k) dst[n][k] = *(const PG8_LAS bf16x8*)(lds + PG8_SB(b, h) + boff + n * 2048 + k * 1024); } while (0)
#define PG8_MMA(ai, bj, At, Bt) do { __builtin_amdgcn_s_setprio(1); _Pragma("unroll") for (int m = 0; m < 4; ++m) _Pragma("unroll") for (int n = 0; n < 2; ++n) _Pragma("unroll") for (int k = 0; k < 2; ++k) \
        acc[ai][bj][m][n] = __builtin_amdgcn_mfma_f32_16x16x32_bf16(Bt[n][k], At[m][k], acc[ai][bj][m][n], 0, 0, 0); __builtin_amdgcn_s_setprio(0); } while (0)
#define PG8_WAIT_V(n) asm volatile("s_waitcnt vmcnt(" #n ")" ::: "memory")
#define PG8_WAIT_L(n) asm volatile("s_waitcnt lgkmcnt(" #n ")" ::: "memory")
#define PG8_BAR __builtin_amdgcn_s_barrier()
#define PG8_SCHED __builtin_amdgcn_sched_barrier(0)
    Unit cur, nxt; int ui = 0;
    if (!S.next(0, cur)) return;
    f32x4 acc[2][2][4][2];
#pragma unroll
    for (int a = 0; a < 2; ++a)
#pragma unroll
        for (int b = 0; b < 2; ++b)
#pragma unroll
            for (int m = 0; m < 4; ++m)
#pragma unroll
                for (int n = 0; n < 2; ++n) acc[a][b][m][n] = (f32x4){0.f, 0.f, 0.f, 0.f};
    bf16x8 At[4][2], B0[2][2], B1[2][2];
    const char* cA = (const char*)g.A + (size_t)cur.pm * tstepA; const char* cB = (const char*)g.Bt + (size_t)cur.pn * tstep;
    S.a_ready(cur);
    if constexpr (SP2) {
        PG8_STAGE(PG8_SB(0, 0), cB, voffB); PG8_STAGE(PG8_SB(0, 1), cB + hstep, voffB); PG8_STAGE(PG8_SA(0, 0), cA, voffA); PG8_STAGE(PG8_SA(0, 1), cA + hstepA, voffA);
        if (wr == 1) PG8_BAR;
        PG8_WAIT_V(2); PG8_BAR;
        PG8_STAGE(PG8_SB(1, 0), cB + kstep, voffB); PG8_STAGE(PG8_SA(1, 0), cA + kstep, voffA); PG8_STAGE(PG8_SB(1, 1), cB + hstep + kstep, voffB);
        PG8_WAIT_V(6); PG8_BAR;
    } else {
        PG8_STAGE(PG8_SB(0, 0), cB, voffB); PG8_STAGE(PG8_SA(0, 0), cA, voffA); PG8_STAGE(PG8_SB(0, 1), cB + hstep, voffB); PG8_STAGE(PG8_SA(0, 1), cA + hstepA, voffA);
        if (wr == 1) PG8_BAR;
        PG8_WAIT_V(4); PG8_BAR;
        PG8_STAGE(PG8_SB(1, 0), cB + kstep, voffB); PG8_STAGE(PG8_SA(1, 0), cA + kstep, voffA); PG8_STAGE(PG8_SB(1, 1), cB + hstep + kstep, voffB);
        PG8_WAIT_V(6); PG8_BAR;
    }
    for (;;) {
        const bool has_next = S.next(ui + 1, nxt);
        const char* nA = has_next ? (const char*)g.A + (size_t)nxt.pm * tstepA : cA; const char* nB = has_next ? (const char*)g.Bt + (size_t)nxt.pn * tstep : cB;
        for (int t = 0; t < nt; t += 2) {
            const bool last = (t == nt - 2);
            const char* a1 = cA + (size_t)(t + 1) * kstep;
            const char* a2 = last ? nA : cA + (size_t)(t + 2) * kstep; const char* b2 = last ? nB : cB + (size_t)(t + 2) * kstep;
            const char* a3 = a2 + kstep; const char* b3 = b2 + kstep;
            if (last && has_next) S.a_ready(nxt);
            if constexpr (SP2) {
            PG8_LDB(B0, 0, 0); PG8_LDB(B1, 0, 1); PG8_SCHED; PG8_LDA(At, 0, 0); PG8_STAGE(PG8_SA(1, 1), a1 + hstepA, voffA);
            PG8_WAIT_V(8); PG8_WAIT_L(0); PG8_BAR; PG8_MMA(0, 0, At, B0); PG8_MMA(0, 1, At, B1); PG8_BAR; PG8_SCHED;
            PG8_LDA(At, 0, 1); PG8_STAGE(PG8_SB(0, 0), b2, voffB); PG8_STAGE(PG8_SB(0, 1), b2 + hstep, voffB); PG8_STAGE(PG8_SA(0, 0), a2, voffA);
            PG8_WAIT_V(8); PG8_WAIT_L(0); PG8_BAR; PG8_MMA(1, 0, At, B0); PG8_MMA(1, 1, At, B1); PG8_BAR; PG8_SCHED;
            PG8_LDB(B0, 1, 0); PG8_LDB(B1, 1, 1); PG8_SCHED; PG8_LDA(At, 1, 0); PG8_STAGE(PG8_SA(0, 1), a2 + hstepA, voffA);
            PG8_WAIT_V(8); PG8_WAIT_L(0); PG8_BAR; PG8_MMA(0, 0, At, B0); PG8_MMA(0, 1, At, B1); PG8_BAR; PG8_SCHED;
            PG8_LDA(At, 1, 1); PG8_STAGE(PG8_SB(1, 0), b3, voffB); PG8_STAGE(PG8_SB(1, 1), b3 + hstep, voffB); PG8_STAGE(PG8_SA(1, 0), a3, voffA);
            PG8_WAIT_V(8); PG8_WAIT_L(0); PG8_BAR; PG8_MMA(1, 0, At, B0); PG8_MMA(1, 1, At, B1); PG8_BAR; PG8_SCHED;
            } else {
            PG8_LDB(B0, 0, 0); PG8_SCHED; PG8_LDA(At, 0, 0); PG8_STAGE(PG8_SA(1, 1), a1 + hstepA, voffA);
            PG8_WAIT_L(8); PG8_BAR; PG8_WAIT_L(0); PG8_MMA(0, 0, At, B0); PG8_BAR; PG8_SCHED;
            PG8_LDB(B1, 0, 1); PG8_STAGE(PG8_SB(0, 0), b2, voffB);
            PG8_BAR; PG8_WAIT_L(0); PG8_MMA(0, 1, At, B1); PG8_BAR;
            PG8_LDA(At, 0, 1); PG8_STAGE(PG8_SA(0, 0), a2, voffA);
            PG8_BAR; PG8_WAIT_L(0); PG8_MMA(1, 0, At, B0); PG8_BAR; PG8_SCHED;
            PG8_STAGE(PG8_SB(0, 1), b2 + hstep, voffB);
            PG8_WAIT_V(6); PG8_BAR; PG8_MMA(1, 1, At, B1); PG8_BAR;
            PG8_LDB(B0, 1, 0); PG8_SCHED; PG8_LDA(At, 1, 0); PG8_STAGE(PG8_SA(0, 1), a2 + hstepA, voffA);
            PG8_WAIT_L(8); PG8_BAR; PG8_WAIT_L(0); PG8_MMA(0, 0, At, B0); PG8_BAR; PG8_SCHED;
            PG8_LDB(B1, 1, 1); PG8_STAGE(PG8_SB(1, 0), b3, voffB);
            PG8_BAR; PG8_WAIT_L(0); PG8_MMA(0, 1, At, B1); PG8_BAR;
            PG8_LDA(At, 1, 1); PG8_STAGE(PG8_SA(1, 0), a3, voffA);
            PG8_BAR; PG8_WAIT_L(0); PG8_MMA(1, 0, At, B0); PG8_BAR; PG8_SCHED;
            PG8_STAGE(PG8_SB(1, 1), b3 + hstep, voffB);
            PG8_WAIT_V(6); PG8_BAR; PG8_MMA(1, 1, At, B1); PG8_BAR;
            }
        }
        if constexpr (ALIGN_EPI) { if (wr == 0) PG8_BAR; }
        if constexpr (!Epi::AFTER_DRAIN) { E(acc, cur, wr, wc, fr, fq); S.done(cur); }
        if (!has_next) break;
#pragma unroll
        for (int a = 0; a < 2; ++a)
#pragma unroll
            for (int b = 0; b < 2; ++b)
#pragma unroll
                for (int m = 0; m < 4; ++m)
#pragma unroll
                    for (int n = 0; n < 2; ++n) acc[a][b][m][n] = (f32x4){0.f, 0.f, 0.f, 0.f};
        cur = nxt; cA = nA; cB = nB; ++ui;
        if constexpr (ALIGN_EPI) { if (wr == 1) PG8_BAR; }
    }
    PG8_WAIT_V(0);
    if constexpr (!ALIGN_EPI) { if (wr == 0) PG8_BAR; }
    PG8_BAR;
    if constexpr (Epi::AFTER_DRAIN) { E.fused(acc, cur, wr, wc, fr, fq, lds, wid, lane); S.done(cur); }
#undef PG8_SA
#undef PG8_SB
#undef PG8_STAGE
#undef PG8_LDA
#undef PG8_LDB
#undef PG8_MMA
#undef PG8_WAIT_V
#undef PG8_WAIT_L
#undef PG8_BAR
#undef PG8_SCHED
}
}

typedef unsigned short bf16_t;
typedef short bf16x8 __attribute__((ext_vector_type(8)));
typedef short s16x4 __attribute__((ext_vector_type(4)));
typedef float f32x4 __attribute__((ext_vector_type(4)));
typedef float f32x2 __attribute__((ext_vector_type(2)));
typedef float f32x16 __attribute__((ext_vector_type(16)));
typedef unsigned u32x4 __attribute__((ext_vector_type(4)));
typedef unsigned u32x2 __attribute__((ext_vector_type(2)));

constexpr int DM = 1024, NB = 4, SEQ = 8192, CTX = 256, TL = NB * SEQ, TC = NB * CTX, TA = TL + TC;
constexpr int DFF = 2816, NIN = 7616;
constexpr float EPS = 1e-6f;
constexpr int NTHREADS = 512, NWAVES = 8;

constexpr size_t al256(size_t x) { return (x + 255) / 256 * 256; }
constexpr size_t WS_MOD = 0;
constexpr size_t WS_PAR = al256(WS_MOD + (size_t)2 * 5 * 6144 * 4);
constexpr size_t WS_BAR = al256(WS_PAR + (size_t)1024 * 256);
constexpr size_t WS_QKM = al256(WS_BAR + (size_t)3456 * 4);
constexpr size_t WS_ROPE = al256(WS_QKM + 256);
constexpr size_t WS_ROT = al256(WS_ROPE + (size_t)192 * 8 * 8);
constexpr size_t WS_HC  = al256(WS_ROT + (size_t)8448 * 64 * 8);
constexpr size_t WS_WT  = al256(WS_HC + (size_t)TC * DM * 4);
constexpr size_t WT_IN = 0, WT_QB = WT_IN + (size_t)7680 * 1024, WT_KVB = WT_QB + (size_t)768 * 256, WT_BR = WT_KVB + (size_t)1024 * 128,
                 WT_OUT = WT_BR + (size_t)3 * 1024 * 512, WT_MIX_END = WT_OUT + (size_t)1024 * 1024;
constexpr size_t WT_F1 = 0, WT_F2 = (size_t)5632 * 1024, WT_FFN_END = WT_F2 + (size_t)1024 * 2816;
constexpr size_t WT_ELEMS = WT_MIX_END > WT_FFN_END ? WT_MIX_END : WT_FFN_END;
constexpr size_t WS_A   = al256(WS_WT + WT_ELEMS * 2);
constexpr size_t WS_SM  = al256(WS_A + (size_t)TA * 1024 * 2);
constexpr size_t WS_Q   = al256(WS_SM + (size_t)TA * 512 * 2);
constexpr size_t WS_R4  = al256(WS_Q + (size_t)TA * 768 * 2);
constexpr size_t WS_OF  = al256(WS_R4 + (size_t)TA * 3072 * 2);
constexpr size_t WS_OB  = al256(WS_OF + (size_t)TA * 1024 * 2);
constexpr size_t WS_END_MIX = al256(WS_OB + (size_t)TA * 1024 * 2);
constexpr size_t WS_K   = WS_OF;
constexpr size_t WS_V   = WS_OB;
constexpr size_t WS_G   = WS_SM;
constexpr size_t WS_U   = al256(WS_G + (size_t)TA * DFF * 2);
constexpr size_t WS_END_FFN = al256(WS_U + (size_t)132 * 6 * DFF * 4);
constexpr size_t WS_NEED = WS_END_MIX > WS_END_FFN ? WS_END_MIX : WS_END_FFN;
static_assert((size_t)TA * 768 * 2 <= (size_t)TA * 1024 * 2, "K/V overlay must fit in OF/OB");

constexpr int LDS_BYTES = 148 * 1024;
constexpr int LDS_BARW = LDS_BYTES - 16;

struct Params { const float* in[26]; float* out; unsigned char* ws; int ph_lo, ph_hi; };
enum { I_X = 0, I_C, I_CTX, I_CCTX, I_WADA, I_BADA, I_N1W, I_N2W, I_WIN, I_BGATE, I_QNA, I_WQB, I_KVNA, I_WKVB, I_QN, I_KN, I_GK2, I_BGK, I_GON, I_RDEC, I_WBR, I_WOUT, I_WF1, I_WDW, I_BDW, I_WF2 };

DI float bflo(unsigned w) { return __uint_as_float(w << 16); }
DI float bfhi(unsigned w) { return __uint_as_float(w & 0xffff0000u); }
DI float bf2f(bf16_t x) { return __uint_as_float((unsigned)x << 16); }
DI unsigned pk2(float lo, float hi) { unsigned r; asm volatile("v_cvt_pk_bf16_f32 %0, %1, %2" : "=v"(r) : "v"(lo), "v"(hi)); return r; }
DI bf16_t f2bf(float x) { return (bf16_t)(pk2(x, 0.f) & 0xffffu); }
DI float wave_sum(float v) {
#pragma unroll
    for (int o = 1; o < 64; o <<= 1) v += __shfl_xor(v, o);
    return v;
}
DI float sigmoidf_(float x) { return 1.f / (1.f + __expf(-x)); }
DI void unpack8(u32x4 w, float* f) { f[0] = bflo(w.x); f[1] = bfhi(w.x); f[2] = bflo(w.y); f[3] = bfhi(w.y); f[4] = bflo(w.z); f[5] = bfhi(w.z); f[6] = bflo(w.w); f[7] = bfhi(w.w); }
DI u32x4 pack8(const float* f) { u32x4 w; w.x = pk2(f[0], f[1]); w.y = pk2(f[2], f[3]); w.z = pk2(f[4], f[5]); w.w = pk2(f[6], f[7]); return w; }

DI void rowinfo(int m, int& b, int& pos, int& isctx) {
    if (m < TL) { b = m >> 13; pos = m & 8191; isctx = 0; } else { const int j = m - TL; b = j >> 8; pos = j & 255; isctx = 1; }
}

DI void phase_prologue(const Params& P, LAS unsigned char* lds) {
    const int tid = threadIdx.x, wave = tid >> 6, lane = tid & 63;
    LAS float* cond = (LAS float*)lds;
    LAS float* part = cond + 5 * 1024;
    const float* c = P.in[I_C]; const float* cc = P.in[I_CCTX];
    for (int i = tid; i < 5 * 1024; i += NTHREADS) { const int r = i >> 10, k = i & 1023; const float v = r < 4 ? c[r * 1024 + k] : cc[k]; cond[i] = v / (1.f + expf(-v)); }
    __syncthreads();
    float* MOD = (float*)(P.ws + WS_MOD);
    for (int item = blockIdx.x; item < 192; item += gridDim.x) {
        const int l = item / 96, j0 = (item % 96) * 64;
        const float* W = P.in[I_WADA] + (size_t)l * 1024 * 6144 + j0 + lane;
        float a0 = 0.f, a1 = 0.f, a2 = 0.f, a3 = 0.f, a4 = 0.f;
#pragma unroll 16
        for (int k = wave * 128; k < wave * 128 + 128; ++k) {
            const float w = W[(size_t)k * 6144];
            a0 += cond[k] * w; a1 += cond[1024 + k] * w; a2 += cond[2048 + k] * w; a3 += cond[3072 + k] * w; a4 += cond[4096 + k] * w;
        }
        part[(wave * 5 + 0) * 64 + lane] = a0; part[(wave * 5 + 1) * 64 + lane] = a1; part[(wave * 5 + 2) * 64 + lane] = a2;
        part[(wave * 5 + 3) * 64 + lane] = a3; part[(wave * 5 + 4) * 64 + lane] = a4;
        __syncthreads();
        if (tid < 320) { const int r = tid >> 6; float s = 0.f;
            for (int w = 0; w < 8; ++w) s += part[(w * 5 + r) * 64 + lane];
            MOD[(size_t)(l * 5 + r) * 6144 + j0 + lane] = s + P.in[I_BADA][l * 6144 + j0 + lane]; }
        __syncthreads();
    }
    { f32x2* ROPE = (f32x2*)(P.ws + WS_ROPE);
      for (int i = blockIdx.x * NTHREADS + tid; i < 192 * 8; i += gridDim.x * NTHREADS) { const int p = i >> 3, f = i & 7; const float pos = (float)(p < 128 ? p : p - 128);
          const float inv = powf(10000.0f, -(float)f * 0.125f); float s, co; sincosf(pos * inv, &s, &co); ROPE[i] = (f32x2){co, s}; } }
    f32x2* ROT = (f32x2*)(P.ws + WS_ROT);
    for (int i = blockIdx.x * NTHREADS + tid; i < 8448 * 64; i += gridDim.x * NTHREADS) {
        const int pos = i >> 6, j = i & 63;
        const float inv = 1.0f / powf(10000.0f, (float)j / 63.0f);
        const float ang = (float)pos * inv; float s, co; sincosf(ang, &s, &co);
        ROT[i] = (f32x2){co, s};
    }
}

DI int wmap(int id, int n) {
    switch (id) {
    case 1: if (n < 416) return n; if (n < 448) return 2464 + (n - 416); return -1;
    case 2: { if (n < 1536) return 416 + n;
              if (n < 2560) { const int base = n < 2048 ? 2496 : 3008; const int j = (n - 1536) & 511; const int hh = j >> 7, v = j & 127, g = v >> 3, e = v & 7;
                              const int d = e < 4 ? 4 * g + e : 64 + 4 * g + (e - 4); return base + hh * 128 + d; }
              return 3520 + (n - 2560); }
    case 3: if (n < 512) return 1952 + n; if (n < 1024) return 4032 + (n - 512); return 4544 + (n - 1024);
    case 4: if (n < 512) return (n >> 6) * 96 + (n & 63); { const int j = n - 512; return (j >> 5) * 96 + 64 + (j & 31); }
    case 5: if (n < 512) return (n >> 6) * 128 + (n & 63); { const int j = n - 512; return (j >> 6) * 128 + 64 + (j & 63); }
    case 6: { const int pn = n >> 8, bj = (n >> 7) & 1, j = n & 127; return bj * 2816 + 128 * pn + j; }
    default: return n;
    }
}
struct TJob { const float* W; int K, Nsrc; bf16_t* WT; int ndst, map_id; const float* kscale; };
DI void transpose_job(const TJob& J, LAS float* scr, int gw, int ngw, int lane) {
    const int nblk = J.ndst / 32, nitems = (J.K / 64) * nblk;
    for (int item = gw; item < nitems; item += ngw) {
        const int kb = item / nblk, nb = item % nblk, k0 = 64 * kb, n0 = 32 * nb;
        const int src = wmap(J.map_id, n0 + (lane & 31));
        float tv[32];
#pragma unroll
        for (int i = 0; i < 32; ++i) { const int kk = 2 * i + (lane >> 5); tv[i] = src >= 0 ? J.W[(size_t)(k0 + kk) * J.Nsrc + src] : 0.f; }
        if (J.kscale) {
#pragma unroll
            for (int i = 0; i < 32; ++i) tv[i] *= J.kscale[k0 + 2 * i + (lane >> 5)]; }
#pragma unroll
        for (int i = 0; i < 32; ++i) scr[(2 * i + (lane >> 5)) * 33 + (lane & 31)] = tv[i];
        asm volatile("s_waitcnt lgkmcnt(0)" ::: "memory");
        const int c = lane & 7;
#pragma unroll
        for (int j = 0; j < 4; ++j) { const int n = (lane >> 3) + 8 * j; const LAS float* s = scr + (8 * c) * 33 + n;
            u32x4 o; o.x = pk2(s[0 * 33], s[1 * 33]); o.y = pk2(s[2 * 33], s[3 * 33]); o.z = pk2(s[4 * 33], s[5 * 33]); o.w = pk2(s[6 * 33], s[7 * 33]);
            *(u32x4*)(J.WT + (size_t)(n0 + n) * J.K + k0 + 8 * c) = o; }
        asm volatile("s_waitcnt lgkmcnt(0)" ::: "memory");
    }
}
DI void phase_wconv_mixer(const Params& P, int l, LAS unsigned char* lds) {
    const int tid = threadIdx.x, wave = tid >> 6, lane = tid & 63, gw = blockIdx.x * NWAVES + wave, ngw = gridDim.x * NWAVES;
    LAS float* scr = (LAS float*)lds + wave * (64 * 33);
    bf16_t* WT = (bf16_t*)(P.ws + WS_WT);
    const float* win = P.in[I_WIN] + (size_t)l * 1024 * NIN;
    TJob j;
    j = TJob{win, 1024, NIN, WT + WT_IN, 512, 1, nullptr}; transpose_job(j, scr, gw, ngw, lane);
    j = TJob{win, 1024, NIN, WT + WT_IN + (size_t)512 * 1024, 3072, 2, nullptr}; transpose_job(j, scr, gw, ngw, lane);
    j = TJob{win, 1024, NIN, WT + WT_IN + (size_t)3584 * 1024, 4096, 3, nullptr}; transpose_job(j, scr, gw, ngw, lane);
    j = TJob{P.in[I_WQB] + (size_t)l * 256 * 768, 256, 768, WT + WT_QB, 768, 4, P.in[I_QNA] + l * 256}; transpose_job(j, scr, gw, ngw, lane);
    j = TJob{P.in[I_WKVB] + (size_t)l * 128 * 1024, 128, 1024, WT + WT_KVB, 1024, 5, P.in[I_KVNA] + l * 128}; transpose_job(j, scr, gw, ngw, lane);
    for (int n = 0; n < 3; ++n) { j = TJob{P.in[I_WBR] + ((size_t)l * 3 + n) * 512 * 1024, 512, 1024, WT + WT_BR + (size_t)n * 1024 * 512, 1024, 0, nullptr}; transpose_job(j, scr, gw, ngw, lane); }
    j = TJob{P.in[I_WOUT] + (size_t)l * 1024 * 1024, 1024, 1024, WT + WT_OUT, 1024, 0, nullptr}; transpose_job(j, scr, gw, ngw, lane);
}
DI void phase_wconv_ffn(const Params& P, int l, LAS unsigned char* lds) {
    const int tid = threadIdx.x, wave = tid >> 6, lane = tid & 63, gw = blockIdx.x * NWAVES + wave, ngw = gridDim.x * NWAVES;
    LAS float* scr = (LAS float*)lds + wave * (64 * 33);
    bf16_t* WT = (bf16_t*)(P.ws + WS_WT);
    TJob j;
    j = TJob{P.in[I_WF1] + (size_t)l * 1024 * 5632, 1024, 5632, WT + WT_F1, 5632, 6, nullptr}; transpose_job(j, scr, gw, ngw, lane);
    j = TJob{P.in[I_WF2] + (size_t)l * 2816 * 1024, 2816, 1024, WT + WT_F2, 1024, 0, nullptr}; transpose_job(j, scr, gw, ngw, lane);
}

DI void phase_norm(const float* __restrict__ hl, const float* __restrict__ hc, const float* __restrict__ nw, const float* __restrict__ MODl, int ishift, int iscale, bf16_t* __restrict__ A, int nrows) {
    const int tid = threadIdx.x, wave = tid >> 6, lane = tid & 63, gw = blockIdx.x * NWAVES + wave, ngw = gridDim.x * NWAVES;
    f32x4 nx[4];
#define NLOAD(dst, m_) do { const float* xr_ = (m_) >= TL ? hc + (size_t)((m_) - TL) * DM : hl + (size_t)(m_) * DM; \
        _Pragma("unroll") for (int j = 0; j < 4; ++j) dst[j] = *(const f32x4*)(xr_ + 4 * lane + 256 * j); } while (0)
    if (gw < nrows) NLOAD(nx, gw);
    for (int m = gw; m < nrows; m += ngw) {
        f32x4 v[4];
#pragma unroll
        for (int j = 0; j < 4; ++j) v[j] = nx[j];
        if (m + ngw < nrows) NLOAD(nx, m + ngw);
        int b, pos, isctx; rowinfo(m, b, pos, isctx);
        const float* mod = MODl + (size_t)(isctx ? 4 : b) * 6144;
        float ss = 0.f;
#pragma unroll
        for (int j = 0; j < 4; ++j) ss += (v[j].x * v[j].x + v[j].y * v[j].y) + (v[j].z * v[j].z + v[j].w * v[j].w);
        const float rstd = rsqrtf(wave_sum(ss) * (1.f / DM) + EPS);
#pragma unroll
        for (int j = 0; j < 4; ++j) { const int c = 4 * lane + 256 * j;
            const f32x4 w = *(const f32x4*)(nw + c), sh = *(const f32x4*)(mod + ishift * 1024 + c), sc = *(const f32x4*)(mod + iscale * 1024 + c);
            const f32x4 y = v[j] * rstd * w * (sc + 1.f) + sh;
            u32x2 o; o.x = pk2(y.x, y.y); o.y = pk2(y.z, y.w);
            *(u32x2*)(A + (size_t)m * DM + c) = o; }
    }
#undef NLOAD
}
#include <cstdlib>
#include <vector>

#define XB_TMO      128
#define XB_XCNT(j)  (256  + 64 * (j))
#define XB_XSUB(j)  (1280 + 64 * (j))
#define XB_XGEN(j)  (2304 + 64 * (j))
#define XB_TOP      3328
#define XB_TOPGEN   3392
#define XCD_BAR_WORDS 3456
#define XB_SPIN_CAP (1u << 18)

__device__ __forceinline__ unsigned xb_ld(unsigned* p)              { return __hip_atomic_load(p, __ATOMIC_RELAXED, __HIP_MEMORY_SCOPE_AGENT); }
__device__ __forceinline__ unsigned xb_add(unsigned* p, unsigned v) { return __hip_atomic_fetch_add(p, v, __ATOMIC_RELAXED, __HIP_MEMORY_SCOPE_AGENT); }
__device__ __forceinline__ unsigned xb_xcc_id() { return (unsigned)__builtin_amdgcn_s_getreg((3 << 11) | 20) & 0xFu; }
#define XB_SPIN(cond, bar) do { unsigned _sp = 0; while (cond) { __builtin_amdgcn_s_sleep(1); \
    if ((++_sp & 255u) == 0u) { if (xb_ld(&(bar)[XB_TMO])) break; if (_sp > XB_SPIN_CAP) { atomicAdd(&(bar)[XB_TMO], 1u); break; } } } } while (0)

struct XcdBarrier {
    unsigned* bar; unsigned x;
    volatile LAS unsigned* st;
};

__device__ __forceinline__ XcdBarrier xcd_barrier_post(unsigned* bar, volatile LAS unsigned* st) {
    XcdBarrier b; b.bar = bar; b.x = xb_xcc_id(); b.st = st;
    if (threadIdx.x == 0) (void)xb_add(&bar[XB_XCNT(b.x)], 1u);
    return b;
}
__device__ __forceinline__ void xcd_barrier_complete(unsigned* bar, unsigned x, unsigned& nloc, unsigned& nx) {
    const unsigned G = gridDim.x * gridDim.y * gridDim.z;
    unsigned sum, cnt, mine, sp = 0u;
    for (;;) {
        sum = 0u; cnt = 0u; mine = 0u;
#pragma unroll
        for (unsigned j = 0; j < 16; ++j) { const unsigned c = xb_ld(&bar[XB_XCNT(j)]); sum += c; cnt += (c > 0u) ? 1u : 0u; mine = (j == x) ? c : mine; }
        if (sum == G) break;
        __builtin_amdgcn_s_sleep(1);
        if ((++sp & 255u) == 0u) { if (xb_ld(&bar[XB_TMO])) break; if (sp > XB_SPIN_CAP) { atomicAdd(&bar[XB_TMO], 1u); break; } }
    }
    nloc = mine > 0u ? mine : 1u; nx = cnt > 0u ? cnt : 1u;
}

__device__ __forceinline__ void xcd_barrier(const XcdBarrier& b) {
    asm volatile("s_waitcnt vmcnt(0)" ::: "memory");
    __syncthreads();
    if (threadIdx.x == 0) {
        unsigned* bar = b.bar;
        __builtin_amdgcn_s_waitcnt(0);
        unsigned nloc = b.st[0], nx = b.st[1];
        if (nloc == 0u) { xcd_barrier_complete(bar, b.x, nloc, nx); b.st[0] = nloc; b.st[1] = nx; }
        const unsigned old = xb_add(&bar[XB_XSUB(b.x)], 1u);
        const unsigned gen = old / nloc;
        if (old + 1u == (gen + 1u) * nloc) {
            __builtin_amdgcn_fence(__ATOMIC_RELEASE, "agent");
            asm volatile("s_waitcnt vmcnt(0)" ::: "memory");
            const unsigned og = xb_add(&bar[XB_TOP], 1u);
            const unsigned tg = og / nx;
            if (og + 1u == (tg + 1u) * nx) xb_add(&bar[XB_TOPGEN], 1u);
            else XB_SPIN(xb_ld(&bar[XB_TOPGEN]) == tg, bar);
            __builtin_amdgcn_fence(__ATOMIC_ACQUIRE, "agent");
            xb_add(&bar[XB_XGEN(b.x)], 1u);
            asm volatile("s_waitcnt vmcnt(0)" ::: "memory");
        } else {
            XB_SPIN(xb_ld(&bar[XB_XGEN(b.x)]) == gen, bar);
            __builtin_amdgcn_fence(__ATOMIC_ACQUIRE, "agent");
            asm volatile("s_waitcnt vmcnt(0)" ::: "memory");
        }
    }
    __syncthreads();
}

enum { EM_PLAIN = 0, EM_KV, EM_BIG, EM_GATES, EM_BRANCH, EM_RES, EM_FFNIN, EM_INPROJ };
template <int MODE> struct Epi {
    static constexpr bool PERM = true, AFTER_DRAIN = false;
    bf16_t* O0; int ld0; bf16_t* O1; int ld1;
    const bf16_t* Gsrc;
    const float* fa;
    const float* hin_l; const float* hin_c; float* hout_l; float* hout_c;
    int ipar;
    DI void emit(int row, int col, f32x4 v0, f32x4 v1) const {
        float f[8] = {v0[0], v0[1], v0[2], v0[3], v1[0], v1[1], v1[2], v1[3]};
        if (MODE == EM_INPROJ) {
            if (col < 512) { *(u32x4*)(O1 + (size_t)row * 512 + col) = pack8(f); return; }
            col -= 512;
        }
        if (MODE == EM_PLAIN) {
            *(u32x4*)(O0 + (size_t)row * ld0 + col) = pack8(f);
        } else if (MODE == EM_KV) {
            if (col < 512) *(u32x4*)(O0 + (size_t)row * 768 + col) = pack8(f);
            else           *(u32x4*)(O1 + (size_t)row * 512 + (col - 512)) = pack8(f);
        } else if (MODE == EM_FFNIN) {
            if (col < DFF) *(u32x4*)(O0 + (size_t)row * DFF + col) = pack8(f);
            else           *(u32x4*)(O1 + (size_t)row * DFF + (col - DFF)) = pack8(f);
        } else if (MODE == EM_BIG || MODE == EM_INPROJ) {
            const float QS = 0.08838834764831845f;
            if (col < 512) { for (int i = 0; i < 8; ++i) f[i] *= QS; }
            else if (col >= 1536 && col < 2560) {
                int b, pos, isctx; rowinfo(row, b, pos, isctx);
                const int sp = isctx ? pos : CTX + pos;
                const int g = ((col - 1536) & 127) >> 3;
                const f32x2* rot = (const f32x2*)fa + (size_t)sp * 64 + 4 * g;
                const float sc = col >= 2048 ? QS : 1.f;
#pragma unroll
                for (int e = 0; e < 4; ++e) { const f32x2 cs = rot[e]; const float x1 = f[e], x2 = f[4 + e];
                    f[e] = (x1 * cs.x - x2 * cs.y) * sc; f[4 + e] = (x1 * cs.y + x2 * cs.x) * sc; }
            }
            *(u32x4*)(O0 + (size_t)row * 3072 + col) = pack8(f);
        } else if (MODE == EM_GATES) {
            if (col < 1024) {
                bf16_t* p = O1 + (size_t)row * 1024 + col; float on[8]; unpack8(*(const u32x4*)p, on);
#pragma unroll
                for (int i = 0; i < 8; ++i) f[i] = on[i] * f[i] * sigmoidf_(f[i]);
                *(u32x4*)p = pack8(f);
            } else {
                const int cc = col - 1024; const f32x4 b0 = *(const f32x4*)(fa + cc), b1 = *(const f32x4*)(fa + cc + 4);
                const float bb[8] = {b0[0], b0[1], b0[2], b0[3], b1[0], b1[1], b1[2], b1[3]};
#pragma unroll
                for (int i = 0; i < 8; ++i) f[i] = sigmoidf_(f[i] + bb[i]);
                *(u32x4*)(O0 + (size_t)row * 3072 + cc) = pack8(f);
            }
        } else if (MODE == EM_BRANCH) {
            float g[8]; unpack8(*(const u32x4*)(Gsrc + (size_t)row * 3072 + col), g);
            bf16_t* p = O0 + (size_t)row * 1024 + col;
            if (ipar > 0) { float pr[8]; unpack8(*(const u32x4*)p, pr);
#pragma unroll
                for (int i = 0; i < 8; ++i) f[i] = pr[i] + g[i] * f[i]; }
            else {
#pragma unroll
                for (int i = 0; i < 8; ++i) f[i] = g[i] * f[i]; }
            *(u32x4*)p = pack8(f);
        } else if (MODE == EM_RES) {
            int b, pos, isctx; rowinfo(row, b, pos, isctx);
            const float* hi_ = isctx ? hin_c + (size_t)(row - TL) * DM : hin_l + (size_t)row * DM;
            float* ho_ = isctx ? hout_c + (size_t)(row - TL) * DM : hout_l + (size_t)row * DM;
            const float* mod = fa + (size_t)(isctx ? 4 : b) * 6144 + ipar * 1024 + col;
            const f32x4 m0 = *(const f32x4*)mod, m1 = *(const f32x4*)(mod + 4);
            const f32x4 h0 = *(const f32x4*)(hi_ + col), h1 = *(const f32x4*)(hi_ + col + 4);
            *(f32x4*)(ho_ + col) = h0 + m0 * v0; *(f32x4*)(ho_ + col + 4) = h1 + m1 * v1;
        }
    }
    DI void operator()(const pg8::f32x4 (&acc)[2][2][4][2], const pg8::Unit& u, int wr, int wc, int fr, int fq) const {
#pragma unroll
        for (int ai = 0; ai < 2; ++ai)
#pragma unroll
            for (int m = 0; m < 4; ++m) { const int row = u.pm * 256 + ai * 128 + wr * 64 + m * 16 + fr;
#pragma unroll
                for (int bj = 0; bj < 2; ++bj) { const int col = u.pn * 256 + bj * 128 + wc * 32 + 8 * fq;
                    emit(row, col, acc[ai][bj][m][0], acc[ai][bj][m][1]); } }
    }
};

DI float dpp_ror1(float x) { return __int_as_float(__builtin_amdgcn_update_dpp(0, __float_as_int(x), 0x121, 0xf, 0xf, false)); }
DI float dpp_ror15(float x) { return __int_as_float(__builtin_amdgcn_update_dpp(0, __float_as_int(x), 0x12F, 0xf, 0xf, false)); }
DI float gelu_gate(float x, float u) { const float t2 = 1.5957691216057308f * (x + 0.044715f * x * x * x); return x / (1.f + __expf(-t2)) * u; }
struct EpiFfnConv {
    static constexpr bool PERM = true, AFTER_DRAIN = false;
    bf16_t* ACT; float* HALO; const float* wdw; const float* bdw; LAS float* X;
    DI void operator()(const pg8::f32x4 (&acc)[2][2][4][2], const pg8::Unit& u, int wr, int wc, int fr, int fq) const {
        const int ch = 128 * u.pn + 32 * wc + 8 * fq, xc = 32 * wc + 8 * fq;
        float w0[8], w1[8], w2[8], bb[8];
#pragma unroll
        for (int k = 0; k < 8; ++k) { w0[k] = wdw[ch + k]; w1[k] = wdw[DFF + ch + k]; w2[k] = wdw[2 * DFF + ch + k]; bb[k] = bdw[ch + k]; }
#pragma unroll
        for (int ai = 0; ai < 2; ++ai) {
            if (fr == 0) {
#pragma unroll
                for (int k = 0; k < 8; ++k) X[((ai * 2 + wr) * 2 + 0) * 128 + xc + k] = acc[ai][0][0][k >> 2][k & 3]; }
            if (fr == 15) {
#pragma unroll
                for (int k = 0; k < 8; ++k) X[((ai * 2 + wr) * 2 + 1) * 128 + xc + k] = acc[ai][0][3][k >> 2][k & 3]; }
        }
        asm volatile("s_waitcnt lgkmcnt(0)" ::: "memory"); __builtin_amdgcn_s_barrier(); asm volatile("" ::: "memory");
        const bool first_tile_row_is_seq_start = (u.pm >= TL / 256) || ((u.pm & 31) == 0);
        const bool last_tile_row_is_seq_end = (u.pm >= TL / 256) || ((u.pm & 31) == 31);
#pragma unroll
        for (int ai = 0; ai < 2; ++ai) {
            float top[8], bot[8];
            { const int tsel = wr == 1 ? ((ai * 2 + 0) * 2 + 1) : ((0 * 2 + 1) * 2 + 1);
              const bool tval = (wr == 1) || (ai == 1);
              const int bsel = wr == 0 ? ((ai * 2 + 1) * 2 + 0) : ((1 * 2 + 0) * 2 + 0);
              const bool bval = (wr == 0) || (ai == 0);
#pragma unroll
              for (int k = 0; k < 8; ++k) { top[k] = tval ? X[tsel * 128 + xc + k] : 0.f; bot[k] = bval ? X[bsel * 128 + xc + k] : 0.f; } }
#pragma unroll
            for (int m = 0; m < 4; ++m) {
                const int row = u.pm * 256 + ai * 128 + wr * 64 + m * 16 + fr;
                float o[8], xs[8];
#pragma unroll
                for (int k = 0; k < 8; ++k) {
                    const float g = acc[ai][0][m][k >> 2][k & 3], up = acc[ai][1][m][k >> 2][k & 3];
                    const float pa = dpp_ror1(g);
                    const float pb = m > 0 ? dpp_ror1(acc[ai][0][m > 0 ? m - 1 : 0][k >> 2][k & 3]) : top[k];
                    const float na = dpp_ror15(g);
                    const float nb = m < 3 ? dpp_ror15(acc[ai][0][m < 3 ? m + 1 : 3][k >> 2][k & 3]) : bot[k];
                    const float gp = fr > 0 ? pa : pb, gn = fr < 15 ? na : nb;
                    const float x = w0[k] * gp + w1[k] * g + w2[k] * gn + bb[k];
                    xs[k] = x; o[k] = gelu_gate(x, up);
                }
                *(u32x4*)(ACT + (size_t)row * DFF + ch) = pack8(o);
                if (ai == 0 && m == 0 && wr == 0 && fr == 0 && !first_tile_row_is_seq_start) { float* h = HALO + ((size_t)u.pm * 6 + 0) * DFF + ch;
#pragma unroll
                    for (int k = 0; k < 8; ++k) { h[k] = acc[0][0][0][k >> 2][k & 3]; h[DFF + k] = xs[k]; h[2 * DFF + k] = acc[0][1][0][k >> 2][k & 3]; } }
                if (ai == 1 && m == 3 && wr == 1 && fr == 15 && !last_tile_row_is_seq_end) { float* h = HALO + ((size_t)u.pm * 6 + 3) * DFF + ch;
#pragma unroll
                    for (int k = 0; k < 8; ++k) { h[k] = acc[1][0][3][k >> 2][k & 3]; h[DFF + k] = xs[k]; h[2 * DFF + k] = acc[1][1][3][k >> 2][k & 3]; } }
            }
        }
    }
};
DI void phase_convfix(const Params& P, int l) {
    bf16_t* ACT = (bf16_t*)(P.ws + WS_G); const float* HALO = (const float*)(P.ws + WS_U);
    const float* wdw = P.in[I_WDW] + (size_t)l * 3 * DFF; const float* bdw = P.in[I_BDW] + (size_t)l * DFF; (void)bdw;
    const int total = 127 * DFF;
    for (int i = blockIdx.x * NTHREADS + threadIdx.x; i < total; i += gridDim.x * NTHREADS) {
        const int pm = i / DFF, c = i - pm * DFF;
        if ((pm & 31) == 31) continue;
        const float* hl = HALO + ((size_t)pm * 6 + 3) * DFF + c; const float* hf = HALO + ((size_t)(pm + 1) * 6 + 0) * DFF + c;
        const float g_last = hl[0], x_last = hl[DFF], u_last = hl[2 * DFF], g_first = hf[0], x_first = hf[DFF], u_first = hf[2 * DFF];
        ACT[(size_t)(pm * 256 + 255) * DFF + c] = f2bf(gelu_gate(x_last + wdw[2 * DFF + c] * g_first, u_last));
        ACT[(size_t)(pm * 256 + 256) * DFF + c] = f2bf(gelu_gate(x_first + wdw[c] * g_last, u_first));
    }
}
template <int MODE>
DI void run_gemm(LAS unsigned char* lds, const bf16_t* A, int lda, const bf16_t* Bt, int M, int N, int K, const Epi<MODE>& E) {
    int Kop = K; if (K < 512) asm volatile("" : "+s"(Kop));
    pg8::Gemm g{A, Bt, M, N, Kop, lda}; pg8::StaticOrder S; S.init(M, N, (int)gridDim.x, (int)blockIdx.x);
    pg8::gemm_phase<Epi<MODE>, pg8::StaticOrder, true, true>((PG8_LAS unsigned char*)lds, g, S, E);
}
DI void run_gemm_ffnconv(LAS unsigned char* lds, const bf16_t* A, const bf16_t* Bt, int M, const EpiFfnConv& E) {
    pg8::Gemm g{A, Bt, M, 5632, 1024, 1024}; pg8::StaticOrder S; S.init(M, 5632, (int)gridDim.x, (int)blockIdx.x);
    pg8::gemm_phase<EpiFfnConv, pg8::StaticOrder, true, true>((PG8_LAS unsigned char*)lds, g, S, E);
}

DI void phase_qkpost(const Params& P, int l, LAS unsigned* lmax, const bool probe = false) {
    const int tid = threadIdx.x, wave = tid >> 6, lane = tid & 63, gw = blockIdx.x * NWAVES + wave, ngw = gridDim.x * NWAVES;
    const bf16_t* __restrict__ SM = (const bf16_t*)(P.ws + WS_SM); bf16_t* __restrict__ Q = (bf16_t*)(P.ws + WS_Q); bf16_t* __restrict__ K = (bf16_t*)(P.ws + WS_K); bf16_t* __restrict__ V = (bf16_t*)(P.ws + WS_V);
    const f32x2* __restrict__ ROPE = (const f32x2*)(P.ws + WS_ROPE);
    const float* qn = P.in[I_QN] + l * 96; const float* kn = P.in[I_KN] + l * 96;
    const int s = lane & 7, h = lane >> 3;
    float qnw[12], knw[12];
#pragma unroll
    for (int i = 0; i < 8; ++i) { qnw[i] = qn[8 * s + i]; knw[i] = kn[8 * s + i]; }
#pragma unroll
    for (int i = 0; i < 4; ++i) { qnw[8 + i] = qn[64 + 4 * s + i]; knw[8 + i] = kn[64 + 4 * s + i]; }
    const bool second = (s & 2) != 0;
    constexpr float QC = 0.10206207261596575f * 1.4426950408889634f;
    if (tid < 64) lmax[tid] = 0u;
    __syncthreads();
    u32x2 n_cq, n_kr, n_qr; unsigned n_ckv; u32x4 n_qn, n_kn, n_v;
#define QLOAD(m_) do { const bf16_t* sm_ = SM + (size_t)(m_) * 512; n_cq = *(const u32x2*)(sm_ + 4 * lane); n_ckv = *(const unsigned*)(sm_ + 256 + 2 * lane); n_kr = *(const u32x2*)(sm_ + 384 + 4 * s); \
        n_qn = *(const u32x4*)(Q + (size_t)(m_) * 768 + 64 * h + 8 * s); n_qr = *(const u32x2*)(Q + (size_t)(m_) * 768 + 512 + 32 * h + 4 * s); \
        n_kn = *(const u32x4*)(K + (size_t)(m_) * 768 + 64 * h + 8 * s); n_v = *(const u32x4*)(V + (size_t)(m_) * 512 + 8 * lane); } while (0)
    if (gw < TA) QLOAD(gw);
    for (int m = gw; m < TA; m += ngw) {
        const u32x2 cq = n_cq, krr = n_kr, qrr = n_qr; const unsigned ckv = n_ckv; const u32x4 qnn = n_qn, knn = n_kn, vraw = n_v;
        if (m + ngw < TA) QLOAD(m + ngw);
        int b, pos, isctx; rowinfo(m, b, pos, isctx);
        float a0 = bflo(cq.x), a1 = bfhi(cq.x), a2 = bflo(cq.y), a3 = bfhi(cq.y), c0 = bflo(ckv), c1 = bfhi(ckv);
        const float s_q = rsqrtf(wave_sum(a0 * a0 + a1 * a1 + a2 * a2 + a3 * a3) * (1.f / 256.f) + EPS);
        const float s_kv = rsqrtf(wave_sum(c0 * c0 + c1 * c1) * (1.f / 128.f) + EPS);
        float cs[4], sn[4];
        if (!isctx) { const f32x2* rp = ROPE + ((s < 4) ? (pos >> 6) : 128 + (pos & 63)) * 8 + 4 * (s & 1);
#pragma unroll
            for (int e = 0; e < 4; ++e) { const f32x2 t = rp[e]; cs[e] = t.x; sn[e] = t.y; } }
        else {
#pragma unroll
            for (int e = 0; e < 4; ++e) { cs[e] = 1.f; sn[e] = 0.f; } }
        {
            bf16_t* qp = (probe ? (bf16_t*)(P.ws + WS_R4) : Q) + (size_t)m * 768;
            float z[12]; unpack8(qnn, z);
            z[8] = bflo(qrr.x); z[9] = bfhi(qrr.x); z[10] = bflo(qrr.y); z[11] = bfhi(qrr.y);
            float ss = 0.f;
#pragma unroll
            for (int i = 0; i < 12; ++i) { z[i] *= s_q; ss += z[i] * z[i]; }
            ss += __shfl_xor(ss, 1); ss += __shfl_xor(ss, 2); ss += __shfl_xor(ss, 4);
            const float r = rsqrtf(ss * (1.f / 96.f) + EPS);
#pragma unroll
            for (int i = 0; i < 12; ++i) z[i] *= r * qnw[i] * QC;
            { float n2 = 0.f;
#pragma unroll
              for (int i = 0; i < 12; ++i) n2 += z[i] * z[i];
              n2 += __shfl_xor(n2, 1); n2 += __shfl_xor(n2, 2); n2 += __shfl_xor(n2, 4);
              if (s == 0 && !probe) atomicMax((unsigned*)&lmax[(b * 8 + h) * 2], __float_as_uint(n2)); }
#pragma unroll
            for (int e = 0; e < 4; ++e) { const float mine = z[8 + e], other = __shfl_xor(mine, 2);
                z[8 + e] = second ? (other * sn[e] + mine * cs[e]) : (mine * cs[e] - other * sn[e]); }
            *(u32x4*)(qp + 64 * h + 8 * s) = pack8(z);
            u32x2 o; o.x = pk2(z[8], z[9]); o.y = pk2(z[10], z[11]); *(u32x2*)(qp + 512 + 32 * h + 4 * s) = o;
        }
        {
            bf16_t* kp = (probe ? (bf16_t*)(P.ws + WS_R4) + (size_t)TA * 768 : K) + (size_t)m * 768;
            float z[12]; unpack8(knn, z);
#pragma unroll
            for (int i = 0; i < 8; ++i) z[i] *= s_kv;
            z[8] = bflo(krr.x); z[9] = bfhi(krr.x); z[10] = bflo(krr.y); z[11] = bfhi(krr.y);
            float ss = 0.f;
#pragma unroll
            for (int i = 0; i < 12; ++i) ss += z[i] * z[i];
            ss += __shfl_xor(ss, 1); ss += __shfl_xor(ss, 2); ss += __shfl_xor(ss, 4);
            const float r = rsqrtf(ss * (1.f / 96.f) + EPS);
#pragma unroll
            for (int i = 0; i < 12; ++i) z[i] *= r * knw[i];
            { float n2 = 0.f;
#pragma unroll
              for (int i = 0; i < 12; ++i) n2 += z[i] * z[i];
              n2 += __shfl_xor(n2, 1); n2 += __shfl_xor(n2, 2); n2 += __shfl_xor(n2, 4);
              if (s == 0 && !probe) atomicMax((unsigned*)&lmax[(b * 8 + h) * 2 + 1], __float_as_uint(n2)); }
#pragma unroll
            for (int e = 0; e < 4; ++e) { const float mine = z[8 + e], other = __shfl_xor(mine, 2);
                z[8 + e] = second ? (other * sn[e] + mine * cs[e]) : (mine * cs[e] - other * sn[e]); }
            *(u32x4*)(kp + 64 * h + 8 * s) = pack8(z);
            u32x2 o; o.x = pk2(z[8], z[9]); o.y = pk2(z[10], z[11]); *(u32x2*)(kp + 512 + 32 * h + 4 * s) = o;
            float vv[8]; unpack8(vraw, vv);
#pragma unroll
            for (int i = 0; i < 8; ++i) vv[i] *= s_kv;
            *(u32x4*)((probe ? (bf16_t*)(P.ws + WS_R4) + (size_t)TA * 1536 : V) + (size_t)m * 512 + 8 * lane) = pack8(vv);
        }
    }
#undef QLOAD
    __syncthreads();
    if (tid < 64 && !probe) atomicMax((unsigned*)(P.ws + WS_QKM) + tid, lmax[tid]);
}

DI void phase_scanpost(const Params& P, int l, int nrows, const bool probe = false) {
    const int tid = threadIdx.x, wave = tid >> 6, lane = tid & 63, gw = blockIdx.x * NWAVES + wave, ngw = gridDim.x * NWAVES;
    bf16_t* __restrict__ OF = (bf16_t*)(P.ws + WS_OF); const bf16_t* __restrict__ OB = (const bf16_t*)(P.ws + WS_OB);
    const float* gw_ = P.in[I_GON] + l * 128;
    const int sub = lane & 7, hd = lane >> 3;
    float w[16];
#pragma unroll
    for (int i = 0; i < 16; ++i) w[i] = hd < 4 ? gw_[16 * sub + i] : 1.f;
    u32x4 nf0, nf1, nb0, nb1;
#define PLOAD(m_) do { const bf16_t* pf_ = OF + (size_t)(m_) * 1024 + 16 * lane; const bf16_t* pb_ = OB + (size_t)(m_) * 1024 + 16 * lane; \
        nf0 = *(const u32x4*)pf_; nf1 = *(const u32x4*)(pf_ + 8); nb0 = *(const u32x4*)pb_; nb1 = *(const u32x4*)(pb_ + 8); } while (0)
    if (gw < nrows) PLOAD(gw);
    for (int m = gw; m < nrows; m += ngw) {
        float a[16], bq[16];
        unpack8(nf0, a); unpack8(nf1, a + 8); unpack8(nb0, bq); unpack8(nb1, bq + 8);
        if (m + ngw < nrows) PLOAD(m + ngw);
        float ss = 0.f;
#pragma unroll
        for (int i = 0; i < 16; ++i) { a[i] += bq[i]; ss += a[i] * a[i]; }
        ss += __shfl_xor(ss, 1); ss += __shfl_xor(ss, 2); ss += __shfl_xor(ss, 4);
        const float r = rsqrtf(ss * (1.f / 128.f) + EPS);
#pragma unroll
        for (int i = 0; i < 16; ++i) a[i] *= r * w[i];
        bf16_t* pf = (probe ? (bf16_t*)(P.ws + WS_R4) : OF) + (size_t)m * 1024 + 16 * lane;
        *(u32x4*)pf = pack8(a); *(u32x4*)(pf + 8) = pack8(a + 8);
    }
#undef PLOAD
}

DI void phase_conv(const Params& P, int l, int nrows) {
    const bf16_t* __restrict__ G = (const bf16_t*)(P.ws + WS_G); bf16_t* __restrict__ U = (bf16_t*)(P.ws + WS_U);
    const float* __restrict__ wdw = P.in[I_WDW] + (size_t)l * 3 * DFF; const float* __restrict__ bdw = P.in[I_BDW] + (size_t)l * DFF;
    const int total = (nrows / 4) * 352;
    for (int i = blockIdx.x * NTHREADS + threadIdx.x; i < total; i += gridDim.x * NTHREADS) {
        const int quad = i / 352, c = (i - quad * 352) * 8, m0 = quad * 4;
        int b, pos, isctx; rowinfo(m0, b, pos, isctx);
        const int last = isctx ? CTX - 1 : SEQ - 1;
        u32x4 g[6], u[4];
#pragma unroll
        for (int r = 0; r < 4; ++r) { g[r + 1] = *(const u32x4*)(G + (size_t)(m0 + r) * DFF + c); u[r] = *(const u32x4*)(U + (size_t)(m0 + r) * DFF + c); }
        g[0] = pos > 0 ? *(const u32x4*)(G + (size_t)(m0 - 1) * DFF + c) : (u32x4){0u, 0u, 0u, 0u};
        g[5] = pos + 3 < last ? *(const u32x4*)(G + (size_t)(m0 + 4) * DFF + c) : (u32x4){0u, 0u, 0u, 0u};
        float w0[8], w1[8], w2[8], bb[8];
#pragma unroll
        for (int k = 0; k < 8; ++k) { w0[k] = wdw[c + k]; w1[k] = wdw[DFF + c + k]; w2[k] = wdw[2 * DFF + c + k]; bb[k] = bdw[c + k]; }
#pragma unroll
        for (int r = 0; r < 4; ++r) {
            float a0[8], a1[8], a2[8], uu[8], o[8];
            unpack8(g[r], a0); unpack8(g[r + 1], a1); unpack8(g[r + 2], a2); unpack8(u[r], uu);
#pragma unroll
            for (int k = 0; k < 8; ++k) {
                const float x = w0[k] * a0[k] + w1[k] * a1[k] + w2[k] * a2[k] + bb[k];
                const float t2 = 1.5957691216057308f * (x + 0.044715f * x * x * x);
                o[k] = x / (1.f + __expf(-t2)) * uu[k];
            }
            *(u32x4*)(U + (size_t)(m0 + r) * DFF + c) = pack8(o);
        }
    }
}

namespace att {
constexpr int NW = 8, QBLK = 32, KVBLK = 64;
constexpr float SCALE = 0.10206207261596575f;
constexpr float THR = 8.f;
constexpr int SHM_V = 64 * 128 * 2, SHM_K = 64 * 256, SHM_ATTN = 2 * SHM_V + 2 * SHM_K + NW * 64 * 4;
#define KSWZ(row, colB) ((row) * 256 + ((colB) ^ (((row) & 7) << 4)))
#define SBAR() __builtin_amdgcn_sched_barrier(0)
DI int crow(int r, int hi) { return (r & 3) + 8 * (r >> 2) + 4 * hi; }
DI unsigned cvtpk(float lo, float hi) { unsigned r; asm volatile("v_cvt_pk_bf16_f32 %0, %1, %2" : "=v"(r) : "v"(lo), "v"(hi)); return r; }
DI bf16x8 ld8(const bf16_t* p) { return *reinterpret_cast<const bf16x8*>(p); }

constexpr float THR2 = 11.5f;
DI void partialSM(f32x16& p0, f32x16& p1, float& m_reg, float& mn, float& alpha) {
  float pmax = p0[0]; for (int r = 1; r < 16; ++r) pmax = fmaxf(pmax, p0[r]); for (int r = 0; r < 16; ++r) pmax = fmaxf(pmax, p1[r]);
  { auto rr = __builtin_amdgcn_permlane32_swap(__float_as_uint(pmax), __float_as_uint(pmax), false, false);
    pmax = fmaxf(__uint_as_float(rr[0]), __uint_as_float(rr[1])); }
  if (__builtin_expect(__all(pmax - m_reg <= THR2), 1)) { mn = m_reg; alpha = 1.f; }
  else { mn = fmaxf(m_reg, pmax); alpha = __builtin_amdgcn_exp2f(m_reg - mn); m_reg = mn; }
  for (int r = 0; r < 16; ++r) p0[r] -= mn; for (int r = 0; r < 16; ++r) p1[r] -= mn;
  for (int r = 0; r < 16; ++r) p0[r] = __builtin_amdgcn_exp2f(p0[r]);
}
DI void partialSM_fix(f32x16& p0) { for (int r = 0; r < 16; ++r) p0[r] = __builtin_amdgcn_exp2f(p0[r]); }
DI void finishSM(f32x16& p0, f32x16& p1, float alpha, float& l_reg, bf16x8& pa0, bf16x8& pa1, bf16x8& pa2, bf16x8& pa3) {
  for (int r = 0; r < 16; ++r) p1[r] = __builtin_amdgcn_exp2f(p1[r]);
  float ps = 0; for (int r = 0; r < 16; ++r) ps += p0[r]; for (int r = 0; r < 16; ++r) ps += p1[r];
  { auto rr = __builtin_amdgcn_permlane32_swap(__float_as_uint(ps), __float_as_uint(ps), false, false);
    ps = __uint_as_float(rr[0]) + __uint_as_float(rr[1]); }
  l_reg = l_reg * alpha + ps;
#define PK4(P, BASE, OUT) do { unsigned a0 = cvtpk(P[BASE + 0], P[BASE + 1]), a1 = cvtpk(P[BASE + 2], P[BASE + 3]);   \
    unsigned b0 = cvtpk(P[BASE + 4], P[BASE + 5]), b1 = cvtpk(P[BASE + 6], P[BASE + 7]);                              \
    auto r0 = __builtin_amdgcn_permlane32_swap(a0, b0, false, false); auto r1 = __builtin_amdgcn_permlane32_swap(a1, b1, false, false); \
    u32x4 w = {r0[0], r1[0], r0[1], r1[1]}; OUT = *reinterpret_cast<bf16x8*>(&w); } while (0)
  PK4(p0, 0, pa0); PK4(p0, 8, pa1); PK4(p1, 0, pa2); PK4(p1, 8, pa3);
#undef PK4
}
template <bool FIX>
DI void qkt(f32x16& p0, f32x16& p1, const char* Ks, const bf16x8* qr, int r32, int hi, const f32x16& init) {
  const f32x16 zero = {};
#pragma unroll
  for (int d0 = 0; d0 < 6; ++d0) { int cb = (d0 * 16 + hi * 8) * 2;
    bf16x8 b0 = *reinterpret_cast<const bf16x8*>(Ks + KSWZ(r32, cb));
    bf16x8 b1 = *reinterpret_cast<const bf16x8*>(Ks + KSWZ(32 + r32, cb));
    p0 = __builtin_amdgcn_mfma_f32_32x32x16_bf16(b0, qr[d0], d0 == 0 ? zero : p0, 0, 0, 0);
    p1 = __builtin_amdgcn_mfma_f32_32x32x16_bf16(b1, qr[d0], d0 == 0 ? zero : p1, 0, 0, 0); }
}
DI int v_st(int k, int c) { const int kk = (k & ~0xC) | ((k & 4) << 1) | ((k & 8) >> 1); return ((kk >> 3) * 4 + (c >> 5)) * 512 + ((kk & 7) * 32 + (c & 31)) * 2; }
DI int v_rd_base(int lane) { return ((lane & 3) << 3) | (((lane >> 2) & 3) << 6) | (((lane >> 4) & 1) << 5) | (((lane >> 5) & 1) << 8); }
constexpr int v_rd_off(int d0, int ks, int half) { return d0 * 512 + ks * 4096 + half * 2048; }
template <int OFF> DI s16x4 tr_read(int vb) {
  s16x4 r; asm volatile("ds_read_b64_tr_b16 %0, %1 offset:%2" : "=&v"(r) : "v"(vb), "i"(OFF) : "memory"); return r;
}
template <int D0> DI void pv_one(f32x16& od, int vb, bf16x8 pa0, bf16x8 pa1, bf16x8 pa2, bf16x8 pa3) {
  const s16x4 l0 = tr_read<v_rd_off(D0, 0, 0)>(vb), h0 = tr_read<v_rd_off(D0, 0, 1)>(vb), l1 = tr_read<v_rd_off(D0, 1, 0)>(vb), h1 = tr_read<v_rd_off(D0, 1, 1)>(vb);
  const s16x4 l2 = tr_read<v_rd_off(D0, 2, 0)>(vb), h2 = tr_read<v_rd_off(D0, 2, 1)>(vb), l3 = tr_read<v_rd_off(D0, 3, 0)>(vb), h3 = tr_read<v_rd_off(D0, 3, 1)>(vb);
  asm volatile("s_waitcnt lgkmcnt(0)" ::: "memory"); SBAR();
#define PK(L, H) (bf16x8){L[0], L[1], L[2], L[3], H[0], H[1], H[2], H[3]}
  od = __builtin_amdgcn_mfma_f32_32x32x16_bf16(pa0, PK(l0, h0), od, 0, 0, 0);
  od = __builtin_amdgcn_mfma_f32_32x32x16_bf16(pa1, PK(l1, h1), od, 0, 0, 0);
  od = __builtin_amdgcn_mfma_f32_32x32x16_bf16(pa2, PK(l2, h2), od, 0, 0, 0);
  od = __builtin_amdgcn_mfma_f32_32x32x16_bf16(pa3, PK(l3, h3), od, 0, 0, 0);
#undef PK
}
DI void pv_d0(f32x16* o, int vb, bf16x8 pa0, bf16x8 pa1, bf16x8 pa2, bf16x8 pa3) {
  pv_one<0>(o[0], vb, pa0, pa1, pa2, pa3); pv_one<1>(o[1], vb, pa0, pa1, pa2, pa3);
}

template <bool FIX>
DI void attn_unit(const bf16_t* Qg, bf16_t* Og, int ldo, const bf16_t* Kg, const bf16_t* Vg, int qrow0, int h, int ctxrow0, int latrow0, int NT, char* lds, float bound) {
  const int tid = threadIdx.x, wid = tid >> 6, lane = tid & 63, r32 = lane & 31, hi = lane >> 5;
  char* V_lds = lds; char* K_lds = lds + 2 * SHM_V;
  float* ws = (float*)(lds + 2 * SHM_V + 2 * SHM_K) + wid * 64; float* li_l = ws; float* al_l = ws + 32;
  float m_reg = -1e30f, l_reg = 0; f32x16 o[2] = {}; bf16x8 qr[6];
  const f32x16 init = {}; (void)bound;
  const bf16_t* Qw = Qg + (size_t)(qrow0 + wid * QBLK + r32) * 768;
#pragma unroll
  for (int d0 = 0; d0 < 6; ++d0) qr[d0] = ld8(Qw + (d0 < 4 ? 64 * h + 16 * d0 + 8 * hi : 512 + 32 * h + 16 * (d0 - 4) + 8 * hi));
  const int vr = tid >> 3, vc = tid & 7, vst = v_st(vr, 8 * vc), vcol = 64 * h + 8 * vc;
  const int c0 = tid, c1 = 512 + (tid & 255);
  const int kr0 = c0 / 12, kc0 = c0 % 12, kr1 = c1 / 12, kc1 = c1 % 12;
  const int kcol0 = kc0 < 8 ? 64 * h + 8 * kc0 : 512 + 32 * h + 8 * (kc0 - 8), kcol1 = kc1 < 8 ? 64 * h + 8 * kc1 : 512 + 32 * h + 8 * (kc1 - 8);
  const int kst0 = KSWZ(kr0, kc0 * 16), kst1 = KSWZ(kr1, kc1 * 16);
  const int vb0 = (int)(uintptr_t)V_lds + v_rd_base(lane);
  struct { bf16x8 vs0, ks0, ks1; } sr_[2];
#define TROW(j) ((j) < 4 ? ctxrow0 + 64 * (j) : latrow0 + 64 * ((j) - 4))
#define SLOAD(i, j) do { const int rb_ = TROW(j); sr_[i].vs0 = ld8(Vg + (size_t)(rb_ + vr) * 512 + vcol); \
    sr_[i].ks0 = ld8(Kg + (size_t)(rb_ + kr0) * 768 + kcol0); sr_[i].ks1 = ld8(Kg + (size_t)(rb_ + kr1) * 768 + kcol1); } while (0)
#define SWRITE(b, i) do { *(bf16x8*)(V_lds + (b) * SHM_V + vst) = sr_[i].vs0; \
    *(bf16x8*)(K_lds + (b) * SHM_K + kst0) = sr_[i].ks0; *(bf16x8*)(K_lds + (b) * SHM_K + kst1) = sr_[i].ks1; } while (0)
#define SWAIT() asm volatile("s_waitcnt vmcnt(3)" ::: "memory")
#define PSM(p0_, p1_, mn_, al_) do { if (FIX) { partialSM_fix(p0_); al_ = 1.f; } else partialSM(p0_, p1_, m_reg, mn_, al_); } while (0)
#define RESC(a) do { if (!FIX) if (__any((a) < 1.f)) { if (hi == 0) al_l[r32] = (a); asm volatile("s_waitcnt lgkmcnt(0)" ::: "memory"); \
    for (int d = 0; d < 2; ++d) for (int r = 0; r < 16; ++r) o[d][r] *= al_l[crow(r, hi)]; } } while (0)
  f32x16 pA0, pA1, pB0, pB1; float mnA, mnB, alA, alB; bf16x8 pa0, pa1, pa2, pa3;
  constexpr int SE = 0, SO = 1;
  SLOAD(SE, 0); asm volatile("s_waitcnt vmcnt(0)" ::: "memory"); SWRITE(0, SE); __syncthreads();
  qkt<FIX>(pA0, pA1, K_lds, qr, r32, hi, init); PSM(pA0, pA1, mnA, alA);
  SLOAD(SO, 1); if (2 < NT) SLOAD(SE, 2);
  SWAIT(); SWRITE(1, SO); __syncthreads();
  for (int j = 1; j + 1 < NT; j += 2) {
    SBAR(); qkt<FIX>(pB0, pB1, K_lds + SHM_K, qr, r32, hi, init);
    finishSM(pA0, pA1, alA, l_reg, pa0, pa1, pa2, pa3); SBAR();
    SLOAD(SO, j + 2); SBAR();
    pv_d0(o, vb0, pa0, pa1, pa2, pa3); PSM(pB0, pB1, mnB, alB);
    __syncthreads(); SWAIT(); SWRITE(0, SE);
    RESC(alB); __syncthreads();
    SBAR(); qkt<FIX>(pA0, pA1, K_lds, qr, r32, hi, init);
    finishSM(pB0, pB1, alB, l_reg, pa0, pa1, pa2, pa3); SBAR();
    if (j + 3 < NT) SLOAD(SE, j + 3); SBAR();
    pv_d0(o, vb0 + SHM_V, pa0, pa1, pa2, pa3); PSM(pA0, pA1, mnA, alA);
    __syncthreads(); SWAIT(); SWRITE(1, SO);
    RESC(alA); __syncthreads();
  }
  SBAR(); qkt<FIX>(pB0, pB1, K_lds + SHM_K, qr, r32, hi, init);
  finishSM(pA0, pA1, alA, l_reg, pa0, pa1, pa2, pa3); SBAR();
  pv_d0(o, vb0, pa0, pa1, pa2, pa3); PSM(pB0, pB1, mnB, alB);
  __syncthreads(); RESC(alB);
  finishSM(pB0, pB1, alB, l_reg, pa0, pa1, pa2, pa3); SBAR();
  pv_d0(o, vb0 + SHM_V, pa0, pa1, pa2, pa3);
  if (hi == 0) li_l[r32] = l_reg; asm volatile("s_waitcnt lgkmcnt(0)" ::: "memory");
  float rli[16];
#pragma unroll
  for (int r = 0; r < 16; ++r) rli[r] = __builtin_amdgcn_rcpf(li_l[crow(r, hi)]);
  bf16_t* Ow = Og + (size_t)(qrow0 + wid * QBLK) * ldo + 64 * h;
#pragma unroll
  for (int r = 0; r < 16; ++r) { const int orow = crow(r, hi);
#pragma unroll
    for (int d0 = 0; d0 < 2; ++d0) Ow[(size_t)orow * ldo + d0 * 32 + r32] = f2bf(o[d0][r] * rli[r]); }
#undef TROW
#undef SLOAD
#undef SWRITE
#undef SWAIT
#undef RESC
#undef PSM
}
}

DI void phase_attention(const Params& P, int l, char* lds, bf16_t* Og, int ldo) {
    const bf16_t* Q = (const bf16_t*)(P.ws + WS_Q); const bf16_t* K = (const bf16_t*)(P.ws + WS_K); const bf16_t* V = (const bf16_t*)(P.ws + WS_V);
    const unsigned* QKM = (const unsigned*)(P.ws + WS_QKM);
    for (int u = blockIdx.x; u < 1024 + (l == 0 ? 32 : 0); u += gridDim.x) {
        int b, h, qrow0, nt;
        if (u < 1024) { const int bh = (u >> 8) * 8 + (u & 7), qb = (u >> 3) & 31; b = bh >> 3; h = bh & 7; qrow0 = b * SEQ + 256 * qb; nt = 132; }
        else { b = (u - 1024) >> 3; h = (u - 1024) & 7; qrow0 = TL + b * CTX; nt = 4; }
        const float bound = sqrtf(__uint_as_float(QKM[(b * 8 + h) * 2]) * __uint_as_float(QKM[(b * 8 + h) * 2 + 1])) * 1.01f + 0.5f;
        __syncthreads();
        if (bound <= 48.f) att::attn_unit<true>(Q, Og, ldo, K, V, qrow0, h, TL + b * CTX, b * SEQ, nt, lds, bound);
        else att::attn_unit<false>(Q, Og, ldo, K, V, qrow0, h, TL + b * CTX, b * SEQ, nt, lds, 0.f);
    }
    __syncthreads();
}

namespace scn {
constexpr int RQ = 0, RK = 16384, RR = 32768;
constexpr int QD = 34816;
constexpr int KN = QD + 64 * 272;
constexpr int KET = KN + 64 * 272;
constexpr int VT = KET + 128 * 144;
constexpr int ST = VT + 128 * 144;
constexpr int PM = ST + 128 * 272;
constexpr int DEC = PM + 64 * 144;
constexpr int END = DEC + 512;
static_assert(END <= LDS_BYTES - 16, "scan LDS");
constexpr size_t US_OFF = 0, DL_OFF = (size_t)64 * 3 * 16384 * 2;
static_assert(DL_OFF + (size_t)64 * 3 * 128 * 4 <= (size_t)3584 * 1024 * 2, "scan hand-off must fit in the dead part of the weight region");
DI int crow(int r, int hi) { return (r & 3) + 8 * (r >> 2) + 4 * hi; }
#define SC_BAR() do { asm volatile("s_waitcnt lgkmcnt(0)" ::: "memory"); __builtin_amdgcn_s_barrier(); asm volatile("" ::: "memory"); } while (0)
#define SMFMA(a, b, c) __builtin_amdgcn_mfma_f32_32x32x16_bf16((a), (b), (c), 0, 0, 0)
}
DI void phase_scan(const Params& P, int l, char* lds, const int pass) {
    using namespace scn;
    const int tid = threadIdx.x, wid = tid >> 6, lane = tid & 63, r32 = lane & 31, hi = lane >> 5;
    const bf16_t* R4 = (const bf16_t*)(P.ws + WS_R4); const bf16_t* SM = (const bf16_t*)(P.ws + WS_SM);
    bf16_t* UST = (bf16_t*)(P.ws + WS_WT + US_OFF); float* DLG = (float*)(P.ws + WS_WT + DL_OFF);
    const int nitems = pass == 1 ? 192 : 256;
    for (int item = blockIdx.x; item < nitems; item += gridDim.x) {
        int seg, scan; if (pass == 1) { seg = item % 3; scan = item / 3; } else { seg = item & 3; scan = item >> 2; }
        const int dir = scan & 1, hd = (scan >> 1) & 7, b = scan >> 4;
        const bool gla = hd < 4; const int hh = hd & 3;
        const int qcol = gla ? hh * 128 : 1536 + hh * 128, kcol = gla ? 512 + hh * 128 : 2048 + hh * 128, vcol = (gla ? 1024 : 2560) + hh * 128;
        bf16_t* Od = (bf16_t*)(P.ws + (dir ? WS_OB : WS_OF)); const int ocol = hd * 128;
        const int pti = wid >> 2, pdj = wid & 3, pd = 32 * pdj + r32;
        const int vt = wid >> 1, dt0 = 2 * (wid & 1);
        bf16x8 w2h = {0, 0, 0, 0, 0, 0, 0, 0}, w2l = {0, 0, 0, 0, 0, 0, 0, 0}; float bias = 0.f, lg = 0.f;
        if (gla) { const float* W2 = P.in[I_GK2] + (size_t)(l * 2 + dir) * 16 * 512 + hh * 128 + pd;
#pragma unroll
            for (int j = 0; j < 8; ++j) { const float w = W2[(8 * hi + j) * 512]; const unsigned u = __float_as_uint(w) & 0xffff0000u; const float res = w - __uint_as_float(u);
                w2h[j] = (short)(u >> 16); w2l[j] = (short)(__float_as_uint(res) >> 16); }
            bias = P.in[I_BGK][(l * 2 + dir) * 512 + hh * 128 + pd]; }
        else lg = -expf(P.in[I_RDEC][(l * 2 + dir) * 4 + hh]);
        f32x16 S0 = {}, S1 = {}; float clsum = 0.f;
        __syncthreads();
        if (pass == 2) {
            for (int sp = 0; sp < seg; ++sp) {
                const bf16_t* U = UST + (size_t)(scan * 3 + sp) * 16384; const float* DL = DLG + (size_t)(scan * 3 + sp) * 128;
                const float e0 = __expf(DL[32 * dt0 + r32]), e1 = __expf(DL[32 * (dt0 + 1) + r32]);
#pragma unroll
                for (int r = 0; r < 16; ++r) { const int v = 32 * vt + crow(r, hi);
                    S0[r] = S0[r] * e0 + bf2f(U[v * 128 + 32 * dt0 + r32]); S1[r] = S1[r] * e1 + bf2f(U[v * 128 + 32 * (dt0 + 1) + r32]); }
            }
#pragma unroll
            for (int r = 0; r < 16; ++r) { const int v = 32 * vt + crow(r, hi);
                *(bf16_t*)(lds + ST + v * 272 + (32 * dt0 + r32) * 2) = f2bf(S0[r]); *(bf16_t*)(lds + ST + v * 272 + (32 * (dt0 + 1) + r32) * 2) = f2bf(S1[r]); }
            { const int i = tid >> 4, j = 32 + (tid & 15) * 2; *(unsigned*)(lds + PM + i * 144 + j * 2) = 0u; }
        }
        u32x4 pq0 = {0u, 0u, 0u, 0u}, pq1 = pq0, pk0, pk1, pr = pq0, pv0, pv1;
#define ROWBASE(n) (dir == 0 ? ((n) < 4 ? TL + b * CTX + 64 * (n) : b * SEQ + 64 * ((n) - 4)) : ((n) < 4 ? TL + b * CTX + 64 * (3 - (n)) : b * SEQ + 64 * (127 - ((n) - 4))))
#define SC_LOADQK(n) do { const int rb_ = ROWBASE(n); \
        if (pass == 2) { pq0 = *(const u32x4*)(R4 + (size_t)(rb_ + (tid >> 4)) * 3072 + qcol + 8 * (tid & 15)); pq1 = *(const u32x4*)(R4 + (size_t)(rb_ + 32 + (tid >> 4)) * 3072 + qcol + 8 * (tid & 15)); } \
        pk0 = *(const u32x4*)(R4 + (size_t)(rb_ + (tid >> 4)) * 3072 + kcol + 8 * (tid & 15)); pk1 = *(const u32x4*)(R4 + (size_t)(rb_ + 32 + (tid >> 4)) * 3072 + kcol + 8 * (tid & 15)); \
        if (tid < 128) pr = *(const u32x4*)(SM + (size_t)(rb_ + (tid >> 1)) * 512 + 416 + dir * 16 + 8 * (tid & 1)); } while (0)
#define SC_LOADV(n) do { const int rb_ = ROWBASE(n); \
        pv0 = *(const u32x4*)(R4 + (size_t)(rb_ + lane) * 3072 + vcol + 8 * wid); pv1 = *(const u32x4*)(R4 + (size_t)(rb_ + lane) * 3072 + vcol + 64 + 8 * wid); } while (0)
#define SC_STOREQK() do { if (pass == 2) { *(u32x4*)(lds + RQ + sr0 * 256 + (tid & 15) * 16) = pq0; *(u32x4*)(lds + RQ + sr1 * 256 + (tid & 15) * 16) = pq1; } \
        *(u32x4*)(lds + RK + sr0 * 256 + (tid & 15) * 16) = pk0; *(u32x4*)(lds + RK + sr1 * 256 + (tid & 15) * 16) = pk1; \
        if (tid < 128) *(u32x4*)(lds + RR + srr * 32 + (tid & 1) * 16) = pr; } while (0)
        const int sr0 = dir ? 63 - (tid >> 4) : (tid >> 4), sr1 = dir ? 31 - (tid >> 4) : 32 + (tid >> 4);
        const int srr = dir ? 63 - (tid >> 1) : (tid >> 1), svi = dir ? 63 - lane : lane;
        const int n0 = 33 * seg;
        SC_LOADQK(n0); SC_STOREQK(); SC_LOADQK(n0 + 1); SC_LOADV(n0);
        for (int n = n0; n < n0 + 33; ++n) {
            int r32v = r32, hiv = hi; asm volatile("" : "+v"(r32v), "+v"(hiv));
            SC_BAR();
            { char* vb = lds + VT + (8 * wid) * 144 + svi * 2;
              const unsigned w0[4] = {pv0.x, pv0.y, pv0.z, pv0.w}, w1[4] = {pv1.x, pv1.y, pv1.z, pv1.w};
#pragma unroll
              for (int e = 0; e < 4; ++e) { *(bf16_t*)(vb + (2 * e) * 144) = (bf16_t)(w0[e] & 0xffffu); *(bf16_t*)(vb + (2 * e + 1) * 144) = (bf16_t)(w0[e] >> 16);
                  *(bf16_t*)(vb + (64 + 2 * e) * 144) = (bf16_t)(w1[e] & 0xffffu); *(bf16_t*)(vb + (64 + 2 * e + 1) * 144) = (bf16_t)(w1[e] >> 16); }
              if (n + 1 < n0 + 33) SC_LOADV(n + 1); }
            {
                f32x16 cum; float cl;
                if (gla) {
                    f32x16 la0, la1;
                    { const bf16x8 a0 = *(const bf16x8*)(lds + RR + r32v * 32 + hiv * 16), a1 = *(const bf16x8*)(lds + RR + (32 + r32v) * 32 + hiv * 16);
                      la0 = SMFMA(a0, w2h, (f32x16{})); la0 = SMFMA(a0, w2l, la0); la1 = SMFMA(a1, w2h, (f32x16{})); la1 = SMFMA(a1, w2l, la1); }
                    float ssum = 0.f;
#pragma unroll
                    for (int r = 0; r < 16; ++r) { const float x0 = la0[r] + bias, x1 = la1[r] + bias;
                        la0[r] = (fminf(x0, 0.f) - __logf(1.f + __expf(-fabsf(x0)))) * (1.f / 16.f);
                        la1[r] = (fminf(x1, 0.f) - __logf(1.f + __expf(-fabsf(x1)))) * (1.f / 16.f);
                        ssum += la0[r] + la1[r]; }
                    cl = ssum + __shfl_xor(ssum, 32);
                    __builtin_amdgcn_sched_barrier(0);
                    cum = f32x16{};
                    bf16x8 tri0, tri1;
#pragma unroll
                    for (int j = 0; j < 8; ++j) { const int k0 = 8 * (j >> 2) + 4 * hiv + (j & 3);
                        tri0[j] = (short)(r32v >= k0 ? 0x3F80 : 0); tri1[j] = (short)(r32v >= k0 + 16 ? 0x3F80 : 0); }
                    const bf16x8 ones = {0x3F80, 0x3F80, 0x3F80, 0x3F80, 0x3F80, 0x3F80, 0x3F80, 0x3F80};
                    const bf16x8 atk0_0 = pti ? ones : tri0, atk0_1 = pti ? ones : tri1;
#pragma unroll
                    for (int st = 0; st < 2; ++st) { bf16x8 h8, l8;
#pragma unroll
                        for (int j = 0; j < 8; ++j) { const float v = la0[8 * st + j]; const unsigned u = __float_as_uint(v) & 0xffff0000u; const float res = v - __uint_as_float(u);
                            h8[j] = (short)(u >> 16); l8[j] = (short)(__float_as_uint(res) >> 16); }
                        const bf16x8 am = st ? atk0_1 : atk0_0; cum = SMFMA(am, h8, cum); cum = SMFMA(am, l8, cum); }
                    if (pti) {
#pragma unroll
                        for (int st = 0; st < 2; ++st) { bf16x8 h8, l8;
#pragma unroll
                            for (int j = 0; j < 8; ++j) { const float v = la1[8 * st + j]; const unsigned u = __float_as_uint(v) & 0xffff0000u; const float res = v - __uint_as_float(u);
                                h8[j] = (short)(u >> 16); l8[j] = (short)(__float_as_uint(res) >> 16); }
                            const bf16x8 am = st ? tri1 : tri0; cum = SMFMA(am, h8, cum); cum = SMFMA(am, l8, cum); } }
                    __builtin_amdgcn_sched_barrier(0);
                } else {
#pragma unroll
                    for (int r = 0; r < 16; ++r) cum[r] = (float)(32 * pti + crow(r, hiv) + 1) * lg;
                    cl = 64.f * lg;
                }
                clsum += cl;
                {
                    const int ibase = 32 * pti + 4 * hiv; const float ecl = __expf(cl);
                    const char* rqb = lds + RQ + ibase * 256 + pd * 2; const char* rkb = lds + RK + ibase * 256 + pd * 2;
                    char* qdb = lds + QD + ibase * 272 + pd * 2; char* knb = lds + KN + ibase * 272 + pd * 2; char* keb = lds + KET + pd * 144 + ibase * 2;
                    if (pass == 2) {
#pragma unroll
                        for (int r = 0; r < 16; ++r) { const int cr = (r & 3) + 8 * (r >> 2);
                            const float c = cum[r]; const float e1 = __expf(c), e2 = __expf(-c);
                            const float q = bf2f(*(const bf16_t*)(rqb + cr * 256)), k = bf2f(*(const bf16_t*)(rkb + cr * 256));
                            const float kn = k * e2;
                            *(bf16_t*)(qdb + cr * 272) = f2bf(q * e1);
                            *(bf16_t*)(knb + cr * 272) = f2bf(kn);
                            *(bf16_t*)(keb + cr * 2) = f2bf(kn * ecl);
                            if ((r & 3) == 3) { asm volatile("" ::: "memory"); } }
                    } else {
#pragma unroll
                        for (int r = 0; r < 16; ++r) { const int cr = (r & 3) + 8 * (r >> 2);
                            const float k = bf2f(*(const bf16_t*)(rkb + cr * 256));
                            *(bf16_t*)(keb + cr * 2) = f2bf(k * __expf(cl - cum[r]));
                            if ((r & 3) == 3) { asm volatile("" ::: "memory"); } }
                    }
                    if (pti == 0 && hiv == 0) *(float*)(lds + DEC + pd * 4) = ecl;
                }
            }
            SC_BAR();
            if (n + 1 < n0 + 33) { SC_STOREQK(); if (n + 2 < n0 + 33) SC_LOADQK(n + 2); }
            f32x16 oacc = {};
            if (pass == 2) {
                if (wid < 3) {
                    const int ti = (wid + 1) >> 1, tj = wid >> 1; f32x16 T0 = {};
#pragma unroll
                    for (int kk = 0; kk < 8; ++kk) { const bf16x8 a = *(const bf16x8*)(lds + QD + (32 * ti + r32v) * 272 + (16 * kk + 8 * hiv) * 2), bb = *(const bf16x8*)(lds + KN + (32 * tj + r32v) * 272 + (16 * kk + 8 * hiv) * 2);
                        T0 = SMFMA(a, bb, T0); }
#pragma unroll
                    for (int r = 0; r < 16; ++r) { const int cr = (r & 3) + 8 * (r >> 2); const int ib = 32 * ti + 4 * hiv, j = 32 * tj + r32v; int jm = j - (dir ? 0 : 1) - ib; asm volatile("" : "+v"(jm));
                        *(bf16_t*)(lds + PM + ib * 144 + j * 2 + cr * 144) = f2bf(cr > jm ? T0[r] : 0.f); }
                }
                { const int ti = wid >> 2, vj = wid & 3;
#pragma unroll
                  for (int kk = 0; kk < 8; ++kk) { const bf16x8 a = *(const bf16x8*)(lds + QD + (32 * ti + r32v) * 272 + (16 * kk + 8 * hiv) * 2), bb = *(const bf16x8*)(lds + ST + (32 * vj + r32v) * 272 + (16 * kk + 8 * hiv) * 2);
                      oacc = SMFMA(a, bb, oacc); } }
            }
            {
                const float dc0 = *(const float*)(lds + DEC + (32 * dt0 + r32v) * 4), dc1 = *(const float*)(lds + DEC + (32 * (dt0 + 1) + r32v) * 4);
#pragma unroll
                for (int r = 0; r < 16; ++r) { S0[r] *= dc0; S1[r] *= dc1; }
#pragma unroll
                for (int kk = 0; kk < 4; ++kk) { const bf16x8 a = *(const bf16x8*)(lds + VT + (32 * vt + r32v) * 144 + (16 * kk + 8 * hiv) * 2);
                    const bf16x8 b0 = *(const bf16x8*)(lds + KET + (32 * dt0 + r32v) * 144 + (16 * kk + 8 * hiv) * 2), b1 = *(const bf16x8*)(lds + KET + (32 * (dt0 + 1) + r32v) * 144 + (16 * kk + 8 * hiv) * 2);
                    S0 = SMFMA(a, b0, S0); S1 = SMFMA(a, b1, S1); }
            }
            if (pass == 2) {
                SC_BAR();
                { const int ti = wid >> 2, vj = wid & 3;
#pragma unroll
                  for (int kk = 0; kk < 4; ++kk) { const bf16x8 a = *(const bf16x8*)(lds + PM + (32 * ti + r32v) * 144 + (16 * kk + 8 * hiv) * 2), bb = *(const bf16x8*)(lds + VT + (32 * vj + r32v) * 144 + (16 * kk + 8 * hiv) * 2);
                      oacc = SMFMA(a, bb, oacc); }
                  const int rb = ROWBASE(n);
#pragma unroll
                  for (int r = 0; r < 16; ++r) { const int i = 32 * ti + crow(r, hiv), row = rb + (dir ? 63 - i : i);
                      Od[(size_t)row * 1024 + ocol + 32 * vj + r32v] = f2bf(oacc[r]); } }
#pragma unroll
                for (int r = 0; r < 16; ++r) { const int cr = (r & 3) + 8 * (r >> 2); char* stb = lds + ST + (32 * vt + 4 * hiv) * 272 + (32 * dt0 + r32v) * 2;
                    *(bf16_t*)(stb + cr * 272) = f2bf(S0[r]); *(bf16_t*)(stb + cr * 272 + 64) = f2bf(S1[r]); }
            }
        }
        if (pass == 1) {
            bf16_t* U = UST + (size_t)(scan * 3 + seg) * 16384;
#pragma unroll
            for (int r = 0; r < 16; ++r) { const int v = 32 * vt + crow(r, hi);
                U[v * 128 + 32 * dt0 + r32] = f2bf(S0[r]); U[v * 128 + 32 * (dt0 + 1) + r32] = f2bf(S1[r]); }
            if (pti == 0 && hi == 0) DLG[(size_t)(scan * 3 + seg) * 128 + pd] = clsum;
        }
#undef ROWBASE
#undef SC_LOADQK
#undef SC_LOADV
#undef SC_STOREQK
    }
    __syncthreads();
}

constexpr int PH_PER_LAYER = 15, N_PHASES = 1 + 2 * PH_PER_LAYER;
#ifndef PHEN
#define PHEN(q) 1
#endif
#ifdef PROBE_GEMM
#define REPG for (int rep_ = 0; rep_ < 2; ++rep_)
#else
#define REPG
#endif
#ifdef PROBE_EW
#define REPE for (int rep_ = 0; rep_ < 2; ++rep_)
#else
#define REPE
#endif
#define PH(k) if (lo <= (k) && (k) < hi && ((k) == lo || (xcd_barrier(xbar), true)))
template <int l>
DI void layer_program(const Params& P, int lo, int hi, LAS unsigned char* lds, unsigned char* lds_raw, const XcdBarrier& xbar) {
    constexpr int base = 1 + PH_PER_LAYER * l;
    constexpr int Mlat = (l == 0) ? TA : TL;
#define WSP(T, off) ((T*)(P.ws + (off)))
#define MODL (WSP(const float, WS_MOD) + (size_t)l * 5 * 6144)
#define HIN_L ((l == 0) ? P.in[I_X] : (const float*)P.out)
#define HIN_C ((l == 0) ? P.in[I_CTX] : WSP(const float, WS_HC))
    PH(base + 0) if (PHEN(0)) REPE { if (blockIdx.x == 0 && threadIdx.x < 64) WSP(unsigned, WS_QKM)[threadIdx.x] = 0u;
        phase_norm(HIN_L, HIN_C, P.in[I_N1W] + l * DM, MODL, 0, 1, WSP(bf16_t, WS_A), TA); if (l > 0) phase_wconv_mixer(P, l, lds); }
    PH(base + 1) if (PHEN(1)) REPG { Epi<EM_PLAIN> E{}; E.O0 = WSP(bf16_t, WS_SM); E.ld0 = 512; run_gemm<EM_PLAIN>(lds, WSP(bf16_t, WS_A), 1024, WSP(bf16_t, WS_WT) + WT_IN, TA, 512, 1024, E); }
    PH(base + 2) if (PHEN(2)) REPG { { Epi<EM_PLAIN> E{}; E.O0 = WSP(bf16_t, WS_Q); E.ld0 = 768; run_gemm<EM_PLAIN>(lds, WSP(bf16_t, WS_SM), 512, WSP(bf16_t, WS_WT) + WT_QB, TA, 768, 256, E); }
                  { Epi<EM_KV> E2{}; E2.O0 = WSP(bf16_t, WS_K); E2.O1 = WSP(bf16_t, WS_V); run_gemm<EM_KV>(lds, WSP(bf16_t, WS_SM) + 256, 512, WSP(bf16_t, WS_WT) + WT_KVB, TA, 1024, 128, E2); } }
    PH(base + 3) if (PHEN(3)) {
#ifdef PROBE_EW
        phase_qkpost(P, l, (LAS unsigned*)lds, true);
#endif
        phase_qkpost(P, l, (LAS unsigned*)lds); }
    PH(base + 4) if (PHEN(4)) {
#ifdef PROBE_ATTN
        phase_attention(P, l, (char*)lds_raw, WSP(bf16_t, WS_OF), 1024);
#endif
        phase_attention(P, l, (char*)lds_raw, WSP(bf16_t, WS_Q), 768);
        { Epi<EM_BIG> E{}; E.O0 = WSP(bf16_t, WS_R4); E.fa = WSP(const float, WS_ROT); run_gemm<EM_BIG>(lds, WSP(bf16_t, WS_A), 1024, WSP(bf16_t, WS_WT) + WT_IN + (size_t)512 * 1024, TA, 3072, 1024, E); } }
    PH(base + 5) if (PHEN(6)) phase_scan(P, l, (char*)lds_raw, 1);
    PH(base + 6) if (PHEN(6)) phase_scan(P, l, (char*)lds_raw, 2);
    PH(base + 7) if (PHEN(7)) {
#ifdef PROBE_EW
        phase_scanpost(P, l, Mlat, true);
#endif
        phase_scanpost(P, l, Mlat); }
    PH(base + 8) if (PHEN(8)) { Epi<EM_GATES> E{}; E.O0 = WSP(bf16_t, WS_R4); E.O1 = WSP(bf16_t, WS_OF); E.fa = P.in[I_BGATE] + (size_t)l * 3072; run_gemm<EM_GATES>(lds, WSP(bf16_t, WS_A), 1024, WSP(bf16_t, WS_WT) + WT_IN + (size_t)3584 * 1024, Mlat, 4096, 1024, E); }
    PH(base + 9) if (PHEN(9)) REPG {
        { Epi<EM_BRANCH> E{}; E.O0 = WSP(bf16_t, WS_OB); E.Gsrc = WSP(bf16_t, WS_R4); E.ipar = 0; run_gemm<EM_BRANCH>(lds, WSP(bf16_t, WS_Q), 768, WSP(bf16_t, WS_WT) + WT_BR, Mlat, 1024, 512, E); }
        { Epi<EM_BRANCH> E{}; E.O0 = WSP(bf16_t, WS_OB); E.Gsrc = WSP(bf16_t, WS_R4) + 1024; E.ipar = 1; run_gemm<EM_BRANCH>(lds, WSP(bf16_t, WS_OF), 1024, WSP(bf16_t, WS_WT) + WT_BR + (size_t)1024 * 512, Mlat, 1024, 512, E); }
        { Epi<EM_BRANCH> E{}; E.O0 = WSP(bf16_t, WS_OB); E.Gsrc = WSP(bf16_t, WS_R4) + 2048; E.ipar = 2; run_gemm<EM_BRANCH>(lds, WSP(bf16_t, WS_OF) + 512, 1024, WSP(bf16_t, WS_WT) + WT_BR + (size_t)2048 * 512, Mlat, 1024, 512, E); } }
    PH(base + 10) if (PHEN(10)) { Epi<EM_RES> E{}; E.fa = MODL; E.ipar = 2; E.hin_l = HIN_L; E.hin_c = HIN_C; E.hout_l = P.out; E.hout_c = WSP(float, WS_HC);
                   run_gemm<EM_RES>(lds, WSP(bf16_t, WS_OB), 1024, WSP(bf16_t, WS_WT) + WT_OUT, Mlat, 1024, 1024, E); }
    PH(base + 11) if (PHEN(11)) REPE { phase_norm(P.out, WSP(const float, WS_HC), P.in[I_N2W] + l * DM, MODL, 3, 4, WSP(bf16_t, WS_A), Mlat); phase_wconv_ffn(P, l, lds); }
    PH(base + 12) if (PHEN(12)) { EpiFfnConv E{}; E.ACT = WSP(bf16_t, WS_G); E.HALO = WSP(float, WS_U); E.wdw = P.in[I_WDW] + (size_t)l * 3 * DFF; E.bdw = P.in[I_BDW] + (size_t)l * DFF; E.X = (LAS float*)(lds + 131072);
                   run_gemm_ffnconv(lds, WSP(bf16_t, WS_A), WSP(bf16_t, WS_WT) + WT_F1, Mlat, E); }
    PH(base + 13) if (PHEN(13)) REPE phase_convfix(P, l);
    PH(base + 14) if (PHEN(14)) { Epi<EM_RES> E{}; E.fa = MODL; E.ipar = 5; E.hin_l = P.out; E.hin_c = WSP(const float, WS_HC); E.hout_l = P.out; E.hout_c = WSP(float, WS_HC);
                   run_gemm<EM_RES>(lds, WSP(bf16_t, WS_G), DFF, WSP(bf16_t, WS_WT) + WT_F2, Mlat, 1024, DFF, E); }
}
__global__ void __launch_bounds__(NTHREADS, 2) fwd_kernel(Params P) {
    extern __shared__ __attribute__((aligned(16))) unsigned char lds_raw[];
    LAS unsigned char* lds = (LAS unsigned char*)lds_raw;
    cg::grid_group grid = cg::this_grid();
    const int lo = P.ph_lo, hi = P.ph_hi;
    Params* G = (Params*)(P.ws + WS_PAR + (size_t)blockIdx.x * 256);
    if (threadIdx.x == 0) {
#pragma unroll
        for (int i = 0; i < 26; ++i) G->in[i] = P.in[i];
        G->out = P.out; G->ws = P.ws; G->ph_lo = lo; G->ph_hi = hi;
    }
    __syncthreads();
    asm volatile("" ::: "memory");
    const Params& Q = *G;
    if (threadIdx.x < 4) ((LAS unsigned*)(lds + LDS_BARW))[threadIdx.x] = 0u;
    __syncthreads();
    const XcdBarrier xbar = xcd_barrier_post((unsigned*)(P.ws + WS_BAR), (volatile LAS unsigned*)(lds + LDS_BARW));
    if (lo < 0) grid.sync();
    PH(0) REPE { phase_prologue(Q, lds); __syncthreads(); phase_wconv_mixer(Q, 0, lds); __syncthreads(); }
    layer_program<0>(Q, lo, hi, lds, lds_raw, xbar);
    layer_program<1>(Q, lo, hi, lds, lds_raw, xbar);
#ifdef PROBE_SYNC
    for (int i = 0; i < 20; ++i) xcd_barrier(xbar);
#endif
}

#ifndef N_LAUNCH_MODE
#define N_LAUNCH_MODE 1
#endif
extern "C" void kernel_launch(void* const* d_in, const int* in_sizes, int n_in, void* d_out, int out_size, void* d_ws, size_t ws_size, hipStream_t stream) {
    static int grid_blocks = 0;
    if (!grid_blocks) {
        if (n_in != 26 || ws_size < WS_NEED) { fprintf(stderr, "kernel_launch: bad inputs (n_in %d, ws %zu < %zu)\n", n_in, ws_size, (size_t)WS_NEED); return; }
        if (hipFuncSetAttribute((const void*)fwd_kernel, hipFuncAttributeMaxDynamicSharedMemorySize, LDS_BYTES) != hipSuccess) { fprintf(stderr, "kernel_launch: hipFuncSetAttribute failed\n"); return; }
        int dev = 0, cus = 0, per_cu = 0;
        hipGetDevice(&dev);
        hipDeviceGetAttribute(&cus, hipDeviceAttributeMultiprocessorCount, dev);
        hipOccupancyMaxActiveBlocksPerMultiprocessor(&per_cu, fwd_kernel, NTHREADS, LDS_BYTES);
        if (per_cu < 1) { fprintf(stderr, "kernel_launch: occupancy query returned %d\n", per_cu); return; }
        grid_blocks = cus * 1;
    }
    Params p{};
    for (int i = 0; i < 26; ++i) p.in[i] = (const float*)d_in[i];
    p.out = (float*)d_out; p.ws = (unsigned char*)d_ws;
#if N_LAUNCH_MODE == 1
    p.ph_lo = 0; p.ph_hi = N_PHASES;
    if (hipMemsetAsync((unsigned char*)d_ws + WS_BAR, 0, XCD_BAR_WORDS * 4, stream) != hipSuccess) { fprintf(stderr, "kernel_launch: memset of the barrier words failed\n"); return; }
    void* args[] = {&p};
    hipError_t e = hipLaunchCooperativeKernel((const void*)fwd_kernel, dim3(grid_blocks), dim3(NTHREADS), args, LDS_BYTES, stream);
    if (e != hipSuccess) fprintf(stderr, "cooperative launch failed: %s (grid %d)\n", hipGetErrorString(e), grid_blocks);
#else
    for (int ph = 0; ph < N_PHASES; ++ph) {
        p.ph_lo = ph; p.ph_hi = ph + 1;
        hipLaunchKernelGGL(fwd_kernel, dim3(grid_blocks), dim3(NTHREADS), LDS_BYTES, stream, p);
    }
#endif
}
```

```cpp
#include <hip/hip_runtime.h>
#include <hip/hip_bf16.h>
#include <hip/hip_cooperative_groups.h>
#include <cstdio>
#include <cstdint>
namespace cg = cooperative_groups;
#define DI __device__ __forceinline__
#define LAS __attribute__((address_space(3)))
namespace pg8 {
#define PG8_LAS __attribute__((address_space(3)))
typedef unsigned short bf16_t;
typedef short bf16x8 __attribute__((ext_vector_type(8)));
typedef float f32x4 __attribute__((ext_vector_type(4)));
typedef unsigned u32x4 __attribute__((ext_vector_type(4)));
constexpr int BM = 256, BK = 64, HALF = 128, HTB = HALF * BK * 2  , STAGE_BYTES = 8 * HTB, NXCD = 8, WGM = 8;

__host__ __device__ __forceinline__ int lds_byte(int r, int c) { const int st = (r >> 4) * 2 + (c >> 5), rr = r & 15, cc = c & 31, ob = rr * 64 + cc * 2; return st * 1024 + (ob ^ (((ob >> 9) & 1) << 5)); }
__host__ __device__ __forceinline__ void stage_rc(int b, int& R, int& C) { const int st = b / 1024, sb = b % 1024, swz = sb ^ (((sb >> 9) & 1) << 5); R = (st >> 1) * 16 + swz / 64; C = (st & 1) * 32 + (swz % 64) / 2; }
__host__ __device__ __forceinline__ int perm32(int rho) { const int n = rho >> 4, i = rho & 15; return 8 * (i >> 2) + 4 * n + (i & 3); }

struct Unit { int pm, pn; };
struct Gemm { const bf16_t* A; const bf16_t* Bt; int M, N, K, lda; };

struct StaticOrder {
    int nM, nN, nwg, G, c;
    __host__ __device__ void init(int M, int N, int G_, int c_) { nM = M / BM; nN = N / BM; nwg = nM * nN; G = G_; c = c_; }
    __host__ __device__ bool next(int i, Unit& u) const {
        const long L = (long)i * G + c; if (L >= nwg) return false;
        int wgid = (int)L; { const int q = nwg / NXCD, r = nwg % NXCD, xcd = wgid % NXCD, off = wgid / NXCD; wgid = (xcd < r ? xcd * (q + 1) : r * (q + 1) + (xcd - r) * q) + off; }
        const int nig = WGM * nN, gid = wgid / nig, fm = gid * WGM, gsz = (nM - fm) < WGM ? (nM - fm) : WGM;
        u.pm = fm + ((wgid % nig) % gsz); u.pn = (wgid % nig) / gsz; return true;
    }
    __device__ __forceinline__ void a_ready(const Unit&) const {}
    __device__ __forceinline__ void done(const Unit&) const {}
};

__device__ __forceinline__ unsigned cvt_pk_bf16(float lo, float hi) { unsigned r; asm volatile("v_cvt_pk_bf16_f32 %0, %1, %2" : "=v"(r) : "v"(lo), "v"(hi)); return r; }
template <class Epi, class Sched, bool ALIGN_EPI = false, bool SP2 = false>
__device__ __forceinline__ void gemm_phase(PG8_LAS unsigned char* lds, const Gemm g, const Sched& S, const Epi& E) {
    const int tid = threadIdx.x, wid = __builtin_amdgcn_readfirstlane(tid >> 6), lane = tid & 63, wr = wid >> 2, wc = wid & 3, fr = lane & 15, fq = lane >> 4;
    const int K = g.K, nt = K / BK;
    unsigned voffA[2], voffB[2];
#pragma unroll
    for (int i = 0; i < 2; ++i) { int R, C; stage_rc(tid * 16 + i * 8192, R, C); const int Rb = Epi::PERM ? ((R & ~31) + perm32(R & 31)) : R;
        voffA[i] = (unsigned)(R * g.lda + C) * 2u; voffB[i] = (unsigned)(Rb * K + C) * 2u; }
    const size_t kstep = (size_t)(BK * 2);
    const size_t hstep = (size_t)HALF * K * 2;
    const size_t tstep = 2 * hstep; const size_t hstepA = (size_t)HALF * g.lda * 2; const size_t tstepA = 2 * hstepA;
    const unsigned ldsw = (unsigned)wid * 1024u;
    const int aoff = lds_byte(wr * 64 + fr, fq * 8), boff = lds_byte(wc * 32 + fr, fq * 8);
#define PG8_SA(b, h) (((b) * 2 + (h)) * HTB)
#define PG8_SB(b, h) ((4 + (b) * 2 + (h)) * HTB)
#define PG8_STAGE(bufoff, gbase, voff) do { _Pragma("unroll") for (int _i = 0; _i < 2; ++_i) \
        __builtin_amdgcn_global_load_lds((const unsigned*)((const char*)(gbase) + (voff)[_i]), (PG8_LAS unsigned*)(lds + (bufoff) + ldsw + _i * 8192), 16, 0, 0); } while (0)
#define PG8_LDA(dst, b, h) do { _Pragma("unroll") for (int m = 0; m < 4; ++m) _Pragma("unroll") for (int k = 0; k < 2; ++k) dst[m][k] = *(const PG8_LAS bf16x8*)(lds + PG8_SA(b, h) + aoff + m * 2048 + k * 1024); } while (0)
#define PG8_LDB(dst, b, h) do { _Pragma("unroll") for (int n = 0; n < 2; ++n) _Pragma("unroll") for (int k = 0; k < 2; ++k) dst[n][k] = *(const PG8_LAS bf16x8*)(lds + PG8_SB(b, h) + boff + n * 2048 + k * 1024); } while (0)
#define PG8_MMA(ai, bj, At, Bt) do { __builtin_amdgcn_s_setprio(1); _Pragma("unroll") for (int m = 0; m < 4; ++m) _Pragma("unroll") for (int n = 0; n < 2; ++n) _Pragma("unroll") for (int k = 0; k < 2; ++k) \
        acc[ai][bj][m][n] = __builtin_amdgcn_mfma_f32_16x16x32_bf16(Bt[n][k], At[m][k], acc[ai][bj][m][n], 0, 0, 0); __builtin_amdgcn_s_setprio(0); } while (0)
#define PG8_WAIT_V(n) asm volatile("s_waitcnt vmcnt(" #n ")" ::: "memory")
#define PG8_WAIT_L(n) asm volatile("s_waitcnt lgkmcnt(" #n ")" ::: "memory")
#define PG8_BAR __builtin_amdgcn_s_barrier()
#define PG8_SCHED __builtin_amdgcn_sched_barrier(0)
    Unit cur, nxt; int ui = 0;
    if (!S.next(0, cur)) return;
    f32x4 acc[2][2][4][2];
#pragma unroll
    for (int a = 0; a < 2; ++a)
#pragma unroll
        for (int b = 0; b < 2; ++b)
#pragma unroll
            for (int m = 0; m < 4; ++m)
#pragma unroll
                for (int n = 0; n < 2; ++n) acc[a][b][m][n] = (f32x4){0.f, 0.f, 0.f, 0.f};
    bf16x8 At[4][2], B0[2][2], B1[2][2];
    const char* cA = (const char*)g.A + (size_t)cur.pm * tstepA; const char* cB = (const char*)g.Bt + (size_t)cur.pn * tstep;
    S.a_ready(cur);
    if constexpr (SP2) {
        PG8_STAGE(PG8_SB(0, 0), cB, voffB); PG8_STAGE(PG8_SB(0, 1), cB + hstep, voffB); PG8_STAGE(PG8_SA(0, 0), cA, voffA); PG8_STAGE(PG8_SA(0, 1), cA + hstepA, voffA);
        if (wr == 1) PG8_BAR;
        PG8_WAIT_V(2); PG8_BAR;
        PG8_STAGE(PG8_SB(1, 0), cB + kstep, voffB); PG8_STAGE(PG8_SA(1, 0), cA + kstep, voffA); PG8_STAGE(PG8_SB(1, 1), cB + hstep + kstep, voffB);
        PG8_WAIT_V(6); PG8_BAR;
    } else {
        PG8_STAGE(PG8_SB(0, 0), cB, voffB); PG8_STAGE(PG8_SA(0, 0), cA, voffA); PG8_STAGE(PG8_SB(0, 1), cB + hstep, voffB); PG8_STAGE(PG8_SA(0, 1), cA + hstepA, voffA);
        if (wr == 1) PG8_BAR;
        PG8_WAIT_V(4); PG8_BAR;
        PG8_STAGE(PG8_SB(1, 0), cB + kstep, voffB); PG8_STAGE(PG8_SA(1, 0), cA + kstep, voffA); PG8_STAGE(PG8_SB(1, 1), cB + hstep + kstep, voffB);
        PG8_WAIT_V(6); PG8_BAR;
    }
    for (;;) {
        const bool has_next = S.next(ui + 1, nxt);
        const char* nA = has_next ? (const char*)g.A + (size_t)nxt.pm * tstepA : cA; const char* nB = has_next ? (const char*)g.Bt + (size_t)nxt.pn * tstep : cB;
        for (int t = 0; t < nt; t += 2) {
            const bool last = (t == nt - 2);
            const char* a1 = cA + (size_t)(t + 1) * kstep;
            const char* a2 = last ? nA : cA + (size_t)(t + 2) * kstep; const char* b2 = last ? nB : cB + (size_t)(t + 2) * kstep;
            const char* a3 = a2 + kstep; const char* b3 = b2 + kstep;
            if (last && has_next) S.a_ready(nxt);
            if constexpr (SP2) {
            PG8_LDB(B0, 0, 0); PG8_LDB(B1, 0, 1); PG8_SCHED; PG8_LDA(At, 0, 0); PG8_STAGE(PG8_SA(1, 1), a1 + hstepA, voffA);
            PG8_WAIT_V(8); PG8_WAIT_L(0); PG8_BAR; PG8_MMA(0, 0, At, B0); PG8_MMA(0, 1, At, B1); PG8_BAR; PG8_SCHED;
            PG8_LDA(At, 0, 1); PG8_STAGE(PG8_SB(0, 0), b2, voffB); PG8_STAGE(PG8_SB(0, 1), b2 + hstep, voffB); PG8_STAGE(PG8_SA(0, 0), a2, voffA);
            PG8_WAIT_V(8); PG8_WAIT_L(0); PG8_BAR; PG8_MMA(1, 0, At, B0); PG8_MMA(1, 1, At, B1); PG8_BAR; PG8_SCHED;
            PG8_LDB(B0, 1, 0); PG8_LDB(B1, 1, 1); PG8_SCHED; PG8_LDA(At, 1, 0); PG8_STAGE(PG8_SA(0, 1), a2 + hstepA, voffA);
            PG8_WAIT_V(8); PG8_WAIT_L(0); PG8_BAR; PG8_MMA(0, 0, At, B0); PG8_MMA(0, 1, At, B1); PG8_BAR; PG8_SCHED;
            PG8_LDA(At, 1, 1); PG8_STAGE(PG8_SB(1, 0), b3, voffB); PG8_STAGE(PG8_SB(1, 1), b3 + hstep, voffB); PG8_STAGE(PG8_SA(1, 0), a3, voffA);
            PG8_WAIT_V(8); PG8_WAIT_L(0); PG8_BAR; PG8_MMA(1, 0, At, B0); PG8_MMA(1, 1, At, B1); PG8_BAR; PG8_SCHED;
            } else {
            PG8_LDB(B0, 0, 0); PG8_SCHED; PG8_LDA(At, 0, 0); PG8_STAGE(PG8_SA(1, 1), a1 + hstepA, voffA);
            PG8_WAIT_L(8); PG8_BAR; PG8_WAIT_L(0); PG8_MMA(0, 0, At, B0); PG8_BAR; PG8_SCHED;
            PG8_LDB(B1, 0, 1); PG8_STAGE(PG8_SB(0, 0), b2, voffB);
            PG8_BAR; PG8_WAIT_L(0); PG8_MMA(0, 1, At, B1); PG8_BAR;
            PG8_LDA(At, 0, 1); PG8_STAGE(PG8_SA(0, 0), a2, voffA);
            PG8_BAR; PG8_WAIT_L(0); PG8_MMA(1, 0, At, B0); PG8_BAR; PG8_SCHED;
            PG8_STAGE(PG8_SB(0, 1), b2 + hstep, voffB);
            PG8_WAIT_V(6); PG8_BAR; PG8_MMA(1, 1, At, B1); PG8_BAR;
            PG8_LDB(B0, 1, 0); PG8_SCHED; PG8_LDA(At, 1, 0); PG8_STAGE(PG8_SA(0, 1), a2 + hstepA, voffA);
            PG8_WAIT_L(8); PG8_BAR; PG8_WAIT_L(0); PG8_MMA(0, 0, At, B0); PG8_BAR; PG8_SCHED;
            PG8_LDB(B1, 1, 1); PG8_STAGE(PG8_SB(1, 0), b3, voffB);
            PG8_BAR; PG8_WAIT_L(0); PG8_MMA(0, 1, At, B1); PG8_BAR;
            PG8_LDA(At, 1, 1); PG8_STAGE(PG8_SA(1, 0), a3, voffA);
            PG8_BAR; PG8_WAIT_L(0); PG8_MMA(1, 0, At, B0); PG8_BAR; PG8_SCHED;
            PG8_STAGE(PG8_SB(1, 1), b3 + hstep, voffB);
            PG8_WAIT_V(6); PG8_BAR; PG8_MMA(1, 1, At, B1); PG8_BAR;
            }
        }
        if constexpr (ALIGN_EPI) { if (wr == 0) PG8_BAR; }
        if constexpr (!Epi::AFTER_DRAIN) { E(acc, cur, wr, wc, fr, fq); S.done(cur); }
        if (!has_next) break;
#pragma unroll
        for (int a = 0; a < 2; ++a)
#pragma unroll
            for (int b = 0; b < 2; ++b)
#pragma unroll
                for (int m = 0; m < 4; ++m)
#pragma unroll
                    for (int n = 0; n < 2; ++n) acc[a][b][m][n] = (f32x4){0.f, 0.f, 0.f, 0.f};
        cur = nxt; cA = nA; cB = nB; ++ui;
        if constexpr (ALIGN_EPI) { if (wr == 1) PG8_BAR; }
    }
    PG8_WAIT_V(0);
    if constexpr (!ALIGN_EPI) { if (wr == 0) PG8_BAR; }
    PG8_BAR;
    if constexpr (Epi::AFTER_DRAIN) { E.fused(acc, cur, wr, wc, fr, fq, lds, wid, lane); S.done(cur); }
#undef PG8_SA
#undef PG8_SB
#undef PG8_STAGE
#undef PG8_LDA
#undef PG8_LDB
#undef PG8_MMA
#undef PG8_WAIT_V
#undef PG8_WAIT_L
#undef PG8_BAR
#undef PG8_SCHED
}
}

typedef unsigned short bf16_t;
typedef short bf16x8 __attribute__((ext_vector_type(8)));
typedef short s16x4 __attribute__((ext_vector_type(4)));
typedef float f32x4 __attribute__((ext_vector_type(4)));
typedef float f32x2 __attribute__((ext_vector_type(2)));
typedef float f32x16 __attribute__((ext_vector_type(16)));
typedef unsigned u32x4 __attribute__((ext_vector_type(4)));
typedef unsigned u32x2 __attribute__((ext_vector_type(2)));

constexpr int DM = 1024, NB = 4, SEQ = 8192, CTX = 256, TL = NB * SEQ, TC = NB * CTX, TA = TL + TC;
constexpr int DFF = 2816, NIN = 7616;
constexpr float EPS = 1e-6f;
constexpr int NTHREADS = 512, NWAVES = 8;

constexpr size_t al256(size_t x) { return (x + 255) / 256 * 256; }
constexpr size_t WS_MOD = 0;
constexpr size_t WS_PAR = al256(WS_MOD + (size_t)2 * 5 * 6144 * 4);
constexpr size_t WS_BAR = al256(WS_PAR + (size_t)1024 * 256);
constexpr size_t WS_QKM = al256(WS_BAR + (size_t)3456 * 4);
constexpr size_t WS_ROPE = al256(WS_QKM + 256);
constexpr size_t WS_ROT = al256(WS_ROPE + (size_t)192 * 8 * 8);
constexpr size_t WS_HC  = al256(WS_ROT + (size_t)8448 * 64 * 8);
constexpr size_t WS_WT  = al256(WS_HC + (size_t)TC * DM * 4);
constexpr size_t WT_IN = 0, WT_QB = WT_IN + (size_t)7680 * 1024, WT_KVB = WT_QB + (size_t)768 * 256, WT_BR = WT_KVB + (size_t)1024 * 128,
                 WT_OUT = WT_BR + (size_t)3 * 1024 * 512, WT_MIX_END = WT_OUT + (size_t)1024 * 1024;
constexpr size_t WT_F1 = 0, WT_F2 = (size_t)5632 * 1024, WT_FFN_END = WT_F2 + (size_t)1024 * 2816;
constexpr size_t WT_ELEMS = WT_MIX_END > WT_FFN_END ? WT_MIX_END : WT_FFN_END;
constexpr size_t WS_A   = al256(WS_WT + WT_ELEMS * 2);
constexpr size_t WS_SM  = al256(WS_A + (size_t)TA * 1024 * 2);
constexpr size_t WS_Q   = al256(WS_SM + (size_t)TA * 512 * 2);
constexpr size_t WS_R4  = al256(WS_Q + (size_t)TA * 768 * 2);
constexpr size_t WS_OF  = al256(WS_R4 + (size_t)TA * 3072 * 2);
constexpr size_t WS_OB  = al256(WS_OF + (size_t)TA * 1024 * 2);
constexpr size_t WS_END_MIX = al256(WS_OB + (size_t)TA * 1024 * 2);
constexpr size_t WS_K   = WS_OF;
constexpr size_t WS_V   = WS_OB;
constexpr size_t WS_G   = WS_SM;
constexpr size_t WS_U   = al256(WS_G + (size_t)TA * DFF * 2);
constexpr size_t WS_END_FFN = al256(WS_U + (size_t)132 * 6 * DFF * 4);
constexpr size_t WS_NEED = WS_END_MIX > WS_END_FFN ? WS_END_MIX : WS_END_FFN;
static_assert((size_t)TA * 768 * 2 <= (size_t)TA * 1024 * 2, "K/V overlay must fit in OF/OB");

constexpr int LDS_BYTES = 150 * 1024;
constexpr int LDS_BARW = LDS_BYTES - 16;

struct Params { const float* in[26]; float* out; unsigned char* ws; int ph_lo, ph_hi; };
enum { I_X = 0, I_C, I_CTX, I_CCTX, I_WADA, I_BADA, I_N1W, I_N2W, I_WIN, I_BGATE, I_QNA, I_WQB, I_KVNA, I_WKVB, I_QN, I_KN, I_GK2, I_BGK, I_GON, I_RDEC, I_WBR, I_WOUT, I_WF1, I_WDW, I_BDW, I_WF2 };

DI float bflo(unsigned w) { return __uint_as_float(w << 16); }
DI float bfhi(unsigned w) { return __uint_as_float(w & 0xffff0000u); }
DI float bf2f(bf16_t x) { return __uint_as_float((unsigned)x << 16); }
DI unsigned pk2(float lo, float hi) { unsigned r; asm volatile("v_cvt_pk_bf16_f32 %0, %1, %2" : "=v"(r) : "v"(lo), "v"(hi)); return r; }
DI bf16_t f2bf(float x) { return (bf16_t)(pk2(x, 0.f) & 0xffffu); }
DI float wave_sum(float v) {
#pragma unroll
    for (int o = 1; o < 64; o <<= 1) v += __shfl_xor(v, o);
    return v;
}
DI float sigmoidf_(float x) { return 1.f / (1.f + __expf(-x)); }
DI void unpack8(u32x4 w, float* f) { f[0] = bflo(w.x); f[1] = bfhi(w.x); f[2] = bflo(w.y); f[3] = bfhi(w.y); f[4] = bflo(w.z); f[5] = bfhi(w.z); f[6] = bflo(w.w); f[7] = bfhi(w.w); }
DI u32x4 pack8(const float* f) { u32x4 w; w.x = pk2(f[0], f[1]); w.y = pk2(f[2], f[3]); w.z = pk2(f[4], f[5]); w.w = pk2(f[6], f[7]); return w; }

DI void rowinfo(int m, int& b, int& pos, int& isctx) {
    if (m < TL) { b = m >> 13; pos = m & 8191; isctx = 0; } else { const int j = m - TL; b = j >> 8; pos = j & 255; isctx = 1; }
}

DI void phase_prologue(const Params& P, LAS unsigned char* lds) {
    const int tid = threadIdx.x, wave = tid >> 6, lane = tid & 63;
    LAS float* cond = (LAS float*)lds;
    LAS float* part = cond + 5 * 1024;
    const float* c = P.in[I_C]; const float* cc = P.in[I_CCTX];
    for (int i = tid; i < 5 * 1024; i += NTHREADS) { const int r = i >> 10, k = i & 1023; const float v = r < 4 ? c[r * 1024 + k] : cc[k]; cond[i] = v / (1.f + expf(-v)); }
    __syncthreads();
    float* MOD = (float*)(P.ws + WS_MOD);
    for (int item = blockIdx.x; item < 192; item += gridDim.x) {
        const int l = item / 96, j0 = (item % 96) * 64;
        const float* W = P.in[I_WADA] + (size_t)l * 1024 * 6144 + j0 + lane;
        float a0 = 0.f, a1 = 0.f, a2 = 0.f, a3 = 0.f, a4 = 0.f;
#pragma unroll 16
        for (int k = wave * 128; k < wave * 128 + 128; ++k) {
            const float w = W[(size_t)k * 6144];
            a0 += cond[k] * w; a1 += cond[1024 + k] * w; a2 += cond[2048 + k] * w; a3 += cond[3072 + k] * w; a4 += cond[4096 + k] * w;
        }
        part[(wave * 5 + 0) * 64 + lane] = a0; part[(wave * 5 + 1) * 64 + lane] = a1; part[(wave * 5 + 2) * 64 + lane] = a2;
        part[(wave * 5 + 3) * 64 + lane] = a3; part[(wave * 5 + 4) * 64 + lane] = a4;
        __syncthreads();
        if (tid < 320) { const int r = tid >> 6; float s = 0.f;
            for (int w = 0; w < 8; ++w) s += part[(w * 5 + r) * 64 + lane];
            MOD[(size_t)(l * 5 + r) * 6144 + j0 + lane] = s + P.in[I_BADA][l * 6144 + j0 + lane]; }
        __syncthreads();
    }
    { f32x2* ROPE = (f32x2*)(P.ws + WS_ROPE);
      for (int i = blockIdx.x * NTHREADS + tid; i < 192 * 8; i += gridDim.x * NTHREADS) { const int p = i >> 3, f = i & 7; const float pos = (float)(p < 128 ? p : p - 128);
          const float inv = powf(10000.0f, -(float)f * 0.125f); float s, co; sincosf(pos * inv, &s, &co); ROPE[i] = (f32x2){co, s}; } }
    f32x2* ROT = (f32x2*)(P.ws + WS_ROT);
    for (int i = blockIdx.x * NTHREADS + tid; i < 8448 * 64; i += gridDim.x * NTHREADS) {
        const int pos = i >> 6, j = i & 63;
        const float inv = 1.0f / powf(10000.0f, (float)j / 63.0f);
        const float ang = (float)pos * inv; float s, co; sincosf(ang, &s, &co);
        ROT[i] = (f32x2){co, s};
    }
}

DI int wmap(int id, int n) {
    switch (id) {
    case 1: if (n < 416) return n; if (n < 448) return 2464 + (n - 416); return -1;
    case 2: { if (n < 1536) return 416 + n;
              if (n < 2560) { const int base = n < 2048 ? 2496 : 3008; const int j = (n - 1536) & 511; const int hh = j >> 7, v = j & 127, g = v >> 3, e = v & 7;
                              const int d = e < 4 ? 4 * g + e : 64 + 4 * g + (e - 4); return base + hh * 128 + d; }
              return 3520 + (n - 2560); }
    case 3: if (n < 512) return 1952 + n; if (n < 1024) return 4032 + (n - 512); return 4544 + (n - 1024);
    case 4: if (n < 512) return (n >> 6) * 96 + (n & 63); { const int j = n - 512; return (j >> 5) * 96 + 64 + (j & 31); }
    case 5: if (n < 512) return (n >> 6) * 128 + (n & 63); { const int j = n - 512; return (j >> 6) * 128 + 64 + (j & 63); }
    case 6: { const int pn = n >> 8, bj = (n >> 7) & 1, j = n & 127; return bj * 2816 + 128 * pn + j; }
    default: return n;
    }
}
struct TJob { const float* W; int K, Nsrc; bf16_t* WT; int ndst, map_id; const float* kscale; };
DI void transpose_job(const TJob& J, LAS float* scr, int gw, int ngw, int lane) {
    const int nblk = J.ndst / 32, nitems = (J.K / 64) * nblk;
    for (int item = gw; item < nitems; item += ngw) {
        const int kb = item / nblk, nb = item % nblk, k0 = 64 * kb, n0 = 32 * nb;
        const int src = wmap(J.map_id, n0 + (lane & 31));
        float tv[32];
#pragma unroll
        for (int i = 0; i < 32; ++i) { const int kk = 2 * i + (lane >> 5); tv[i] = src >= 0 ? J.W[(size_t)(k0 + kk) * J.Nsrc + src] : 0.f; }
        if (J.kscale) {
#pragma unroll
            for (int i = 0; i < 32; ++i) tv[i] *= J.kscale[k0 + 2 * i + (lane >> 5)]; }
#pragma unroll
        for (int i = 0; i < 32; ++i) scr[(2 * i + (lane >> 5)) * 33 + (lane & 31)] = tv[i];
        asm volatile("s_waitcnt lgkmcnt(0)" ::: "memory");
        const int c = lane & 7;
#pragma unroll
        for (int j = 0; j < 4; ++j) { const int n = (lane >> 3) + 8 * j; const LAS float* s = scr + (8 * c) * 33 + n;
            u32x4 o; o.x = pk2(s[0 * 33], s[1 * 33]); o.y = pk2(s[2 * 33], s[3 * 33]); o.z = pk2(s[4 * 33], s[5 * 33]); o.w = pk2(s[6 * 33], s[7 * 33]);
            *(u32x4*)(J.WT + (size_t)(n0 + n) * J.K + k0 + 8 * c) = o; }
        asm volatile("s_waitcnt lgkmcnt(0)" ::: "memory");
    }
}
DI void phase_wconv_mixer(const Params& P, int l, LAS unsigned char* lds) {
    const int tid = threadIdx.x, wave = tid >> 6, lane = tid & 63, gw = blockIdx.x * NWAVES + wave, ngw = gridDim.x * NWAVES;
    LAS float* scr = (LAS float*)lds + wave * (64 * 33);
    bf16_t* WT = (bf16_t*)(P.ws + WS_WT);
    const float* win = P.in[I_WIN] + (size_t)l * 1024 * NIN;
    TJob j;
    j = TJob{win, 1024, NIN, WT + WT_IN, 512, 1, nullptr}; transpose_job(j, scr, gw, ngw, lane);
    j = TJob{win, 1024, NIN, WT + WT_IN + (size_t)512 * 1024, 3072, 2, nullptr}; transpose_job(j, scr, gw, ngw, lane);
    j = TJob{win, 1024, NIN, WT + WT_IN + (size_t)3584 * 1024, 4096, 3, nullptr}; transpose_job(j, scr, gw, ngw, lane);
    j = TJob{P.in[I_WQB] + (size_t)l * 256 * 768, 256, 768, WT + WT_QB, 768, 4, P.in[I_QNA] + l * 256}; transpose_job(j, scr, gw, ngw, lane);
    j = TJob{P.in[I_WKVB] + (size_t)l * 128 * 1024, 128, 1024, WT + WT_KVB, 1024, 5, P.in[I_KVNA] + l * 128}; transpose_job(j, scr, gw, ngw, lane);
    for (int n = 0; n < 3; ++n) { j = TJob{P.in[I_WBR] + ((size_t)l * 3 + n) * 512 * 1024, 512, 1024, WT + WT_BR + (size_t)n * 1024 * 512, 1024, 0, nullptr}; transpose_job(j, scr, gw, ngw, lane); }
    j = TJob{P.in[I_WOUT] + (size_t)l * 1024 * 1024, 1024, 1024, WT + WT_OUT, 1024, 0, nullptr}; transpose_job(j, scr, gw, ngw, lane);
}
DI void phase_wconv_ffn(const Params& P, int l, LAS unsigned char* lds) {
    const int tid = threadIdx.x, wave = tid >> 6, lane = tid & 63, gw = blockIdx.x * NWAVES + wave, ngw = gridDim.x * NWAVES;
    LAS float* scr = (LAS float*)lds + wave * (64 * 33);
    bf16_t* WT = (bf16_t*)(P.ws + WS_WT);
    TJob j;
    j = TJob{P.in[I_WF1] + (size_t)l * 1024 * 5632, 1024, 5632, WT + WT_F1, 5632, 6, nullptr}; transpose_job(j, scr, gw, ngw, lane);
    j = TJob{P.in[I_WF2] + (size_t)l * 2816 * 1024, 2816, 1024, WT + WT_F2, 1024, 0, nullptr}; transpose_job(j, scr, gw, ngw, lane);
}

DI void phase_norm(const float* __restrict__ hl, const float* __restrict__ hc, const float* __restrict__ nw, const float* __restrict__ MODl, int ishift, int iscale, bf16_t* __restrict__ A, int nrows) {
    const int tid = threadIdx.x, wave = tid >> 6, lane = tid & 63, gw = blockIdx.x * NWAVES + wave, ngw = gridDim.x * NWAVES;
    f32x4 nx[4];
#define NLOAD(dst, m_) do { const float* xr_ = (m_) >= TL ? hc + (size_t)((m_) - TL) * DM : hl + (size_t)(m_) * DM; \
        _Pragma("unroll") for (int j = 0; j < 4; ++j) dst[j] = *(const f32x4*)(xr_ + 4 * lane + 256 * j); } while (0)
    if (gw < nrows) NLOAD(nx, gw);
    for (int m = gw; m < nrows; m += ngw) {
        f32x4 v[4];
#pragma unroll
        for (int j = 0; j < 4; ++j) v[j] = nx[j];
        if (m + ngw < nrows) NLOAD(nx, m + ngw);
        int b, pos, isctx; rowinfo(m, b, pos, isctx);
        const float* mod = MODl + (size_t)(isctx ? 4 : b) * 6144;
        float ss = 0.f;
#pragma unroll
        for (int j = 0; j < 4; ++j) ss += (v[j].x * v[j].x + v[j].y * v[j].y) + (v[j].z * v[j].z + v[j].w * v[j].w);
        const float rstd = rsqrtf(wave_sum(ss) * (1.f / DM) + EPS);
#pragma unroll
        for (int j = 0; j < 4; ++j) { const int c = 4 * lane + 256 * j;
            const f32x4 w = *(const f32x4*)(nw + c), sh = *(const f32x4*)(mod + ishift * 1024 + c), sc = *(const f32x4*)(mod + iscale * 1024 + c);
            const f32x4 y = v[j] * rstd * w * (sc + 1.f) + sh;
            u32x2 o; o.x = pk2(y.x, y.y); o.y = pk2(y.z, y.w);
            *(u32x2*)(A + (size_t)m * DM + c) = o; }
    }
#undef NLOAD
}
#include <cstdlib>
#include <vector>

#define XB_TMO      128
#define XB_XCNT(j)  (256  + 64 * (j))
#define XB_XSUB(j)  (1280 + 64 * (j))
#define XB_XGEN(j)  (2304 + 64 * (j))
#define XB_TOP      3328
#define XB_TOPGEN   3392
#define XCD_BAR_WORDS 3456
#define XB_SPIN_CAP (1u << 18)

__device__ __forceinline__ unsigned xb_ld(unsigned* p)              { return __hip_atomic_load(p, __ATOMIC_RELAXED, __HIP_MEMORY_SCOPE_AGENT); }
__device__ __forceinline__ unsigned xb_add(unsigned* p, unsigned v) { return __hip_atomic_fetch_add(p, v, __ATOMIC_RELAXED, __HIP_MEMORY_SCOPE_AGENT); }
__device__ __forceinline__ unsigned xb_xcc_id() { return (unsigned)__builtin_amdgcn_s_getreg((3 << 11) | 20) & 0xFu; }
#define XB_SPIN(cond, bar) do { unsigned _sp = 0; while (cond) { __builtin_amdgcn_s_sleep(1); \
    if ((++_sp & 255u) == 0u) { if (xb_ld(&(bar)[XB_TMO])) break; if (_sp > XB_SPIN_CAP) { atomicAdd(&(bar)[XB_TMO], 1u); break; } } } } while (0)

struct XcdBarrier {
    unsigned* bar; unsigned x;
    volatile LAS unsigned* st;
};

__device__ __forceinline__ XcdBarrier xcd_barrier_post(unsigned* bar, volatile LAS unsigned* st) {
    XcdBarrier b; b.bar = bar; b.x = xb_xcc_id(); b.st = st;
    if (threadIdx.x == 0) (void)xb_add(&bar[XB_XCNT(b.x)], 1u);
    return b;
}
__device__ __forceinline__ void xcd_barrier_complete(unsigned* bar, unsigned x, unsigned& nloc, unsigned& nx) {
    const unsigned G = gridDim.x * gridDim.y * gridDim.z;
    unsigned sum, cnt, mine, sp = 0u;
    for (;;) {
        sum = 0u; cnt = 0u; mine = 0u;
#pragma unroll
        for (unsigned j = 0; j < 16; ++j) { const unsigned c = xb_ld(&bar[XB_XCNT(j)]); sum += c; cnt += (c > 0u) ? 1u : 0u; mine = (j == x) ? c : mine; }
        if (sum == G) break;
        __builtin_amdgcn_s_sleep(1);
        if ((++sp & 255u) == 0u) { if (xb_ld(&bar[XB_TMO])) break; if (sp > XB_SPIN_CAP) { atomicAdd(&bar[XB_TMO], 1u); break; } }
    }
    nloc = mine > 0u ? mine : 1u; nx = cnt > 0u ? cnt : 1u;
}

__device__ __forceinline__ void xcd_barrier(const XcdBarrier& b) {
    asm volatile("s_waitcnt vmcnt(0)" ::: "memory");
    __syncthreads();
    if (threadIdx.x == 0) {
        unsigned* bar = b.bar;
        __builtin_amdgcn_s_waitcnt(0);
        unsigned nloc = b.st[0], nx = b.st[1];
        if (nloc == 0u) { xcd_barrier_complete(bar, b.x, nloc, nx); b.st[0] = nloc; b.st[1] = nx; }
        const unsigned old = xb_add(&bar[XB_XSUB(b.x)], 1u);
        const unsigned gen = old / nloc;
        if (old + 1u == (gen + 1u) * nloc) {
            __builtin_amdgcn_fence(__ATOMIC_RELEASE, "agent");
            asm volatile("s_waitcnt vmcnt(0)" ::: "memory");
            const unsigned og = xb_add(&bar[XB_TOP], 1u);
            const unsigned tg = og / nx;
            if (og + 1u == (tg + 1u) * nx) xb_add(&bar[XB_TOPGEN], 1u);
            else XB_SPIN(xb_ld(&bar[XB_TOPGEN]) == tg, bar);
            __builtin_amdgcn_fence(__ATOMIC_ACQUIRE, "agent");
            xb_add(&bar[XB_XGEN(b.x)], 1u);
            asm volatile("s_waitcnt vmcnt(0)" ::: "memory");
        } else {
            XB_SPIN(xb_ld(&bar[XB_XGEN(b.x)]) == gen, bar);
            __builtin_amdgcn_fence(__ATOMIC_ACQUIRE, "agent");
            asm volatile("s_waitcnt vmcnt(0)" ::: "memory");
        }
    }
    __syncthreads();
}

enum { EM_PLAIN = 0, EM_KV, EM_BIG, EM_GATES, EM_BRANCH, EM_RES, EM_FFNIN, EM_INPROJ };
template <int MODE> struct Epi {
    static constexpr bool PERM = true, AFTER_DRAIN = false;
    bf16_t* O0; int ld0; bf16_t* O1; int ld1;
    const bf16_t* Gsrc;
    const float* fa;
    const float* hin_l; const float* hin_c; float* hout_l; float* hout_c;
    int ipar;
    DI void emit(int row, int col, f32x4 v0, f32x4 v1) const {
        float f[8] = {v0[0], v0[1], v0[2], v0[3], v1[0], v1[1], v1[2], v1[3]};
        if (MODE == EM_INPROJ) {
            if (col < 512) { *(u32x4*)(O1 + (size_t)row * 512 + col) = pack8(f); return; }
            col -= 512;
        }
        if (MODE == EM_PLAIN) {
            *(u32x4*)(O0 + (size_t)row * ld0 + col) = pack8(f);
        } else if (MODE == EM_KV) {
            if (col < 512) *(u32x4*)(O0 + (size_t)row * 768 + col) = pack8(f);
            else           *(u32x4*)(O1 + (size_t)row * 512 + (col - 512)) = pack8(f);
        } else if (MODE == EM_FFNIN) {
            if (col < DFF) *(u32x4*)(O0 + (size_t)row * DFF + col) = pack8(f);
            else           *(u32x4*)(O1 + (size_t)row * DFF + (col - DFF)) = pack8(f);
        } else if (MODE == EM_BIG || MODE == EM_INPROJ) {
            const float QS = 0.08838834764831845f;
            if (col < 512) { for (int i = 0; i < 8; ++i) f[i] *= QS; }
            else if (col >= 1536 && col < 2560) {
                int b, pos, isctx; rowinfo(row, b, pos, isctx);
                const int sp = isctx ? pos : CTX + pos;
                const int g = ((col - 1536) & 127) >> 3;
                const f32x2* rot = (const f32x2*)fa + (size_t)sp * 64 + 4 * g;
                const float sc = col >= 2048 ? QS : 1.f;
#pragma unroll
                for (int e = 0; e < 4; ++e) { const f32x2 cs = rot[e]; const float x1 = f[e], x2 = f[4 + e];
                    f[e] = (x1 * cs.x - x2 * cs.y) * sc; f[4 + e] = (x1 * cs.y + x2 * cs.x) * sc; }
            }
            *(u32x4*)(O0 + (size_t)row * 3072 + col) = pack8(f);
        } else if (MODE == EM_GATES) {
            if (col < 1024) {
                bf16_t* p = O1 + (size_t)row * 1024 + col; float on[8]; unpack8(*(const u32x4*)p, on);
#pragma unroll
                for (int i = 0; i < 8; ++i) f[i] = on[i] * f[i] * sigmoidf_(f[i]);
                *(u32x4*)p = pack8(f);
            } else {
                const int cc = col - 1024; const f32x4 b0 = *(const f32x4*)(fa + cc), b1 = *(const f32x4*)(fa + cc + 4);
                const float bb[8] = {b0[0], b0[1], b0[2], b0[3], b1[0], b1[1], b1[2], b1[3]};
#pragma unroll
                for (int i = 0; i < 8; ++i) f[i] = sigmoidf_(f[i] + bb[i]);
                *(u32x4*)(O0 + (size_t)row * 3072 + cc) = pack8(f);
            }
        } else if (MODE == EM_BRANCH) {
            float g[8]; unpack8(*(const u32x4*)(Gsrc + (size_t)row * 3072 + col), g);
            bf16_t* p = O0 + (size_t)row * 1024 + col;
            if (ipar > 0) { float pr[8]; unpack8(*(const u32x4*)p, pr);
#pragma unroll
                for (int i = 0; i < 8; ++i) f[i] = pr[i] + g[i] * f[i]; }
            else {
#pragma unroll
                for (int i = 0; i < 8; ++i) f[i] = g[i] * f[i]; }
            *(u32x4*)p = pack8(f);
        } else if (MODE == EM_RES) {
            int b, pos, isctx; rowinfo(row, b, pos, isctx);
            const float* hi_ = isctx ? hin_c + (size_t)(row - TL) * DM : hin_l + (size_t)row * DM;
            float* ho_ = isctx ? hout_c + (size_t)(row - TL) * DM : hout_l + (size_t)row * DM;
            const float* mod = fa + (size_t)(isctx ? 4 : b) * 6144 + ipar * 1024 + col;
            const f32x4 m0 = *(const f32x4*)mod, m1 = *(const f32x4*)(mod + 4);
            const f32x4 h0 = *(const f32x4*)(hi_ + col), h1 = *(const f32x4*)(hi_ + col + 4);
            *(f32x4*)(ho_ + col) = h0 + m0 * v0; *(f32x4*)(ho_ + col + 4) = h1 + m1 * v1;
        }
    }
    DI void operator()(const pg8::f32x4 (&acc)[2][2][4][2], const pg8::Unit& u, int wr, int wc, int fr, int fq) const {
#pragma unroll
        for (int ai = 0; ai < 2; ++ai)
#pragma unroll
            for (int m = 0; m < 4; ++m) { const int row = u.pm * 256 + ai * 128 + wr * 64 + m * 16 + fr;
#pragma unroll
                for (int bj = 0; bj < 2; ++bj) { const int col = u.pn * 256 + bj * 128 + wc * 32 + 8 * fq;
                    emit(row, col, acc[ai][bj][m][0], acc[ai][bj][m][1]); } }
    }
};

DI float dpp_ror1(float x) { return __int_as_float(__builtin_amdgcn_update_dpp(0, __float_as_int(x), 0x121, 0xf, 0xf, false)); }
DI float dpp_ror15(float x) { return __int_as_float(__builtin_amdgcn_update_dpp(0, __float_as_int(x), 0x12F, 0xf, 0xf, false)); }
DI float gelu_gate(float x, float u) { const float t2 = 1.5957691216057308f * (x + 0.044715f * x * x * x); return x / (1.f + __expf(-t2)) * u; }
struct EpiFfnConv {
    static constexpr bool PERM = true, AFTER_DRAIN = false;
    bf16_t* ACT; float* HALO; const float* wdw; const float* bdw; LAS float* X;
    DI void operator()(const pg8::f32x4 (&acc)[2][2][4][2], const pg8::Unit& u, int wr, int wc, int fr, int fq) const {
        const int ch = 128 * u.pn + 32 * wc + 8 * fq, xc = 32 * wc + 8 * fq;
        float w0[8], w1[8], w2[8], bb[8];
#pragma unroll
        for (int k = 0; k < 8; ++k) { w0[k] = wdw[ch + k]; w1[k] = wdw[DFF + ch + k]; w2[k] = wdw[2 * DFF + ch + k]; bb[k] = bdw[ch + k]; }
#pragma unroll
        for (int ai = 0; ai < 2; ++ai) {
            if (fr == 0) {
#pragma unroll
                for (int k = 0; k < 8; ++k) X[((ai * 2 + wr) * 2 + 0) * 128 + xc + k] = acc[ai][0][0][k >> 2][k & 3]; }
            if (fr == 15) {
#pragma unroll
                for (int k = 0; k < 8; ++k) X[((ai * 2 + wr) * 2 + 1) * 128 + xc + k] = acc[ai][0][3][k >> 2][k & 3]; }
        }
        asm volatile("s_waitcnt lgkmcnt(0)" ::: "memory"); __builtin_amdgcn_s_barrier(); asm volatile("" ::: "memory");
        const bool first_tile_row_is_seq_start = (u.pm >= TL / 256) || ((u.pm & 31) == 0);
        const bool last_tile_row_is_seq_end = (u.pm >= TL / 256) || ((u.pm & 31) == 31);
#pragma unroll
        for (int ai = 0; ai < 2; ++ai) {
            float top[8], bot[8];
            { const int tsel = wr == 1 ? ((ai * 2 + 0) * 2 + 1) : ((0 * 2 + 1) * 2 + 1);
              const bool tval = (wr == 1) || (ai == 1);
              const int bsel = wr == 0 ? ((ai * 2 + 1) * 2 + 0) : ((1 * 2 + 0) * 2 + 0);
              const bool bval = (wr == 0) || (ai == 0);
#pragma unroll
              for (int k = 0; k < 8; ++k) { top[k] = tval ? X[tsel * 128 + xc + k] : 0.f; bot[k] = bval ? X[bsel * 128 + xc + k] : 0.f; } }
#pragma unroll
            for (int m = 0; m < 4; ++m) {
                const int row = u.pm * 256 + ai * 128 + wr * 64 + m * 16 + fr;
                float o[8], xs[8];
#pragma unroll
                for (int k = 0; k < 8; ++k) {
                    const float g = acc[ai][0][m][k >> 2][k & 3], up = acc[ai][1][m][k >> 2][k & 3];
                    const float pa = dpp_ror1(g);
                    const float pb = m > 0 ? dpp_ror1(acc[ai][0][m > 0 ? m - 1 : 0][k >> 2][k & 3]) : top[k];
                    const float na = dpp_ror15(g);
                    const float nb = m < 3 ? dpp_ror15(acc[ai][0][m < 3 ? m + 1 : 3][k >> 2][k & 3]) : bot[k];
                    const float gp = fr > 0 ? pa : pb, gn = fr < 15 ? na : nb;
                    const float x = w0[k] * gp + w1[k] * g + w2[k] * gn + bb[k];
                    xs[k] = x; o[k] = gelu_gate(x, up);
                }
                *(u32x4*)(ACT + (size_t)row * DFF + ch) = pack8(o);
                if (ai == 0 && m == 0 && wr == 0 && fr == 0 && !first_tile_row_is_seq_start) { float* h = HALO + ((size_t)u.pm * 6 + 0) * DFF + ch;
#pragma unroll
                    for (int k = 0; k < 8; ++k) { h[k] = acc[0][0][0][k >> 2][k & 3]; h[DFF + k] = xs[k]; h[2 * DFF + k] = acc[0][1][0][k >> 2][k & 3]; } }
                if (ai == 1 && m == 3 && wr == 1 && fr == 15 && !last_tile_row_is_seq_end) { float* h = HALO + ((size_t)u.pm * 6 + 3) * DFF + ch;
#pragma unroll
                    for (int k = 0; k < 8; ++k) { h[k] = acc[1][0][3][k >> 2][k & 3]; h[DFF + k] = xs[k]; h[2 * DFF + k] = acc[1][1][3][k >> 2][k & 3]; } }
            }
        }
    }
};
DI void phase_convfix(const Params& P, int l) {
    bf16_t* ACT = (bf16_t*)(P.ws + WS_G); const float* HALO = (const float*)(P.ws + WS_U);
    const float* wdw = P.in[I_WDW] + (size_t)l * 3 * DFF; const float* bdw = P.in[I_BDW] + (size_t)l * DFF; (void)bdw;
    const int total = 127 * DFF;
    for (int i = blockIdx.x * NTHREADS + threadIdx.x; i < total; i += gridDim.x * NTHREADS) {
        const int pm = i / DFF, c = i - pm * DFF;
        if ((pm & 31) == 31) continue;
        const float* hl = HALO + ((size_t)pm * 6 + 3) * DFF + c; const float* hf = HALO + ((size_t)(pm + 1) * 6 + 0) * DFF + c;
        const float g_last = hl[0], x_last = hl[DFF], u_last = hl[2 * DFF], g_first = hf[0], x_first = hf[DFF], u_first = hf[2 * DFF];
        ACT[(size_t)(pm * 256 + 255) * DFF + c] = f2bf(gelu_gate(x_last + wdw[2 * DFF + c] * g_first, u_last));
        ACT[(size_t)(pm * 256 + 256) * DFF + c] = f2bf(gelu_gate(x_first + wdw[c] * g_last, u_first));
    }
}
template <int MODE>
DI void run_gemm(LAS unsigned char* lds, const bf16_t* A, int lda, const bf16_t* Bt, int M, int N, int K, const Epi<MODE>& E) {
    int Kop = K; if (K < 512) asm volatile("" : "+s"(Kop));
    pg8::Gemm g{A, Bt, M, N, Kop, lda}; pg8::StaticOrder S; S.init(M, N, (int)gridDim.x, (int)blockIdx.x);
    pg8::gemm_phase<Epi<MODE>, pg8::StaticOrder, true, true>((PG8_LAS unsigned char*)lds, g, S, E);
}
DI void run_gemm_ffnconv(LAS unsigned char* lds, const bf16_t* A, const bf16_t* Bt, int M, const EpiFfnConv& E) {
    pg8::Gemm g{A, Bt, M, 5632, 1024, 1024}; pg8::StaticOrder S; S.init(M, 5632, (int)gridDim.x, (int)blockIdx.x);
    pg8::gemm_phase<EpiFfnConv, pg8::StaticOrder, true, true>((PG8_LAS unsigned char*)lds, g, S, E);
}

DI void phase_qkpost(const Params& P, int l, LAS unsigned* lmax, const bool probe = false) {
    const int tid = threadIdx.x, wave = tid >> 6, lane = tid & 63, gw = blockIdx.x * NWAVES + wave, ngw = gridDim.x * NWAVES;
    const bf16_t* __restrict__ SM = (const bf16_t*)(P.ws + WS_SM); bf16_t* __restrict__ Q = (bf16_t*)(P.ws + WS_Q); bf16_t* __restrict__ K = (bf16_t*)(P.ws + WS_K); bf16_t* __restrict__ V = (bf16_t*)(P.ws + WS_V);
    const f32x2* __restrict__ ROPE = (const f32x2*)(P.ws + WS_ROPE);
    const float* qn = P.in[I_QN] + l * 96; const float* kn = P.in[I_KN] + l * 96;
    const int s = lane & 7, h = lane >> 3;
    float qnw[12], knw[12];
#pragma unroll
    for (int i = 0; i < 8; ++i) { qnw[i] = qn[8 * s + i]; knw[i] = kn[8 * s + i]; }
#pragma unroll
    for (int i = 0; i < 4; ++i) { qnw[8 + i] = qn[64 + 4 * s + i]; knw[8 + i] = kn[64 + 4 * s + i]; }
    const bool second = (s & 2) != 0;
    constexpr float QC = 0.10206207261596575f * 1.4426950408889634f;
    if (tid < 64) lmax[tid] = 0u;
    __syncthreads();
    u32x2 n_cq, n_kr, n_qr; unsigned n_ckv; u32x4 n_qn, n_kn, n_v;
#define QLOAD(m_) do { const bf16_t* sm_ = SM + (size_t)(m_) * 512; n_cq = *(const u32x2*)(sm_ + 4 * lane); n_ckv = *(const unsigned*)(sm_ + 256 + 2 * lane); n_kr = *(const u32x2*)(sm_ + 384 + 4 * s); \
        n_qn = *(const u32x4*)(Q + (size_t)(m_) * 768 + 64 * h + 8 * s); n_qr = *(const u32x2*)(Q + (size_t)(m_) * 768 + 512 + 32 * h + 4 * s); \
        n_kn = *(const u32x4*)(K + (size_t)(m_) * 768 + 64 * h + 8 * s); n_v = *(const u32x4*)(V + (size_t)(m_) * 512 + 8 * lane); } while (0)
    if (gw < TA) QLOAD(gw);
    for (int m = gw; m < TA; m += ngw) {
        const u32x2 cq = n_cq, krr = n_kr, qrr = n_qr; const unsigned ckv = n_ckv; const u32x4 qnn = n_qn, knn = n_kn, vraw = n_v;
        if (m + ngw < TA) QLOAD(m + ngw);
        int b, pos, isctx; rowinfo(m, b, pos, isctx);
        float a0 = bflo(cq.x), a1 = bfhi(cq.x), a2 = bflo(cq.y), a3 = bfhi(cq.y), c0 = bflo(ckv), c1 = bfhi(ckv);
        const float s_q = rsqrtf(wave_sum(a0 * a0 + a1 * a1 + a2 * a2 + a3 * a3) * (1.f / 256.f) + EPS);
        const float s_kv = rsqrtf(wave_sum(c0 * c0 + c1 * c1) * (1.f / 128.f) + EPS);
        float cs[4], sn[4];
        if (!isctx) { const f32x2* rp = ROPE + ((s < 4) ? (pos >> 6) : 128 + (pos & 63)) * 8 + 4 * (s & 1);
#pragma unroll
            for (int e = 0; e < 4; ++e) { const f32x2 t = rp[e]; cs[e] = t.x; sn[e] = t.y; } }
        else {
#pragma unroll
            for (int e = 0; e < 4; ++e) { cs[e] = 1.f; sn[e] = 0.f; } }
        {
            bf16_t* qp = (probe ? (bf16_t*)(P.ws + WS_R4) : Q) + (size_t)m * 768;
            float z[12]; unpack8(qnn, z);
            z[8] = bflo(qrr.x); z[9] = bfhi(qrr.x); z[10] = bflo(qrr.y); z[11] = bfhi(qrr.y);
            float ss = 0.f;
#pragma unroll
            for (int i = 0; i < 12; ++i) { z[i] *= s_q; ss += z[i] * z[i]; }
            ss += __shfl_xor(ss, 1); ss += __shfl_xor(ss, 2); ss += __shfl_xor(ss, 4);
            const float r = rsqrtf(ss * (1.f / 96.f) + EPS);
#pragma unroll
            for (int i = 0; i < 12; ++i) z[i] *= r * qnw[i] * QC;
            { float n2 = 0.f;
#pragma unroll
              for (int i = 0; i < 12; ++i) n2 += z[i] * z[i];
              n2 += __shfl_xor(n2, 1); n2 += __shfl_xor(n2, 2); n2 += __shfl_xor(n2, 4);
              if (s == 0 && !probe) atomicMax((unsigned*)&lmax[(b * 8 + h) * 2], __float_as_uint(n2)); }
#pragma unroll
            for (int e = 0; e < 4; ++e) { const float mine = z[8 + e], other = __shfl_xor(mine, 2);
                z[8 + e] = second ? (other * sn[e] + mine * cs[e]) : (mine * cs[e] - other * sn[e]); }
            *(u32x4*)(qp + 64 * h + 8 * s) = pack8(z);
            u32x2 o; o.x = pk2(z[8], z[9]); o.y = pk2(z[10], z[11]); *(u32x2*)(qp + 512 + 32 * h + 4 * s) = o;
        }
        {
            bf16_t* kp = (probe ? (bf16_t*)(P.ws + WS_R4) + (size_t)TA * 768 : K) + (size_t)m * 768;
            float z[12]; unpack8(knn, z);
#pragma unroll
            for (int i = 0; i < 8; ++i) z[i] *= s_kv;
            z[8] = bflo(krr.x); z[9] = bfhi(krr.x); z[10] = bflo(krr.y); z[11] = bfhi(krr.y);
            float ss = 0.f;
#pragma unroll
            for (int i = 0; i < 12; ++i) ss += z[i] * z[i];
            ss += __shfl_xor(ss, 1); ss += __shfl_xor(ss, 2); ss += __shfl_xor(ss, 4);
            const float r = rsqrtf(ss * (1.f / 96.f) + EPS);
#pragma unroll
            for (int i = 0; i < 12; ++i) z[i] *= r * knw[i];
            { float n2 = 0.f;
#pragma unroll
              for (int i = 0; i < 12; ++i) n2 += z[i] * z[i];
              n2 += __shfl_xor(n2, 1); n2 += __shfl_xor(n2, 2); n2 += __shfl_xor(n2, 4);
              if (s == 0 && !probe) atomicMax((unsigned*)&lmax[(b * 8 + h) * 2 + 1], __float_as_uint(n2)); }
#pragma unroll
            for (int e = 0; e < 4; ++e) { const float mine = z[8 + e], other = __shfl_xor(mine, 2);
                z[8 + e] = second ? (other * sn[e] + mine * cs[e]) : (mine * cs[e] - other * sn[e]); }
            *(u32x4*)(kp + 64 * h + 8 * s) = pack8(z);
            u32x2 o; o.x = pk2(z[8], z[9]); o.y = pk2(z[10], z[11]); *(u32x2*)(kp + 512 + 32 * h + 4 * s) = o;
            float vv[8]; unpack8(vraw, vv);
#pragma unroll
            for (int i = 0; i < 8; ++i) vv[i] *= s_kv;
            *(u32x4*)((probe ? (bf16_t*)(P.ws + WS_R4) + (size_t)TA * 1536 : V) + (size_t)m * 512 + 8 * lane) = pack8(vv);
        }
    }
#undef QLOAD
    __syncthreads();
    if (tid < 64 && !probe) atomicMax((unsigned*)(P.ws + WS_QKM) + tid, lmax[tid]);
}

DI void phase_scanpost(const Params& P, int l, int nrows, const bool probe = false) {
    const int tid = threadIdx.x, wave = tid >> 6, lane = tid & 63, gw = blockIdx.x * NWAVES + wave, ngw = gridDim.x * NWAVES;
    bf16_t* __restrict__ OF = (bf16_t*)(P.ws + WS_OF); const bf16_t* __restrict__ OB = (const bf16_t*)(P.ws + WS_OB);
    const float* gw_ = P.in[I_GON] + l * 128;
    const int sub = lane & 7, hd = lane >> 3;
    float w[16];
#pragma unroll
    for (int i = 0; i < 16; ++i) w[i] = hd < 4 ? gw_[16 * sub + i] : 1.f;
    u32x4 nf0, nf1, nb0, nb1;
#define PLOAD(m_) do { const bf16_t* pf_ = OF + (size_t)(m_) * 1024 + 16 * lane; const bf16_t* pb_ = OB + (size_t)(m_) * 1024 + 16 * lane; \
        nf0 = *(const u32x4*)pf_; nf1 = *(const u32x4*)(pf_ + 8); nb0 = *(const u32x4*)pb_; nb1 = *(const u32x4*)(pb_ + 8); } while (0)
    if (gw < nrows) PLOAD(gw);
    for (int m = gw; m < nrows; m += ngw) {
        float a[16], bq[16];
        unpack8(nf0, a); unpack8(nf1, a + 8); unpack8(nb0, bq); unpack8(nb1, bq + 8);
        if (m + ngw < nrows) PLOAD(m + ngw);
        float ss = 0.f;
#pragma unroll
        for (int i = 0; i < 16; ++i) { a[i] += bq[i]; ss += a[i] * a[i]; }
        ss += __shfl_xor(ss, 1); ss += __shfl_xor(ss, 2); ss += __shfl_xor(ss, 4);
        const float r = rsqrtf(ss * (1.f / 128.f) + EPS);
#pragma unroll
        for (int i = 0; i < 16; ++i) a[i] *= r * w[i];
        bf16_t* pf = (probe ? (bf16_t*)(P.ws + WS_R4) : OF) + (size_t)m * 1024 + 16 * lane;
        *(u32x4*)pf = pack8(a); *(u32x4*)(pf + 8) = pack8(a + 8);
    }
#undef PLOAD
}

DI void phase_conv(const Params& P, int l, int nrows) {
    const bf16_t* __restrict__ G = (const bf16_t*)(P.ws + WS_G); bf16_t* __restrict__ U = (bf16_t*)(P.ws + WS_U);
    const float* __restrict__ wdw = P.in[I_WDW] + (size_t)l * 3 * DFF; const float* __restrict__ bdw = P.in[I_BDW] + (size_t)l * DFF;
    const int total = (nrows / 4) * 352;
    for (int i = blockIdx.x * NTHREADS + threadIdx.x; i < total; i += gridDim.x * NTHREADS) {
        const int quad = i / 352, c = (i - quad * 352) * 8, m0 = quad * 4;
        int b, pos, isctx; rowinfo(m0, b, pos, isctx);
        const int last = isctx ? CTX - 1 : SEQ - 1;
        u32x4 g[6], u[4];
#pragma unroll
        for (int r = 0; r < 4; ++r) { g[r + 1] = *(const u32x4*)(G + (size_t)(m0 + r) * DFF + c); u[r] = *(const u32x4*)(U + (size_t)(m0 + r) * DFF + c); }
        g[0] = pos > 0 ? *(const u32x4*)(G + (size_t)(m0 - 1) * DFF + c) : (u32x4){0u, 0u, 0u, 0u};
        g[5] = pos + 3 < last ? *(const u32x4*)(G + (size_t)(m0 + 4) * DFF + c) : (u32x4){0u, 0u, 0u, 0u};
        float w0[8], w1[8], w2[8], bb[8];
#pragma unroll
        for (int k = 0; k < 8; ++k) { w0[k] = wdw[c + k]; w1[k] = wdw[DFF + c + k]; w2[k] = wdw[2 * DFF + c + k]; bb[k] = bdw[c + k]; }
#pragma unroll
        for (int r = 0; r < 4; ++r) {
            float a0[8], a1[8], a2[8], uu[8], o[8];
            unpack8(g[r], a0); unpack8(g[r + 1], a1); unpack8(g[r + 2], a2); unpack8(u[r], uu);
#pragma unroll
            for (int k = 0; k < 8; ++k) {
                const float x = w0[k] * a0[k] + w1[k] * a1[k] + w2[k] * a2[k] + bb[k];
                const float t2 = 1.5957691216057308f * (x + 0.044715f * x * x * x);
                o[k] = x / (1.f + __expf(-t2)) * uu[k];
            }
            *(u32x4*)(U + (size_t)(m0 + r) * DFF + c) = pack8(o);
        }
    }
}

namespace att {
constexpr int NW = 8, QBLK = 32, KVBLK = 64;
constexpr float SCALE = 0.10206207261596575f;
constexpr float THR = 8.f;
constexpr int SHM_V = 64 * 128 * 2, SHM_K = 64 * 256, SHM_ATTN = 2 * SHM_V + 2 * SHM_K + NW * 64 * 4;
#define KSWZ(row, colB) ((row) * 256 + ((colB) ^ (((row) & 7) << 4)))
#define SBAR() __builtin_amdgcn_sched_barrier(0)
DI int crow(int r, int hi) { return (r & 3) + 8 * (r >> 2) + 4 * hi; }
DI unsigned cvtpk(float lo, float hi) { unsigned r; asm volatile("v_cvt_pk_bf16_f32 %0, %1, %2" : "=v"(r) : "v"(lo), "v"(hi)); return r; }
DI bf16x8 ld8(const bf16_t* p) { return *reinterpret_cast<const bf16x8*>(p); }

constexpr float THR2 = 11.5f;
DI void partialSM(f32x16& p0, f32x16& p1, float& m_reg, float& mn, float& alpha) {
  float pmax = p0[0]; for (int r = 1; r < 16; ++r) pmax = fmaxf(pmax, p0[r]); for (int r = 0; r < 16; ++r) pmax = fmaxf(pmax, p1[r]);
  { auto rr = __builtin_amdgcn_permlane32_swap(__float_as_uint(pmax), __float_as_uint(pmax), false, false);
    pmax = fmaxf(__uint_as_float(rr[0]), __uint_as_float(rr[1])); }
  if (__builtin_expect(__all(pmax - m_reg <= THR2), 1)) { mn = m_reg; alpha = 1.f; }
  else { mn = fmaxf(m_reg, pmax); alpha = __builtin_amdgcn_exp2f(m_reg - mn); m_reg = mn; }
  for (int r = 0; r < 16; ++r) p0[r] -= mn; for (int r = 0; r < 16; ++r) p1[r] -= mn;
  for (int r = 0; r < 16; ++r) p0[r] = __builtin_amdgcn_exp2f(p0[r]);
}
DI void partialSM_fix(f32x16& p0) { for (int r = 0; r < 16; ++r) p0[r] = __builtin_amdgcn_exp2f(p0[r]); }
DI void finishSM(f32x16& p0, f32x16& p1, float alpha, float& l_reg, bf16x8& pa0, bf16x8& pa1, bf16x8& pa2, bf16x8& pa3) {
  for (int r = 0; r < 16; ++r) p1[r] = __builtin_amdgcn_exp2f(p1[r]);
  float ps = 0; for (int r = 0; r < 16; ++r) ps += p0[r]; for (int r = 0; r < 16; ++r) ps += p1[r];
  { auto rr = __builtin_amdgcn_permlane32_swap(__float_as_uint(ps), __float_as_uint(ps), false, false);
    ps = __uint_as_float(rr[0]) + __uint_as_float(rr[1]); }
  l_reg = l_reg * alpha + ps;
#define PK4(P, BASE, OUT) do { unsigned a0 = cvtpk(P[BASE + 0], P[BASE + 1]), a1 = cvtpk(P[BASE + 2], P[BASE + 3]);   \
    unsigned b0 = cvtpk(P[BASE + 4], P[BASE + 5]), b1 = cvtpk(P[BASE + 6], P[BASE + 7]);                              \
    auto r0 = __builtin_amdgcn_permlane32_swap(a0, b0, false, false); auto r1 = __builtin_amdgcn_permlane32_swap(a1, b1, false, false); \
    u32x4 w = {r0[0], r1[0], r0[1], r1[1]}; OUT = *reinterpret_cast<bf16x8*>(&w); } while (0)
  PK4(p0, 0, pa0); PK4(p0, 8, pa1); PK4(p1, 0, pa2); PK4(p1, 8, pa3);
#undef PK4
}
template <bool FIX>
DI void qkt(f32x16& p0, f32x16& p1, const char* Ks, const bf16x8* qr, int r32, int hi, const f32x16& init) {
  const f32x16 zero = {};
#pragma unroll
  for (int d0 = 0; d0 < 6; ++d0) { int cb = (d0 * 16 + hi * 8) * 2;
    bf16x8 b0 = *reinterpret_cast<const bf16x8*>(Ks + KSWZ(r32, cb));
    bf16x8 b1 = *reinterpret_cast<const bf16x8*>(Ks + KSWZ(32 + r32, cb));
    p0 = __builtin_amdgcn_mfma_f32_32x32x16_bf16(b0, qr[d0], d0 == 0 ? zero : p0, 0, 0, 0);
    p1 = __builtin_amdgcn_mfma_f32_32x32x16_bf16(b1, qr[d0], d0 == 0 ? zero : p1, 0, 0, 0); }
}
DI int v_st(int k, int c) { const int kk = (k & ~0xC) | ((k & 4) << 1) | ((k & 8) >> 1); return ((kk >> 3) * 4 + (c >> 5)) * 512 + ((kk & 7) * 32 + (c & 31)) * 2; }
DI int v_rd_base(int lane) { return ((lane & 3) << 3) | (((lane >> 2) & 3) << 6) | (((lane >> 4) & 1) << 5) | (((lane >> 5) & 1) << 8); }
constexpr int v_rd_off(int d0, int ks, int half) { return d0 * 512 + ks * 4096 + half * 2048; }
template <int OFF> DI s16x4 tr_read(int vb) {
  s16x4 r; asm volatile("ds_read_b64_tr_b16 %0, %1 offset:%2" : "=&v"(r) : "v"(vb), "i"(OFF) : "memory"); return r;
}
template <int D0> DI void pv_one(f32x16& od, int vb, bf16x8 pa0, bf16x8 pa1, bf16x8 pa2, bf16x8 pa3) {
  const s16x4 l0 = tr_read<v_rd_off(D0, 0, 0)>(vb), h0 = tr_read<v_rd_off(D0, 0, 1)>(vb), l1 = tr_read<v_rd_off(D0, 1, 0)>(vb), h1 = tr_read<v_rd_off(D0, 1, 1)>(vb);
  const s16x4 l2 = tr_read<v_rd_off(D0, 2, 0)>(vb), h2 = tr_read<v_rd_off(D0, 2, 1)>(vb), l3 = tr_read<v_rd_off(D0, 3, 0)>(vb), h3 = tr_read<v_rd_off(D0, 3, 1)>(vb);
  asm volatile("s_waitcnt lgkmcnt(0)" ::: "memory"); SBAR();
#define PK(L, H) (bf16x8){L[0], L[1], L[2], L[3], H[0], H[1], H[2], H[3]}
  od = __builtin_amdgcn_mfma_f32_32x32x16_bf16(pa0, PK(l0, h0), od, 0, 0, 0);
  od = __builtin_amdgcn_mfma_f32_32x32x16_bf16(pa1, PK(l1, h1), od, 0, 0, 0);
  od = __builtin_amdgcn_mfma_f32_32x32x16_bf16(pa2, PK(l2, h2), od, 0, 0, 0);
  od = __builtin_amdgcn_mfma_f32_32x32x16_bf16(pa3, PK(l3, h3), od, 0, 0, 0);
#undef PK
}
DI void pv_d0(f32x16* o, int vb, bf16x8 pa0, bf16x8 pa1, bf16x8 pa2, bf16x8 pa3) {
  pv_one<0>(o[0], vb, pa0, pa1, pa2, pa3); pv_one<1>(o[1], vb, pa0, pa1, pa2, pa3);
}

template <bool FIX>
DI void attn_unit(const bf16_t* Qg, bf16_t* Og, int ldo, const bf16_t* Kg, const bf16_t* Vg, int qrow0, int h, int ctxrow0, int latrow0, int NT, char* lds, float bound) {
  const int tid = threadIdx.x, wid = tid >> 6, lane = tid & 63, r32 = lane & 31, hi = lane >> 5;
  char* V_lds = lds; char* K_lds = lds + 2 * SHM_V;
  float* ws = (float*)(lds + 2 * SHM_V + 2 * SHM_K) + wid * 64; float* li_l = ws; float* al_l = ws + 32;
  float m_reg = -1e30f, l_reg = 0; f32x16 o[2] = {}; bf16x8 qr[6];
  const f32x16 init = {}; (void)bound;
  const bf16_t* Qw = Qg + (size_t)(qrow0 + wid * QBLK + r32) * 768;
#pragma unroll
  for (int d0 = 0; d0 < 6; ++d0) qr[d0] = ld8(Qw + (d0 < 4 ? 64 * h + 16 * d0 + 8 * hi : 512 + 32 * h + 16 * (d0 - 4) + 8 * hi));
  const int vr = tid >> 3, vc = tid & 7, vst = v_st(vr, 8 * vc), vcol = 64 * h + 8 * vc;
  const int c0 = tid, c1 = 512 + (tid & 255);
  const int kr0 = c0 / 12, kc0 = c0 % 12, kr1 = c1 / 12, kc1 = c1 % 12;
  const int kcol0 = kc0 < 8 ? 64 * h + 8 * kc0 : 512 + 32 * h + 8 * (kc0 - 8), kcol1 = kc1 < 8 ? 64 * h + 8 * kc1 : 512 + 32 * h + 8 * (kc1 - 8);
  const int kst0 = KSWZ(kr0, kc0 * 16), kst1 = KSWZ(kr1, kc1 * 16);
  const int vb0 = (int)(uintptr_t)V_lds + v_rd_base(lane);
  struct { bf16x8 vs0, ks0, ks1; } sr_[2];
#define TROW(j) ((j) < 4 ? ctxrow0 + 64 * (j) : latrow0 + 64 * ((j) - 4))
#define SLOAD(i, j) do { const int rb_ = TROW(j); sr_[i].vs0 = ld8(Vg + (size_t)(rb_ + vr) * 512 + vcol); \
    sr_[i].ks0 = ld8(Kg + (size_t)(rb_ + kr0) * 768 + kcol0); sr_[i].ks1 = ld8(Kg + (size_t)(rb_ + kr1) * 768 + kcol1); } while (0)
#define SWRITE(b, i) do { *(bf16x8*)(V_lds + (b) * SHM_V + vst) = sr_[i].vs0; \
    *(bf16x8*)(K_lds + (b) * SHM_K + kst0) = sr_[i].ks0; *(bf16x8*)(K_lds + (b) * SHM_K + kst1) = sr_[i].ks1; } while (0)
#define SWAIT() asm volatile("s_waitcnt vmcnt(3)" ::: "memory")
#define PSM(p0_, p1_, mn_, al_) do { if (FIX) { partialSM_fix(p0_); al_ = 1.f; } else partialSM(p0_, p1_, m_reg, mn_, al_); } while (0)
#define RESC(a) do { if (!FIX) if (__any((a) < 1.f)) { if (hi == 0) al_l[r32] = (a); asm volatile("s_waitcnt lgkmcnt(0)" ::: "memory"); \
    for (int d = 0; d < 2; ++d) for (int r = 0; r < 16; ++r) o[d][r] *= al_l[crow(r, hi)]; } } while (0)
  f32x16 pA0, pA1, pB0, pB1; float mnA, mnB, alA, alB; bf16x8 pa0, pa1, pa2, pa3;
  constexpr int SE = 0, SO = 1;
  SLOAD(SE, 0); asm volatile("s_waitcnt vmcnt(0)" ::: "memory"); SWRITE(0, SE); __syncthreads();
  qkt<FIX>(pA0, pA1, K_lds, qr, r32, hi, init); PSM(pA0, pA1, mnA, alA);
  SLOAD(SO, 1); if (2 < NT) SLOAD(SE, 2);
  SWAIT(); SWRITE(1, SO); __syncthreads();
  for (int j = 1; j + 1 < NT; j += 2) {
    SBAR(); qkt<FIX>(pB0, pB1, K_lds + SHM_K, qr, r32, hi, init);
    finishSM(pA0, pA1, alA, l_reg, pa0, pa1, pa2, pa3); SBAR();
    SLOAD(SO, j + 2); SBAR();
    pv_d0(o, vb0, pa0, pa1, pa2, pa3); PSM(pB0, pB1, mnB, alB);
    __syncthreads(); SWAIT(); SWRITE(0, SE);
    RESC(alB); __syncthreads();
    SBAR(); qkt<FIX>(pA0, pA1, K_lds, qr, r32, hi, init);
    finishSM(pB0, pB1, alB, l_reg, pa0, pa1, pa2, pa3); SBAR();
    if (j + 3 < NT) SLOAD(SE, j + 3); SBAR();
    pv_d0(o, vb0 + SHM_V, pa0, pa1, pa2, pa3); PSM(pA0, pA1, mnA, alA);
    __syncthreads(); SWAIT(); SWRITE(1, SO);
    RESC(alA); __syncthreads();
  }
  SBAR(); qkt<FIX>(pB0, pB1, K_lds + SHM_K, qr, r32, hi, init);
  finishSM(pA0, pA1, alA, l_reg, pa0, pa1, pa2, pa3); SBAR();
  pv_d0(o, vb0, pa0, pa1, pa2, pa3); PSM(pB0, pB1, mnB, alB);
  __syncthreads(); RESC(alB);
  finishSM(pB0, pB1, alB, l_reg, pa0, pa1, pa2, pa3); SBAR();
  pv_d0(o, vb0 + SHM_V, pa0, pa1, pa2, pa3);
  if (hi == 0) li_l[r32] = l_reg; asm volatile("s_waitcnt lgkmcnt(0)" ::: "memory");
  float rli[16];
#pragma unroll
  for (int r = 0; r < 16; ++r) rli[r] = __builtin_amdgcn_rcpf(li_l[crow(r, hi)]);
  bf16_t* Ow = Og + (size_t)(qrow0 + wid * QBLK) * ldo + 64 * h;
#pragma unroll
  for (int r = 0; r < 16; ++r) { const int orow = crow(r, hi);
#pragma unroll
    for (int d0 = 0; d0 < 2; ++d0) Ow[(size_t)orow * ldo + d0 * 32 + r32] = f2bf(o[d0][r] * rli[r]); }
#undef TROW
#undef SLOAD
#undef SWRITE
#undef SWAIT
#undef RESC
#undef PSM
}
}

DI void phase_attention(const Params& P, int l, char* lds, bf16_t* Og, int ldo) {
    const bf16_t* Q = (const bf16_t*)(P.ws + WS_Q); const bf16_t* K = (const bf16_t*)(P.ws + WS_K); const bf16_t* V = (const bf16_t*)(P.ws + WS_V);
    const unsigned* QKM = (const unsigned*)(P.ws + WS_QKM);
    for (int u = blockIdx.x; u < 1024 + (l == 0 ? 32 : 0); u += gridDim.x) {
        int b, h, qrow0, nt;
        if (u < 1024) { const int bh = (u >> 8) * 8 + (u & 7), qb = (u >> 3) & 31; b = bh >> 3; h = bh & 7; qrow0 = b * SEQ + 256 * qb; nt = 132; }
        else { b = (u - 1024) >> 3; h = (u - 1024) & 7; qrow0 = TL + b * CTX; nt = 4; }
        const float bound = sqrtf(__uint_as_float(QKM[(b * 8 + h) * 2]) * __uint_as_float(QKM[(b * 8 + h) * 2 + 1])) * 1.01f + 0.5f;
        __syncthreads();
        if (bound <= 48.f) att::attn_unit<true>(Q, Og, ldo, K, V, qrow0, h, TL + b * CTX, b * SEQ, nt, lds, bound);
        else att::attn_unit<false>(Q, Og, ldo, K, V, qrow0, h, TL + b * CTX, b * SEQ, nt, lds, 0.f);
    }
    __syncthreads();
}

namespace scn {
constexpr int RQ = 0, RK = 16384, RR = 32768;
constexpr int QD = 34816;
constexpr int KN = QD + 64 * 272;
constexpr int KET = KN + 64 * 272;
constexpr int VT = KET + 128 * 144;
constexpr int ST = VT + 128 * 144;
constexpr int PM = ST + 128 * 272;
constexpr int DEC = PM + 64 * 144;
constexpr int CSUM = DEC + 512;
constexpr int END = CSUM + 1024;
static_assert(END <= LDS_BYTES - 16, "scan LDS");
constexpr size_t US_OFF = 0, DL_OFF = (size_t)64 * 3 * 16384 * 2;
static_assert(DL_OFF + (size_t)64 * 3 * 128 * 4 <= (size_t)3584 * 1024 * 2, "scan hand-off must fit in the dead part of the weight region");
DI int crow(int r, int hi) { return (r & 3) + 8 * (r >> 2) + 4 * hi; }
#define SC_BAR() do { asm volatile("s_waitcnt lgkmcnt(0)" ::: "memory"); __builtin_amdgcn_s_barrier(); asm volatile("" ::: "memory"); } while (0)
#define SMFMA(a, b, c) __builtin_amdgcn_mfma_f32_32x32x16_bf16((a), (b), (c), 0, 0, 0)
}
DI void phase_scan(const Params& P, int l, char* lds, const int pass) {
    using namespace scn;
    const int tid = threadIdx.x, wid = tid >> 6, lane = tid & 63, r32 = lane & 31, hi = lane >> 5;
    const bf16_t* R4 = (const bf16_t*)(P.ws + WS_R4); const bf16_t* SM = (const bf16_t*)(P.ws + WS_SM);
    bf16_t* UST = (bf16_t*)(P.ws + WS_WT + US_OFF); float* DLG = (float*)(P.ws + WS_WT + DL_OFF);
    const int nitems = pass == 1 ? 192 : 256;
    for (int item = blockIdx.x; item < nitems; item += gridDim.x) {
        int seg, scan; if (pass == 1) { seg = item % 3; scan = item / 3; } else { seg = item & 3; scan = item >> 2; }
        const int dir = scan & 1, hd = (scan >> 1) & 7, b = scan >> 4;
        const bool gla = hd < 4; const int hh = hd & 3;
        const int qcol = gla ? hh * 128 : 1536 + hh * 128, kcol = gla ? 512 + hh * 128 : 2048 + hh * 128, vcol = (gla ? 1024 : 2560) + hh * 128;
        bf16_t* Od = (bf16_t*)(P.ws + (dir ? WS_OB : WS_OF)); const int ocol = hd * 128;
        const int pti = wid >> 2, pdj = wid & 3, pd = 32 * pdj + r32;
        const int vt = wid >> 1, dt0 = 2 * (wid & 1);
        bf16x8 w2h = {0, 0, 0, 0, 0, 0, 0, 0}, w2l = {0, 0, 0, 0, 0, 0, 0, 0}; float bias = 0.f, lg = 0.f;
        if (gla) { const float* W2 = P.in[I_GK2] + (size_t)(l * 2 + dir) * 16 * 512 + hh * 128 + pd;
#pragma unroll
            for (int j = 0; j < 8; ++j) { const float w = W2[(8 * hi + j) * 512]; const unsigned u = __float_as_uint(w) & 0xffff0000u; const float res = w - __uint_as_float(u);
                w2h[j] = (short)(u >> 16); w2l[j] = (short)(__float_as_uint(res) >> 16); }
            bias = P.in[I_BGK][(l * 2 + dir) * 512 + hh * 128 + pd]; }
        else lg = -expf(P.in[I_RDEC][(l * 2 + dir) * 4 + hh]);
        f32x16 S0 = {}, S1 = {}; float clsum = 0.f;
        __syncthreads();
        if (pass == 2) {
            for (int sp = 0; sp < seg; ++sp) {
                const bf16_t* U = UST + (size_t)(scan * 3 + sp) * 16384; const float* DL = DLG + (size_t)(scan * 3 + sp) * 128;
                const float e0 = __expf(DL[32 * dt0 + r32]), e1 = __expf(DL[32 * (dt0 + 1) + r32]);
#pragma unroll
                for (int r = 0; r < 16; ++r) { const int v = 32 * vt + crow(r, hi);
                    S0[r] = S0[r] * e0 + bf2f(U[v * 128 + 32 * dt0 + r32]); S1[r] = S1[r] * e1 + bf2f(U[v * 128 + 32 * (dt0 + 1) + r32]); }
            }
#pragma unroll
            for (int r = 0; r < 16; ++r) { const int v = 32 * vt + crow(r, hi);
                *(bf16_t*)(lds + ST + v * 272 + (32 * dt0 + r32) * 2) = f2bf(S0[r]); *(bf16_t*)(lds + ST + v * 272 + (32 * (dt0 + 1) + r32) * 2) = f2bf(S1[r]); }
            { const int i = tid >> 4, j = 32 + (tid & 15) * 2; *(unsigned*)(lds + PM + i * 144 + j * 2) = 0u; }
        }
        u32x4 pq0 = {0u, 0u, 0u, 0u}, pq1 = pq0, pk0, pk1, pr = pq0, pv0, pv1;
#define ROWBASE(n) (dir == 0 ? ((n) < 4 ? TL + b * CTX + 64 * (n) : b * SEQ + 64 * ((n) - 4)) : ((n) < 4 ? TL + b * CTX + 64 * (3 - (n)) : b * SEQ + 64 * (127 - ((n) - 4))))
#define SC_LOADQK(n) do { const int rb_ = ROWBASE(n); \
        if (pass == 2) { pq0 = *(const u32x4*)(R4 + (size_t)(rb_ + (tid >> 4)) * 3072 + qcol + 8 * (tid & 15)); pq1 = *(const u32x4*)(R4 + (size_t)(rb_ + 32 + (tid >> 4)) * 3072 + qcol + 8 * (tid & 15)); } \
        pk0 = *(const u32x4*)(R4 + (size_t)(rb_ + (tid >> 4)) * 3072 + kcol + 8 * (tid & 15)); pk1 = *(const u32x4*)(R4 + (size_t)(rb_ + 32 + (tid >> 4)) * 3072 + kcol + 8 * (tid & 15)); \
        if (tid < 128) pr = *(const u32x4*)(SM + (size_t)(rb_ + (tid >> 1)) * 512 + 416 + dir * 16 + 8 * (tid & 1)); } while (0)
#define SC_LOADV(n) do { const int rb_ = ROWBASE(n); \
        pv0 = *(const u32x4*)(R4 + (size_t)(rb_ + lane) * 3072 + vcol + 8 * wid); pv1 = *(const u32x4*)(R4 + (size_t)(rb_ + lane) * 3072 + vcol + 64 + 8 * wid); } while (0)
#define SC_STOREQK() do { if (pass == 2) { *(u32x4*)(lds + RQ + sr0 * 256 + (tid & 15) * 16) = pq0; *(u32x4*)(lds + RQ + sr1 * 256 + (tid & 15) * 16) = pq1; } \
        *(u32x4*)(lds + RK + sr0 * 256 + (tid & 15) * 16) = pk0; *(u32x4*)(lds + RK + sr1 * 256 + (tid & 15) * 16) = pk1; \
        if (tid < 128) *(u32x4*)(lds + RR + srr * 32 + (tid & 1) * 16) = pr; } while (0)
        const int sr0 = dir ? 63 - (tid >> 4) : (tid >> 4), sr1 = dir ? 31 - (tid >> 4) : 32 + (tid >> 4);
        const int srr = dir ? 63 - (tid >> 1) : (tid >> 1), svi = dir ? 63 - lane : lane;
        const int n0 = 33 * seg;
        SC_LOADQK(n0); SC_STOREQK(); SC_LOADQK(n0 + 1); SC_LOADV(n0);
        for (int n = n0; n < n0 + 33; ++n) {
            int r32v = r32, hiv = hi; asm volatile("" : "+v"(r32v), "+v"(hiv));
            SC_BAR();
            { char* vb = lds + VT + (8 * wid) * 144 + svi * 2;
              const unsigned w0[4] = {pv0.x, pv0.y, pv0.z, pv0.w}, w1[4] = {pv1.x, pv1.y, pv1.z, pv1.w};
#pragma unroll
              for (int e = 0; e < 4; ++e) { *(bf16_t*)(vb + (2 * e) * 144) = (bf16_t)(w0[e] & 0xffffu); *(bf16_t*)(vb + (2 * e + 1) * 144) = (bf16_t)(w0[e] >> 16);
                  *(bf16_t*)(vb + (64 + 2 * e) * 144) = (bf16_t)(w1[e] & 0xffffu); *(bf16_t*)(vb + (64 + 2 * e + 1) * 144) = (bf16_t)(w1[e] >> 16); }
              if (n + 1 < n0 + 33) SC_LOADV(n + 1); }
            {
                f32x16 cum; float cl;
                if (gla) {
                    f32x16 la;
                    { const bf16x8 a0 = *(const bf16x8*)(lds + RR + (32 * pti + r32v) * 32 + hiv * 16);
                      la = SMFMA(a0, w2h, (f32x16{})); la = SMFMA(a0, w2l, la); }
                    float ssum = 0.f;
#pragma unroll
                    for (int r = 0; r < 16; ++r) { const float x0 = la[r] + bias;
                        la[r] = (fminf(x0, 0.f) - __logf(1.f + __expf(-fabsf(x0)))) * (1.f / 16.f);
                        ssum += la[r]; }
                    const float cs_own = ssum + __shfl_xor(ssum, 32);
                    if (hiv == 0) *(float*)(lds + CSUM + (pti * 128 + pd) * 4) = cs_own;
                    SC_BAR();
                    const float cs_other = *(const float*)(lds + CSUM + ((1 - pti) * 128 + pd) * 4);
                    cl = cs_own + cs_other;
                    bf16x8 tri0, tri1;
#pragma unroll
                    for (int j = 0; j < 8; ++j) { const int k0 = 8 * (j >> 2) + 4 * hiv + (j & 3);
                        tri0[j] = (short)(r32v >= k0 ? 0x3F80 : 0); tri1[j] = (short)(r32v >= k0 + 16 ? 0x3F80 : 0); }
                    cum = f32x16{};
#pragma unroll
                    for (int st = 0; st < 2; ++st) { bf16x8 h8, l8;
#pragma unroll
                        for (int j = 0; j < 8; ++j) { const float v = la[8 * st + j]; const unsigned u = __float_as_uint(v) & 0xffff0000u; const float res = v - __uint_as_float(u);
                            h8[j] = (short)(u >> 16); l8[j] = (short)(__float_as_uint(res) >> 16); }
                        const bf16x8 am = st ? tri1 : tri0; cum = SMFMA(am, h8, cum); cum = SMFMA(am, l8, cum); }
                    if (pti) {
#pragma unroll
                        for (int r = 0; r < 16; ++r) cum[r] += cs_other; }
                    __builtin_amdgcn_sched_barrier(0);
                } else {
#pragma unroll
                    for (int r = 0; r < 16; ++r) cum[r] = (float)(32 * pti + crow(r, hiv) + 1) * lg;
                    cl = 64.f * lg;
                }
                clsum += cl;
                {
                    const int ibase = 32 * pti + 4 * hiv; const float ecl = __expf(cl);
                    const char* rqb = lds + RQ + ibase * 256 + pd * 2; const char* rkb = lds + RK + ibase * 256 + pd * 2;
                    char* qdb = lds + QD + ibase * 272 + pd * 2; char* knb = lds + KN + ibase * 272 + pd * 2; char* keb = lds + KET + pd * 144 + ibase * 2;
                    if (pass == 2) {
#pragma unroll
                        for (int r = 0; r < 16; ++r) { const int cr = (r & 3) + 8 * (r >> 2);
                            const float c = cum[r]; const float e1 = __expf(c), e2 = __expf(-c);
                            const float q = bf2f(*(const bf16_t*)(rqb + cr * 256)), k = bf2f(*(const bf16_t*)(rkb + cr * 256));
                            const float kn = k * e2;
                            *(bf16_t*)(qdb + cr * 272) = f2bf(q * e1);
                            *(bf16_t*)(knb + cr * 272) = f2bf(kn);
                            *(bf16_t*)(keb + cr * 2) = f2bf(kn * ecl);
                            if ((r & 3) == 3) { asm volatile("" ::: "memory"); } }
                    } else {
#pragma unroll
                        for (int r = 0; r < 16; ++r) { const int cr = (r & 3) + 8 * (r >> 2);
                            const float k = bf2f(*(const bf16_t*)(rkb + cr * 256));
                            *(bf16_t*)(keb + cr * 2) = f2bf(k * __expf(cl - cum[r]));
                            if ((r & 3) == 3) { asm volatile("" ::: "memory"); } }
                    }
                    if (pti == 0 && hiv == 0) *(float*)(lds + DEC + pd * 4) = ecl;
                }
            }
            SC_BAR();
            if (n + 1 < n0 + 33) { SC_STOREQK(); if (n + 2 < n0 + 33) SC_LOADQK(n + 2); }
            f32x16 oacc = {};
            if (pass == 2) {
                if (wid < 3) {
                    const int ti = (wid + 1) >> 1, tj = wid >> 1; f32x16 T0 = {};
#pragma unroll
                    for (int kk = 0; kk < 8; ++kk) { const bf16x8 a = *(const bf16x8*)(lds + QD + (32 * ti + r32v) * 272 + (16 * kk + 8 * hiv) * 2), bb = *(const bf16x8*)(lds + KN + (32 * tj + r32v) * 272 + (16 * kk + 8 * hiv) * 2);
                        T0 = SMFMA(a, bb, T0); }
#pragma unroll
                    for (int r = 0; r < 16; ++r) { const int cr = (r & 3) + 8 * (r >> 2); const int ib = 32 * ti + 4 * hiv, j = 32 * tj + r32v; int jm = j - (dir ? 0 : 1) - ib; asm volatile("" : "+v"(jm));
                        *(bf16_t*)(lds + PM + ib * 144 + j * 2 + cr * 144) = f2bf(cr > jm ? T0[r] : 0.f); }
                }
                { const int ti = wid >> 2, vj = wid & 3;
#pragma unroll
                  for (int kk = 0; kk < 8; ++kk) { const bf16x8 a = *(const bf16x8*)(lds + QD + (32 * ti + r32v) * 272 + (16 * kk + 8 * hiv) * 2), bb = *(const bf16x8*)(lds + ST + (32 * vj + r32v) * 272 + (16 * kk + 8 * hiv) * 2);
                      oacc = SMFMA(a, bb, oacc); } }
            }
            {
                const float dc0 = *(const float*)(lds + DEC + (32 * dt0 + r32v) * 4), dc1 = *(const float*)(lds + DEC + (32 * (dt0 + 1) + r32v) * 4);
#pragma unroll
                for (int r = 0; r < 16; ++r) { S0[r] *= dc0; S1[r] *= dc1; }
#pragma unroll
                for (int kk = 0; kk < 4; ++kk) { const bf16x8 a = *(const bf16x8*)(lds + VT + (32 * vt + r32v) * 144 + (16 * kk + 8 * hiv) * 2);
                    const bf16x8 b0 = *(const bf16x8*)(lds + KET + (32 * dt0 + r32v) * 144 + (16 * kk + 8 * hiv) * 2), b1 = *(const bf16x8*)(lds + KET + (32 * (dt0 + 1) + r32v) * 144 + (16 * kk + 8 * hiv) * 2);
                    S0 = SMFMA(a, b0, S0); S1 = SMFMA(a, b1, S1); }
            }
            if (pass == 2) {
                SC_BAR();
                { const int ti = wid >> 2, vj = wid & 3;
#pragma unroll
                  for (int kk = 0; kk < 4; ++kk) { const bf16x8 a = *(const bf16x8*)(lds + PM + (32 * ti + r32v) * 144 + (16 * kk + 8 * hiv) * 2), bb = *(const bf16x8*)(lds + VT + (32 * vj + r32v) * 144 + (16 * kk + 8 * hiv) * 2);
                      oacc = SMFMA(a, bb, oacc); }
                  const int rb = ROWBASE(n);
#pragma unroll
                  for (int r = 0; r < 16; ++r) { const int i = 32 * ti + crow(r, hiv), row = rb + (dir ? 63 - i : i);
                      Od[(size_t)row * 1024 + ocol + 32 * vj + r32v] = f2bf(oacc[r]); } }
#pragma unroll
                for (int r = 0; r < 16; ++r) { const int cr = (r & 3) + 8 * (r >> 2); char* stb = lds + ST + (32 * vt + 4 * hiv) * 272 + (32 * dt0 + r32v) * 2;
                    *(bf16_t*)(stb + cr * 272) = f2bf(S0[r]); *(bf16_t*)(stb + cr * 272 + 64) = f2bf(S1[r]); }
            }
        }
        if (pass == 1) {
            bf16_t* U = UST + (size_t)(scan * 3 + seg) * 16384;
#pragma unroll
            for (int r = 0; r < 16; ++r) { const int v = 32 * vt + crow(r, hi);
                U[v * 128 + 32 * dt0 + r32] = f2bf(S0[r]); U[v * 128 + 32 * (dt0 + 1) + r32] = f2bf(S1[r]); }
            if (pti == 0 && hi == 0) DLG[(size_t)(scan * 3 + seg) * 128 + pd] = clsum;
        }
#undef ROWBASE
#undef SC_LOADQK
#undef SC_LOADV
#undef SC_STOREQK
    }
    __syncthreads();
}

constexpr int PH_PER_LAYER = 15, N_PHASES = 1 + 2 * PH_PER_LAYER;
#ifndef PHEN
#define PHEN(q) 1
#endif
#ifdef PROBE_GEMM
#define REPG for (int rep_ = 0; rep_ < 2; ++rep_)
#else
#define REPG
#endif
#ifdef PROBE_EW
#define REPE for (int rep_ = 0; rep_ < 2; ++rep_)
#else
#define REPE
#endif
#define PH(k) if (lo <= (k) && (k) < hi && ((k) == lo || (xcd_barrier(xbar), true)))
template <int l>
DI void layer_program(const Params& P, int lo, int hi, LAS unsigned char* lds, unsigned char* lds_raw, const XcdBarrier& xbar) {
    constexpr int base = 1 + PH_PER_LAYER * l;
    constexpr int Mlat = (l == 0) ? TA : TL;
#define WSP(T, off) ((T*)(P.ws + (off)))
#define MODL (WSP(const float, WS_MOD) + (size_t)l * 5 * 6144)
#define HIN_L ((l == 0) ? P.in[I_X] : (const float*)P.out)
#define HIN_C ((l == 0) ? P.in[I_CTX] : WSP(const float, WS_HC))
    PH(base + 0) if (PHEN(0)) REPE { if (blockIdx.x == 0 && threadIdx.x < 64) WSP(unsigned, WS_QKM)[threadIdx.x] = 0u;
        phase_norm(HIN_L, HIN_C, P.in[I_N1W] + l * DM, MODL, 0, 1, WSP(bf16_t, WS_A), TA); if (l > 0) phase_wconv_mixer(P, l, lds); }
    PH(base + 1) if (PHEN(1)) REPG { Epi<EM_PLAIN> E{}; E.O0 = WSP(bf16_t, WS_SM); E.ld0 = 512; run_gemm<EM_PLAIN>(lds, WSP(bf16_t, WS_A), 1024, WSP(bf16_t, WS_WT) + WT_IN, TA, 512, 1024, E); }
    PH(base + 2) if (PHEN(2)) REPG { { Epi<EM_PLAIN> E{}; E.O0 = WSP(bf16_t, WS_Q); E.ld0 = 768; run_gemm<EM_PLAIN>(lds, WSP(bf16_t, WS_SM), 512, WSP(bf16_t, WS_WT) + WT_QB, TA, 768, 256, E); }
                  { Epi<EM_KV> E2{}; E2.O0 = WSP(bf16_t, WS_K); E2.O1 = WSP(bf16_t, WS_V); run_gemm<EM_KV>(lds, WSP(bf16_t, WS_SM) + 256, 512, WSP(bf16_t, WS_WT) + WT_KVB, TA, 1024, 128, E2); } }
    PH(base + 3) if (PHEN(3)) {
#ifdef PROBE_EW
        phase_qkpost(P, l, (LAS unsigned*)lds, true);
#endif
        phase_qkpost(P, l, (LAS unsigned*)lds); }
    PH(base + 4) if (PHEN(4)) {
#ifdef PROBE_ATTN
        phase_attention(P, l, (char*)lds_raw, WSP(bf16_t, WS_OF), 1024);
#endif
        phase_attention(P, l, (char*)lds_raw, WSP(bf16_t, WS_Q), 768);
        { Epi<EM_BIG> E{}; E.O0 = WSP(bf16_t, WS_R4); E.fa = WSP(const float, WS_ROT); run_gemm<EM_BIG>(lds, WSP(bf16_t, WS_A), 1024, WSP(bf16_t, WS_WT) + WT_IN + (size_t)512 * 1024, TA, 3072, 1024, E); } }
    PH(base + 5) if (PHEN(6)) phase_scan(P, l, (char*)lds_raw, 1);
    PH(base + 6) if (PHEN(6)) phase_scan(P, l, (char*)lds_raw, 2);
    PH(base + 7) if (PHEN(7)) {
#ifdef PROBE_EW
        phase_scanpost(P, l, Mlat, true);
#endif
        phase_scanpost(P, l, Mlat); }
    PH(base + 8) if (PHEN(8)) { Epi<EM_GATES> E{}; E.O0 = WSP(bf16_t, WS_R4); E.O1 = WSP(bf16_t, WS_OF); E.fa = P.in[I_BGATE] + (size_t)l * 3072; run_gemm<EM_GATES>(lds, WSP(bf16_t, WS_A), 1024, WSP(bf16_t, WS_WT) + WT_IN + (size_t)3584 * 1024, Mlat, 4096, 1024, E); }
    PH(base + 9) if (PHEN(9)) REPG {
        { Epi<EM_BRANCH> E{}; E.O0 = WSP(bf16_t, WS_OB); E.Gsrc = WSP(bf16_t, WS_R4); E.ipar = 0; run_gemm<EM_BRANCH>(lds, WSP(bf16_t, WS_Q), 768, WSP(bf16_t, WS_WT) + WT_BR, Mlat, 1024, 512, E); }
        { Epi<EM_BRANCH> E{}; E.O0 = WSP(bf16_t, WS_OB); E.Gsrc = WSP(bf16_t, WS_R4) + 1024; E.ipar = 1; run_gemm<EM_BRANCH>(lds, WSP(bf16_t, WS_OF), 1024, WSP(bf16_t, WS_WT) + WT_BR + (size_t)1024 * 512, Mlat, 1024, 512, E); }
        { Epi<EM_BRANCH> E{}; E.O0 = WSP(bf16_t, WS_OB); E.Gsrc = WSP(bf16_t, WS_R4) + 2048; E.ipar = 2; run_gemm<EM_BRANCH>(lds, WSP(bf16_t, WS_OF) + 512, 1024, WSP(bf16_t, WS_WT) + WT_BR + (size_t)2048 * 512, Mlat, 1024, 512, E); } }
    PH(base + 10) if (PHEN(10)) { Epi<EM_RES> E{}; E.fa = MODL; E.ipar = 2; E.hin_l = HIN_L; E.hin_c = HIN_C; E.hout_l = P.out; E.hout_c = WSP(float, WS_HC);
                   run_gemm<EM_RES>(lds, WSP(bf16_t, WS_OB), 1024, WSP(bf16_t, WS_WT) + WT_OUT, Mlat, 1024, 1024, E); }
    PH(base + 11) if (PHEN(11)) REPE { phase_norm(P.out, WSP(const float, WS_HC), P.in[I_N2W] + l * DM, MODL, 3, 4, WSP(bf16_t, WS_A), Mlat); phase_wconv_ffn(P, l, lds); }
    PH(base + 12) if (PHEN(12)) { EpiFfnConv E{}; E.ACT = WSP(bf16_t, WS_G); E.HALO = WSP(float, WS_U); E.wdw = P.in[I_WDW] + (size_t)l * 3 * DFF; E.bdw = P.in[I_BDW] + (size_t)l * DFF; E.X = (LAS float*)(lds + 131072);
                   run_gemm_ffnconv(lds, WSP(bf16_t, WS_A), WSP(bf16_t, WS_WT) + WT_F1, Mlat, E); }
    PH(base + 13) if (PHEN(13)) REPE phase_convfix(P, l);
    PH(base + 14) if (PHEN(14)) { Epi<EM_RES> E{}; E.fa = MODL; E.ipar = 5; E.hin_l = P.out; E.hin_c = WSP(const float, WS_HC); E.hout_l = P.out; E.hout_c = WSP(float, WS_HC);
                   run_gemm<EM_RES>(lds, WSP(bf16_t, WS_G), DFF, WSP(bf16_t, WS_WT) + WT_F2, Mlat, 1024, DFF, E); }
}
__global__ void __launch_bounds__(NTHREADS, 2) fwd_kernel(Params P) {
    extern __shared__ __attribute__((aligned(16))) unsigned char lds_raw[];
    LAS unsigned char* lds = (LAS unsigned char*)lds_raw;
    cg::grid_group grid = cg::this_grid();
    const int lo = P.ph_lo, hi = P.ph_hi;
    Params* G = (Params*)(P.ws + WS_PAR + (size_t)blockIdx.x * 256);
    if (threadIdx.x == 0) {
#pragma unroll
        for (int i = 0; i < 26; ++i) G->in[i] = P.in[i];
        G->out = P.out; G->ws = P.ws; G->ph_lo = lo; G->ph_hi = hi;
    }
    __syncthreads();
    asm volatile("" ::: "memory");
    const Params& Q = *G;
    if (threadIdx.x < 4) ((LAS unsigned*)(lds + LDS_BARW))[threadIdx.x] = 0u;
    __syncthreads();
    const XcdBarrier xbar = xcd_barrier_post((unsigned*)(P.ws + WS_BAR), (volatile LAS unsigned*)(lds + LDS_BARW));
    if (lo < 0) grid.sync();
    PH(0) REPE { phase_prologue(Q, lds); __syncthreads(); phase_wconv_mixer(Q, 0, lds); __syncthreads(); }
    layer_program<0>(Q, lo, hi, lds, lds_raw, xbar);
    layer_program<1>(Q, lo, hi, lds, lds_raw, xbar);
#ifdef PROBE_SYNC
    for (int i = 0; i < 20; ++i) xcd_barrier(xbar);
#endif
}

#ifndef N_LAUNCH_MODE
#define N_LAUNCH_MODE 1
#endif
extern "C" void kernel_launch(void* const* d_in, const int* in_sizes, int n_in, void* d_out, int out_size, void* d_ws, size_t ws_size, hipStream_t stream) {
    static int grid_blocks = 0;
    if (!grid_blocks) {
        if (n_in != 26 || ws_size < WS_NEED) { fprintf(stderr, "kernel_launch: bad inputs (n_in %d, ws %zu < %zu)\n", n_in, ws_size, (size_t)WS_NEED); return; }
        if (hipFuncSetAttribute((const void*)fwd_kernel, hipFuncAttributeMaxDynamicSharedMemorySize, LDS_BYTES) != hipSuccess) { fprintf(stderr, "kernel_launch: hipFuncSetAttribute failed\n"); return; }
        int dev = 0, cus = 0, per_cu = 0;
        hipGetDevice(&dev);
        hipDeviceGetAttribute(&cus, hipDeviceAttributeMultiprocessorCount, dev);
        hipOccupancyMaxActiveBlocksPerMultiprocessor(&per_cu, fwd_kernel, NTHREADS, LDS_BYTES);
        if (per_cu < 1) { fprintf(stderr, "kernel_launch: occupancy query returned %d\n", per_cu); return; }
        grid_blocks = cus * 1;
    }
    Params p{};
    for (int i = 0; i < 26; ++i) p.in[i] = (const float*)d_in[i];
    p.out = (float*)d_out; p.ws = (unsigned char*)d_ws;
#if N_LAUNCH_MODE == 1
    p.ph_lo = 0; p.ph_hi = N_PHASES;
    if (hipMemsetAsync((unsigned char*)d_ws + WS_BAR, 0, XCD_BAR_WORDS * 4, stream) != hipSuccess) { fprintf(stderr, "kernel_launch: memset of the barrier words failed\n"); return; }
    void* args[] = {&p};
    hipError_t e = hipLaunchCooperativeKernel((const void*)fwd_kernel, dim3(grid_blocks), dim3(NTHREADS), args, LDS_BYTES, stream);
    if (e != hipSuccess) fprintf(stderr, "cooperative launch failed: %s (grid %d)\n", hipGetErrorString(e), grid_blocks);
#else
    for (int ph = 0; ph < N_PHASES; ++ph) {
        p.ph_lo = ph; p.ph_hi = ph + 1;
        hipLaunchKernelGGL(fwd_kernel, dim3(grid_blocks), dim3(NTHREADS), LDS_BYTES, stream, p);
    }
#endif
}
```

```cpp
#include <hip/hip_runtime.h>
#include <hip/hip_bf16.h>
#include <hip/hip_cooperative_groups.h>
#include <cstdio>
#include <cstdint>
namespace cg = cooperative_groups;
#define DI __device__ __forceinline__
#define LAS __attribute__((address_space(3)))
namespace pg8 {
#define PG8_LAS __attribute__((address_space(3)))
typedef unsigned short bf16_t;
typedef short bf16x8 __attribute__((ext_vector_type(8)));
typedef float f32x4 __attribute__((ext_vector_type(4)));
typedef unsigned u32x4 __attribute__((ext_vector_type(4)));
constexpr int BM = 256, BK = 64, HALF = 128, HTB = HALF * BK * 2  , STAGE_BYTES = 8 * HTB, NXCD = 8, WGM = 8;

__host__ __device__ __forceinline__ int lds_byte(int r, int c) { const int st = (r >> 4) * 2 + (c >> 5), rr = r & 15, cc = c & 31, ob = rr * 64 + cc * 2; return st * 1024 + (ob ^ (((ob >> 9) & 1) << 5)); }
__host__ __device__ __forceinline__ void stage_rc(int b, int& R, int& C) { const int st = b / 1024, sb = b % 1024, swz = sb ^ (((sb >> 9) & 1) << 5); R = (st >> 1) * 16 + swz / 64; C = (st & 1) * 32 + (swz % 64) / 2; }
__host__ __device__ __forceinline__ int perm32(int rho) { const int n = rho >> 4, i = rho & 15; return 8 * (i >> 2) + 4 * n + (i & 3); }

struct Unit { int pm, pn; };
struct Gemm { const bf16_t* A; const bf16_t* Bt; int M, N, K, lda; };

struct StaticOrder {
    int nM, nN, nwg, G, c;
    __host__ __device__ void init(int M, int N, int G_, int c_) { nM = M / BM; nN = N / BM; nwg = nM * nN; G = G_; c = c_; }
    __host__ __device__ bool next(int i, Unit& u) const {
        const long L = (long)i * G + c; if (L >= nwg) return false;
        int wgid = (int)L; { const int q = nwg / NXCD, r = nwg % NXCD, xcd = wgid % NXCD, off = wgid / NXCD; wgid = (xcd < r ? xcd * (q + 1) : r * (q + 1) + (xcd - r) * q) + off; }
        const int nig = WGM * nN, gid = wgid / nig, fm = gid * WGM, gsz = (nM - fm) < WGM ? (nM - fm) : WGM;
        u.pm = fm + ((wgid % nig) % gsz); u.pn = (wgid % nig) / gsz; return true;
    }
    __device__ __forceinline__ void a_ready(const Unit&) const {}
    __device__ __forceinline__ void done(const Unit&) const {}
};

__device__ __forceinline__ unsigned cvt_pk_bf16(float lo, float hi) { unsigned r; asm volatile("v_cvt_pk_bf16_f32 %0, %1, %2" : "=v"(r) : "v"(lo), "v"(hi)); return r; }
template <class Epi, class Sched, bool ALIGN_EPI = false, bool SP2 = false>
__device__ __forceinline__ void gemm_phase(PG8_LAS unsigned char* lds, const Gemm g, const Sched& S, const Epi& E) {
    const int tid = threadIdx.x, wid = __builtin_amdgcn_readfirstlane(tid >> 6), lane = tid & 63, wr = wid >> 2, wc = wid & 3, fr = lane & 15, fq = lane >> 4;
    const int K = g.K, nt = K / BK;
    unsigned voffA[2], voffB[2];
#pragma unroll
    for (int i = 0; i < 2; ++i) { int R, C; stage_rc(tid * 16 + i * 8192, R, C); const int Rb = Epi::PERM ? ((R & ~31) + perm32(R & 31)) : R;
        voffA[i] = (unsigned)(R * g.lda + C) * 2u; voffB[i] = (unsigned)(Rb * K + C) * 2u; }
    const size_t kstep = (size_t)(BK * 2);
    const size_t hstep = (size_t)HALF * K * 2;
    const size_t tstep = 2 * hstep; const size_t hstepA = (size_t)HALF * g.lda * 2; const size_t tstepA = 2 * hstepA;
    const unsigned ldsw = (unsigned)wid * 1024u;
    const int aoff = lds_byte(wr * 64 + fr, fq * 8), boff = lds_byte(wc * 32 + fr, fq * 8);
#define PG8_SA(b, h) (((b) * 2 + (h)) * HTB)
#define PG8_SB(b, h) ((4 + (b) * 2 + (h)) * HTB)
#define PG8_STAGE(bufoff, gbase, voff) do { _Pragma("unroll") for (int _i = 0; _i < 2; ++_i) \
        __builtin_amdgcn_global_load_lds((const unsigned*)((const char*)(gbase) + (voff)[_i]), (PG8_LAS unsigned*)(lds + (bufoff) + ldsw + _i * 8192), 16, 0, 0); } while (0)
#define PG8_LDA(dst, b, h) do { _Pragma("unroll") for (int m = 0; m < 4; ++m) _Pragma("unroll") for (int k = 0; k < 2; ++k) dst[m][k] = *(const PG8_LAS bf16x8*)(lds + PG8_SA(b, h) + aoff + m * 2048 + k * 1024); } while (0)
#define PG8_LDB(dst, b, h) do { _Pragma("unroll") for (int n = 0; n < 2; ++n) _Pragma("unroll") for (int k = 0; k < 2; ++k) dst[n][k] = *(const PG8_LAS bf16x8*)(lds + PG8_SB(b, h) + boff + n * 2048 + k * 1024); } while (0)
#define PG8_MMA(ai, bj, At, Bt) do { __builtin_amdgcn_s_setprio(1); _Pragma("unroll") for (int m = 0; m < 4; ++m) _Pragma("unroll") for (int n = 0; n < 2; ++n) _Pragma("unroll") for (int k = 0; k < 2; ++k) \
        acc[ai][bj][m][n] = __builtin_amdgcn_mfma_f32_16x16x32_bf16(Bt[n][k], At[m][k], acc[ai][bj][m][n], 0, 0, 0); __builtin_amdgcn_s_setprio(0); } while (0)
#define PG8_WAIT_V(n) asm volatile("s_waitcnt vmcnt(" #n ")" ::: "memory")
#define PG8_WAIT_L(n) asm volatile("s_waitcnt lgkmcnt(" #n ")" ::: "memory")
#define PG8_BAR __builtin_amdgcn_s_barrier()
#define PG8_SCHED __builtin_amdgcn_sched_barrier(0)
    Unit cur, nxt; int ui = 0;
    if (!S.next(0, cur)) return;
    f32x4 acc[2][2][4][2];
#pragma unroll
    for (int a = 0; a < 2; ++a)
#pragma unroll
        for (int b = 0; b < 2; ++b)
#pragma unroll
            for (int m = 0; m < 4; ++m)
#pragma unroll
                for (int n = 0; n < 2; ++n) acc[a][b][m][n] = (f32x4){0.f, 0.f, 0.f, 0.f};
    bf16x8 At[4][2], B0[2][2], B1[2][2];
    const char* cA = (const char*)g.A + (size_t)cur.pm * tstepA; const char* cB = (const char*)g.Bt + (size_t)cur.pn * tstep;
    S.a_ready(cur);
    if constexpr (SP2) {
        PG8_STAGE(PG8_SB(0, 0), cB, voffB); PG8_STAGE(PG8_SB(0, 1), cB + hstep, voffB); PG8_STAGE(PG8_SA(0, 0), cA, voffA); PG8_STAGE(PG8_SA(0, 1), cA + hstepA, voffA);
        if (wr == 1) PG8_BAR;
        PG8_WAIT_V(2); PG8_BAR;
        PG8_STAGE(PG8_SB(1, 0), cB + kstep, voffB); PG8_STAGE(PG8_SA(1, 0), cA + kstep, voffA); PG8_STAGE(PG8_SB(1, 1), cB + hstep + kstep, voffB);
        PG8_WAIT_V(6); PG8_BAR;
    } else {
        PG8_STAGE(PG8_SB(0, 0), cB, voffB); PG8_STAGE(PG8_SA(0, 0), cA, voffA); PG8_STAGE(PG8_SB(0, 1), cB + hstep, voffB); PG8_STAGE(PG8_SA(0, 1), cA + hstepA, voffA);
        if (wr == 1) PG8_BAR;
        PG8_WAIT_V(4); PG8_BAR;
        PG8_STAGE(PG8_SB(1, 0), cB + kstep, voffB); PG8_STAGE(PG8_SA(1, 0), cA + kstep, voffA); PG8_STAGE(PG8_SB(1, 1), cB + hstep + kstep, voffB);
        PG8_WAIT_V(6); PG8_BAR;
    }
    for (;;) {
        const bool has_next = S.next(ui + 1, nxt);
        const char* nA = has_next ? (const char*)g.A + (size_t)nxt.pm * tstepA : cA; const char* nB = has_next ? (const char*)g.Bt + (size_t)nxt.pn * tstep : cB;
        for (int t = 0; t < nt; t += 2) {
            const bool last = (t == nt - 2);
            const char* a1 = cA + (size_t)(t + 1) * kstep;
            const char* a2 = last ? nA : cA + (size_t)(t + 2) * kstep; const char* b2 = last ? nB : cB + (size_t)(t + 2) * kstep;
            const char* a3 = a2 + kstep; const char* b3 = b2 + kstep;
            if (last && has_next) S.a_ready(nxt);
            if constexpr (SP2) {
            PG8_LDB(B0, 0, 0); PG8_LDB(B1, 0, 1); PG8_SCHED; PG8_LDA(At, 0, 0); PG8_STAGE(PG8_SA(1, 1), a1 + hstepA, voffA);
            PG8_WAIT_V(8); PG8_WAIT_L(0); PG8_BAR; PG8_MMA(0, 0, At, B0); PG8_MMA(0, 1, At, B1); PG8_BAR; PG8_SCHED;
            PG8_LDA(At, 0, 1); PG8_STAGE(PG8_SB(0, 0), b2, voffB); PG8_STAGE(PG8_SB(0, 1), b2 + hstep, voffB); PG8_STAGE(PG8_SA(0, 0), a2, voffA);
            PG8_WAIT_V(8); PG8_WAIT_L(0); PG8_BAR; PG8_MMA(1, 0, At, B0); PG8_MMA(1, 1, At, B1); PG8_BAR; PG8_SCHED;
            PG8_LDB(B0, 1, 0); PG8_LDB(B1, 1, 1); PG8_SCHED; PG8_LDA(At, 1, 0); PG8_STAGE(PG8_SA(0, 1), a2 + hstepA, voffA);
            PG8_WAIT_V(8); PG8_WAIT_L(0); PG8_BAR; PG8_MMA(0, 0, At, B0); PG8_MMA(0, 1, At, B1); PG8_BAR; PG8_SCHED;
            PG8_LDA(At, 1, 1); PG8_STAGE(PG8_SB(1, 0), b3, voffB); PG8_STAGE(PG8_SB(1, 1), b3 + hstep, voffB); PG8_STAGE(PG8_SA(1, 0), a3, voffA);
            PG8_WAIT_V(8); PG8_WAIT_L(0); PG8_BAR; PG8_MMA(1, 0, At, B0); PG8_MMA(1, 1, At, B1); PG8_BAR; PG8_SCHED;
            } else {
            PG8_LDB(B0, 0, 0); PG8_SCHED; PG8_LDA(At, 0, 0); PG8_STAGE(PG8_SA(1, 1), a1 + hstepA, voffA);
            PG8_WAIT_L(8); PG8_BAR; PG8_WAIT_L(0); PG8_MMA(0, 0, At, B0); PG8_BAR; PG8_SCHED;
            PG8_LDB(B1, 0, 1); PG8_STAGE(PG8_SB(0, 0), b2, voffB);
            PG8_BAR; PG8_WAIT_L(0); PG8_MMA(0, 1, At, B1); PG8_BAR;
            PG8_LDA(At, 0, 1); PG8_STAGE(PG8_SA(0, 0), a2, voffA);
            PG8_BAR; PG8_WAIT_L(0); PG8_MMA(1, 0, At, B0); PG8_BAR; PG8_SCHED;
            PG8_STAGE(PG8_SB(0, 1), b2 + hstep, voffB);
            PG8_WAIT_V(6); PG8_BAR; PG8_MMA(1, 1, At, B1); PG8_BAR;
            PG8_LDB(B0, 1, 0); PG8_SCHED; PG8_LDA(At, 1, 0); PG8_STAGE(PG8_SA(0, 1), a2 + hstepA, voffA);
            PG8_WAIT_L(8); PG8_BAR; PG8_WAIT_L(0); PG8_MMA(0, 0, At, B0); PG8_BAR; PG8_SCHED;
            PG8_LDB(B1, 1, 1); PG8_STAGE(PG8_SB(1, 0), b3, voffB);
            PG8_BAR; PG8_WAIT_L(0); PG8_MMA(0, 1, At, B1); PG8_BAR;
            PG8_LDA(At, 1, 1); PG8_STAGE(PG8_SA(1, 0), a3, voffA);
            PG8_BAR; PG8_WAIT_L(0); PG8_MMA(1, 0, At, B0); PG8_BAR; PG8_SCHED;
            PG8_STAGE(PG8_SB(1, 1), b3 + hstep, voffB);
            PG8_WAIT_V(6); PG8_BAR; PG8_MMA(1, 1, At, B1); PG8_BAR;
            }
        }
        if constexpr (ALIGN_EPI) { if (wr == 0) PG8_BAR; }
        if constexpr (!Epi::AFTER_DRAIN) { E(acc, cur, wr, wc, fr, fq); S.done(cur); }
        if (!has_next) break;
#pragma unroll
        for (int a = 0; a < 2; ++a)
#pragma unroll
            for (int b = 0; b < 2; ++b)
#pragma unroll
                for (int m = 0; m < 4; ++m)
#pragma unroll
                    for (int n = 0; n < 2; ++n) acc[a][b][m][n] = (f32x4){0.f, 0.f, 0.f, 0.f};
        cur = nxt; cA = nA; cB = nB; ++ui;
        if constexpr (ALIGN_EPI) { if (wr == 1) PG8_BAR; }
    }
    PG8_WAIT_V(0);
    if constexpr (!ALIGN_EPI) { if (wr == 0) PG8_BAR; }
    PG8_BAR;
    if constexpr (Epi::AFTER_DRAIN) { E.fused(acc, cur, wr, wc, fr, fq, lds, wid, lane); S.done(cur); }
#undef PG8_SA
#undef PG8_SB
#undef PG8_STAGE
#undef PG8_LDA
#undef PG8_LDB
#undef PG8_MMA
#undef PG8_WAIT_V
#undef PG8_WAIT_L
#undef PG8_BAR
#undef PG8_SCHED
}
}

typedef unsigned short bf16_t;
typedef short bf16x8 __attribute__((ext_vector_type(8)));
typedef short s16x4 __attribute__((ext_vector_type(4)));
typedef float f32x4 __attribute__((ext_vector_type(4)));
typedef float f32x2 __attribute__((ext_vector_type(2)));
typedef float f32x16 __attribute__((ext_vector_type(16)));
typedef unsigned u32x4 __attribute__((ext_vector_type(4)));
typedef unsigned u32x2 __attribute__((ext_vector_type(2)));

constexpr int DM = 1024, NB = 4, SEQ = 8192, CTX = 256, TL = NB * SEQ, TC = NB * CTX, TA = TL + TC;
constexpr int DFF = 2816, NIN = 7616;
constexpr float EPS = 1e-6f;
constexpr int NTHREADS = 512, NWAVES = 8;

constexpr size_t al256(size_t x) { return (x + 255) / 256 * 256; }
constexpr size_t WS_MOD = 0;
constexpr size_t WS_PAR = al256(WS_MOD + (size_t)2 * 5 * 6144 * 4);
constexpr size_t WS_BAR = al256(WS_PAR + (size_t)1024 * 256);
constexpr size_t WS_QKM = al256(WS_BAR + (size_t)3456 * 4);
constexpr size_t WS_ROPE = al256(WS_QKM + 256);
constexpr size_t WS_ROT = al256(WS_ROPE + (size_t)192 * 8 * 8);
constexpr size_t WS_HC  = al256(WS_ROT + (size_t)8448 * 64 * 8);
constexpr size_t WS_WT  = al256(WS_HC + (size_t)TC * DM * 4);
constexpr size_t WT_IN = 0, WT_QB = WT_IN + (size_t)7680 * 1024, WT_KVB = WT_QB + (size_t)768 * 256, WT_BR = WT_KVB + (size_t)1024 * 128,
                 WT_OUT = WT_BR + (size_t)3 * 1024 * 512, WT_MIX_END = WT_OUT + (size_t)1024 * 1024;
constexpr size_t WT_F1 = 0, WT_F2 = (size_t)5632 * 1024, WT_FFN_END = WT_F2 + (size_t)1024 * 2816;
constexpr size_t WT_ELEMS = WT_MIX_END > WT_FFN_END ? WT_MIX_END : WT_FFN_END;
constexpr size_t WS_A   = al256(WS_WT + WT_ELEMS * 2);
constexpr size_t WS_SM  = al256(WS_A + (size_t)TA * 1024 * 2);
constexpr size_t WS_Q   = al256(WS_SM + (size_t)TA * 512 * 2);
constexpr size_t WS_R4  = al256(WS_Q + (size_t)TA * 768 * 2);
constexpr size_t WS_OF  = al256(WS_R4 + (size_t)TA * 3072 * 2);
constexpr size_t WS_OB  = al256(WS_OF + (size_t)TA * 1024 * 2);
constexpr size_t WS_END_MIX = al256(WS_OB + (size_t)TA * 1024 * 2);
constexpr size_t WS_K   = WS_R4;
constexpr size_t WS_V   = al256(WS_K + (size_t)TA * 768 * 2);
constexpr size_t WS_G   = WS_SM;
constexpr size_t WS_U   = al256(WS_G + (size_t)TA * DFF * 2);
constexpr size_t WS_END_FFN = al256(WS_U + (size_t)132 * 6 * DFF * 4);
constexpr size_t WS_NEED = WS_END_MIX > WS_END_FFN ? WS_END_MIX : WS_END_FFN;
static_assert(WS_V + (size_t)TA * 512 * 2 <= WS_OF, "K/V overlay must fit in R4");

constexpr int LDS_BYTES = 150 * 1024;
constexpr int LDS_BARW = LDS_BYTES - 16;

struct Params { const float* in[26]; float* out; unsigned char* ws; int ph_lo, ph_hi; };
enum { I_X = 0, I_C, I_CTX, I_CCTX, I_WADA, I_BADA, I_N1W, I_N2W, I_WIN, I_BGATE, I_QNA, I_WQB, I_KVNA, I_WKVB, I_QN, I_KN, I_GK2, I_BGK, I_GON, I_RDEC, I_WBR, I_WOUT, I_WF1, I_WDW, I_BDW, I_WF2 };

DI float bflo(unsigned w) { return __uint_as_float(w << 16); }
DI float bfhi(unsigned w) { return __uint_as_float(w & 0xffff0000u); }
DI float bf2f(bf16_t x) { return __uint_as_float((unsigned)x << 16); }
DI unsigned pk2(float lo, float hi) { unsigned r; asm volatile("s_nop 0\n\tv_cvt_pk_bf16_f32 %0, %1, %2" : "=v"(r) : "v"(lo), "v"(hi)); return r; }
DI bf16_t f2bf(float x) { return (bf16_t)(pk2(x, 0.f) & 0xffffu); }
DI float wave_sum(float v) {
#pragma unroll
    for (int o = 1; o < 64; o <<= 1) v += __shfl_xor(v, o);
    return v;
}
DI float sigmoidf_(float x) { return __builtin_amdgcn_rcpf(1.f + __builtin_amdgcn_exp2f(-1.4426950408889634f * x)); }
DI void unpack8(u32x4 w, float* f) { f[0] = bflo(w.x); f[1] = bfhi(w.x); f[2] = bflo(w.y); f[3] = bfhi(w.y); f[4] = bflo(w.z); f[5] = bfhi(w.z); f[6] = bflo(w.w); f[7] = bfhi(w.w); }
DI u32x4 pack8(const float* f) { u32x4 w; w.x = pk2(f[0], f[1]); w.y = pk2(f[2], f[3]); w.z = pk2(f[4], f[5]); w.w = pk2(f[6], f[7]); return w; }

DI void rowinfo(int m, int& b, int& pos, int& isctx) {
    if (m < TL) { b = m >> 13; pos = m & 8191; isctx = 0; } else { const int j = m - TL; b = j >> 8; pos = j & 255; isctx = 1; }
}

DI void phase_prologue(const Params& P, LAS unsigned char* lds) {
    const int tid = threadIdx.x, wave = tid >> 6, lane = tid & 63;
    LAS float* cond = (LAS float*)lds;
    LAS float* part = cond + 5 * 1024;
    const float* c = P.in[I_C]; const float* cc = P.in[I_CCTX];
    for (int i = tid; i < 5 * 1024; i += NTHREADS) { const int r = i >> 10, k = i & 1023; const float v = r < 4 ? c[r * 1024 + k] : cc[k]; cond[i] = v / (1.f + expf(-v)); }
    __syncthreads();
    float* MOD = (float*)(P.ws + WS_MOD);
    for (int item = blockIdx.x; item < 192; item += gridDim.x) {
        const int l = item / 96, j0 = (item % 96) * 64;
        const float* W = P.in[I_WADA] + (size_t)l * 1024 * 6144 + j0 + lane;
        float a0 = 0.f, a1 = 0.f, a2 = 0.f, a3 = 0.f, a4 = 0.f;
#pragma unroll 16
        for (int k = wave * 128; k < wave * 128 + 128; ++k) {
            const float w = W[(size_t)k * 6144];
            a0 += cond[k] * w; a1 += cond[1024 + k] * w; a2 += cond[2048 + k] * w; a3 += cond[3072 + k] * w; a4 += cond[4096 + k] * w;
        }
        part[(wave * 5 + 0) * 64 + lane] = a0; part[(wave * 5 + 1) * 64 + lane] = a1; part[(wave * 5 + 2) * 64 + lane] = a2;
        part[(wave * 5 + 3) * 64 + lane] = a3; part[(wave * 5 + 4) * 64 + lane] = a4;
        __syncthreads();
        if (tid < 320) { const int r = tid >> 6; float s = 0.f;
            for (int w = 0; w < 8; ++w) s += part[(w * 5 + r) * 64 + lane];
            MOD[(size_t)(l * 5 + r) * 6144 + j0 + lane] = s + P.in[I_BADA][l * 6144 + j0 + lane]; }
        __syncthreads();
    }
    { f32x2* ROPE = (f32x2*)(P.ws + WS_ROPE);
      for (int i = blockIdx.x * NTHREADS + tid; i < 192 * 8; i += gridDim.x * NTHREADS) { const int p = i >> 3, f = i & 7; const float pos = (float)(p < 128 ? p : p - 128);
          const float inv = powf(10000.0f, -(float)f * 0.125f); float s, co; sincosf(pos * inv, &s, &co); ROPE[i] = (f32x2){co, s}; } }
    f32x2* ROT = (f32x2*)(P.ws + WS_ROT);
    for (int i = blockIdx.x * NTHREADS + tid; i < 8448 * 64; i += gridDim.x * NTHREADS) {
        const int pos = i >> 6, j = i & 63;
        const float inv = 1.0f / powf(10000.0f, (float)j / 63.0f);
        const float ang = (float)pos * inv; float s, co; sincosf(ang, &s, &co);
        ROT[i] = (f32x2){co, s};
    }
}

DI int wmap(int id, int n) {
    switch (id) {
    case 1: if (n < 416) return n; if (n < 448) return 2464 + (n - 416); return -1;
    case 2: { if (n < 1536) return 416 + n;
              if (n < 2560) { const int base = n < 2048 ? 2496 : 3008; const int j = (n - 1536) & 511; const int hh = j >> 7, v = j & 127, g = v >> 3, e = v & 7;
                              const int d = e < 4 ? 4 * g + e : 64 + 4 * g + (e - 4); return base + hh * 128 + d; }
              return 3520 + (n - 2560); }
    case 3: if (n < 512) return 1952 + n; if (n < 1024) return 4032 + (n - 512); return 4544 + (n - 1024);
    case 4: if (n < 512) return (n >> 6) * 96 + (n & 63); { const int j = n - 512; return (j >> 5) * 96 + 64 + (j & 31); }
    case 5: if (n < 512) return (n >> 6) * 128 + (n & 63); { const int j = n - 512; return (j >> 6) * 128 + 64 + (j & 63); }
    case 6: { const int pn = n >> 8, bj = (n >> 7) & 1, j = n & 127; return bj * 2816 + 128 * pn + j; }
    default: return n;
    }
}
struct TJob { const float* W; int K, Nsrc; bf16_t* WT; int ndst, map_id; const float* kscale; };
DI void transpose_job(const TJob& J, LAS float* scr, int gw, int ngw, int lane) {
    const int nblk = J.ndst / 32, nitems = (J.K / 64) * nblk;
    for (int item = gw; item < nitems; item += ngw) {
        const int kb = item / nblk, nb = item % nblk, k0 = 64 * kb, n0 = 32 * nb;
        const int src = wmap(J.map_id, n0 + (lane & 31));
        float tv[32];
#pragma unroll
        for (int i = 0; i < 32; ++i) { const int kk = 2 * i + (lane >> 5); tv[i] = src >= 0 ? J.W[(size_t)(k0 + kk) * J.Nsrc + src] : 0.f; }
        if (J.kscale) {
#pragma unroll
            for (int i = 0; i < 32; ++i) tv[i] *= J.kscale[k0 + 2 * i + (lane >> 5)]; }
#pragma unroll
        for (int i = 0; i < 32; ++i) scr[(2 * i + (lane >> 5)) * 33 + (lane & 31)] = tv[i];
        asm volatile("s_waitcnt lgkmcnt(0)" ::: "memory");
        const int c = lane & 7;
#pragma unroll
        for (int j = 0; j < 4; ++j) { const int n = (lane >> 3) + 8 * j; const LAS float* s = scr + (8 * c) * 33 + n;
            u32x4 o; o.x = pk2(s[0 * 33], s[1 * 33]); o.y = pk2(s[2 * 33], s[3 * 33]); o.z = pk2(s[4 * 33], s[5 * 33]); o.w = pk2(s[6 * 33], s[7 * 33]);
            *(u32x4*)(J.WT + (size_t)(n0 + n) * J.K + k0 + 8 * c) = o; }
        asm volatile("s_waitcnt lgkmcnt(0)" ::: "memory");
    }
}
DI void phase_wconv_mixer(const Params& P, int l, LAS unsigned char* lds) {
    const int tid = threadIdx.x, wave = tid >> 6, lane = tid & 63, gw = blockIdx.x * NWAVES + wave, ngw = gridDim.x * NWAVES;
    LAS float* scr = (LAS float*)lds + wave * (64 * 33);
    bf16_t* WT = (bf16_t*)(P.ws + WS_WT);
    const float* win = P.in[I_WIN] + (size_t)l * 1024 * NIN;
    TJob j;
    j = TJob{win, 1024, NIN, WT + WT_IN, 512, 1, nullptr}; transpose_job(j, scr, gw, ngw, lane);
    j = TJob{win, 1024, NIN, WT + WT_IN + (size_t)512 * 1024, 3072, 2, nullptr}; transpose_job(j, scr, gw, ngw, lane);
    j = TJob{win, 1024, NIN, WT + WT_IN + (size_t)3584 * 1024, 4096, 3, nullptr}; transpose_job(j, scr, gw, ngw, lane);
    j = TJob{P.in[I_WQB] + (size_t)l * 256 * 768, 256, 768, WT + WT_QB, 768, 4, P.in[I_QNA] + l * 256}; transpose_job(j, scr, gw, ngw, lane);
    j = TJob{P.in[I_WKVB] + (size_t)l * 128 * 1024, 128, 1024, WT + WT_KVB, 1024, 5, P.in[I_KVNA] + l * 128}; transpose_job(j, scr, gw, ngw, lane);
    for (int n = 0; n < 3; ++n) { j = TJob{P.in[I_WBR] + ((size_t)l * 3 + n) * 512 * 1024, 512, 1024, WT + WT_BR + (size_t)n * 1024 * 512, 1024, 0, nullptr}; transpose_job(j, scr, gw, ngw, lane); }
    j = TJob{P.in[I_WOUT] + (size_t)l * 1024 * 1024, 1024, 1024, WT + WT_OUT, 1024, 0, nullptr}; transpose_job(j, scr, gw, ngw, lane);
}
DI void phase_wconv_ffn(const Params& P, int l, LAS unsigned char* lds) {
    const int tid = threadIdx.x, wave = tid >> 6, lane = tid & 63, gw = blockIdx.x * NWAVES + wave, ngw = gridDim.x * NWAVES;
    LAS float* scr = (LAS float*)lds + wave * (64 * 33);
    bf16_t* WT = (bf16_t*)(P.ws + WS_WT);
    TJob j;
    j = TJob{P.in[I_WF1] + (size_t)l * 1024 * 5632, 1024, 5632, WT + WT_F1, 5632, 6, nullptr}; transpose_job(j, scr, gw, ngw, lane);
    j = TJob{P.in[I_WF2] + (size_t)l * 2816 * 1024, 2816, 1024, WT + WT_F2, 1024, 0, nullptr}; transpose_job(j, scr, gw, ngw, lane);
}

DI void phase_norm(const float* __restrict__ hl, const float* __restrict__ hc, const float* __restrict__ nw, const float* __restrict__ MODl, int ishift, int iscale, bf16_t* __restrict__ A, int nrows) {
    const int tid = threadIdx.x, wave = tid >> 6, lane = tid & 63, gw = blockIdx.x * NWAVES + wave, ngw = gridDim.x * NWAVES;
    f32x4 nx[4];
#define NLOAD(dst, m_) do { const float* xr_ = (m_) >= TL ? hc + (size_t)((m_) - TL) * DM : hl + (size_t)(m_) * DM; \
        _Pragma("unroll") for (int j = 0; j < 4; ++j) dst[j] = *(const f32x4*)(xr_ + 4 * lane + 256 * j); } while (0)
    if (gw < nrows) NLOAD(nx, gw);
    for (int m = gw; m < nrows; m += ngw) {
        f32x4 v[4];
#pragma unroll
        for (int j = 0; j < 4; ++j) v[j] = nx[j];
        if (m + ngw < nrows) NLOAD(nx, m + ngw);
        int b, pos, isctx; rowinfo(m, b, pos, isctx);
        const float* mod = MODl + (size_t)(isctx ? 4 : b) * 6144;
        float ss = 0.f;
#pragma unroll
        for (int j = 0; j < 4; ++j) ss += (v[j].x * v[j].x + v[j].y * v[j].y) + (v[j].z * v[j].z + v[j].w * v[j].w);
        const float rstd = rsqrtf(wave_sum(ss) * (1.f / DM) + EPS);
#pragma unroll
        for (int j = 0; j < 4; ++j) { const int c = 4 * lane + 256 * j;
            const f32x4 w = *(const f32x4*)(nw + c), sh = *(const f32x4*)(mod + ishift * 1024 + c), sc = *(const f32x4*)(mod + iscale * 1024 + c);
            const f32x4 y = v[j] * rstd * w * (sc + 1.f) + sh;
            u32x2 o; o.x = pk2(y.x, y.y); o.y = pk2(y.z, y.w);
            *(u32x2*)(A + (size_t)m * DM + c) = o; }
    }
#undef NLOAD
}
#include <cstdlib>
#include <vector>

#define XB_TMO      128
#define XB_XCNT(j)  (256  + 64 * (j))
#define XB_XSUB(j)  (1280 + 64 * (j))
#define XB_XGEN(j)  (2304 + 64 * (j))
#define XB_TOP      3328
#define XB_TOPGEN   3392
#define XCD_BAR_WORDS 3456
#define XB_SPIN_CAP (1u << 18)

__device__ __forceinline__ unsigned xb_ld(unsigned* p)              { return __hip_atomic_load(p, __ATOMIC_RELAXED, __HIP_MEMORY_SCOPE_AGENT); }
__device__ __forceinline__ unsigned xb_add(unsigned* p, unsigned v) { return __hip_atomic_fetch_add(p, v, __ATOMIC_RELAXED, __HIP_MEMORY_SCOPE_AGENT); }
__device__ __forceinline__ unsigned xb_xcc_id() { return (unsigned)__builtin_amdgcn_s_getreg((3 << 11) | 20) & 0xFu; }
#define XB_SPIN(cond, bar) do { unsigned _sp = 0; while (cond) { __builtin_amdgcn_s_sleep(1); \
    if ((++_sp & 255u) == 0u) { if (xb_ld(&(bar)[XB_TMO])) break; if (_sp > XB_SPIN_CAP) { atomicAdd(&(bar)[XB_TMO], 1u); break; } } } } while (0)

struct XcdBarrier {
    unsigned* bar; unsigned x;
    volatile LAS unsigned* st;
};

__device__ __forceinline__ XcdBarrier xcd_barrier_post(unsigned* bar, volatile LAS unsigned* st) {
    XcdBarrier b; b.bar = bar; b.x = xb_xcc_id(); b.st = st;
    if (threadIdx.x == 0) (void)xb_add(&bar[XB_XCNT(b.x)], 1u);
    return b;
}
__device__ __forceinline__ void xcd_barrier_complete(unsigned* bar, unsigned x, unsigned& nloc, unsigned& nx) {
    const unsigned G = gridDim.x * gridDim.y * gridDim.z;
    unsigned sum, cnt, mine, sp = 0u;
    for (;;) {
        sum = 0u; cnt = 0u; mine = 0u;
#pragma unroll
        for (unsigned j = 0; j < 16; ++j) { const unsigned c = xb_ld(&bar[XB_XCNT(j)]); sum += c; cnt += (c > 0u) ? 1u : 0u; mine = (j == x) ? c : mine; }
        if (sum == G) break;
        __builtin_amdgcn_s_sleep(1);
        if ((++sp & 255u) == 0u) { if (xb_ld(&bar[XB_TMO])) break; if (sp > XB_SPIN_CAP) { atomicAdd(&bar[XB_TMO], 1u); break; } }
    }
    nloc = mine > 0u ? mine : 1u; nx = cnt > 0u ? cnt : 1u;
}

__device__ __forceinline__ void xcd_barrier(const XcdBarrier& b) {
    asm volatile("s_waitcnt vmcnt(0)" ::: "memory");
    __syncthreads();
    if (threadIdx.x == 0) {
        unsigned* bar = b.bar;
        __builtin_amdgcn_s_waitcnt(0);
        unsigned nloc = b.st[0], nx = b.st[1];
        if (nloc == 0u) { xcd_barrier_complete(bar, b.x, nloc, nx); b.st[0] = nloc; b.st[1] = nx; }
        const unsigned old = xb_add(&bar[XB_XSUB(b.x)], 1u);
        const unsigned gen = old / nloc;
        if (old + 1u == (gen + 1u) * nloc) {
            __builtin_amdgcn_fence(__ATOMIC_RELEASE, "agent");
            asm volatile("s_waitcnt vmcnt(0)" ::: "memory");
            const unsigned og = xb_add(&bar[XB_TOP], 1u);
            const unsigned tg = og / nx;
            if (og + 1u == (tg + 1u) * nx) xb_add(&bar[XB_TOPGEN], 1u);
            else XB_SPIN(xb_ld(&bar[XB_TOPGEN]) == tg, bar);
            __builtin_amdgcn_fence(__ATOMIC_ACQUIRE, "agent");
            xb_add(&bar[XB_XGEN(b.x)], 1u);
            asm volatile("s_waitcnt vmcnt(0)" ::: "memory");
        } else {
            XB_SPIN(xb_ld(&bar[XB_XGEN(b.x)]) == gen, bar);
            __builtin_amdgcn_fence(__ATOMIC_ACQUIRE, "agent");
            asm volatile("s_waitcnt vmcnt(0)" ::: "memory");
        }
    }
    __syncthreads();
}

enum { EM_PLAIN = 0, EM_KV, EM_BIG, EM_GATES, EM_BRANCH, EM_RES, EM_FFNIN, EM_INPROJ };
template <int MODE> struct Epi {
    static constexpr bool PERM = true, AFTER_DRAIN = false;
    bf16_t* O0; int ld0; bf16_t* O1; int ld1;
    const bf16_t* Gsrc;
    const float* fa;
    const float* hin_l; const float* hin_c; float* hout_l; float* hout_c;
    int ipar;
    DI void emit(int row, int col, f32x4 v0, f32x4 v1) const {
        float f[8] = {v0[0], v0[1], v0[2], v0[3], v1[0], v1[1], v1[2], v1[3]};
        if (MODE == EM_INPROJ) {
            if (col < 512) { *(u32x4*)(O1 + (size_t)row * 512 + col) = pack8(f); return; }
            col -= 512;
        }
        if (MODE == EM_PLAIN) {
            *(u32x4*)(O0 + (size_t)row * ld0 + col) = pack8(f);
        } else if (MODE == EM_KV) {
            if (col < 512) *(u32x4*)(O0 + (size_t)row * 768 + col) = pack8(f);
            else           *(u32x4*)(O1 + (size_t)row * 512 + (col - 512)) = pack8(f);
        } else if (MODE == EM_FFNIN) {
            if (col < DFF) *(u32x4*)(O0 + (size_t)row * DFF + col) = pack8(f);
            else           *(u32x4*)(O1 + (size_t)row * DFF + (col - DFF)) = pack8(f);
        } else if (MODE == EM_BIG || MODE == EM_INPROJ) {
            const float QS = 0.08838834764831845f;
            if (col < 512) { for (int i = 0; i < 8; ++i) f[i] *= QS; }
            else if (col >= 1536 && col < 2560) {
                int b, pos, isctx; rowinfo(row, b, pos, isctx);
                const int sp = isctx ? pos : CTX + pos;
                const int g = ((col - 1536) & 127) >> 3;
                const f32x2* rot = (const f32x2*)fa + (size_t)sp * 64 + 4 * g;
                const float sc = col >= 2048 ? QS : 1.f;
#pragma unroll
                for (int e = 0; e < 4; ++e) { const f32x2 cs = rot[e]; const float x1 = f[e], x2 = f[4 + e];
                    f[e] = (x1 * cs.x - x2 * cs.y) * sc; f[4 + e] = (x1 * cs.y + x2 * cs.x) * sc; }
            }
            *(u32x4*)(O0 + (size_t)row * 3072 + col) = pack8(f);
        } else if (MODE == EM_GATES) {
            if (col < 1024) {
                bf16_t* p = O1 + (size_t)row * 1024 + col; float on[8]; unpack8(*(const u32x4*)p, on);
#pragma unroll
                for (int i = 0; i < 8; ++i) f[i] = on[i] * f[i] * sigmoidf_(f[i]);
                *(u32x4*)p = pack8(f);
            } else {
                const int cc = col - 1024; const f32x4 b0 = *(const f32x4*)(fa + cc), b1 = *(const f32x4*)(fa + cc + 4);
                const float bb[8] = {b0[0], b0[1], b0[2], b0[3], b1[0], b1[1], b1[2], b1[3]};
#pragma unroll
                for (int i = 0; i < 8; ++i) f[i] = sigmoidf_(f[i] + bb[i]);
                *(u32x4*)(O0 + (size_t)row * 3072 + cc) = pack8(f);
            }
        } else if (MODE == EM_BRANCH) {
            float g[8]; unpack8(*(const u32x4*)(Gsrc + (size_t)row * 3072 + col), g);
            bf16_t* p = O0 + (size_t)row * 1024 + col;
            if (ipar > 0) { float pr[8]; unpack8(*(const u32x4*)p, pr);
#pragma unroll
                for (int i = 0; i < 8; ++i) f[i] = pr[i] + g[i] * f[i]; }
            else {
#pragma unroll
                for (int i = 0; i < 8; ++i) f[i] = g[i] * f[i]; }
            *(u32x4*)p = pack8(f);
        } else if (MODE == EM_RES) {
            int b, pos, isctx; rowinfo(row, b, pos, isctx);
            const float* hi_ = isctx ? hin_c + (size_t)(row - TL) * DM : hin_l + (size_t)row * DM;
            float* ho_ = isctx ? hout_c + (size_t)(row - TL) * DM : hout_l + (size_t)row * DM;
            const float* mod = fa + (size_t)(isctx ? 4 : b) * 6144 + ipar * 1024 + col;
            const f32x4 m0 = *(const f32x4*)mod, m1 = *(const f32x4*)(mod + 4);
            const f32x4 h0 = *(const f32x4*)(hi_ + col), h1 = *(const f32x4*)(hi_ + col + 4);
            *(f32x4*)(ho_ + col) = h0 + m0 * v0; *(f32x4*)(ho_ + col + 4) = h1 + m1 * v1;
        }
    }
    DI void operator()(const pg8::f32x4 (&acc)[2][2][4][2], const pg8::Unit& u, int wr, int wc, int fr, int fq) const {
#pragma unroll
        for (int ai = 0; ai < 2; ++ai)
#pragma unroll
            for (int m = 0; m < 4; ++m) { const int row = u.pm * 256 + ai * 128 + wr * 64 + m * 16 + fr;
#pragma unroll
                for (int bj = 0; bj < 2; ++bj) { const int col = u.pn * 256 + bj * 128 + wc * 32 + 8 * fq;
                    emit(row, col, acc[ai][bj][m][0], acc[ai][bj][m][1]); } }
    }
};

DI float dpp_ror1(float x) { return __int_as_float(__builtin_amdgcn_update_dpp(0, __float_as_int(x), 0x121, 0xf, 0xf, false)); }
DI float dpp_ror15(float x) { return __int_as_float(__builtin_amdgcn_update_dpp(0, __float_as_int(x), 0x12F, 0xf, 0xf, false)); }
DI float gelu_gate(float x, float u) { const float t2 = (-1.5957691216057308f * 1.4426950408889634f) * (x + 0.044715f * x * x * x); return x * __builtin_amdgcn_rcpf(1.f + __builtin_amdgcn_exp2f(t2)) * u; }
struct EpiFfnConv {
    static constexpr bool PERM = true, AFTER_DRAIN = false;
    bf16_t* ACT; float* HALO; const float* wdw; const float* bdw; LAS float* X;
    DI void operator()(const pg8::f32x4 (&acc)[2][2][4][2], const pg8::Unit& u, int wr, int wc, int fr, int fq) const {
        const int ch = 128 * u.pn + 32 * wc + 8 * fq, xc = 32 * wc + 8 * fq;
        float w0[8], w1[8], w2[8], bb[8];
#pragma unroll
        for (int k = 0; k < 8; ++k) { w0[k] = wdw[ch + k]; w1[k] = wdw[DFF + ch + k]; w2[k] = wdw[2 * DFF + ch + k]; bb[k] = bdw[ch + k]; }
#pragma unroll
        for (int ai = 0; ai < 2; ++ai) {
            if (fr == 0) {
#pragma unroll
                for (int k = 0; k < 8; ++k) X[((ai * 2 + wr) * 2 + 0) * 128 + xc + k] = acc[ai][0][0][k >> 2][k & 3]; }
            if (fr == 15) {
#pragma unroll
                for (int k = 0; k < 8; ++k) X[((ai * 2 + wr) * 2 + 1) * 128 + xc + k] = acc[ai][0][3][k >> 2][k & 3]; }
        }
        asm volatile("s_waitcnt lgkmcnt(0)" ::: "memory"); __builtin_amdgcn_s_barrier(); asm volatile("" ::: "memory");
        const bool first_tile_row_is_seq_start = (u.pm >= TL / 256) || ((u.pm & 31) == 0);
        const bool last_tile_row_is_seq_end = (u.pm >= TL / 256) || ((u.pm & 31) == 31);
#pragma unroll
        for (int ai = 0; ai < 2; ++ai) {
            float top[8], bot[8];
            { const int tsel = wr == 1 ? ((ai * 2 + 0) * 2 + 1) : ((0 * 2 + 1) * 2 + 1);
              const bool tval = (wr == 1) || (ai == 1);
              const int bsel = wr == 0 ? ((ai * 2 + 1) * 2 + 0) : ((1 * 2 + 0) * 2 + 0);
              const bool bval = (wr == 0) || (ai == 0);
#pragma unroll
              for (int k = 0; k < 8; ++k) { top[k] = tval ? X[tsel * 128 + xc + k] : 0.f; bot[k] = bval ? X[bsel * 128 + xc + k] : 0.f; } }
#pragma unroll
            for (int m = 0; m < 4; ++m) {
                const int row = u.pm * 256 + ai * 128 + wr * 64 + m * 16 + fr;
                float o[8], xs[8];
#pragma unroll
                for (int k = 0; k < 8; ++k) {
                    const float g = acc[ai][0][m][k >> 2][k & 3], up = acc[ai][1][m][k >> 2][k & 3];
                    const float pa = dpp_ror1(g);
                    const float pb = m > 0 ? dpp_ror1(acc[ai][0][m > 0 ? m - 1 : 0][k >> 2][k & 3]) : top[k];
                    const float na = dpp_ror15(g);
                    const float nb = m < 3 ? dpp_ror15(acc[ai][0][m < 3 ? m + 1 : 3][k >> 2][k & 3]) : bot[k];
                    const float gp = fr > 0 ? pa : pb, gn = fr < 15 ? na : nb;
                    const float x = w0[k] * gp + w1[k] * g + w2[k] * gn + bb[k];
                    xs[k] = x; o[k] = gelu_gate(x, up);
                }
                *(u32x4*)(ACT + (size_t)row * DFF + ch) = pack8(o);
                if (ai == 0 && m == 0 && wr == 0 && fr == 0 && !first_tile_row_is_seq_start) { float* h = HALO + ((size_t)u.pm * 6 + 0) * DFF + ch;
#pragma unroll
                    for (int k = 0; k < 8; ++k) { h[k] = acc[0][0][0][k >> 2][k & 3]; h[DFF + k] = xs[k]; h[2 * DFF + k] = acc[0][1][0][k >> 2][k & 3]; } }
                if (ai == 1 && m == 3 && wr == 1 && fr == 15 && !last_tile_row_is_seq_end) { float* h = HALO + ((size_t)u.pm * 6 + 3) * DFF + ch;
#pragma unroll
                    for (int k = 0; k < 8; ++k) { h[k] = acc[1][0][3][k >> 2][k & 3]; h[DFF + k] = xs[k]; h[2 * DFF + k] = acc[1][1][3][k >> 2][k & 3]; } }
            }
        }
    }
};
DI void convfix_tile(const Params& P, int l, int pm) {
    if (pm >= TL / 256) return;
    bf16_t* ACT = (bf16_t*)(P.ws + WS_G); const float* HALO = (const float*)(P.ws + WS_U);
    const float* wdw = P.in[I_WDW] + (size_t)l * 3 * DFF;
    for (int c = threadIdx.x; c < 2 * DFF; c += NTHREADS) {
        const int which = c >= DFF, ch = which ? c - DFF : c;
        if (which == 0) {
            if ((pm & 31) == 0) continue;
            const float* hf = HALO + ((size_t)pm * 6 + 0) * DFF + ch; const float g_prev = HALO[((size_t)(pm - 1) * 6 + 3) * DFF + ch];
            ACT[(size_t)(pm * 256) * DFF + ch] = f2bf(gelu_gate(hf[DFF] + wdw[ch] * g_prev, hf[2 * DFF]));
        } else {
            if ((pm & 31) == 31) continue;
            const float* hl = HALO + ((size_t)pm * 6 + 3) * DFF + ch; const float g_next = HALO[((size_t)(pm + 1) * 6 + 0) * DFF + ch];
            ACT[(size_t)(pm * 256 + 255) * DFF + ch] = f2bf(gelu_gate(hl[DFF] + wdw[2 * DFF + ch] * g_next, hl[2 * DFF]));
        }
    }
}
DI void phase_convfix_mine(const Params& P, int l, int M) {
    pg8::StaticOrder S; S.init(M, 1024, (int)gridDim.x, (int)blockIdx.x);
    pg8::Unit u; int prev = -1;
    for (int i = 0; S.next(i, u); ++i) { if (u.pm != prev) convfix_tile(P, l, u.pm); prev = u.pm; }
    asm volatile("s_waitcnt vmcnt(0)" ::: "memory");
    __syncthreads();
}
template <int MODE>
DI void run_gemm(LAS unsigned char* lds, const bf16_t* A, int lda, const bf16_t* Bt, int M, int N, int K, const Epi<MODE>& E) {
    int Kop = K; if (K < 512) asm volatile("" : "+s"(Kop));
    pg8::Gemm g{A, Bt, M, N, Kop, lda}; pg8::StaticOrder S; S.init(M, N, (int)gridDim.x, (int)blockIdx.x);
    pg8::gemm_phase<Epi<MODE>, pg8::StaticOrder, true, true>((PG8_LAS unsigned char*)lds, g, S, E);
}
DI void run_gemm_ffnconv(LAS unsigned char* lds, const bf16_t* A, const bf16_t* Bt, int M, const EpiFfnConv& E) {
    pg8::Gemm g{A, Bt, M, 5632, 1024, 1024}; pg8::StaticOrder S; S.init(M, 5632, (int)gridDim.x, (int)blockIdx.x);
    pg8::gemm_phase<EpiFfnConv, pg8::StaticOrder, true, true>((PG8_LAS unsigned char*)lds, g, S, E);
}

DI void phase_qkpost(const Params& P, int l, LAS unsigned* lmax, const bool probe = false) {
    const int tid = threadIdx.x, wave = tid >> 6, lane = tid & 63, gw = blockIdx.x * NWAVES + wave, ngw = gridDim.x * NWAVES;
    const bf16_t* __restrict__ SM = (const bf16_t*)(P.ws + WS_SM); bf16_t* __restrict__ Q = (bf16_t*)(P.ws + WS_Q); bf16_t* __restrict__ K = (bf16_t*)(P.ws + WS_K); bf16_t* __restrict__ V = (bf16_t*)(P.ws + WS_V);
    const f32x2* __restrict__ ROPE = (const f32x2*)(P.ws + WS_ROPE);
    const float* qn = P.in[I_QN] + l * 96; const float* kn = P.in[I_KN] + l * 96;
    const int s = lane & 7, h = lane >> 3;
    float qnw[12], knw[12];
#pragma unroll
    for (int i = 0; i < 8; ++i) { qnw[i] = qn[8 * s + i]; knw[i] = kn[8 * s + i]; }
#pragma unroll
    for (int i = 0; i < 4; ++i) { qnw[8 + i] = qn[64 + 4 * s + i]; knw[8 + i] = kn[64 + 4 * s + i]; }
    const bool second = (s & 2) != 0;
    constexpr float QC = 0.10206207261596575f * 1.4426950408889634f;
    if (tid < 64) lmax[tid] = 0u;
    __syncthreads();
    u32x2 n_cq, n_kr, n_qr; unsigned n_ckv; u32x4 n_qn, n_kn, n_v;
#define QLOAD(m_) do { const bf16_t* sm_ = SM + (size_t)(m_) * 512; n_cq = *(const u32x2*)(sm_ + 4 * lane); n_ckv = *(const unsigned*)(sm_ + 256 + 2 * lane); n_kr = *(const u32x2*)(sm_ + 384 + 4 * s); \
        n_qn = *(const u32x4*)(Q + (size_t)(m_) * 768 + 64 * h + 8 * s); n_qr = *(const u32x2*)(Q + (size_t)(m_) * 768 + 512 + 32 * h + 4 * s); \
        n_kn = *(const u32x4*)(K + (size_t)(m_) * 768 + 64 * h + 8 * s); n_v = *(const u32x4*)(V + (size_t)(m_) * 512 + 8 * lane); } while (0)
    if (gw < TA) QLOAD(gw);
    for (int m = gw; m < TA; m += ngw) {
        const u32x2 cq = n_cq, krr = n_kr, qrr = n_qr; const unsigned ckv = n_ckv; const u32x4 qnn = n_qn, knn = n_kn, vraw = n_v;
        if (m + ngw < TA) QLOAD(m + ngw);
        int b, pos, isctx; rowinfo(m, b, pos, isctx);
        float a0 = bflo(cq.x), a1 = bfhi(cq.x), a2 = bflo(cq.y), a3 = bfhi(cq.y), c0 = bflo(ckv), c1 = bfhi(ckv);
        const float s_q = rsqrtf(wave_sum(a0 * a0 + a1 * a1 + a2 * a2 + a3 * a3) * (1.f / 256.f) + EPS);
        const float s_kv = rsqrtf(wave_sum(c0 * c0 + c1 * c1) * (1.f / 128.f) + EPS);
        float cs[4], sn[4];
        if (!isctx) { const f32x2* rp = ROPE + ((s < 4) ? (pos >> 6) : 128 + (pos & 63)) * 8 + 4 * (s & 1);
#pragma unroll
            for (int e = 0; e < 4; ++e) { const f32x2 t = rp[e]; cs[e] = t.x; sn[e] = t.y; } }
        else {
#pragma unroll
            for (int e = 0; e < 4; ++e) { cs[e] = 1.f; sn[e] = 0.f; } }
        {
            bf16_t* qp = (probe ? (bf16_t*)(P.ws + WS_R4) : Q) + (size_t)m * 768;
            float z[12]; unpack8(qnn, z);
            z[8] = bflo(qrr.x); z[9] = bfhi(qrr.x); z[10] = bflo(qrr.y); z[11] = bfhi(qrr.y);
            float ss = 0.f;
#pragma unroll
            for (int i = 0; i < 12; ++i) { z[i] *= s_q; ss += z[i] * z[i]; }
            ss += __shfl_xor(ss, 1); ss += __shfl_xor(ss, 2); ss += __shfl_xor(ss, 4);
            const float r = rsqrtf(ss * (1.f / 96.f) + EPS);
#pragma unroll
            for (int i = 0; i < 12; ++i) z[i] *= r * qnw[i] * QC;
            { float n2 = 0.f;
#pragma unroll
              for (int i = 0; i < 12; ++i) n2 += z[i] * z[i];
              n2 += __shfl_xor(n2, 1); n2 += __shfl_xor(n2, 2); n2 += __shfl_xor(n2, 4);
              if (s == 0 && !probe) atomicMax((unsigned*)&lmax[(b * 8 + h) * 2], __float_as_uint(n2)); }
#pragma unroll
            for (int e = 0; e < 4; ++e) { const float mine = z[8 + e], other = __shfl_xor(mine, 2);
                z[8 + e] = second ? (other * sn[e] + mine * cs[e]) : (mine * cs[e] - other * sn[e]); }
            *(u32x4*)(qp + 64 * h + 8 * s) = pack8(z);
            u32x2 o; o.x = pk2(z[8], z[9]); o.y = pk2(z[10], z[11]); *(u32x2*)(qp + 512 + 32 * h + 4 * s) = o;
        }
        {
            bf16_t* kp = (probe ? (bf16_t*)(P.ws + WS_R4) + (size_t)TA * 768 : K) + (size_t)m * 768;
            float z[12]; unpack8(knn, z);
#pragma unroll
            for (int i = 0; i < 8; ++i) z[i] *= s_kv;
            z[8] = bflo(krr.x); z[9] = bfhi(krr.x); z[10] = bflo(krr.y); z[11] = bfhi(krr.y);
            float ss = 0.f;
#pragma unroll
            for (int i = 0; i < 12; ++i) ss += z[i] * z[i];
            ss += __shfl_xor(ss, 1); ss += __shfl_xor(ss, 2); ss += __shfl_xor(ss, 4);
            const float r = rsqrtf(ss * (1.f / 96.f) + EPS);
#pragma unroll
            for (int i = 0; i < 12; ++i) z[i] *= r * knw[i];
            { float n2 = 0.f;
#pragma unroll
              for (int i = 0; i < 12; ++i) n2 += z[i] * z[i];
              n2 += __shfl_xor(n2, 1); n2 += __shfl_xor(n2, 2); n2 += __shfl_xor(n2, 4);
              if (s == 0 && !probe) atomicMax((unsigned*)&lmax[(b * 8 + h) * 2 + 1], __float_as_uint(n2)); }
#pragma unroll
            for (int e = 0; e < 4; ++e) { const float mine = z[8 + e], other = __shfl_xor(mine, 2);
                z[8 + e] = second ? (other * sn[e] + mine * cs[e]) : (mine * cs[e] - other * sn[e]); }
            *(u32x4*)(kp + 64 * h + 8 * s) = pack8(z);
            u32x2 o; o.x = pk2(z[8], z[9]); o.y = pk2(z[10], z[11]); *(u32x2*)(kp + 512 + 32 * h + 4 * s) = o;
            float vv[8]; unpack8(vraw, vv);
#pragma unroll
            for (int i = 0; i < 8; ++i) vv[i] *= s_kv;
            *(u32x4*)((probe ? (bf16_t*)(P.ws + WS_R4) + (size_t)TA * 1536 : V) + (size_t)m * 512 + 8 * lane) = pack8(vv);
        }
    }
#undef QLOAD
    __syncthreads();
    if (tid < 64 && !probe) atomicMax((unsigned*)(P.ws + WS_QKM) + tid, lmax[tid]);
}

DI void phase_scanpost(const Params& P, int l, int nrows, const bool probe = false) {
    const int tid = threadIdx.x, wave = tid >> 6, lane = tid & 63, gw = blockIdx.x * NWAVES + wave, ngw = gridDim.x * NWAVES;
    bf16_t* __restrict__ OF = (bf16_t*)(P.ws + WS_OF); const bf16_t* __restrict__ OB = (const bf16_t*)(P.ws + WS_OB);
    const float* gw_ = P.in[I_GON] + l * 128;
    const int sub = lane & 7, hd = lane >> 3;
    float w[16];
#pragma unroll
    for (int i = 0; i < 16; ++i) w[i] = hd < 4 ? gw_[16 * sub + i] : 1.f;
    u32x4 nf0, nf1, nb0, nb1;
#define PLOAD(m_) do { const bf16_t* pf_ = OF + (size_t)(m_) * 1024 + 16 * lane; const bf16_t* pb_ = OB + (size_t)(m_) * 1024 + 16 * lane; \
        nf0 = *(const u32x4*)pf_; nf1 = *(const u32x4*)(pf_ + 8); nb0 = *(const u32x4*)pb_; nb1 = *(const u32x4*)(pb_ + 8); } while (0)
    if (gw < nrows) PLOAD(gw);
    for (int m = gw; m < nrows; m += ngw) {
        float a[16], bq[16];
        unpack8(nf0, a); unpack8(nf1, a + 8); unpack8(nb0, bq); unpack8(nb1, bq + 8);
        if (m + ngw < nrows) PLOAD(m + ngw);
        float ss = 0.f;
#pragma unroll
        for (int i = 0; i < 16; ++i) { a[i] += bq[i]; ss += a[i] * a[i]; }
        ss += __shfl_xor(ss, 1); ss += __shfl_xor(ss, 2); ss += __shfl_xor(ss, 4);
        const float r = rsqrtf(ss * (1.f / 128.f) + EPS);
#pragma unroll
        for (int i = 0; i < 16; ++i) a[i] *= r * w[i];
        bf16_t* pf = (probe ? (bf16_t*)(P.ws + WS_R4) : OF) + (size_t)m * 1024 + 16 * lane;
        *(u32x4*)pf = pack8(a); *(u32x4*)(pf + 8) = pack8(a + 8);
    }
#undef PLOAD
}

DI void phase_conv(const Params& P, int l, int nrows) {
    const bf16_t* __restrict__ G = (const bf16_t*)(P.ws + WS_G); bf16_t* __restrict__ U = (bf16_t*)(P.ws + WS_U);
    const float* __restrict__ wdw = P.in[I_WDW] + (size_t)l * 3 * DFF; const float* __restrict__ bdw = P.in[I_BDW] + (size_t)l * DFF;
    const int total = (nrows / 4) * 352;
    for (int i = blockIdx.x * NTHREADS + threadIdx.x; i < total; i += gridDim.x * NTHREADS) {
        const int quad = i / 352, c = (i - quad * 352) * 8, m0 = quad * 4;
        int b, pos, isctx; rowinfo(m0, b, pos, isctx);
        const int last = isctx ? CTX - 1 : SEQ - 1;
        u32x4 g[6], u[4];
#pragma unroll
        for (int r = 0; r < 4; ++r) { g[r + 1] = *(const u32x4*)(G + (size_t)(m0 + r) * DFF + c); u[r] = *(const u32x4*)(U + (size_t)(m0 + r) * DFF + c); }
        g[0] = pos > 0 ? *(const u32x4*)(G + (size_t)(m0 - 1) * DFF + c) : (u32x4){0u, 0u, 0u, 0u};
        g[5] = pos + 3 < last ? *(const u32x4*)(G + (size_t)(m0 + 4) * DFF + c) : (u32x4){0u, 0u, 0u, 0u};
        float w0[8], w1[8], w2[8], bb[8];
#pragma unroll
        for (int k = 0; k < 8; ++k) { w0[k] = wdw[c + k]; w1[k] = wdw[DFF + c + k]; w2[k] = wdw[2 * DFF + c + k]; bb[k] = bdw[c + k]; }
#pragma unroll
        for (int r = 0; r < 4; ++r) {
            float a0[8], a1[8], a2[8], uu[8], o[8];
            unpack8(g[r], a0); unpack8(g[r + 1], a1); unpack8(g[r + 2], a2); unpack8(u[r], uu);
#pragma unroll
            for (int k = 0; k < 8; ++k) {
                const float x = w0[k] * a0[k] + w1[k] * a1[k] + w2[k] * a2[k] + bb[k];
                const float t2 = 1.5957691216057308f * (x + 0.044715f * x * x * x);
                o[k] = x / (1.f + __expf(-t2)) * uu[k];
            }
            *(u32x4*)(U + (size_t)(m0 + r) * DFF + c) = pack8(o);
        }
    }
}

namespace att {
constexpr int NW = 8, QBLK = 32, KVBLK = 64;
constexpr float SCALE = 0.10206207261596575f;
constexpr float THR = 8.f;
constexpr int SHM_V = 64 * 128 * 2, SHM_K = 64 * 256, SHM_ATTN = 2 * SHM_V + 2 * SHM_K + NW * 64 * 4;
#define KSWZ(row, colB) ((row) * 256 + ((colB) ^ (((row) & 7) << 4)))
#define SBAR() __builtin_amdgcn_sched_barrier(0)
DI int crow(int r, int hi) { return (r & 3) + 8 * (r >> 2) + 4 * hi; }
DI unsigned cvtpk(float lo, float hi) { unsigned r; asm volatile("v_cvt_pk_bf16_f32 %0, %1, %2" : "=v"(r) : "v"(lo), "v"(hi)); return r; }
DI bf16x8 ld8(const bf16_t* p) { return *reinterpret_cast<const bf16x8*>(p); }

constexpr float THR2 = 11.5f;
DI void partialSM(f32x16& p0, f32x16& p1, float& m_reg, float& mn, float& alpha) {
  float pmax = p0[0]; for (int r = 1; r < 16; ++r) pmax = fmaxf(pmax, p0[r]); for (int r = 0; r < 16; ++r) pmax = fmaxf(pmax, p1[r]);
  { auto rr = __builtin_amdgcn_permlane32_swap(__float_as_uint(pmax), __float_as_uint(pmax), false, false);
    pmax = fmaxf(__uint_as_float(rr[0]), __uint_as_float(rr[1])); }
  if (__builtin_expect(__all(pmax - m_reg <= THR2), 1)) { mn = m_reg; alpha = 1.f; }
  else { mn = fmaxf(m_reg, pmax); alpha = __builtin_amdgcn_exp2f(m_reg - mn); m_reg = mn; }
  for (int r = 0; r < 16; ++r) p0[r] -= mn; for (int r = 0; r < 16; ++r) p1[r] -= mn;
  for (int r = 0; r < 16; ++r) p0[r] = __builtin_amdgcn_exp2f(p0[r]);
}
DI void partialSM_fix(f32x16& p0) { for (int r = 0; r < 16; ++r) p0[r] = __builtin_amdgcn_exp2f(p0[r]); }
DI void finishSM(f32x16& p0, f32x16& p1, float alpha, float& l_reg, bf16x8& pa0, bf16x8& pa1, bf16x8& pa2, bf16x8& pa3) {
  for (int r = 0; r < 16; ++r) p1[r] = __builtin_amdgcn_exp2f(p1[r]);
  float ps = 0; for (int r = 0; r < 16; ++r) ps += p0[r]; for (int r = 0; r < 16; ++r) ps += p1[r];
  { auto rr = __builtin_amdgcn_permlane32_swap(__float_as_uint(ps), __float_as_uint(ps), false, false);
    ps = __uint_as_float(rr[0]) + __uint_as_float(rr[1]); }
  l_reg = l_reg * alpha + ps;
#define PK4(P, BASE, OUT) do { unsigned a0 = cvtpk(P[BASE + 0], P[BASE + 1]), a1 = cvtpk(P[BASE + 2], P[BASE + 3]);   \
    unsigned b0 = cvtpk(P[BASE + 4], P[BASE + 5]), b1 = cvtpk(P[BASE + 6], P[BASE + 7]);                              \
    auto r0 = __builtin_amdgcn_permlane32_swap(a0, b0, false, false); auto r1 = __builtin_amdgcn_permlane32_swap(a1, b1, false, false); \
    u32x4 w = {r0[0], r1[0], r0[1], r1[1]}; OUT = *reinterpret_cast<bf16x8*>(&w); } while (0)
  PK4(p0, 0, pa0); PK4(p0, 8, pa1); PK4(p1, 0, pa2); PK4(p1, 8, pa3);
#undef PK4
}
template <bool FIX>
DI void qkt(f32x16& p0, f32x16& p1, const char* Ks, const bf16x8* qr, int r32, int hi, const f32x16& init) {
  const f32x16 zero = {};
#pragma unroll
  for (int d0 = 0; d0 < 6; ++d0) { int cb = (d0 * 16 + hi * 8) * 2;
    bf16x8 b0 = *reinterpret_cast<const bf16x8*>(Ks + KSWZ(r32, cb));
    bf16x8 b1 = *reinterpret_cast<const bf16x8*>(Ks + KSWZ(32 + r32, cb));
    p0 = __builtin_amdgcn_mfma_f32_32x32x16_bf16(b0, qr[d0], d0 == 0 ? zero : p0, 0, 0, 0);
    p1 = __builtin_amdgcn_mfma_f32_32x32x16_bf16(b1, qr[d0], d0 == 0 ? zero : p1, 0, 0, 0); }
}
DI int v_st(int k, int c) { const int kk = (k & ~0xC) | ((k & 4) << 1) | ((k & 8) >> 1); return ((kk >> 3) * 4 + (c >> 5)) * 512 + ((kk & 7) * 32 + (c & 31)) * 2; }
DI int v_rd_base(int lane) { return ((lane & 3) << 3) | (((lane >> 2) & 3) << 6) | (((lane >> 4) & 1) << 5) | (((lane >> 5) & 1) << 8); }
constexpr int v_rd_off(int d0, int ks, int half) { return d0 * 512 + ks * 4096 + half * 2048; }
template <int OFF> DI s16x4 tr_read(int vb) {
  s16x4 r; asm volatile("ds_read_b64_tr_b16 %0, %1 offset:%2" : "=&v"(r) : "v"(vb), "i"(OFF) : "memory"); return r;
}
template <int D0> DI void pv_one(f32x16& od, int vb, bf16x8 pa0, bf16x8 pa1, bf16x8 pa2, bf16x8 pa3) {
  const s16x4 l0 = tr_read<v_rd_off(D0, 0, 0)>(vb), h0 = tr_read<v_rd_off(D0, 0, 1)>(vb), l1 = tr_read<v_rd_off(D0, 1, 0)>(vb), h1 = tr_read<v_rd_off(D0, 1, 1)>(vb);
  const s16x4 l2 = tr_read<v_rd_off(D0, 2, 0)>(vb), h2 = tr_read<v_rd_off(D0, 2, 1)>(vb), l3 = tr_read<v_rd_off(D0, 3, 0)>(vb), h3 = tr_read<v_rd_off(D0, 3, 1)>(vb);
  asm volatile("s_waitcnt lgkmcnt(0)" ::: "memory"); SBAR();
#define PK(L, H) (bf16x8){L[0], L[1], L[2], L[3], H[0], H[1], H[2], H[3]}
  od = __builtin_amdgcn_mfma_f32_32x32x16_bf16(pa0, PK(l0, h0), od, 0, 0, 0);
  od = __builtin_amdgcn_mfma_f32_32x32x16_bf16(pa1, PK(l1, h1), od, 0, 0, 0);
  od = __builtin_amdgcn_mfma_f32_32x32x16_bf16(pa2, PK(l2, h2), od, 0, 0, 0);
  od = __builtin_amdgcn_mfma_f32_32x32x16_bf16(pa3, PK(l3, h3), od, 0, 0, 0);
#undef PK
}
DI void pv_d0(f32x16* o, int vb, bf16x8 pa0, bf16x8 pa1, bf16x8 pa2, bf16x8 pa3) {
  pv_one<0>(o[0], vb, pa0, pa1, pa2, pa3); pv_one<1>(o[1], vb, pa0, pa1, pa2, pa3);
}

template <bool FIX>
DI void attn_unit(const bf16_t* Qg, bf16_t* Og, int ldo, const bf16_t* Kg, const bf16_t* Vg, int qrow0, int h, int ctxrow0, int latrow0, int NT, char* lds, float bound) {
  const int tid = threadIdx.x, wid = tid >> 6, lane = tid & 63, r32 = lane & 31, hi = lane >> 5;
  char* V_lds = lds; char* K_lds = lds + 2 * SHM_V;
  float* ws = (float*)(lds + 2 * SHM_V + 2 * SHM_K) + wid * 64; float* li_l = ws; float* al_l = ws + 32;
  float m_reg = -1e30f, l_reg = 0; f32x16 o[2] = {}; bf16x8 qr[6];
  const f32x16 init = {}; (void)bound;
  const bf16_t* Qw = Qg + (size_t)(qrow0 + wid * QBLK + r32) * 768;
#pragma unroll
  for (int d0 = 0; d0 < 6; ++d0) qr[d0] = ld8(Qw + (d0 < 4 ? 64 * h + 16 * d0 + 8 * hi : 512 + 32 * h + 16 * (d0 - 4) + 8 * hi));
  const int vr = tid >> 3, vc = tid & 7, vst = v_st(vr, 8 * vc), vcol = 64 * h + 8 * vc;
  const int c0 = tid, c1 = 512 + (tid & 255);
  const int kr0 = c0 / 12, kc0 = c0 % 12, kr1 = c1 / 12, kc1 = c1 % 12;
  const int kcol0 = kc0 < 8 ? 64 * h + 8 * kc0 : 512 + 32 * h + 8 * (kc0 - 8), kcol1 = kc1 < 8 ? 64 * h + 8 * kc1 : 512 + 32 * h + 8 * (kc1 - 8);
  const int kst0 = KSWZ(kr0, kc0 * 16), kst1 = KSWZ(kr1, kc1 * 16);
  const int vb0 = (int)(uintptr_t)V_lds + v_rd_base(lane);
  struct { bf16x8 vs0, ks0, ks1; } sr_[2];
#define TROW(j) ((j) < 4 ? ctxrow0 + 64 * (j) : latrow0 + 64 * ((j) - 4))
#define SLOAD(i, j) do { const int rb_ = TROW(j); sr_[i].vs0 = ld8(Vg + (size_t)(rb_ + vr) * 512 + vcol); \
    sr_[i].ks0 = ld8(Kg + (size_t)(rb_ + kr0) * 768 + kcol0); sr_[i].ks1 = ld8(Kg + (size_t)(rb_ + kr1) * 768 + kcol1); } while (0)
#define SWRITE(b, i) do { *(bf16x8*)(V_lds + (b) * SHM_V + vst) = sr_[i].vs0; \
    *(bf16x8*)(K_lds + (b) * SHM_K + kst0) = sr_[i].ks0; *(bf16x8*)(K_lds + (b) * SHM_K + kst1) = sr_[i].ks1; } while (0)
#define SWAIT() asm volatile("s_waitcnt vmcnt(3)" ::: "memory")
#define PSM(p0_, p1_, mn_, al_) do { if (FIX) { partialSM_fix(p0_); al_ = 1.f; } else partialSM(p0_, p1_, m_reg, mn_, al_); } while (0)
#define RESC(a) do { if (!FIX) if (__any((a) < 1.f)) { if (hi == 0) al_l[r32] = (a); asm volatile("s_waitcnt lgkmcnt(0)" ::: "memory"); \
    for (int d = 0; d < 2; ++d) for (int r = 0; r < 16; ++r) o[d][r] *= al_l[crow(r, hi)]; } } while (0)
  f32x16 pA0, pA1, pB0, pB1; float mnA, mnB, alA, alB; bf16x8 pa0, pa1, pa2, pa3;
  constexpr int SE = 0, SO = 1;
  SLOAD(SE, 0); asm volatile("s_waitcnt vmcnt(0)" ::: "memory"); SWRITE(0, SE); __syncthreads();
  qkt<FIX>(pA0, pA1, K_lds, qr, r32, hi, init); PSM(pA0, pA1, mnA, alA);
  SLOAD(SO, 1); if (2 < NT) SLOAD(SE, 2);
  SWAIT(); SWRITE(1, SO); __syncthreads();
  for (int j = 1; j + 1 < NT; j += 2) {
    SBAR(); qkt<FIX>(pB0, pB1, K_lds + SHM_K, qr, r32, hi, init);
    finishSM(pA0, pA1, alA, l_reg, pa0, pa1, pa2, pa3); SBAR();
    SLOAD(SO, j + 2); SBAR();
    pv_d0(o, vb0, pa0, pa1, pa2, pa3); PSM(pB0, pB1, mnB, alB);
    __syncthreads(); SWAIT(); SWRITE(0, SE);
    RESC(alB); __syncthreads();
    SBAR(); qkt<FIX>(pA0, pA1, K_lds, qr, r32, hi, init);
    finishSM(pB0, pB1, alB, l_reg, pa0, pa1, pa2, pa3); SBAR();
    if (j + 3 < NT) SLOAD(SE, j + 3); SBAR();
    pv_d0(o, vb0 + SHM_V, pa0, pa1, pa2, pa3); PSM(pA0, pA1, mnA, alA);
    __syncthreads(); SWAIT(); SWRITE(1, SO);
    RESC(alA); __syncthreads();
  }
  SBAR(); qkt<FIX>(pB0, pB1, K_lds + SHM_K, qr, r32, hi, init);
  finishSM(pA0, pA1, alA, l_reg, pa0, pa1, pa2, pa3); SBAR();
  pv_d0(o, vb0, pa0, pa1, pa2, pa3); PSM(pB0, pB1, mnB, alB);
  __syncthreads(); RESC(alB);
  finishSM(pB0, pB1, alB, l_reg, pa0, pa1, pa2, pa3); SBAR();
  pv_d0(o, vb0 + SHM_V, pa0, pa1, pa2, pa3);
  if (hi == 0) li_l[r32] = l_reg; asm volatile("s_waitcnt lgkmcnt(0)" ::: "memory");
  float rli[16];
#pragma unroll
  for (int r = 0; r < 16; ++r) rli[r] = __builtin_amdgcn_rcpf(li_l[crow(r, hi)]);
  bf16_t* Ow = Og + (size_t)(qrow0 + wid * QBLK) * ldo + 64 * h;
#pragma unroll
  for (int r = 0; r < 16; ++r) { const int orow = crow(r, hi);
#pragma unroll
    for (int d0 = 0; d0 < 2; ++d0) Ow[(size_t)orow * ldo + d0 * 32 + r32] = f2bf(o[d0][r] * rli[r]); }
#undef TROW
#undef SLOAD
#undef SWRITE
#undef SWAIT
#undef RESC
#undef PSM
}
}

DI void phase_attention(const Params& P, int l, char* lds, bf16_t* Og, int ldo) {
    const bf16_t* Q = (const bf16_t*)(P.ws + WS_Q); const bf16_t* K = (const bf16_t*)(P.ws + WS_K); const bf16_t* V = (const bf16_t*)(P.ws + WS_V);
    const unsigned* QKM = (const unsigned*)(P.ws + WS_QKM);
    for (int u = blockIdx.x; u < 1024 + (l == 0 ? 32 : 0); u += gridDim.x) {
        int b, h, qrow0, nt;
        if (u < 1024) { const int bh = (u >> 8) * 8 + (u & 7), qb = (u >> 3) & 31; b = bh >> 3; h = bh & 7; qrow0 = b * SEQ + 256 * qb; nt = 132; }
        else { b = (u - 1024) >> 3; h = (u - 1024) & 7; qrow0 = TL + b * CTX; nt = 4; }
        const float bound = sqrtf(__uint_as_float(QKM[(b * 8 + h) * 2]) * __uint_as_float(QKM[(b * 8 + h) * 2 + 1])) * 1.01f + 0.5f;
        __syncthreads();
        if (bound <= 48.f) att::attn_unit<true>(Q, Og, ldo, K, V, qrow0, h, TL + b * CTX, b * SEQ, nt, lds, bound);
        else att::attn_unit<false>(Q, Og, ldo, K, V, qrow0, h, TL + b * CTX, b * SEQ, nt, lds, 0.f);
    }
    __syncthreads();
}

namespace scn {
constexpr int RQ = 0, RK = 16384, RR = 32768;
constexpr int QD = 34816;
constexpr int KN = QD + 64 * 272;
constexpr int KET = KN + 64 * 272;
constexpr int VT = KET + 128 * 144;
constexpr int ST = VT + 128 * 144;
constexpr int PM = ST + 128 * 272;
constexpr int DEC = PM + 64 * 144;
constexpr int CSUM = DEC + 512;
constexpr int END = CSUM + 1024;
static_assert(END <= LDS_BYTES - 16, "scan LDS");
constexpr size_t US_OFF = 0, DL_OFF = (size_t)64 * 3 * 16384 * 2;
static_assert(DL_OFF + (size_t)64 * 3 * 128 * 4 <= (size_t)3584 * 1024 * 2, "scan hand-off must fit in the dead part of the weight region");
DI int crow(int r, int hi) { return (r & 3) + 8 * (r >> 2) + 4 * hi; }
#define SC_BAR() do { asm volatile("s_waitcnt lgkmcnt(0)" ::: "memory"); __builtin_amdgcn_s_barrier(); asm volatile("" ::: "memory"); } while (0)
#define SMFMA(a, b, c) __builtin_amdgcn_mfma_f32_32x32x16_bf16((a), (b), (c), 0, 0, 0)
}
DI void phase_scan(const Params& P, int l, char* lds, const int pass) {
    using namespace scn;
    const int tid = threadIdx.x, wid = tid >> 6, lane = tid & 63, r32 = lane & 31, hi = lane >> 5;
    const bf16_t* R4 = (const bf16_t*)(P.ws + WS_R4); const bf16_t* SM = (const bf16_t*)(P.ws + WS_SM);
    bf16_t* UST = (bf16_t*)(P.ws + WS_WT + US_OFF); float* DLG = (float*)(P.ws + WS_WT + DL_OFF);
    const int nitems = pass == 1 ? 192 : 256;
    for (int item = blockIdx.x; item < nitems; item += gridDim.x) {
        bool gla; int seg, g;
        if (pass == 1) { gla = item < 128; if (gla) { seg = item & 3; g = item >> 2; } else { seg = (item - 128) & 1; g = (item - 128) >> 1; } }
        else { gla = item < 160; if (gla) { seg = item % 5; g = item / 5; } else { seg = (item - 160) % 3; g = (item - 160) / 3; } }
        const int dir = g & 1, hh = (g >> 1) & 3, b = g >> 3, hd = hh + (gla ? 0 : 4);
        const int uidx0 = gla ? g * 4 : 128 + g * 2;
        const int n0 = gla ? seg * 26 + (seg < 2 ? seg : 2) : 44 * seg, nlen = gla ? (seg < 2 ? 27 : 26) : 44;
        const int qcol = gla ? hh * 128 : 1536 + hh * 128, kcol = gla ? 512 + hh * 128 : 2048 + hh * 128, vcol = (gla ? 1024 : 2560) + hh * 128;
        bf16_t* Od = (bf16_t*)(P.ws + (dir ? WS_OB : WS_OF)); const int ocol = hd * 128;
        const int pti = wid >> 2, pdj = wid & 3, pd = 32 * pdj + r32;
        const int vt = wid >> 1, dt0 = 2 * (wid & 1);
        bf16x8 w2h = {0, 0, 0, 0, 0, 0, 0, 0}, w2l = {0, 0, 0, 0, 0, 0, 0, 0}; float bias = 0.f, lg = 0.f;
        if (gla) { const float* W2 = P.in[I_GK2] + (size_t)(l * 2 + dir) * 16 * 512 + hh * 128 + pd;
#pragma unroll
            for (int j = 0; j < 8; ++j) { const float w = W2[(8 * hi + j) * 512]; const unsigned u = __float_as_uint(w) & 0xffff0000u; const float res = w - __uint_as_float(u);
                w2h[j] = (short)(u >> 16); w2l[j] = (short)(__float_as_uint(res) >> 16); }
            bias = P.in[I_BGK][(l * 2 + dir) * 512 + hh * 128 + pd]; }
        else lg = -expf(P.in[I_RDEC][(l * 2 + dir) * 4 + hh]);
        f32x16 S0 = {}, S1 = {}; float clsum = 0.f;
        __syncthreads();
        if (pass == 2) {
            for (int sp = 0; sp < seg; ++sp) {
                const bf16_t* U = UST + (size_t)(uidx0 + sp) * 16384; const float* DL = DLG + (size_t)(uidx0 + sp) * 128;
                const float e0 = __expf(DL[32 * dt0 + r32]), e1 = __expf(DL[32 * (dt0 + 1) + r32]);
#pragma unroll
                for (int r = 0; r < 16; ++r) { const int v = 32 * vt + crow(r, hi);
                    S0[r] = S0[r] * e0 + bf2f(U[v * 128 + 32 * dt0 + r32]); S1[r] = S1[r] * e1 + bf2f(U[v * 128 + 32 * (dt0 + 1) + r32]); }
            }
#pragma unroll
            for (int r = 0; r < 16; ++r) { const int v = 32 * vt + crow(r, hi);
                *(bf16_t*)(lds + ST + v * 272 + (32 * dt0 + r32) * 2) = f2bf(S0[r]); *(bf16_t*)(lds + ST + v * 272 + (32 * (dt0 + 1) + r32) * 2) = f2bf(S1[r]); }
            { const int i = tid >> 4, j = 32 + (tid & 15) * 2; *(unsigned*)(lds + PM + i * 144 + j * 2) = 0u; }
        }
        u32x4 pq0 = {0u, 0u, 0u, 0u}, pq1 = pq0, pk0, pk1, pr = pq0, pv0, pv1;
#define ROWBASE(n) (dir == 0 ? ((n) < 4 ? TL + b * CTX + 64 * (n) : b * SEQ + 64 * ((n) - 4)) : ((n) < 4 ? TL + b * CTX + 64 * (3 - (n)) : b * SEQ + 64 * (127 - ((n) - 4))))
#define SC_LOADQK(n) do { const int rb_ = ROWBASE(n); \
        if (pass == 2) { pq0 = *(const u32x4*)(R4 + (size_t)(rb_ + (tid >> 4)) * 3072 + qcol + 8 * (tid & 15)); pq1 = *(const u32x4*)(R4 + (size_t)(rb_ + 32 + (tid >> 4)) * 3072 + qcol + 8 * (tid & 15)); } \
        pk0 = *(const u32x4*)(R4 + (size_t)(rb_ + (tid >> 4)) * 3072 + kcol + 8 * (tid & 15)); pk1 = *(const u32x4*)(R4 + (size_t)(rb_ + 32 + (tid >> 4)) * 3072 + kcol + 8 * (tid & 15)); \
        if (tid < 128) pr = *(const u32x4*)(SM + (size_t)(rb_ + (tid >> 1)) * 512 + 416 + dir * 16 + 8 * (tid & 1)); } while (0)
#define SC_LOADV(n) do { const int rb_ = ROWBASE(n); \
        pv0 = *(const u32x4*)(R4 + (size_t)(rb_ + lane) * 3072 + vcol + 8 * wid); pv1 = *(const u32x4*)(R4 + (size_t)(rb_ + lane) * 3072 + vcol + 64 + 8 * wid); } while (0)
#define SC_STOREQK() do { if (pass == 2) { *(u32x4*)(lds + RQ + sr0 * 256 + (tid & 15) * 16) = pq0; *(u32x4*)(lds + RQ + sr1 * 256 + (tid & 15) * 16) = pq1; } \
        *(u32x4*)(lds + RK + sr0 * 256 + (tid & 15) * 16) = pk0; *(u32x4*)(lds + RK + sr1 * 256 + (tid & 15) * 16) = pk1; \
        if (tid < 128) *(u32x4*)(lds + RR + srr * 32 + (tid & 1) * 16) = pr; } while (0)
        const int sr0 = dir ? 63 - (tid >> 4) : (tid >> 4), sr1 = dir ? 31 - (tid >> 4) : 32 + (tid >> 4);
        const int srr = dir ? 63 - (tid >> 1) : (tid >> 1), svi = dir ? 63 - lane : lane;
        SC_LOADQK(n0); SC_STOREQK(); SC_LOADQK(n0 + 1); SC_LOADV(n0);
        for (int n = n0; n < n0 + nlen; ++n) {
            int r32v = r32, hiv = hi; asm volatile("" : "+v"(r32v), "+v"(hiv));
            SC_BAR();
            { char* vb = lds + VT + (8 * wid) * 144 + svi * 2;
              const unsigned w0[4] = {pv0.x, pv0.y, pv0.z, pv0.w}, w1[4] = {pv1.x, pv1.y, pv1.z, pv1.w};
#pragma unroll
              for (int e = 0; e < 4; ++e) { *(bf16_t*)(vb + (2 * e) * 144) = (bf16_t)(w0[e] & 0xffffu); *(bf16_t*)(vb + (2 * e + 1) * 144) = (bf16_t)(w0[e] >> 16);
                  *(bf16_t*)(vb + (64 + 2 * e) * 144) = (bf16_t)(w1[e] & 0xffffu); *(bf16_t*)(vb + (64 + 2 * e + 1) * 144) = (bf16_t)(w1[e] >> 16); }
              if (n + 1 < n0 + nlen) SC_LOADV(n + 1); }
            {
                f32x16 cum; float cl;
                if (gla) {
                    f32x16 la;
                    { const bf16x8 a0 = *(const bf16x8*)(lds + RR + (32 * pti + r32v) * 32 + hiv * 16);
                      la = SMFMA(a0, w2h, (f32x16{})); la = SMFMA(a0, w2l, la); }
                    float ssum = 0.f;
#pragma unroll
                    for (int r = 0; r < 16; ++r) { const float x0 = la[r] + bias;
                        la[r] = (fminf(x0, 0.f) - __logf(1.f + __expf(-fabsf(x0)))) * (1.f / 16.f);
                        ssum += la[r]; }
                    const float cs_own = ssum + __shfl_xor(ssum, 32);
                    if (hiv == 0) *(float*)(lds + CSUM + (pti * 128 + pd) * 4) = cs_own;
                    SC_BAR();
                    const float cs_other = *(const float*)(lds + CSUM + ((1 - pti) * 128 + pd) * 4);
                    cl = cs_own + cs_other;
                    bf16x8 tri0, tri1;
#pragma unroll
                    for (int j = 0; j < 8; ++j) { const int k0 = 8 * (j >> 2) + 4 * hiv + (j & 3);
                        tri0[j] = (short)(r32v >= k0 ? 0x3F80 : 0); tri1[j] = (short)(r32v >= k0 + 16 ? 0x3F80 : 0); }
                    cum = f32x16{};
#pragma unroll
                    for (int st = 0; st < 2; ++st) { bf16x8 h8, l8;
#pragma unroll
                        for (int j = 0; j < 8; ++j) { const float v = la[8 * st + j]; const unsigned u = __float_as_uint(v) & 0xffff0000u; const float res = v - __uint_as_float(u);
                            h8[j] = (short)(u >> 16); l8[j] = (short)(__float_as_uint(res) >> 16); }
                        const bf16x8 am = st ? tri1 : tri0; cum = SMFMA(am, h8, cum); cum = SMFMA(am, l8, cum); }
                    if (pti) {
#pragma unroll
                        for (int r = 0; r < 16; ++r) cum[r] += cs_other; }
                    __builtin_amdgcn_sched_barrier(0);
                } else {
#pragma unroll
                    for (int r = 0; r < 16; ++r) cum[r] = (float)(32 * pti + crow(r, hiv) + 1) * lg;
                    cl = 64.f * lg;
                }
                clsum += cl;
                {
                    const int ibase = 32 * pti + 4 * hiv; const float ecl = __expf(cl);
                    const char* rqb = lds + RQ + ibase * 256 + pd * 2; const char* rkb = lds + RK + ibase * 256 + pd * 2;
                    char* qdb = lds + QD + ibase * 272 + pd * 2; char* knb = lds + KN + ibase * 272 + pd * 2; char* keb = lds + KET + pd * 144 + ibase * 2;
                    if (pass == 2) {
#pragma unroll
                        for (int r = 0; r < 16; ++r) { const int cr = (r & 3) + 8 * (r >> 2);
                            const float c = cum[r]; const float e1 = __expf(c), e2 = __expf(-c);
                            const float q = bf2f(*(const bf16_t*)(rqb + cr * 256)), k = bf2f(*(const bf16_t*)(rkb + cr * 256));
                            const float kn = k * e2;
                            *(bf16_t*)(qdb + cr * 272) = f2bf(q * e1);
                            *(bf16_t*)(knb + cr * 272) = f2bf(kn);
                            *(bf16_t*)(keb + cr * 2) = f2bf(kn * ecl);
                            if ((r & 3) == 3) { asm volatile("" ::: "memory"); } }
                    } else {
#pragma unroll
                        for (int r = 0; r < 16; ++r) { const int cr = (r & 3) + 8 * (r >> 2);
                            const float k = bf2f(*(const bf16_t*)(rkb + cr * 256));
                            *(bf16_t*)(keb + cr * 2) = f2bf(k * __expf(cl - cum[r]));
                            if ((r & 3) == 3) { asm volatile("" ::: "memory"); } }
                    }
                    if (pti == 0 && hiv == 0) *(float*)(lds + DEC + pd * 4) = ecl;
                }
            }
            SC_BAR();
            if (n + 1 < n0 + nlen) { SC_STOREQK(); if (n + 2 < n0 + nlen) SC_LOADQK(n + 2); }
            f32x16 oacc = {};
            if (pass == 2) {
                if (wid < 3) {
                    const int ti = (wid + 1) >> 1, tj = wid >> 1; f32x16 T0 = {};
#pragma unroll
                    for (int kk = 0; kk < 8; ++kk) { const bf16x8 a = *(const bf16x8*)(lds + QD + (32 * ti + r32v) * 272 + (16 * kk + 8 * hiv) * 2), bb = *(const bf16x8*)(lds + KN + (32 * tj + r32v) * 272 + (16 * kk + 8 * hiv) * 2);
                        T0 = SMFMA(a, bb, T0); }
#pragma unroll
                    for (int r = 0; r < 16; ++r) { const int cr = (r & 3) + 8 * (r >> 2); const int ib = 32 * ti + 4 * hiv, j = 32 * tj + r32v; int jm = j - (dir ? 0 : 1) - ib; asm volatile("" : "+v"(jm));
                        *(bf16_t*)(lds + PM + ib * 144 + j * 2 + cr * 144) = f2bf(cr > jm ? T0[r] : 0.f); }
                }
                { const int ti = wid >> 2, vj = wid & 3;
#pragma unroll
                  for (int kk = 0; kk < 8; ++kk) { const bf16x8 a = *(const bf16x8*)(lds + QD + (32 * ti + r32v) * 272 + (16 * kk + 8 * hiv) * 2), bb = *(const bf16x8*)(lds + ST + (32 * vj + r32v) * 272 + (16 * kk + 8 * hiv) * 2);
                      oacc = SMFMA(a, bb, oacc); } }
            }
            {
                const float dc0 = *(const float*)(lds + DEC + (32 * dt0 + r32v) * 4), dc1 = *(const float*)(lds + DEC + (32 * (dt0 + 1) + r32v) * 4);
#pragma unroll
                for (int r = 0; r < 16; ++r) { S0[r] *= dc0; S1[r] *= dc1; }
#pragma unroll
                for (int kk = 0; kk < 4; ++kk) { const bf16x8 a = *(const bf16x8*)(lds + VT + (32 * vt + r32v) * 144 + (16 * kk + 8 * hiv) * 2);
                    const bf16x8 b0 = *(const bf16x8*)(lds + KET + (32 * dt0 + r32v) * 144 + (16 * kk + 8 * hiv) * 2), b1 = *(const bf16x8*)(lds + KET + (32 * (dt0 + 1) + r32v) * 144 + (16 * kk + 8 * hiv) * 2);
                    S0 = SMFMA(a, b0, S0); S1 = SMFMA(a, b1, S1); }
            }
            if (pass == 2) {
                SC_BAR();
                { const int ti = wid >> 2, vj = wid & 3;
#pragma unroll
                  for (int kk = 0; kk < 4; ++kk) { const bf16x8 a = *(const bf16x8*)(lds + PM + (32 * ti + r32v) * 144 + (16 * kk + 8 * hiv) * 2), bb = *(const bf16x8*)(lds + VT + (32 * vj + r32v) * 144 + (16 * kk + 8 * hiv) * 2);
                      oacc = SMFMA(a, bb, oacc); }
                  const int rb = ROWBASE(n);
#pragma unroll
                  for (int r = 0; r < 16; ++r) { const int i = 32 * ti + crow(r, hiv), row = rb + (dir ? 63 - i : i);
                      Od[(size_t)row * 1024 + ocol + 32 * vj + r32v] = f2bf(oacc[r]); } }
#pragma unroll
                for (int r = 0; r < 16; ++r) { const int cr = (r & 3) + 8 * (r >> 2); char* stb = lds + ST + (32 * vt + 4 * hiv) * 272 + (32 * dt0 + r32v) * 2;
                    *(bf16_t*)(stb + cr * 272) = f2bf(S0[r]); *(bf16_t*)(stb + cr * 272 + 64) = f2bf(S1[r]); }
            }
        }
        if (pass == 1) {
            bf16_t* U = UST + (size_t)(uidx0 + seg) * 16384;
#pragma unroll
            for (int r = 0; r < 16; ++r) { const int v = 32 * vt + crow(r, hi);
                U[v * 128 + 32 * dt0 + r32] = f2bf(S0[r]); U[v * 128 + 32 * (dt0 + 1) + r32] = f2bf(S1[r]); }
            if (pti == 0 && hi == 0) DLG[(size_t)(uidx0 + seg) * 128 + pd] = clsum;
        }
#undef ROWBASE
#undef SC_LOADQK
#undef SC_LOADV
#undef SC_STOREQK
    }
    __syncthreads();
}

constexpr int PH_PER_LAYER = 14, N_PHASES = 1 + 2 * PH_PER_LAYER;
#ifndef PHEN
#define PHEN(q) 1
#endif
#ifdef PROBE_GEMM
#define REPG for (int rep_ = 0; rep_ < 2; ++rep_)
#else
#define REPG
#endif
#ifdef PROBE_EW
#define REPE for (int rep_ = 0; rep_ < 2; ++rep_)
#else
#define REPE
#endif
#define PH(k) if (lo <= (k) && (k) < hi && ((k) == lo || (xcd_barrier(xbar), true)))
template <int l>
DI void layer_program(const Params& P, int lo, int hi, LAS unsigned char* lds, unsigned char* lds_raw, const XcdBarrier& xbar) {
    constexpr int base = 1 + PH_PER_LAYER * l;
    constexpr int Mlat = (l == 0) ? TA : TL;
#define WSP(T, off) ((T*)(P.ws + (off)))
#define MODL (WSP(const float, WS_MOD) + (size_t)l * 5 * 6144)
#define HIN_L ((l == 0) ? P.in[I_X] : (const float*)P.out)
#define HIN_C ((l == 0) ? P.in[I_CTX] : WSP(const float, WS_HC))
    PH(base + 0) if (PHEN(0)) REPE { if (blockIdx.x == 0 && threadIdx.x < 64) WSP(unsigned, WS_QKM)[threadIdx.x] = 0u;
        phase_norm(HIN_L, HIN_C, P.in[I_N1W] + l * DM, MODL, 0, 1, WSP(bf16_t, WS_A), TA); if (l > 0) phase_wconv_mixer(P, l, lds); }
    PH(base + 1) if (PHEN(1)) { Epi<EM_INPROJ> E{}; E.O0 = WSP(bf16_t, WS_R4); E.O1 = WSP(bf16_t, WS_SM); E.fa = WSP(const float, WS_ROT); run_gemm<EM_INPROJ>(lds, WSP(bf16_t, WS_A), 1024, WSP(bf16_t, WS_WT) + WT_IN, TA, 3584, 1024, E); }
    PH(base + 2) if (PHEN(6)) phase_scan(P, l, (char*)lds_raw, 1);
    PH(base + 3) if (PHEN(6)) phase_scan(P, l, (char*)lds_raw, 2);
    PH(base + 4) if (PHEN(2)) REPG { { Epi<EM_PLAIN> E{}; E.O0 = WSP(bf16_t, WS_Q); E.ld0 = 768; run_gemm<EM_PLAIN>(lds, WSP(bf16_t, WS_SM), 512, WSP(bf16_t, WS_WT) + WT_QB, TA, 768, 256, E); }
                  { Epi<EM_KV> E2{}; E2.O0 = WSP(bf16_t, WS_K); E2.O1 = WSP(bf16_t, WS_V); run_gemm<EM_KV>(lds, WSP(bf16_t, WS_SM) + 256, 512, WSP(bf16_t, WS_WT) + WT_KVB, TA, 1024, 128, E2); } }
    PH(base + 5) if (PHEN(3)) {
#ifdef PROBE_EW
        phase_qkpost(P, l, (LAS unsigned*)lds, true);
#endif
        phase_qkpost(P, l, (LAS unsigned*)lds); }
    PH(base + 6) if (PHEN(4)) phase_attention(P, l, (char*)lds_raw, WSP(bf16_t, WS_Q), 768);
    PH(base + 7) if (PHEN(7)) {
#ifdef PROBE_EW
        phase_scanpost(P, l, Mlat, true);
#endif
        phase_scanpost(P, l, Mlat); }
    PH(base + 8) if (PHEN(8)) { Epi<EM_GATES> E{}; E.O0 = WSP(bf16_t, WS_R4); E.O1 = WSP(bf16_t, WS_OF); E.fa = P.in[I_BGATE] + (size_t)l * 3072; run_gemm<EM_GATES>(lds, WSP(bf16_t, WS_A), 1024, WSP(bf16_t, WS_WT) + WT_IN + (size_t)3584 * 1024, Mlat, 4096, 1024, E); }
    PH(base + 9) if (PHEN(9)) REPG {
        { Epi<EM_BRANCH> E{}; E.O0 = WSP(bf16_t, WS_OB); E.Gsrc = WSP(bf16_t, WS_R4); E.ipar = 0; run_gemm<EM_BRANCH>(lds, WSP(bf16_t, WS_Q), 768, WSP(bf16_t, WS_WT) + WT_BR, Mlat, 1024, 512, E); }
        { Epi<EM_BRANCH> E{}; E.O0 = WSP(bf16_t, WS_OB); E.Gsrc = WSP(bf16_t, WS_R4) + 1024; E.ipar = 1; run_gemm<EM_BRANCH>(lds, WSP(bf16_t, WS_OF), 1024, WSP(bf16_t, WS_WT) + WT_BR + (size_t)1024 * 512, Mlat, 1024, 512, E); }
        { Epi<EM_BRANCH> E{}; E.O0 = WSP(bf16_t, WS_OB); E.Gsrc = WSP(bf16_t, WS_R4) + 2048; E.ipar = 2; run_gemm<EM_BRANCH>(lds, WSP(bf16_t, WS_OF) + 512, 1024, WSP(bf16_t, WS_WT) + WT_BR + (size_t)2048 * 512, Mlat, 1024, 512, E); } }
    PH(base + 10) if (PHEN(10)) { Epi<EM_RES> E{}; E.fa = MODL; E.ipar = 2; E.hin_l = HIN_L; E.hin_c = HIN_C; E.hout_l = P.out; E.hout_c = WSP(float, WS_HC);
                   run_gemm<EM_RES>(lds, WSP(bf16_t, WS_OB), 1024, WSP(bf16_t, WS_WT) + WT_OUT, Mlat, 1024, 1024, E); }
    PH(base + 11) if (PHEN(11)) REPE { phase_norm(P.out, WSP(const float, WS_HC), P.in[I_N2W] + l * DM, MODL, 3, 4, WSP(bf16_t, WS_A), Mlat); phase_wconv_ffn(P, l, lds); }
    PH(base + 12) if (PHEN(12)) { EpiFfnConv E{}; E.ACT = WSP(bf16_t, WS_G); E.HALO = WSP(float, WS_U); E.wdw = P.in[I_WDW] + (size_t)l * 3 * DFF; E.bdw = P.in[I_BDW] + (size_t)l * DFF; E.X = (LAS float*)(lds + 131072);
                   run_gemm_ffnconv(lds, WSP(bf16_t, WS_A), WSP(bf16_t, WS_WT) + WT_F1, Mlat, E); }
    PH(base + 13) if (PHEN(14)) { phase_convfix_mine(P, l, Mlat); Epi<EM_RES> E{}; E.fa = MODL; E.ipar = 5; E.hin_l = P.out; E.hin_c = WSP(const float, WS_HC); E.hout_l = P.out; E.hout_c = WSP(float, WS_HC);
                   run_gemm<EM_RES>(lds, WSP(bf16_t, WS_G), DFF, WSP(bf16_t, WS_WT) + WT_F2, Mlat, 1024, DFF, E); }
}
__global__ void __launch_bounds__(NTHREADS, 2) fwd_kernel(Params P) {
    extern __shared__ __attribute__((aligned(16))) unsigned char lds_raw[];
    LAS unsigned char* lds = (LAS unsigned char*)lds_raw;
    cg::grid_group grid = cg::this_grid();
    const int lo = P.ph_lo, hi = P.ph_hi;
    Params* G = (Params*)(P.ws + WS_PAR + (size_t)blockIdx.x * 256);
    if (threadIdx.x == 0) {
#pragma unroll
        for (int i = 0; i < 26; ++i) G->in[i] = P.in[i];
        G->out = P.out; G->ws = P.ws; G->ph_lo = lo; G->ph_hi = hi;
    }
    __syncthreads();
    asm volatile("" ::: "memory");
    const Params& Q = *G;
    if (threadIdx.x < 4) ((LAS unsigned*)(lds + LDS_BARW))[threadIdx.x] = 0u;
    __syncthreads();
    const XcdBarrier xbar = xcd_barrier_post((unsigned*)(P.ws + WS_BAR), (volatile LAS unsigned*)(lds + LDS_BARW));
    if (lo < 0) grid.sync();
    PH(0) REPE { phase_prologue(Q, lds); __syncthreads(); phase_wconv_mixer(Q, 0, lds); __syncthreads(); }
    layer_program<0>(Q, lo, hi, lds, lds_raw, xbar);
    layer_program<1>(Q, lo, hi, lds, lds_raw, xbar);
#ifdef PROBE_SYNC
    for (int i = 0; i < 20; ++i) xcd_barrier(xbar);
#endif
}

#ifndef N_LAUNCH_MODE
#define N_LAUNCH_MODE 1
#endif
extern "C" void kernel_launch(void* const* d_in, const int* in_sizes, int n_in, void* d_out, int out_size, void* d_ws, size_t ws_size, hipStream_t stream) {
    static int grid_blocks = 0;
    if (!grid_blocks) {
        if (n_in != 26 || ws_size < WS_NEED) { fprintf(stderr, "kernel_launch: bad inputs (n_in %d, ws %zu < %zu)\n", n_in, ws_size, (size_t)WS_NEED); return; }
        if (hipFuncSetAttribute((const void*)fwd_kernel, hipFuncAttributeMaxDynamicSharedMemorySize, LDS_BYTES) != hipSuccess) { fprintf(stderr, "kernel_launch: hipFuncSetAttribute failed\n"); return; }
        int dev = 0, cus = 0, per_cu = 0;
        hipGetDevice(&dev);
        hipDeviceGetAttribute(&cus, hipDeviceAttributeMultiprocessorCount, dev);
        hipOccupancyMaxActiveBlocksPerMultiprocessor(&per_cu, fwd_kernel, NTHREADS, LDS_BYTES);
        if (per_cu < 1) { fprintf(stderr, "kernel_launch: occupancy query returned %d\n", per_cu); return; }
        grid_blocks = cus * 1;
    }
    Params p{};
    for (int i = 0; i < 26; ++i) p.in[i] = (const float*)d_in[i];
    p.out = (float*)d_out; p.ws = (unsigned char*)d_ws;
#if N_LAUNCH_MODE == 1
    p.ph_lo = 0; p.ph_hi = N_PHASES;
    if (hipMemsetAsync((unsigned char*)d_ws + WS_BAR, 0, XCD_BAR_WORDS * 4, stream) != hipSuccess) { fprintf(stderr, "kernel_launch: memset of the barrier words failed\n"); return; }
    void* args[] = {&p};
    hipError_t e = hipLaunchCooperativeKernel((const void*)fwd_kernel, dim3(grid_blocks), dim3(NTHREADS), args, LDS_BYTES, stream);
    if (e != hipSuccess) fprintf(stderr, "cooperative launch failed: %s (grid %d)\n", hipGetErrorString(e), grid_blocks);
#else
    for (int ph = 0; ph < N_PHASES; ++ph) {
        p.ph_lo = ph; p.ph_hi = ph + 1;
        hipLaunchKernelGGL(fwd_kernel, dim3(grid_blocks), dim3(NTHREADS), LDS_BYTES, stream, p);
    }
#endif
}
```

```cpp
#include <hip/hip_runtime.h>
#include <hip/hip_bf16.h>
#include <hip/hip_cooperative_groups.h>
#include <cstdio>
#include <cstdint>
namespace cg = cooperative_groups;
#define DI __device__ __forceinline__
#define LAS __attribute__((address_space(3)))
namespace pg8 {
#define PG8_LAS __attribute__((address_space(3)))
typedef unsigned short bf16_t;
typedef short bf16x8 __attribute__((ext_vector_type(8)));
typedef float f32x4 __attribute__((ext_vector_type(4)));
typedef unsigned u32x4 __attribute__((ext_vector_type(4)));
constexpr int BM = 256, BK = 64, HALF = 128, HTB = HALF * BK * 2  , STAGE_BYTES = 8 * HTB, NXCD = 8, WGM = 8;

__host__ __device__ __forceinline__ int lds_byte(int r, int c) { const int st = (r >> 4) * 2 + (c >> 5), rr = r & 15, cc = c & 31, ob = rr * 64 + cc * 2; return st * 1024 + (ob ^ (((ob >> 9) & 1) << 5)); }
__host__ __device__ __forceinline__ void stage_rc(int b, int& R, int& C) { const int st = b / 1024, sb = b % 1024, swz = sb ^ (((sb >> 9) & 1) << 5); R = (st >> 1) * 16 + swz / 64; C = (st & 1) * 32 + (swz % 64) / 2; }
__host__ __device__ __forceinline__ int perm32(int rho) { const int n = rho >> 4, i = rho & 15; return 8 * (i >> 2) + 4 * n + (i & 3); }

struct Unit { int pm, pn; };
struct Gemm { const bf16_t* A; const bf16_t* Bt; int M, N, K, lda; };

struct StaticOrder {
    int nM, nN, nwg, G, c;
    __host__ __device__ void init(int M, int N, int G_, int c_) { nM = M / BM; nN = N / BM; nwg = nM * nN; G = G_; c = c_; }
    __host__ __device__ bool next(int i, Unit& u) const {
        const long L = (long)i * G + c; if (L >= nwg) return false;
        int wgid = (int)L; { const int q = nwg / NXCD, r = nwg % NXCD, xcd = wgid % NXCD, off = wgid / NXCD; wgid = (xcd < r ? xcd * (q + 1) : r * (q + 1) + (xcd - r) * q) + off; }
        const int nig = WGM * nN, gid = wgid / nig, fm = gid * WGM, gsz = (nM - fm) < WGM ? (nM - fm) : WGM;
        u.pm = fm + ((wgid % nig) % gsz); u.pn = (wgid % nig) / gsz; return true;
    }
    __device__ __forceinline__ void a_ready(const Unit&) const {}
    __device__ __forceinline__ void done(const Unit&) const {}
};

__device__ __forceinline__ unsigned cvt_pk_bf16(float lo, float hi) { unsigned r; asm volatile("v_cvt_pk_bf16_f32 %0, %1, %2" : "=v"(r) : "v"(lo), "v"(hi)); return r; }
template <class Epi, class Sched, bool ALIGN_EPI = false, bool SP2 = false>
__device__ __forceinline__ void gemm_phase(PG8_LAS unsigned char* lds, const Gemm g, const Sched& S, const Epi& E) {
    const int tid = threadIdx.x, wid = __builtin_amdgcn_readfirstlane(tid >> 6), lane = tid & 63, wr = wid >> 2, wc = wid & 3, fr = lane & 15, fq = lane >> 4;
    const int K = g.K, nt = K / BK;
    unsigned voffA[2], voffB[2];
#pragma unroll
    for (int i = 0; i < 2; ++i) { int R, C; stage_rc(tid * 16 + i * 8192, R, C); const int Rb = Epi::PERM ? ((R & ~31) + perm32(R & 31)) : R;
        voffA[i] = (unsigned)(R * g.lda + C) * 2u; voffB[i] = (unsigned)(Rb * K + C) * 2u; }
    const size_t kstep = (size_t)(BK * 2);
    const size_t hstep = (size_t)HALF * K * 2;
    const size_t tstep = 2 * hstep; const size_t hstepA = (size_t)HALF * g.lda * 2; const size_t tstepA = 2 * hstepA;
    const unsigned ldsw = (unsigned)wid * 1024u;
    const int aoff = lds_byte(wr * 64 + fr, fq * 8), boff = lds_byte(wc * 32 + fr, fq * 8);
#define PG8_SA(b, h) (((b) * 2 + (h)) * HTB)
#define PG8_SB(b, h) ((4 + (b) * 2 + (h)) * HTB)
#define PG8_STAGE(bufoff, gbase, voff) do { _Pragma("unroll") for (int _i = 0; _i < 2; ++_i) \
        __builtin_amdgcn_global_load_lds((const unsigned*)((const char*)(gbase) + (voff)[_i]), (PG8_LAS unsigned*)(lds + (bufoff) + ldsw + _i * 8192), 16, 0, 0); } while (0)
#define PG8_LDA(dst, b, h) do { _Pragma("unroll") for (int m = 0; m < 4; ++m) _Pragma("unroll") for (int k = 0; k < 2; ++k) dst[m][k] = *(const PG8_LAS bf16x8*)(lds + PG8_SA(b, h) + aoff + m * 2048 + k * 1024); } while (0)
#define PG8_LDB(dst, b, h) do { _Pragma("unroll") for (int n = 0; n < 2; ++n) _Pragma("unroll") for (int k = 0; k < 2; ++k) dst[n][k] = *(const PG8_LAS bf16x8*)(lds + PG8_SB(b, h) + boff + n * 2048 + k * 1024); } while (0)
#define PG8_MMA(ai, bj, At, Bt) do { __builtin_amdgcn_s_setprio(1); _Pragma("unroll") for (int m = 0; m < 4; ++m) _Pragma("unroll") for (int n = 0; n < 2; ++n) _Pragma("unroll") for (int k = 0; k < 2; ++k) \
        acc[ai][bj][m][n] = __builtin_amdgcn_mfma_f32_16x16x32_bf16(Bt[n][k], At[m][k], acc[ai][bj][m][n], 0, 0, 0); __builtin_amdgcn_s_setprio(0); } while (0)
#define PG8_WAIT_V(n) asm volatile("s_waitcnt vmcnt(" #n ")" ::: "memory")
#define PG8_WAIT_L(n) asm volatile("s_waitcnt lgkmcnt(" #n ")" ::: "memory")
#define PG8_BAR __builtin_amdgcn_s_barrier()
#define PG8_SCHED __builtin_amdgcn_sched_barrier(0)
    Unit cur, nxt; int ui = 0;
    if (!S.next(0, cur)) return;
    f32x4 acc[2][2][4][2];
#pragma unroll
    for (int a = 0; a < 2; ++a)
#pragma unroll
        for (int b = 0; b < 2; ++b)
#pragma unroll
            for (int m = 0; m < 4; ++m)
#pragma unroll
                for (int n = 0; n < 2; ++n) acc[a][b][m][n] = (f32x4){0.f, 0.f, 0.f, 0.f};
    bf16x8 At[4][2], B0[2][2], B1[2][2];
    const char* cA = (const char*)g.A + (size_t)cur.pm * tstepA; const char* cB = (const char*)g.Bt + (size_t)cur.pn * tstep;
    S.a_ready(cur);
    if constexpr (SP2) {
        PG8_STAGE(PG8_SB(0, 0), cB, voffB); PG8_STAGE(PG8_SB(0, 1), cB + hstep, voffB); PG8_STAGE(PG8_SA(0, 0), cA, voffA); PG8_STAGE(PG8_SA(0, 1), cA + hstepA, voffA);
        if (wr == 1) PG8_BAR;
        PG8_WAIT_V(2); PG8_BAR;
        PG8_STAGE(PG8_SB(1, 0), cB + kstep, voffB); PG8_STAGE(PG8_SA(1, 0), cA + kstep, voffA); PG8_STAGE(PG8_SB(1, 1), cB + hstep + kstep, voffB);
        PG8_WAIT_V(6); PG8_BAR;
    } else {
        PG8_STAGE(PG8_SB(0, 0), cB, voffB); PG8_STAGE(PG8_SA(0, 0), cA, voffA); PG8_STAGE(PG8_SB(0, 1), cB + hstep, voffB); PG8_STAGE(PG8_SA(0, 1), cA + hstepA, voffA);
        if (wr == 1) PG8_BAR;
        PG8_WAIT_V(4); PG8_BAR;
        PG8_STAGE(PG8_SB(1, 0), cB + kstep, voffB); PG8_STAGE(PG8_SA(1, 0), cA + kstep, voffA); PG8_STAGE(PG8_SB(1, 1), cB + hstep + kstep, voffB);
        PG8_WAIT_V(6); PG8_BAR;
    }
    for (;;) {
        const bool has_next = S.next(ui + 1, nxt);
        const char* nA = has_next ? (const char*)g.A + (size_t)nxt.pm * tstepA : cA; const char* nB = has_next ? (const char*)g.Bt + (size_t)nxt.pn * tstep : cB;
        for (int t = 0; t < nt; t += 2) {
            const bool last = (t == nt - 2);
            const char* a1 = cA + (size_t)(t + 1) * kstep;
            const char* a2 = last ? nA : cA + (size_t)(t + 2) * kstep; const char* b2 = last ? nB : cB + (size_t)(t + 2) * kstep;
            const char* a3 = a2 + kstep; const char* b3 = b2 + kstep;
            if (last && has_next) S.a_ready(nxt);
            if constexpr (SP2) {
            PG8_LDB(B0, 0, 0); PG8_LDB(B1, 0, 1); PG8_SCHED; PG8_LDA(At, 0, 0); PG8_STAGE(PG8_SA(1, 1), a1 + hstepA, voffA);
            PG8_WAIT_V(8); PG8_WAIT_L(0); PG8_BAR; PG8_MMA(0, 0, At, B0); PG8_MMA(0, 1, At, B1); PG8_BAR; PG8_SCHED;
            PG8_LDA(At, 0, 1); PG8_STAGE(PG8_SB(0, 0), b2, voffB); PG8_STAGE(PG8_SB(0, 1), b2 + hstep, voffB); PG8_STAGE(PG8_SA(0, 0), a2, voffA);
            PG8_WAIT_V(8); PG8_WAIT_L(0); PG8_BAR; PG8_MMA(1, 0, At, B0); PG8_MMA(1, 1, At, B1); PG8_BAR; PG8_SCHED;
            PG8_LDB(B0, 1, 0); PG8_LDB(B1, 1, 1); PG8_SCHED; PG8_LDA(At, 1, 0); PG8_STAGE(PG8_SA(0, 1), a2 + hstepA, voffA);
            PG8_WAIT_V(8); PG8_WAIT_L(0); PG8_BAR; PG8_MMA(0, 0, At, B0); PG8_MMA(0, 1, At, B1); PG8_BAR; PG8_SCHED;
            PG8_LDA(At, 1, 1); PG8_STAGE(PG8_SB(1, 0), b3, voffB); PG8_STAGE(PG8_SB(1, 1), b3 + hstep, voffB); PG8_STAGE(PG8_SA(1, 0), a3, voffA);
            PG8_WAIT_V(8); PG8_WAIT_L(0); PG8_BAR; PG8_MMA(1, 0, At, B0); PG8_MMA(1, 1, At, B1); PG8_BAR; PG8_SCHED;
            } else {
            PG8_LDB(B0, 0, 0); PG8_SCHED; PG8_LDA(At, 0, 0); PG8_STAGE(PG8_SA(1, 1), a1 + hstepA, voffA);
            PG8_WAIT_L(8); PG8_BAR; PG8_WAIT_L(0); PG8_MMA(0, 0, At, B0); PG8_BAR; PG8_SCHED;
            PG8_LDB(B1, 0, 1); PG8_STAGE(PG8_SB(0, 0), b2, voffB);
            PG8_BAR; PG8_WAIT_L(0); PG8_MMA(0, 1, At, B1); PG8_BAR;
            PG8_LDA(At, 0, 1); PG8_STAGE(PG8_SA(0, 0), a2, voffA);
            PG8_BAR; PG8_WAIT_L(0); PG8_MMA(1, 0, At, B0); PG8_BAR; PG8_SCHED;
            PG8_STAGE(PG8_SB(0, 1), b2 + hstep, voffB);
            PG8_WAIT_V(6); PG8_BAR; PG8_MMA(1, 1, At, B1); PG8_BAR;
            PG8_LDB(B0, 1, 0); PG8_SCHED; PG8_LDA(At, 1, 0); PG8_STAGE(PG8_SA(0, 1), a2 + hstepA, voffA);
            PG8_WAIT_L(8); PG8_BAR; PG8_WAIT_L(0); PG8_MMA(0, 0, At, B0); PG8_BAR; PG8_SCHED;
            PG8_LDB(B1, 1, 1); PG8_STAGE(PG8_SB(1, 0), b3, voffB);
            PG8_BAR; PG8_WAIT_L(0); PG8_MMA(0, 1, At, B1); PG8_BAR;
            PG8_LDA(At, 1, 1); PG8_STAGE(PG8_SA(1, 0), a3, voffA);
            PG8_BAR; PG8_WAIT_L(0); PG8_MMA(1, 0, At, B0); PG8_BAR; PG8_SCHED;
            PG8_STAGE(PG8_SB(1, 1), b3 + hstep, voffB);
            PG8_WAIT_V(6); PG8_BAR; PG8_MMA(1, 1, At, B1); PG8_BAR;
            }
        }
        if constexpr (ALIGN_EPI) { if (wr == 0) PG8_BAR; }
        if constexpr (!Epi::AFTER_DRAIN) { E(acc, cur, wr, wc, fr, fq); S.done(cur); }
        if (!has_next) break;
#pragma unroll
        for (int a = 0; a < 2; ++a)
#pragma unroll
            for (int b = 0; b < 2; ++b)
#pragma unroll
                for (int m = 0; m < 4; ++m)
#pragma unroll
                    for (int n = 0; n < 2; ++n) acc[a][b][m][n] = (f32x4){0.f, 0.f, 0.f, 0.f};
        cur = nxt; cA = nA; cB = nB; ++ui;
        if constexpr (ALIGN_EPI) { if (wr == 1) PG8_BAR; }
    }
    PG8_WAIT_V(0);
    if constexpr (!ALIGN_EPI) { if (wr == 0) PG8_BAR; }
    PG8_BAR;
    if constexpr (Epi::AFTER_DRAIN) { E.fused(acc, cur, wr, wc, fr, fq, lds, wid, lane); S.done(cur); }
#undef PG8_SA
#undef PG8_SB
#undef PG8_STAGE
#undef PG8_LDA
#undef PG8_LDB
#undef PG8_MMA
#undef PG8_WAIT_V
#undef PG8_WAIT_L
#undef PG8_BAR
#undef PG8_SCHED
}
}

typedef unsigned short bf16_t;
typedef short bf16x8 __attribute__((ext_vector_type(8)));
typedef short s16x4 __attribute__((ext_vector_type(4)));
typedef float f32x4 __attribute__((ext_vector_type(4)));
typedef float f32x2 __attribute__((ext_vector_type(2)));
typedef float f32x16 __attribute__((ext_vector_type(16)));
typedef unsigned u32x4 __attribute__((ext_vector_type(4)));
typedef unsigned u32x2 __attribute__((ext_vector_type(2)));

constexpr int DM = 1024, NB = 4, SEQ = 8192, CTX = 256, TL = NB * SEQ, TC = NB * CTX, TA = TL + TC;
constexpr int DFF = 2816, NIN = 7616;
constexpr float EPS = 1e-6f;
constexpr int NTHREADS = 512, NWAVES = 8;

constexpr size_t al256(size_t x) { return (x + 255) / 256 * 256; }
constexpr size_t WS_MOD = 0;
constexpr size_t WS_PAR = al256(WS_MOD + (size_t)2 * 5 * 6144 * 4);
constexpr size_t WS_BAR = al256(WS_PAR + (size_t)1024 * 256);
constexpr size_t WS_QKM = al256(WS_BAR + (size_t)3456 * 4);
constexpr size_t WS_ROPE = al256(WS_QKM + 256);
constexpr size_t WS_ROT = al256(WS_ROPE + (size_t)192 * 8 * 8);
constexpr size_t WS_HC  = al256(WS_ROT + (size_t)8448 * 64 * 8);
constexpr size_t WS_WT  = al256(WS_HC + (size_t)TC * DM * 4);
constexpr size_t WT_IN = 0, WT_QB = WT_IN + (size_t)7680 * 1024, WT_KVB = WT_QB + (size_t)768 * 256, WT_BR = WT_KVB + (size_t)1024 * 128,
                 WT_OUT = WT_BR + (size_t)3 * 1024 * 512, WT_MIX_END = WT_OUT + (size_t)1024 * 1024;
constexpr size_t WT_F1 = 0, WT_F2 = (size_t)5632 * 1024, WT_FFN_END = WT_F2 + (size_t)1024 * 2816;
constexpr size_t WT_ELEMS = WT_MIX_END > WT_FFN_END ? WT_MIX_END : WT_FFN_END;
constexpr size_t WS_A   = al256(WS_WT + WT_ELEMS * 2);
constexpr size_t WS_SM  = al256(WS_A + (size_t)TA * 1024 * 2);
constexpr size_t WS_Q   = al256(WS_SM + (size_t)TA * 512 * 2);
constexpr size_t WS_R4  = al256(WS_Q + (size_t)TA * 768 * 2);
constexpr size_t WS_OF  = al256(WS_R4 + (size_t)TA * 3072 * 2);
constexpr size_t WS_OB  = al256(WS_OF + (size_t)TA * 1024 * 2);
constexpr size_t WS_END_MIX = al256(WS_OB + (size_t)TA * 1024 * 2);
constexpr size_t WS_K   = WS_R4;
constexpr size_t WS_V   = al256(WS_K + (size_t)TA * 768 * 2);
constexpr size_t WS_G   = WS_SM;
constexpr size_t WS_U   = al256(WS_G + (size_t)TA * DFF * 2);
constexpr size_t WS_END_FFN = al256(WS_U + (size_t)132 * 6 * DFF * 4);
constexpr size_t WS_NEED = WS_END_MIX > WS_END_FFN ? WS_END_MIX : WS_END_FFN;
static_assert(WS_V + (size_t)TA * 512 * 2 <= WS_OF, "K/V overlay must fit in R4");

constexpr int LDS_BYTES = 150 * 1024;
constexpr int LDS_BARW = LDS_BYTES - 16;

struct Params { const float* in[26]; float* out; unsigned char* ws; int ph_lo, ph_hi; };
enum { I_X = 0, I_C, I_CTX, I_CCTX, I_WADA, I_BADA, I_N1W, I_N2W, I_WIN, I_BGATE, I_QNA, I_WQB, I_KVNA, I_WKVB, I_QN, I_KN, I_GK2, I_BGK, I_GON, I_RDEC, I_WBR, I_WOUT, I_WF1, I_WDW, I_BDW, I_WF2 };

DI float bflo(unsigned w) { return __uint_as_float(w << 16); }
DI float bfhi(unsigned w) { return __uint_as_float(w & 0xffff0000u); }
DI float bf2f(bf16_t x) { return __uint_as_float((unsigned)x << 16); }
DI unsigned pk2(float lo, float hi) { unsigned r; asm volatile("s_nop 0\n\tv_cvt_pk_bf16_f32 %0, %1, %2" : "=v"(r) : "v"(lo), "v"(hi)); return r; }
DI bf16_t f2bf(float x) { return (bf16_t)(pk2(x, 0.f) & 0xffffu); }
DI float wave_sum(float v) {
#pragma unroll
    for (int o = 1; o < 64; o <<= 1) v += __shfl_xor(v, o);
    return v;
}
DI float sigmoidf_(float x) { return __builtin_amdgcn_rcpf(1.f + __builtin_amdgcn_exp2f(-1.4426950408889634f * x)); }
DI void unpack8(u32x4 w, float* f) { f[0] = bflo(w.x); f[1] = bfhi(w.x); f[2] = bflo(w.y); f[3] = bfhi(w.y); f[4] = bflo(w.z); f[5] = bfhi(w.z); f[6] = bflo(w.w); f[7] = bfhi(w.w); }
DI u32x4 pack8(const float* f) { u32x4 w; w.x = pk2(f[0], f[1]); w.y = pk2(f[2], f[3]); w.z = pk2(f[4], f[5]); w.w = pk2(f[6], f[7]); return w; }

DI void rowinfo(int m, int& b, int& pos, int& isctx) {
    if (m < TL) { b = m >> 13; pos = m & 8191; isctx = 0; } else { const int j = m - TL; b = j >> 8; pos = j & 255; isctx = 1; }
}

DI void phase_prologue(const Params& P, LAS unsigned char* lds) {
    const int tid = threadIdx.x, wave = tid >> 6, lane = tid & 63;
    LAS float* cond = (LAS float*)lds;
    LAS float* part = cond + 5 * 1024;
    const float* c = P.in[I_C]; const float* cc = P.in[I_CCTX];
    for (int i = tid; i < 5 * 1024; i += NTHREADS) { const int r = i >> 10, k = i & 1023; const float v = r < 4 ? c[r * 1024 + k] : cc[k]; cond[i] = v / (1.f + expf(-v)); }
    __syncthreads();
    float* MOD = (float*)(P.ws + WS_MOD);
    for (int item = blockIdx.x; item < 192; item += gridDim.x) {
        const int l = item / 96, j0 = (item % 96) * 64;
        const float* W = P.in[I_WADA] + (size_t)l * 1024 * 6144 + j0 + lane;
        float a0 = 0.f, a1 = 0.f, a2 = 0.f, a3 = 0.f, a4 = 0.f;
#pragma unroll 16
        for (int k = wave * 128; k < wave * 128 + 128; ++k) {
            const float w = W[(size_t)k * 6144];
            a0 += cond[k] * w; a1 += cond[1024 + k] * w; a2 += cond[2048 + k] * w; a3 += cond[3072 + k] * w; a4 += cond[4096 + k] * w;
        }
        part[(wave * 5 + 0) * 64 + lane] = a0; part[(wave * 5 + 1) * 64 + lane] = a1; part[(wave * 5 + 2) * 64 + lane] = a2;
        part[(wave * 5 + 3) * 64 + lane] = a3; part[(wave * 5 + 4) * 64 + lane] = a4;
        __syncthreads();
        if (tid < 320) { const int r = tid >> 6; float s = 0.f;
            for (int w = 0; w < 8; ++w) s += part[(w * 5 + r) * 64 + lane];
            MOD[(size_t)(l * 5 + r) * 6144 + j0 + lane] = s + P.in[I_BADA][l * 6144 + j0 + lane]; }
        __syncthreads();
    }
    { f32x2* ROPE = (f32x2*)(P.ws + WS_ROPE);
      for (int i = blockIdx.x * NTHREADS + tid; i < 192 * 8; i += gridDim.x * NTHREADS) { const int p = i >> 3, f = i & 7; const float pos = (float)(p < 128 ? p : p - 128);
          const float inv = powf(10000.0f, -(float)f * 0.125f); float s, co; sincosf(pos * inv, &s, &co); ROPE[i] = (f32x2){co, s}; } }
    f32x2* ROT = (f32x2*)(P.ws + WS_ROT);
    for (int i = blockIdx.x * NTHREADS + tid; i < 8448 * 64; i += gridDim.x * NTHREADS) {
        const int pos = i >> 6, j = i & 63;
        const float inv = 1.0f / powf(10000.0f, (float)j / 63.0f);
        const float ang = (float)pos * inv; float s, co; sincosf(ang, &s, &co);
        ROT[i] = (f32x2){co, s};
    }
}

DI int wmap(int id, int n) {
    switch (id) {
    case 1: if (n < 416) return n; if (n < 448) return 2464 + (n - 416); return -1;
    case 2: { if (n < 1536) return 416 + n;
              if (n < 2560) { const int base = n < 2048 ? 2496 : 3008; const int j = (n - 1536) & 511; const int hh = j >> 7, v = j & 127, g = v >> 3, e = v & 7;
                              const int d = e < 4 ? 4 * g + e : 64 + 4 * g + (e - 4); return base + hh * 128 + d; }
              return 3520 + (n - 2560); }
    case 3: if (n < 512) return 1952 + n; if (n < 1024) return 4032 + (n - 512); return 4544 + (n - 1024);
    case 4: if (n < 512) return (n >> 6) * 96 + (n & 63); { const int j = n - 512; return (j >> 5) * 96 + 64 + (j & 31); }
    case 5: if (n < 512) return (n >> 6) * 128 + (n & 63); { const int j = n - 512; return (j >> 6) * 128 + 64 + (j & 63); }
    case 6: { const int pn = n >> 8, bj = (n >> 7) & 1, j = n & 127; return bj * 2816 + 128 * pn + j; }
    default: return n;
    }
}
struct TJob { const float* W; int K, Nsrc; bf16_t* WT; int ndst, map_id; const float* kscale; };
DI void transpose_job(const TJob& J, LAS float* scr, int gw, int ngw, int lane) {
    const int nblk = J.ndst / 32, nitems = (J.K / 64) * nblk;
    for (int item = gw; item < nitems; item += ngw) {
        const int kb = item / nblk, nb = item % nblk, k0 = 64 * kb, n0 = 32 * nb;
        const int src = wmap(J.map_id, n0 + (lane & 31));
        float tv[32];
#pragma unroll
        for (int i = 0; i < 32; ++i) { const int kk = 2 * i + (lane >> 5); tv[i] = src >= 0 ? J.W[(size_t)(k0 + kk) * J.Nsrc + src] : 0.f; }
        if (J.kscale) {
#pragma unroll
            for (int i = 0; i < 32; ++i) tv[i] *= J.kscale[k0 + 2 * i + (lane >> 5)]; }
#pragma unroll
        for (int i = 0; i < 32; ++i) scr[(2 * i + (lane >> 5)) * 33 + (lane & 31)] = tv[i];
        asm volatile("s_waitcnt lgkmcnt(0)" ::: "memory");
        const int c = lane & 7;
#pragma unroll
        for (int j = 0; j < 4; ++j) { const int n = (lane >> 3) + 8 * j; const LAS float* s = scr + (8 * c) * 33 + n;
            u32x4 o; o.x = pk2(s[0 * 33], s[1 * 33]); o.y = pk2(s[2 * 33], s[3 * 33]); o.z = pk2(s[4 * 33], s[5 * 33]); o.w = pk2(s[6 * 33], s[7 * 33]);
            *(u32x4*)(J.WT + (size_t)(n0 + n) * J.K + k0 + 8 * c) = o; }
        asm volatile("s_waitcnt lgkmcnt(0)" ::: "memory");
    }
}
DI void phase_wconv_mixer(const Params& P, int l, LAS unsigned char* lds) {
    const int tid = threadIdx.x, wave = tid >> 6, lane = tid & 63, gw = blockIdx.x * NWAVES + wave, ngw = gridDim.x * NWAVES;
    LAS float* scr = (LAS float*)lds + wave * (64 * 33);
    bf16_t* WT = (bf16_t*)(P.ws + WS_WT);
    const float* win = P.in[I_WIN] + (size_t)l * 1024 * NIN;
    TJob j;
    j = TJob{win, 1024, NIN, WT + WT_IN, 512, 1, nullptr}; transpose_job(j, scr, gw, ngw, lane);
    j = TJob{win, 1024, NIN, WT + WT_IN + (size_t)512 * 1024, 3072, 2, nullptr}; transpose_job(j, scr, gw, ngw, lane);
    j = TJob{win, 1024, NIN, WT + WT_IN + (size_t)3584 * 1024, 4096, 3, nullptr}; transpose_job(j, scr, gw, ngw, lane);
    j = TJob{P.in[I_WQB] + (size_t)l * 256 * 768, 256, 768, WT + WT_QB, 768, 4, P.in[I_QNA] + l * 256}; transpose_job(j, scr, gw, ngw, lane);
    j = TJob{P.in[I_WKVB] + (size_t)l * 128 * 1024, 128, 1024, WT + WT_KVB, 1024, 5, P.in[I_KVNA] + l * 128}; transpose_job(j, scr, gw, ngw, lane);
    for (int n = 0; n < 3; ++n) { j = TJob{P.in[I_WBR] + ((size_t)l * 3 + n) * 512 * 1024, 512, 1024, WT + WT_BR + (size_t)n * 1024 * 512, 1024, 0, nullptr}; transpose_job(j, scr, gw, ngw, lane); }
    j = TJob{P.in[I_WOUT] + (size_t)l * 1024 * 1024, 1024, 1024, WT + WT_OUT, 1024, 0, nullptr}; transpose_job(j, scr, gw, ngw, lane);
}
DI void phase_wconv_ffn(const Params& P, int l, LAS unsigned char* lds) {
    const int tid = threadIdx.x, wave = tid >> 6, lane = tid & 63, gw = blockIdx.x * NWAVES + wave, ngw = gridDim.x * NWAVES;
    LAS float* scr = (LAS float*)lds + wave * (64 * 33);
    bf16_t* WT = (bf16_t*)(P.ws + WS_WT);
    TJob j;
    j = TJob{P.in[I_WF1] + (size_t)l * 1024 * 5632, 1024, 5632, WT + WT_F1, 5632, 6, nullptr}; transpose_job(j, scr, gw, ngw, lane);
    j = TJob{P.in[I_WF2] + (size_t)l * 2816 * 1024, 2816, 1024, WT + WT_F2, 1024, 0, nullptr}; transpose_job(j, scr, gw, ngw, lane);
}

DI void phase_norm(const float* __restrict__ hl, const float* __restrict__ hc, const float* __restrict__ nw, const float* __restrict__ MODl, int ishift, int iscale, bf16_t* __restrict__ A, int nrows) {
    const int tid = threadIdx.x, wave = tid >> 6, lane = tid & 63, gw = blockIdx.x * NWAVES + wave, ngw = gridDim.x * NWAVES;
    f32x4 nx[4];
#define NLOAD(dst, m_) do { const float* xr_ = (m_) >= TL ? hc + (size_t)((m_) - TL) * DM : hl + (size_t)(m_) * DM; \
        _Pragma("unroll") for (int j = 0; j < 4; ++j) dst[j] = *(const f32x4*)(xr_ + 4 * lane + 256 * j); } while (0)
    if (gw < nrows) NLOAD(nx, gw);
    for (int m = gw; m < nrows; m += ngw) {
        f32x4 v[4];
#pragma unroll
        for (int j = 0; j < 4; ++j) v[j] = nx[j];
        if (m + ngw < nrows) NLOAD(nx, m + ngw);
        int b, pos, isctx; rowinfo(m, b, pos, isctx);
        const float* mod = MODl + (size_t)(isctx ? 4 : b) * 6144;
        float ss = 0.f;
#pragma unroll
        for (int j = 0; j < 4; ++j) ss += (v[j].x * v[j].x + v[j].y * v[j].y) + (v[j].z * v[j].z + v[j].w * v[j].w);
        const float rstd = rsqrtf(wave_sum(ss) * (1.f / DM) + EPS);
#pragma unroll
        for (int j = 0; j < 4; ++j) { const int c = 4 * lane + 256 * j;
            const f32x4 w = *(const f32x4*)(nw + c), sh = *(const f32x4*)(mod + ishift * 1024 + c), sc = *(const f32x4*)(mod + iscale * 1024 + c);
            const f32x4 y = v[j] * rstd * w * (sc + 1.f) + sh;
            u32x2 o; o.x = pk2(y.x, y.y); o.y = pk2(y.z, y.w);
            *(u32x2*)(A + (size_t)m * DM + c) = o; }
    }
#undef NLOAD
}
#include <cstdlib>
#include <vector>

#define XB_TMO      128
#define XB_XCNT(j)  (256  + 64 * (j))
#define XB_XSUB(j)  (1280 + 64 * (j))
#define XB_XGEN(j)  (2304 + 64 * (j))
#define XB_TOP      3328
#define XB_TOPGEN   3392
#define XCD_BAR_WORDS 3456
#define XB_SPIN_CAP (1u << 18)

__device__ __forceinline__ unsigned xb_ld(unsigned* p)              { return __hip_atomic_load(p, __ATOMIC_RELAXED, __HIP_MEMORY_SCOPE_AGENT); }
__device__ __forceinline__ unsigned xb_add(unsigned* p, unsigned v) { return __hip_atomic_fetch_add(p, v, __ATOMIC_RELAXED, __HIP_MEMORY_SCOPE_AGENT); }
__device__ __forceinline__ unsigned xb_xcc_id() { return (unsigned)__builtin_amdgcn_s_getreg((3 << 11) | 20) & 0xFu; }
#define XB_SPIN(cond, bar) do { unsigned _sp = 0; while (cond) { __builtin_amdgcn_s_sleep(1); \
    if ((++_sp & 255u) == 0u) { if (xb_ld(&(bar)[XB_TMO])) break; if (_sp > XB_SPIN_CAP) { atomicAdd(&(bar)[XB_TMO], 1u); break; } } } } while (0)

struct XcdBarrier {
    unsigned* bar; unsigned x;
    volatile LAS unsigned* st;
};

__device__ __forceinline__ XcdBarrier xcd_barrier_post(unsigned* bar, volatile LAS unsigned* st) {
    XcdBarrier b; b.bar = bar; b.x = xb_xcc_id(); b.st = st;
    if (threadIdx.x == 0) (void)xb_add(&bar[XB_XCNT(b.x)], 1u);
    return b;
}
__device__ __forceinline__ void xcd_barrier_complete(unsigned* bar, unsigned x, unsigned& nloc, unsigned& nx) {
    const unsigned G = gridDim.x * gridDim.y * gridDim.z;
    unsigned sum, cnt, mine, sp = 0u;
    for (;;) {
        sum = 0u; cnt = 0u; mine = 0u;
#pragma unroll
        for (unsigned j = 0; j < 16; ++j) { const unsigned c = xb_ld(&bar[XB_XCNT(j)]); sum += c; cnt += (c > 0u) ? 1u : 0u; mine = (j == x) ? c : mine; }
        if (sum == G) break;
        __builtin_amdgcn_s_sleep(1);
        if ((++sp & 255u) == 0u) { if (xb_ld(&bar[XB_TMO])) break; if (sp > XB_SPIN_CAP) { atomicAdd(&bar[XB_TMO], 1u); break; } }
    }
    nloc = mine > 0u ? mine : 1u; nx = cnt > 0u ? cnt : 1u;
}

__device__ __forceinline__ void xcd_barrier(const XcdBarrier& b) {
    asm volatile("s_waitcnt vmcnt(0)" ::: "memory");
    __syncthreads();
    if (threadIdx.x == 0) {
        unsigned* bar = b.bar;
        __builtin_amdgcn_s_waitcnt(0);
        unsigned nloc = b.st[0], nx = b.st[1];
        if (nloc == 0u) { xcd_barrier_complete(bar, b.x, nloc, nx); b.st[0] = nloc; b.st[1] = nx; }
        const unsigned old = xb_add(&bar[XB_XSUB(b.x)], 1u);
        const unsigned gen = old / nloc;
        if (old + 1u == (gen + 1u) * nloc) {
            __builtin_amdgcn_fence(__ATOMIC_RELEASE, "agent");
            asm volatile("s_waitcnt vmcnt(0)" ::: "memory");
            const unsigned og = xb_add(&bar[XB_TOP], 1u);
            const unsigned tg = og / nx;
            if (og + 1u == (tg + 1u) * nx) xb_add(&bar[XB_TOPGEN], 1u);
            else XB_SPIN(xb_ld(&bar[XB_TOPGEN]) == tg, bar);
            __builtin_amdgcn_fence(__ATOMIC_ACQUIRE, "agent");
            xb_add(&bar[XB_XGEN(b.x)], 1u);
            asm volatile("s_waitcnt vmcnt(0)" ::: "memory");
        } else {
            XB_SPIN(xb_ld(&bar[XB_XGEN(b.x)]) == gen, bar);
            __builtin_amdgcn_fence(__ATOMIC_ACQUIRE, "agent");
            asm volatile("s_waitcnt vmcnt(0)" ::: "memory");
        }
    }
    __syncthreads();
}

enum { EM_PLAIN = 0, EM_KV, EM_BIG, EM_GATES, EM_BRANCH, EM_RES, EM_FFNIN, EM_INPROJ };
template <int MODE> struct Epi {
    static constexpr bool PERM = true, AFTER_DRAIN = false;
    bf16_t* O0; int ld0; bf16_t* O1; int ld1;
    const bf16_t* Gsrc;
    const float* fa;
    const float* hin_l; const float* hin_c; float* hout_l; float* hout_c;
    int ipar;
    DI void emit(int row, int col, f32x4 v0, f32x4 v1) const {
        float f[8] = {v0[0], v0[1], v0[2], v0[3], v1[0], v1[1], v1[2], v1[3]};
        if (MODE == EM_INPROJ) {
            if (col < 512) { *(u32x4*)(O1 + (size_t)row * 512 + col) = pack8(f); return; }
            col -= 512;
        }
        if (MODE == EM_PLAIN) {
            *(u32x4*)(O0 + (size_t)row * ld0 + col) = pack8(f);
        } else if (MODE == EM_KV) {
            if (col < 512) *(u32x4*)(O0 + (size_t)row * 768 + col) = pack8(f);
            else           *(u32x4*)(O1 + (size_t)row * 512 + (col - 512)) = pack8(f);
        } else if (MODE == EM_FFNIN) {
            if (col < DFF) *(u32x4*)(O0 + (size_t)row * DFF + col) = pack8(f);
            else           *(u32x4*)(O1 + (size_t)row * DFF + (col - DFF)) = pack8(f);
        } else if (MODE == EM_BIG || MODE == EM_INPROJ) {
            const float QS = 0.08838834764831845f;
            if (col < 512) { for (int i = 0; i < 8; ++i) f[i] *= QS; }
            else if (col >= 1536 && col < 2560) {
                int b, pos, isctx; rowinfo(row, b, pos, isctx);
                const int sp = isctx ? pos : CTX + pos;
                const int g = ((col - 1536) & 127) >> 3;
                const f32x2* rot = (const f32x2*)fa + (size_t)sp * 64 + 4 * g;
                const float sc = col >= 2048 ? QS : 1.f;
#pragma unroll
                for (int e = 0; e < 4; ++e) { const f32x2 cs = rot[e]; const float x1 = f[e], x2 = f[4 + e];
                    f[e] = (x1 * cs.x - x2 * cs.y) * sc; f[4 + e] = (x1 * cs.y + x2 * cs.x) * sc; }
            }
            *(u32x4*)(O0 + (size_t)row * 3072 + col) = pack8(f);
        } else if (MODE == EM_GATES) {
            if (col < 1024) {
                bf16_t* p = O1 + (size_t)row * 1024 + col; float on[8]; unpack8(*(const u32x4*)p, on);
#pragma unroll
                for (int i = 0; i < 8; ++i) f[i] = on[i] * f[i] * sigmoidf_(f[i]);
                *(u32x4*)p = pack8(f);
            } else {
                const int cc = col - 1024; const f32x4 b0 = *(const f32x4*)(fa + cc), b1 = *(const f32x4*)(fa + cc + 4);
                const float bb[8] = {b0[0], b0[1], b0[2], b0[3], b1[0], b1[1], b1[2], b1[3]};
#pragma unroll
                for (int i = 0; i < 8; ++i) f[i] = sigmoidf_(f[i] + bb[i]);
                *(u32x4*)(O0 + (size_t)row * 3072 + cc) = pack8(f);
            }
        } else if (MODE == EM_BRANCH) {
            float g[8]; unpack8(*(const u32x4*)(Gsrc + (size_t)row * 3072 + col), g);
            bf16_t* p = O0 + (size_t)row * 1024 + col;
            if (ipar > 0) { float pr[8]; unpack8(*(const u32x4*)p, pr);
#pragma unroll
                for (int i = 0; i < 8; ++i) f[i] = pr[i] + g[i] * f[i]; }
            else {
#pragma unroll
                for (int i = 0; i < 8; ++i) f[i] = g[i] * f[i]; }
            *(u32x4*)p = pack8(f);
        } else if (MODE == EM_RES) {
            int b, pos, isctx; rowinfo(row, b, pos, isctx);
            const float* hi_ = isctx ? hin_c + (size_t)(row - TL) * DM : hin_l + (size_t)row * DM;
            float* ho_ = isctx ? hout_c + (size_t)(row - TL) * DM : hout_l + (size_t)row * DM;
            const float* mod = fa + (size_t)(isctx ? 4 : b) * 6144 + ipar * 1024 + col;
            const f32x4 m0 = *(const f32x4*)mod, m1 = *(const f32x4*)(mod + 4);
            const f32x4 h0 = *(const f32x4*)(hi_ + col), h1 = *(const f32x4*)(hi_ + col + 4);
            *(f32x4*)(ho_ + col) = h0 + m0 * v0; *(f32x4*)(ho_ + col + 4) = h1 + m1 * v1;
        }
    }
    DI void operator()(const pg8::f32x4 (&acc)[2][2][4][2], const pg8::Unit& u, int wr, int wc, int fr, int fq) const {
#pragma unroll
        for (int ai = 0; ai < 2; ++ai)
#pragma unroll
            for (int m = 0; m < 4; ++m) { const int row = u.pm * 256 + ai * 128 + wr * 64 + m * 16 + fr;
#pragma unroll
                for (int bj = 0; bj < 2; ++bj) { const int col = u.pn * 256 + bj * 128 + wc * 32 + 8 * fq;
                    emit(row, col, acc[ai][bj][m][0], acc[ai][bj][m][1]); } }
    }
};

DI float dpp_ror1(float x) { return __int_as_float(__builtin_amdgcn_update_dpp(0, __float_as_int(x), 0x121, 0xf, 0xf, false)); }
DI float dpp_ror15(float x) { return __int_as_float(__builtin_amdgcn_update_dpp(0, __float_as_int(x), 0x12F, 0xf, 0xf, false)); }
DI float gelu_gate(float x, float u) { const float t2 = (-1.5957691216057308f * 1.4426950408889634f) * (x + 0.044715f * x * x * x); return x * __builtin_amdgcn_rcpf(1.f + __builtin_amdgcn_exp2f(t2)) * u; }
struct EpiFfnConv {
    static constexpr bool PERM = true, AFTER_DRAIN = false;
    bf16_t* ACT; float* HALO; const float* wdw; const float* bdw; LAS float* X;
    DI void operator()(const pg8::f32x4 (&acc)[2][2][4][2], const pg8::Unit& u, int wr, int wc, int fr, int fq) const {
        const int ch = 128 * u.pn + 32 * wc + 8 * fq, xc = 32 * wc + 8 * fq;
        float w0[8], w1[8], w2[8], bb[8];
#pragma unroll
        for (int k = 0; k < 8; ++k) { w0[k] = wdw[ch + k]; w1[k] = wdw[DFF + ch + k]; w2[k] = wdw[2 * DFF + ch + k]; bb[k] = bdw[ch + k]; }
#pragma unroll
        for (int ai = 0; ai < 2; ++ai) {
            if (fr == 0) {
#pragma unroll
                for (int k = 0; k < 8; ++k) X[((ai * 2 + wr) * 2 + 0) * 128 + xc + k] = acc[ai][0][0][k >> 2][k & 3]; }
            if (fr == 15) {
#pragma unroll
                for (int k = 0; k < 8; ++k) X[((ai * 2 + wr) * 2 + 1) * 128 + xc + k] = acc[ai][0][3][k >> 2][k & 3]; }
        }
        asm volatile("s_waitcnt lgkmcnt(0)" ::: "memory"); __builtin_amdgcn_s_barrier(); asm volatile("" ::: "memory");
        const bool first_tile_row_is_seq_start = (u.pm >= TL / 256) || ((u.pm & 31) == 0);
        const bool last_tile_row_is_seq_end = (u.pm >= TL / 256) || ((u.pm & 31) == 31);
#pragma unroll
        for (int ai = 0; ai < 2; ++ai) {
            float top[8], bot[8];
            { const int tsel = wr == 1 ? ((ai * 2 + 0) * 2 + 1) : ((0 * 2 + 1) * 2 + 1);
              const bool tval = (wr == 1) || (ai == 1);
              const int bsel = wr == 0 ? ((ai * 2 + 1) * 2 + 0) : ((1 * 2 + 0) * 2 + 0);
              const bool bval = (wr == 0) || (ai == 0);
#pragma unroll
              for (int k = 0; k < 8; ++k) { top[k] = tval ? X[tsel * 128 + xc + k] : 0.f; bot[k] = bval ? X[bsel * 128 + xc + k] : 0.f; } }
#pragma unroll
            for (int m = 0; m < 4; ++m) {
                const int row = u.pm * 256 + ai * 128 + wr * 64 + m * 16 + fr;
                float o[8], xs[8];
#pragma unroll
                for (int k = 0; k < 8; ++k) {
                    const float g = acc[ai][0][m][k >> 2][k & 3], up = acc[ai][1][m][k >> 2][k & 3];
                    const float pa = dpp_ror1(g);
                    const float pb = m > 0 ? dpp_ror1(acc[ai][0][m > 0 ? m - 1 : 0][k >> 2][k & 3]) : top[k];
                    const float na = dpp_ror15(g);
                    const float nb = m < 3 ? dpp_ror15(acc[ai][0][m < 3 ? m + 1 : 3][k >> 2][k & 3]) : bot[k];
                    const float gp = fr > 0 ? pa : pb, gn = fr < 15 ? na : nb;
                    const float x = w0[k] * gp + w1[k] * g + w2[k] * gn + bb[k];
                    xs[k] = x; o[k] = gelu_gate(x, up);
                }
                *(u32x4*)(ACT + (size_t)row * DFF + ch) = pack8(o);
                if (ai == 0 && m == 0 && wr == 0 && fr == 0 && !first_tile_row_is_seq_start) { float* h = HALO + ((size_t)u.pm * 6 + 0) * DFF + ch;
#pragma unroll
                    for (int k = 0; k < 8; ++k) { h[k] = acc[0][0][0][k >> 2][k & 3]; h[DFF + k] = xs[k]; h[2 * DFF + k] = acc[0][1][0][k >> 2][k & 3]; } }
                if (ai == 1 && m == 3 && wr == 1 && fr == 15 && !last_tile_row_is_seq_end) { float* h = HALO + ((size_t)u.pm * 6 + 3) * DFF + ch;
#pragma unroll
                    for (int k = 0; k < 8; ++k) { h[k] = acc[1][0][3][k >> 2][k & 3]; h[DFF + k] = xs[k]; h[2 * DFF + k] = acc[1][1][3][k >> 2][k & 3]; } }
            }
        }
    }
};
DI void convfix_tile(const Params& P, int l, int pm) {
    if (pm >= TL / 256) return;
    bf16_t* ACT = (bf16_t*)(P.ws + WS_G); const float* HALO = (const float*)(P.ws + WS_U);
    const float* wdw = P.in[I_WDW] + (size_t)l * 3 * DFF;
    for (int c = threadIdx.x; c < 2 * DFF; c += NTHREADS) {
        const int which = c >= DFF, ch = which ? c - DFF : c;
        if (which == 0) {
            if ((pm & 31) == 0) continue;
            const float* hf = HALO + ((size_t)pm * 6 + 0) * DFF + ch; const float g_prev = HALO[((size_t)(pm - 1) * 6 + 3) * DFF + ch];
            ACT[(size_t)(pm * 256) * DFF + ch] = f2bf(gelu_gate(hf[DFF] + wdw[ch] * g_prev, hf[2 * DFF]));
        } else {
            if ((pm & 31) == 31) continue;
            const float* hl = HALO + ((size_t)pm * 6 + 3) * DFF + ch; const float g_next = HALO[((size_t)(pm + 1) * 6 + 0) * DFF + ch];
            ACT[(size_t)(pm * 256 + 255) * DFF + ch] = f2bf(gelu_gate(hl[DFF] + wdw[2 * DFF + ch] * g_next, hl[2 * DFF]));
        }
    }
}
DI void phase_convfix_mine(const Params& P, int l, int M) {
    pg8::StaticOrder S; S.init(M, 1024, (int)gridDim.x, (int)blockIdx.x);
    pg8::Unit u; int prev = -1;
    for (int i = 0; S.next(i, u); ++i) { if (u.pm != prev) convfix_tile(P, l, u.pm); prev = u.pm; }
    asm volatile("s_waitcnt vmcnt(0)" ::: "memory");
    __syncthreads();
}

struct EpiGates {
    static constexpr bool PERM = true, AFTER_DRAIN = false;
    bf16_t* G3; bf16_t* OF; const bf16_t* OB; const float* bgate; const float* gon; LAS float* RS;
    DI void operator()(const pg8::f32x4 (&acc)[2][2][4][2], const pg8::Unit& u, int wr, int wc, int fr, int fq) const {
        if (u.pn < 4) {
#pragma unroll
            for (int ai = 0; ai < 2; ++ai)
#pragma unroll
                for (int m = 0; m < 4; ++m) { const int lr = ai * 128 + wr * 64 + m * 16 + fr, row = u.pm * 256 + lr;
#pragma unroll
                    for (int bj = 0; bj < 2; ++bj) { const int col = u.pn * 256 + bj * 128 + wc * 32 + 8 * fq;
                        float a[8], b[8]; unpack8(*(const u32x4*)(OF + (size_t)row * 1024 + col), a); unpack8(*(const u32x4*)(OB + (size_t)row * 1024 + col), b);
                        float ss = 0.f;
#pragma unroll
                        for (int k = 0; k < 8; ++k) { const float o = a[k] + b[k]; ss += o * o; }
                        ss += __shfl_xor(ss, 16); ss += __shfl_xor(ss, 32);
                        if (fq == 0) RS[(lr * 2 + bj) * 4 + wc] = ss; } }
            asm volatile("s_waitcnt lgkmcnt(0)" ::: "memory"); __builtin_amdgcn_s_barrier(); asm volatile("" ::: "memory");
#pragma unroll
            for (int ai = 0; ai < 2; ++ai)
#pragma unroll
                for (int m = 0; m < 4; ++m) { const int lr = ai * 128 + wr * 64 + m * 16 + fr, row = u.pm * 256 + lr;
#pragma unroll
                    for (int bj = 0; bj < 2; ++bj) { const int col = u.pn * 256 + bj * 128 + wc * 32 + 8 * fq, hd = 2 * u.pn + bj, cw = wc * 32 + 8 * fq;
                        bf16_t* p = OF + (size_t)row * 1024 + col;
                        float a[8], b[8]; unpack8(*(const u32x4*)p, a); unpack8(*(const u32x4*)(OB + (size_t)row * 1024 + col), b);
                        const f32x4 t = *(const LAS f32x4*)(RS + (lr * 2 + bj) * 4);
                        const float rstd = rsqrtf(((t[0] + t[1]) + (t[2] + t[3])) * (1.f / 128.f) + EPS);
                        float f[8];
#pragma unroll
                        for (int k = 0; k < 8; ++k) { const float g = acc[ai][bj][m][k >> 2][k & 3]; const float w = hd < 4 ? gon[cw + k] : 1.f;
                            f[k] = (a[k] + b[k]) * rstd * w * g * sigmoidf_(g); }
                        *(u32x4*)p = pack8(f); } }
        } else {
#pragma unroll
            for (int ai = 0; ai < 2; ++ai)
#pragma unroll
                for (int m = 0; m < 4; ++m) { const int row = u.pm * 256 + ai * 128 + wr * 64 + m * 16 + fr;
#pragma unroll
                    for (int bj = 0; bj < 2; ++bj) { const int cc = u.pn * 256 + bj * 128 + wc * 32 + 8 * fq - 1024;
                        const f32x4 b0 = *(const f32x4*)(bgate + cc), b1 = *(const f32x4*)(bgate + cc + 4);
                        float f[8];
#pragma unroll
                        for (int k = 0; k < 8; ++k) f[k] = sigmoidf_(acc[ai][bj][m][k >> 2][k & 3] + (k < 4 ? b0[k & 3] : b1[k & 3]));
                        *(u32x4*)(G3 + (size_t)row * 3072 + cc) = pack8(f); } }
        }
    }
};
DI void run_gemm_gates(LAS unsigned char* lds, const bf16_t* A, const bf16_t* Bt, int M, const EpiGates& E) {
    pg8::Gemm g{A, Bt, M, 4096, 1024, 1024}; pg8::StaticOrder S; S.init(M, 4096, (int)gridDim.x, (int)blockIdx.x);
    pg8::gemm_phase<EpiGates, pg8::StaticOrder, true, true>((PG8_LAS unsigned char*)lds, g, S, E);
}
template <int MODE>
DI void run_gemm(LAS unsigned char* lds, const bf16_t* A, int lda, const bf16_t* Bt, int M, int N, int K, const Epi<MODE>& E) {
    int Kop = K; if (K < 512) asm volatile("" : "+s"(Kop));
    pg8::Gemm g{A, Bt, M, N, Kop, lda}; pg8::StaticOrder S; S.init(M, N, (int)gridDim.x, (int)blockIdx.x);
    pg8::gemm_phase<Epi<MODE>, pg8::StaticOrder, true, true>((PG8_LAS unsigned char*)lds, g, S, E);
}
DI void run_gemm_ffnconv(LAS unsigned char* lds, const bf16_t* A, const bf16_t* Bt, int M, const EpiFfnConv& E) {
    pg8::Gemm g{A, Bt, M, 5632, 1024, 1024}; pg8::StaticOrder S; S.init(M, 5632, (int)gridDim.x, (int)blockIdx.x);
    pg8::gemm_phase<EpiFfnConv, pg8::StaticOrder, true, true>((PG8_LAS unsigned char*)lds, g, S, E);
}

DI void phase_qkpost(const Params& P, int l, LAS unsigned* lmax, const bool probe = false) {
    const int tid = threadIdx.x, wave = tid >> 6, lane = tid & 63, gw = blockIdx.x * NWAVES + wave, ngw = gridDim.x * NWAVES;
    const bf16_t* __restrict__ SM = (const bf16_t*)(P.ws + WS_SM); bf16_t* __restrict__ Q = (bf16_t*)(P.ws + WS_Q); bf16_t* __restrict__ K = (bf16_t*)(P.ws + WS_K); bf16_t* __restrict__ V = (bf16_t*)(P.ws + WS_V);
    const f32x2* __restrict__ ROPE = (const f32x2*)(P.ws + WS_ROPE);
    const float* qn = P.in[I_QN] + l * 96; const float* kn = P.in[I_KN] + l * 96;
    const int s = lane & 7, h = lane >> 3;
    float qnw[12], knw[12];
#pragma unroll
    for (int i = 0; i < 8; ++i) { qnw[i] = qn[8 * s + i]; knw[i] = kn[8 * s + i]; }
#pragma unroll
    for (int i = 0; i < 4; ++i) { qnw[8 + i] = qn[64 + 4 * s + i]; knw[8 + i] = kn[64 + 4 * s + i]; }
    const bool second = (s & 2) != 0;
    constexpr float QC = 0.10206207261596575f * 1.4426950408889634f;
    if (tid < 64) lmax[tid] = 0u;
    __syncthreads();
    u32x2 n_cq, n_kr, n_qr; unsigned n_ckv; u32x4 n_qn, n_kn, n_v;
#define QLOAD(m_) do { const bf16_t* sm_ = SM + (size_t)(m_) * 512; n_cq = *(const u32x2*)(sm_ + 4 * lane); n_ckv = *(const unsigned*)(sm_ + 256 + 2 * lane); n_kr = *(const u32x2*)(sm_ + 384 + 4 * s); \
        n_qn = *(const u32x4*)(Q + (size_t)(m_) * 768 + 64 * h + 8 * s); n_qr = *(const u32x2*)(Q + (size_t)(m_) * 768 + 512 + 32 * h + 4 * s); \
        n_kn = *(const u32x4*)(K + (size_t)(m_) * 768 + 64 * h + 8 * s); n_v = *(const u32x4*)(V + (size_t)(m_) * 512 + 8 * lane); } while (0)
    if (gw < TA) QLOAD(gw);
    for (int m = gw; m < TA; m += ngw) {
        const u32x2 cq = n_cq, krr = n_kr, qrr = n_qr; const unsigned ckv = n_ckv; const u32x4 qnn = n_qn, knn = n_kn, vraw = n_v;
        if (m + ngw < TA) QLOAD(m + ngw);
        int b, pos, isctx; rowinfo(m, b, pos, isctx);
        float a0 = bflo(cq.x), a1 = bfhi(cq.x), a2 = bflo(cq.y), a3 = bfhi(cq.y), c0 = bflo(ckv), c1 = bfhi(ckv);
        const float s_q = rsqrtf(wave_sum(a0 * a0 + a1 * a1 + a2 * a2 + a3 * a3) * (1.f / 256.f) + EPS);
        const float s_kv = rsqrtf(wave_sum(c0 * c0 + c1 * c1) * (1.f / 128.f) + EPS);
        float cs[4], sn[4];
        if (!isctx) { const f32x2* rp = ROPE + ((s < 4) ? (pos >> 6) : 128 + (pos & 63)) * 8 + 4 * (s & 1);
#pragma unroll
            for (int e = 0; e < 4; ++e) { const f32x2 t = rp[e]; cs[e] = t.x; sn[e] = t.y; } }
        else {
#pragma unroll
            for (int e = 0; e < 4; ++e) { cs[e] = 1.f; sn[e] = 0.f; } }
        {
            bf16_t* qp = (probe ? (bf16_t*)(P.ws + WS_R4) : Q) + (size_t)m * 768;
            float z[12]; unpack8(qnn, z);
            z[8] = bflo(qrr.x); z[9] = bfhi(qrr.x); z[10] = bflo(qrr.y); z[11] = bfhi(qrr.y);
            float ss = 0.f;
#pragma unroll
            for (int i = 0; i < 12; ++i) { z[i] *= s_q; ss += z[i] * z[i]; }
            ss += __shfl_xor(ss, 1); ss += __shfl_xor(ss, 2); ss += __shfl_xor(ss, 4);
            const float r = rsqrtf(ss * (1.f / 96.f) + EPS);
#pragma unroll
            for (int i = 0; i < 12; ++i) z[i] *= r * qnw[i] * QC;
            { float n2 = 0.f;
#pragma unroll
              for (int i = 0; i < 12; ++i) n2 += z[i] * z[i];
              n2 += __shfl_xor(n2, 1); n2 += __shfl_xor(n2, 2); n2 += __shfl_xor(n2, 4);
              if (s == 0 && !probe) atomicMax((unsigned*)&lmax[(b * 8 + h) * 2], __float_as_uint(n2)); }
#pragma unroll
            for (int e = 0; e < 4; ++e) { const float mine = z[8 + e], other = __shfl_xor(mine, 2);
                z[8 + e] = second ? (other * sn[e] + mine * cs[e]) : (mine * cs[e] - other * sn[e]); }
            *(u32x4*)(qp + 64 * h + 8 * s) = pack8(z);
            u32x2 o; o.x = pk2(z[8], z[9]); o.y = pk2(z[10], z[11]); *(u32x2*)(qp + 512 + 32 * h + 4 * s) = o;
        }
        {
            bf16_t* kp = (probe ? (bf16_t*)(P.ws + WS_R4) + (size_t)TA * 768 : K) + (size_t)m * 768;
            float z[12]; unpack8(knn, z);
#pragma unroll
            for (int i = 0; i < 8; ++i) z[i] *= s_kv;
            z[8] = bflo(krr.x); z[9] = bfhi(krr.x); z[10] = bflo(krr.y); z[11] = bfhi(krr.y);
            float ss = 0.f;
#pragma unroll
            for (int i = 0; i < 12; ++i) ss += z[i] * z[i];
            ss += __shfl_xor(ss, 1); ss += __shfl_xor(ss, 2); ss += __shfl_xor(ss, 4);
            const float r = rsqrtf(ss * (1.f / 96.f) + EPS);
#pragma unroll
            for (int i = 0; i < 12; ++i) z[i] *= r * knw[i];
            { float n2 = 0.f;
#pragma unroll
              for (int i = 0; i < 12; ++i) n2 += z[i] * z[i];
              n2 += __shfl_xor(n2, 1); n2 += __shfl_xor(n2, 2); n2 += __shfl_xor(n2, 4);
              if (s == 0 && !probe) atomicMax((unsigned*)&lmax[(b * 8 + h) * 2 + 1], __float_as_uint(n2)); }
#pragma unroll
            for (int e = 0; e < 4; ++e) { const float mine = z[8 + e], other = __shfl_xor(mine, 2);
                z[8 + e] = second ? (other * sn[e] + mine * cs[e]) : (mine * cs[e] - other * sn[e]); }
            *(u32x4*)(kp + 64 * h + 8 * s) = pack8(z);
            u32x2 o; o.x = pk2(z[8], z[9]); o.y = pk2(z[10], z[11]); *(u32x2*)(kp + 512 + 32 * h + 4 * s) = o;
            float vv[8]; unpack8(vraw, vv);
#pragma unroll
            for (int i = 0; i < 8; ++i) vv[i] *= s_kv;
            *(u32x4*)((probe ? (bf16_t*)(P.ws + WS_R4) + (size_t)TA * 1536 : V) + (size_t)m * 512 + 8 * lane) = pack8(vv);
        }
    }
#undef QLOAD
    __syncthreads();
    if (tid < 64 && !probe) atomicMax((unsigned*)(P.ws + WS_QKM) + tid, lmax[tid]);
}

DI void phase_scanpost(const Params& P, int l, int nrows, const bool probe = false) {
    const int tid = threadIdx.x, wave = tid >> 6, lane = tid & 63, gw = blockIdx.x * NWAVES + wave, ngw = gridDim.x * NWAVES;
    bf16_t* __restrict__ OF = (bf16_t*)(P.ws + WS_OF); const bf16_t* __restrict__ OB = (const bf16_t*)(P.ws + WS_OB);
    const float* gw_ = P.in[I_GON] + l * 128;
    const int sub = lane & 7, hd = lane >> 3;
    float w[16];
#pragma unroll
    for (int i = 0; i < 16; ++i) w[i] = hd < 4 ? gw_[16 * sub + i] : 1.f;
    u32x4 nf0, nf1, nb0, nb1;
#define PLOAD(m_) do { const bf16_t* pf_ = OF + (size_t)(m_) * 1024 + 16 * lane; const bf16_t* pb_ = OB + (size_t)(m_) * 1024 + 16 * lane; \
        nf0 = *(const u32x4*)pf_; nf1 = *(const u32x4*)(pf_ + 8); nb0 = *(const u32x4*)pb_; nb1 = *(const u32x4*)(pb_ + 8); } while (0)
    if (gw < nrows) PLOAD(gw);
    for (int m = gw; m < nrows; m += ngw) {
        float a[16], bq[16];
        unpack8(nf0, a); unpack8(nf1, a + 8); unpack8(nb0, bq); unpack8(nb1, bq + 8);
        if (m + ngw < nrows) PLOAD(m + ngw);
        float ss = 0.f;
#pragma unroll
        for (int i = 0; i < 16; ++i) { a[i] += bq[i]; ss += a[i] * a[i]; }
        ss += __shfl_xor(ss, 1); ss += __shfl_xor(ss, 2); ss += __shfl_xor(ss, 4);
        const float r = rsqrtf(ss * (1.f / 128.f) + EPS);
#pragma unroll
        for (int i = 0; i < 16; ++i) a[i] *= r * w[i];
        bf16_t* pf = (probe ? (bf16_t*)(P.ws + WS_R4) : OF) + (size_t)m * 1024 + 16 * lane;
        *(u32x4*)pf = pack8(a); *(u32x4*)(pf + 8) = pack8(a + 8);
    }
#undef PLOAD
}

DI void phase_conv(const Params& P, int l, int nrows) {
    const bf16_t* __restrict__ G = (const bf16_t*)(P.ws + WS_G); bf16_t* __restrict__ U = (bf16_t*)(P.ws + WS_U);
    const float* __restrict__ wdw = P.in[I_WDW] + (size_t)l * 3 * DFF; const float* __restrict__ bdw = P.in[I_BDW] + (size_t)l * DFF;
    const int total = (nrows / 4) * 352;
    for (int i = blockIdx.x * NTHREADS + threadIdx.x; i < total; i += gridDim.x * NTHREADS) {
        const int quad = i / 352, c = (i - quad * 352) * 8, m0 = quad * 4;
        int b, pos, isctx; rowinfo(m0, b, pos, isctx);
        const int last = isctx ? CTX - 1 : SEQ - 1;
        u32x4 g[6], u[4];
#pragma unroll
        for (int r = 0; r < 4; ++r) { g[r + 1] = *(const u32x4*)(G + (size_t)(m0 + r) * DFF + c); u[r] = *(const u32x4*)(U + (size_t)(m0 + r) * DFF + c); }
        g[0] = pos > 0 ? *(const u32x4*)(G + (size_t)(m0 - 1) * DFF + c) : (u32x4){0u, 0u, 0u, 0u};
        g[5] = pos + 3 < last ? *(const u32x4*)(G + (size_t)(m0 + 4) * DFF + c) : (u32x4){0u, 0u, 0u, 0u};
        float w0[8], w1[8], w2[8], bb[8];
#pragma unroll
        for (int k = 0; k < 8; ++k) { w0[k] = wdw[c + k]; w1[k] = wdw[DFF + c + k]; w2[k] = wdw[2 * DFF + c + k]; bb[k] = bdw[c + k]; }
#pragma unroll
        for (int r = 0; r < 4; ++r) {
            float a0[8], a1[8], a2[8], uu[8], o[8];
            unpack8(g[r], a0); unpack8(g[r + 1], a1); unpack8(g[r + 2], a2); unpack8(u[r], uu);
#pragma unroll
            for (int k = 0; k < 8; ++k) {
                const float x = w0[k] * a0[k] + w1[k] * a1[k] + w2[k] * a2[k] + bb[k];
                const float t2 = 1.5957691216057308f * (x + 0.044715f * x * x * x);
                o[k] = x / (1.f + __expf(-t2)) * uu[k];
            }
            *(u32x4*)(U + (size_t)(m0 + r) * DFF + c) = pack8(o);
        }
    }
}

namespace att {
constexpr int NW = 8, QBLK = 32, KVBLK = 64;
constexpr float SCALE = 0.10206207261596575f;
constexpr float THR = 8.f;
constexpr int SHM_V = 64 * 128 * 2, SHM_K = 64 * 256, SHM_ATTN = 2 * SHM_V + 2 * SHM_K + NW * 64 * 4;
#define KSWZ(row, colB) ((row) * 256 + ((colB) ^ (((row) & 7) << 4)))
#define SBAR() __builtin_amdgcn_sched_barrier(0)
DI int crow(int r, int hi) { return (r & 3) + 8 * (r >> 2) + 4 * hi; }
DI unsigned cvtpk(float lo, float hi) { unsigned r; asm volatile("s_nop 0\n\tv_cvt_pk_bf16_f32 %0, %1, %2" : "=v"(r) : "v"(lo), "v"(hi)); return r; }
DI bf16x8 ld8(const bf16_t* p) { return *reinterpret_cast<const bf16x8*>(p); }

constexpr float THR2 = 11.5f;
DI void partialSM(f32x16& p0, f32x16& p1, float& m_reg, float& mn, float& alpha) {
  float pmax = p0[0]; for (int r = 1; r < 16; ++r) pmax = fmaxf(pmax, p0[r]); for (int r = 0; r < 16; ++r) pmax = fmaxf(pmax, p1[r]);
  { auto rr = __builtin_amdgcn_permlane32_swap(__float_as_uint(pmax), __float_as_uint(pmax), false, false);
    pmax = fmaxf(__uint_as_float(rr[0]), __uint_as_float(rr[1])); }
  if (__builtin_expect(__all(pmax - m_reg <= THR2), 1)) { mn = m_reg; alpha = 1.f; }
  else { mn = fmaxf(m_reg, pmax); alpha = __builtin_amdgcn_exp2f(m_reg - mn); m_reg = mn; }
  for (int r = 0; r < 16; ++r) p0[r] -= mn; for (int r = 0; r < 16; ++r) p1[r] -= mn;
  for (int r = 0; r < 16; ++r) p0[r] = __builtin_amdgcn_exp2f(p0[r]);
}
DI void partialSM_fix(f32x16& p0) { for (int r = 0; r < 16; ++r) p0[r] = __builtin_amdgcn_exp2f(p0[r]); }
DI void finishSM(f32x16& p0, f32x16& p1, float alpha, float& l_reg, bf16x8& pa0, bf16x8& pa1, bf16x8& pa2, bf16x8& pa3) {
  for (int r = 0; r < 16; ++r) p1[r] = __builtin_amdgcn_exp2f(p1[r]);
  float ps = 0; for (int r = 0; r < 16; ++r) ps += p0[r]; for (int r = 0; r < 16; ++r) ps += p1[r];
  { auto rr = __builtin_amdgcn_permlane32_swap(__float_as_uint(ps), __float_as_uint(ps), false, false);
    ps = __uint_as_float(rr[0]) + __uint_as_float(rr[1]); }
  l_reg = l_reg * alpha + ps;
#define PK4(P, BASE, OUT) do { unsigned a0 = cvtpk(P[BASE + 0], P[BASE + 1]), a1 = cvtpk(P[BASE + 2], P[BASE + 3]);   \
    unsigned b0 = cvtpk(P[BASE + 4], P[BASE + 5]), b1 = cvtpk(P[BASE + 6], P[BASE + 7]);                              \
    auto r0 = __builtin_amdgcn_permlane32_swap(a0, b0, false, false); auto r1 = __builtin_amdgcn_permlane32_swap(a1, b1, false, false); \
    u32x4 w = {r0[0], r1[0], r0[1], r1[1]}; OUT = *reinterpret_cast<bf16x8*>(&w); } while (0)
  PK4(p0, 0, pa0); PK4(p0, 8, pa1); PK4(p1, 0, pa2); PK4(p1, 8, pa3);
#undef PK4
}
template <bool FIX>
DI void qkt(f32x16& p0, f32x16& p1, const char* Ks, const bf16x8* qr, int r32, int hi, const f32x16& init) {
  const f32x16 zero = {};
#pragma unroll
  for (int d0 = 0; d0 < 6; ++d0) { int cb = (d0 * 16 + hi * 8) * 2;
    bf16x8 b0 = *reinterpret_cast<const bf16x8*>(Ks + KSWZ(r32, cb));
    bf16x8 b1 = *reinterpret_cast<const bf16x8*>(Ks + KSWZ(32 + r32, cb));
    p0 = __builtin_amdgcn_mfma_f32_32x32x16_bf16(b0, qr[d0], d0 == 0 ? zero : p0, 0, 0, 0);
    p1 = __builtin_amdgcn_mfma_f32_32x32x16_bf16(b1, qr[d0], d0 == 0 ? zero : p1, 0, 0, 0); }
}
DI int v_st(int k, int c) { const int kk = (k & ~0xC) | ((k & 4) << 1) | ((k & 8) >> 1); return ((kk >> 3) * 4 + (c >> 5)) * 512 + ((kk & 7) * 32 + (c & 31)) * 2; }
DI int v_rd_base(int lane) { return ((lane & 3) << 3) | (((lane >> 2) & 3) << 6) | (((lane >> 4) & 1) << 5) | (((lane >> 5) & 1) << 8); }
constexpr int v_rd_off(int d0, int ks, int half) { return d0 * 512 + ks * 4096 + half * 2048; }
template <int OFF> DI s16x4 tr_read(int vb) {
  s16x4 r; asm volatile("ds_read_b64_tr_b16 %0, %1 offset:%2" : "=&v"(r) : "v"(vb), "i"(OFF) : "memory"); return r;
}
template <int D0> DI void pv_one(f32x16& od, int vb, bf16x8 pa0, bf16x8 pa1, bf16x8 pa2, bf16x8 pa3) {
  const s16x4 l0 = tr_read<v_rd_off(D0, 0, 0)>(vb), h0 = tr_read<v_rd_off(D0, 0, 1)>(vb), l1 = tr_read<v_rd_off(D0, 1, 0)>(vb), h1 = tr_read<v_rd_off(D0, 1, 1)>(vb);
  const s16x4 l2 = tr_read<v_rd_off(D0, 2, 0)>(vb), h2 = tr_read<v_rd_off(D0, 2, 1)>(vb), l3 = tr_read<v_rd_off(D0, 3, 0)>(vb), h3 = tr_read<v_rd_off(D0, 3, 1)>(vb);
  asm volatile("s_waitcnt lgkmcnt(0)" ::: "memory"); SBAR();
#define PK(L, H) (bf16x8){L[0], L[1], L[2], L[3], H[0], H[1], H[2], H[3]}
  od = __builtin_amdgcn_mfma_f32_32x32x16_bf16(pa0, PK(l0, h0), od, 0, 0, 0);
  od = __builtin_amdgcn_mfma_f32_32x32x16_bf16(pa1, PK(l1, h1), od, 0, 0, 0);
  od = __builtin_amdgcn_mfma_f32_32x32x16_bf16(pa2, PK(l2, h2), od, 0, 0, 0);
  od = __builtin_amdgcn_mfma_f32_32x32x16_bf16(pa3, PK(l3, h3), od, 0, 0, 0);
#undef PK
}
DI void pv_d0(f32x16* o, int vb, bf16x8 pa0, bf16x8 pa1, bf16x8 pa2, bf16x8 pa3) {
  pv_one<0>(o[0], vb, pa0, pa1, pa2, pa3); pv_one<1>(o[1], vb, pa0, pa1, pa2, pa3);
}

template <bool FIX>
DI void attn_unit(const bf16_t* Qg, bf16_t* Og, int ldo, const bf16_t* Kg, const bf16_t* Vg, int qrow0, int h, int ctxrow0, int latrow0, int NT, char* lds, float bound) {
  const int tid = threadIdx.x, wid = tid >> 6, lane = tid & 63, r32 = lane & 31, hi = lane >> 5;
  char* V_lds = lds; char* K_lds = lds + 2 * SHM_V;
  float* ws = (float*)(lds + 2 * SHM_V + 2 * SHM_K) + wid * 64; float* li_l = ws; float* al_l = ws + 32;
  float m_reg = -1e30f, l_reg = 0; f32x16 o[2] = {}; bf16x8 qr[6];
  const f32x16 init = {}; (void)bound;
  const bf16_t* Qw = Qg + (size_t)(qrow0 + wid * QBLK + r32) * 768;
#pragma unroll
  for (int d0 = 0; d0 < 6; ++d0) qr[d0] = ld8(Qw + (d0 < 4 ? 64 * h + 16 * d0 + 8 * hi : 512 + 32 * h + 16 * (d0 - 4) + 8 * hi));
  const int vr = tid >> 3, vc = tid & 7, vst = v_st(vr, 8 * vc), vcol = 64 * h + 8 * vc;
  const int c0 = tid, c1 = 512 + (tid & 255);
  const int kr0 = c0 / 12, kc0 = c0 % 12, kr1 = c1 / 12, kc1 = c1 % 12;
  const int kcol0 = kc0 < 8 ? 64 * h + 8 * kc0 : 512 + 32 * h + 8 * (kc0 - 8), kcol1 = kc1 < 8 ? 64 * h + 8 * kc1 : 512 + 32 * h + 8 * (kc1 - 8);
  const int kst0 = KSWZ(kr0, kc0 * 16), kst1 = KSWZ(kr1, kc1 * 16);
  const int vb0 = (int)(uintptr_t)V_lds + v_rd_base(lane);
  struct { bf16x8 vs0, ks0, ks1; } sr_[2] = {};
#define TROW(j) ((j) < 4 ? ctxrow0 + 64 * (j) : latrow0 + 64 * ((j) - 4))
#define SLOAD(i, j) do { const int rb_ = TROW(j); sr_[i].vs0 = ld8(Vg + (size_t)(rb_ + vr) * 512 + vcol); \
    sr_[i].ks0 = ld8(Kg + (size_t)(rb_ + kr0) * 768 + kcol0); if (tid < 256) sr_[i].ks1 = ld8(Kg + (size_t)(rb_ + kr1) * 768 + kcol1); } while (0)
#define SWRITE(b, i) do { *(bf16x8*)(V_lds + (b) * SHM_V + vst) = sr_[i].vs0; \
    *(bf16x8*)(K_lds + (b) * SHM_K + kst0) = sr_[i].ks0; if (tid < 256) *(bf16x8*)(K_lds + (b) * SHM_K + kst1) = sr_[i].ks1; } while (0)
#define SWAIT() asm volatile("s_waitcnt vmcnt(3)" ::: "memory")
#define PSM(p0_, p1_, mn_, al_) do { if (FIX) { partialSM_fix(p0_); al_ = 1.f; } else partialSM(p0_, p1_, m_reg, mn_, al_); } while (0)
#define RESC(a) do { if (!FIX) if (__any((a) < 1.f)) { if (hi == 0) al_l[r32] = (a); asm volatile("s_waitcnt lgkmcnt(0)" ::: "memory"); \
    for (int d = 0; d < 2; ++d) for (int r = 0; r < 16; ++r) o[d][r] *= al_l[crow(r, hi)]; } } while (0)
  f32x16 pA0, pA1, pB0, pB1; float mnA, mnB, alA, alB; bf16x8 pa0, pa1, pa2, pa3;
  constexpr int SE = 0, SO = 1;
  SLOAD(SE, 0); asm volatile("s_waitcnt vmcnt(0)" ::: "memory"); SWRITE(0, SE); __syncthreads();
  qkt<FIX>(pA0, pA1, K_lds, qr, r32, hi, init); PSM(pA0, pA1, mnA, alA);
  SLOAD(SO, 1); if (2 < NT) SLOAD(SE, 2);
  SWAIT(); SWRITE(1, SO); __syncthreads();
  for (int j = 1; j + 1 < NT; j += 2) {
    SBAR(); qkt<FIX>(pB0, pB1, K_lds + SHM_K, qr, r32, hi, init);
    finishSM(pA0, pA1, alA, l_reg, pa0, pa1, pa2, pa3); SBAR();
    SLOAD(SO, j + 2); SBAR();
    pv_d0(o, vb0, pa0, pa1, pa2, pa3); PSM(pB0, pB1, mnB, alB);
    __syncthreads(); SWAIT(); SWRITE(0, SE);
    RESC(alB); __syncthreads();
    SBAR(); qkt<FIX>(pA0, pA1, K_lds, qr, r32, hi, init);
    finishSM(pB0, pB1, alB, l_reg, pa0, pa1, pa2, pa3); SBAR();
    if (j + 3 < NT) SLOAD(SE, j + 3); SBAR();
    pv_d0(o, vb0 + SHM_V, pa0, pa1, pa2, pa3); PSM(pA0, pA1, mnA, alA);
    __syncthreads(); SWAIT(); SWRITE(1, SO);
    RESC(alA); __syncthreads();
  }
  SBAR(); qkt<FIX>(pB0, pB1, K_lds + SHM_K, qr, r32, hi, init);
  finishSM(pA0, pA1, alA, l_reg, pa0, pa1, pa2, pa3); SBAR();
  pv_d0(o, vb0, pa0, pa1, pa2, pa3); PSM(pB0, pB1, mnB, alB);
  __syncthreads(); RESC(alB);
  finishSM(pB0, pB1, alB, l_reg, pa0, pa1, pa2, pa3); SBAR();
  pv_d0(o, vb0 + SHM_V, pa0, pa1, pa2, pa3);
  if (hi == 0) li_l[r32] = l_reg; asm volatile("s_waitcnt lgkmcnt(0)" ::: "memory");
  float rli[16];
#pragma unroll
  for (int r = 0; r < 16; ++r) rli[r] = __builtin_amdgcn_rcpf(li_l[crow(r, hi)]);
  bf16_t* Ow = Og + (size_t)(qrow0 + wid * QBLK) * ldo + 64 * h;
#pragma unroll
  for (int r = 0; r < 16; ++r) { const int orow = crow(r, hi);
#pragma unroll
    for (int d0 = 0; d0 < 2; ++d0) Ow[(size_t)orow * ldo + d0 * 32 + r32] = f2bf(o[d0][r] * rli[r]); }
#undef TROW
#undef SLOAD
#undef SWRITE
#undef SWAIT
#undef RESC
#undef PSM
}
}

DI void phase_attention(const Params& P, int l, char* lds, bf16_t* Og, int ldo) {
    const bf16_t* Q = (const bf16_t*)(P.ws + WS_Q); const bf16_t* K = (const bf16_t*)(P.ws + WS_K); const bf16_t* V = (const bf16_t*)(P.ws + WS_V);
    const unsigned* QKM = (const unsigned*)(P.ws + WS_QKM);
    for (int u = blockIdx.x; u < 1024 + (l == 0 ? 32 : 0); u += gridDim.x) {
        int b, h, qrow0, nt;
        if (u < 1024) { const int bh = (u >> 8) * 8 + (u & 7), qb = (u >> 3) & 31; b = bh >> 3; h = bh & 7; qrow0 = b * SEQ + 256 * qb; nt = 132; }
        else { b = (u - 1024) >> 3; h = (u - 1024) & 7; qrow0 = TL + b * CTX; nt = 4; }
        const float bound = sqrtf(__uint_as_float(QKM[(b * 8 + h) * 2]) * __uint_as_float(QKM[(b * 8 + h) * 2 + 1])) * 1.01f + 0.5f;
        __syncthreads();
        if (bound <= 48.f) att::attn_unit<true>(Q, Og, ldo, K, V, qrow0, h, TL + b * CTX, b * SEQ, nt, lds, bound);
        else att::attn_unit<false>(Q, Og, ldo, K, V, qrow0, h, TL + b * CTX, b * SEQ, nt, lds, 0.f);
    }
    __syncthreads();
}

namespace scn {
constexpr int RQ = 0, RK = 16384, RR = 32768;
constexpr int QD = 34816;
constexpr int KN = QD + 64 * 272;
constexpr int KET = KN + 64 * 272;
constexpr int VT = KET + 128 * 144;
constexpr int ST = VT + 128 * 144;
constexpr int PM = ST + 128 * 272;
constexpr int DEC = PM + 64 * 144;
constexpr int CSUM = DEC + 512;
constexpr int END = CSUM + 1024;
static_assert(END <= LDS_BYTES - 16, "scan LDS");
constexpr size_t US_OFF = 0, DL_OFF = (size_t)64 * 3 * 16384 * 2;
static_assert(DL_OFF + (size_t)64 * 3 * 128 * 4 <= (size_t)3584 * 1024 * 2, "scan hand-off must fit in the dead part of the weight region");
DI int crow(int r, int hi) { return (r & 3) + 8 * (r >> 2) + 4 * hi; }
#define SC_BAR() do { asm volatile("s_waitcnt lgkmcnt(0)" ::: "memory"); __builtin_amdgcn_s_barrier(); asm volatile("" ::: "memory"); } while (0)
#define SMFMA(a, b, c) __builtin_amdgcn_mfma_f32_32x32x16_bf16((a), (b), (c), 0, 0, 0)
}
DI void phase_scan(const Params& P, int l, char* lds, const int pass) {
    using namespace scn;
    const int tid = threadIdx.x, wid = tid >> 6, lane = tid & 63, r32 = lane & 31, hi = lane >> 5;
    const bf16_t* R4 = (const bf16_t*)(P.ws + WS_R4); const bf16_t* SM = (const bf16_t*)(P.ws + WS_SM);
    bf16_t* UST = (bf16_t*)(P.ws + WS_WT + US_OFF); float* DLG = (float*)(P.ws + WS_WT + DL_OFF);
    const int nitems = pass == 1 ? 192 : 256;
    for (int item = blockIdx.x; item < nitems; item += gridDim.x) {
        bool gla; int seg, g;
        if (pass == 1) { gla = item < 128; if (gla) { seg = item & 3; g = item >> 2; } else { seg = (item - 128) & 1; g = (item - 128) >> 1; } }
        else { gla = item < 160; if (gla) { seg = item % 5; g = item / 5; } else { seg = (item - 160) % 3; g = (item - 160) / 3; } }
        const int dir = g & 1, hh = (g >> 1) & 3, b = g >> 3, hd = hh + (gla ? 0 : 4);
        const int uidx0 = gla ? g * 4 : 128 + g * 2;
        const int n0 = gla ? seg * 26 + (seg < 2 ? seg : 2) : 44 * seg, nlen = gla ? (seg < 2 ? 27 : 26) : 44;
        const int qcol = gla ? hh * 128 : 1536 + hh * 128, kcol = gla ? 512 + hh * 128 : 2048 + hh * 128, vcol = (gla ? 1024 : 2560) + hh * 128;
        bf16_t* Od = (bf16_t*)(P.ws + (dir ? WS_OB : WS_OF)); const int ocol = hd * 128;
        const int pti = wid >> 2, pdj = wid & 3, pd = 32 * pdj + r32;
        const int vt = wid >> 1, dt0 = 2 * (wid & 1);
        bf16x8 w2h = {0, 0, 0, 0, 0, 0, 0, 0}, w2l = {0, 0, 0, 0, 0, 0, 0, 0}; float bias = 0.f, lg = 0.f;
        if (gla) { const float* W2 = P.in[I_GK2] + (size_t)(l * 2 + dir) * 16 * 512 + hh * 128 + pd;
#pragma unroll
            for (int j = 0; j < 8; ++j) { const float w = W2[(8 * hi + j) * 512]; const unsigned u = __float_as_uint(w) & 0xffff0000u; const float res = w - __uint_as_float(u);
                w2h[j] = (short)(u >> 16); w2l[j] = (short)(__float_as_uint(res) >> 16); }
            bias = P.in[I_BGK][(l * 2 + dir) * 512 + hh * 128 + pd]; }
        else lg = -expf(P.in[I_RDEC][(l * 2 + dir) * 4 + hh]) * 1.4426950408889634f;
        f32x16 S0 = {}, S1 = {}; float clsum = 0.f;
        __syncthreads();
        if (pass == 2) {
            for (int sp = 0; sp < seg; ++sp) {
                const bf16_t* U = UST + (size_t)(uidx0 + sp) * 16384; const float* DL = DLG + (size_t)(uidx0 + sp) * 128;
                const float e0 = __builtin_amdgcn_exp2f(DL[32 * dt0 + r32]), e1 = __builtin_amdgcn_exp2f(DL[32 * (dt0 + 1) + r32]);
#pragma unroll
                for (int r = 0; r < 16; ++r) { const int v = 32 * vt + crow(r, hi);
                    S0[r] = S0[r] * e0 + bf2f(U[v * 128 + 32 * dt0 + r32]); S1[r] = S1[r] * e1 + bf2f(U[v * 128 + 32 * (dt0 + 1) + r32]); }
            }
#pragma unroll
            for (int r = 0; r < 16; ++r) { const int v = 32 * vt + crow(r, hi);
                *(bf16_t*)(lds + ST + v * 272 + (32 * dt0 + r32) * 2) = f2bf(S0[r]); *(bf16_t*)(lds + ST + v * 272 + (32 * (dt0 + 1) + r32) * 2) = f2bf(S1[r]); }
            { const int i = tid >> 4, j = 32 + (tid & 15) * 2; *(unsigned*)(lds + PM + i * 144 + j * 2) = 0u; }
        }
        u32x4 pq0 = {0u, 0u, 0u, 0u}, pq1 = pq0, pk0, pk1, pr = pq0, pv0, pv1;
#define ROWBASE(n) (dir == 0 ? ((n) < 4 ? TL + b * CTX + 64 * (n) : b * SEQ + 64 * ((n) - 4)) : ((n) < 4 ? TL + b * CTX + 64 * (3 - (n)) : b * SEQ + 64 * (127 - ((n) - 4))))
#define SC_LOADQK(n) do { const int rb_ = ROWBASE(n); \
        if (pass == 2) { pq0 = *(const u32x4*)(R4 + (size_t)(rb_ + (tid >> 4)) * 3072 + qcol + 8 * (tid & 15)); pq1 = *(const u32x4*)(R4 + (size_t)(rb_ + 32 + (tid >> 4)) * 3072 + qcol + 8 * (tid & 15)); } \
        pk0 = *(const u32x4*)(R4 + (size_t)(rb_ + (tid >> 4)) * 3072 + kcol + 8 * (tid & 15)); pk1 = *(const u32x4*)(R4 + (size_t)(rb_ + 32 + (tid >> 4)) * 3072 + kcol + 8 * (tid & 15)); \
        if (tid < 128) pr = *(const u32x4*)(SM + (size_t)(rb_ + (tid >> 1)) * 512 + 416 + dir * 16 + 8 * (tid & 1)); } while (0)
#define SC_LOADV(n) do { const int rb_ = ROWBASE(n); \
        pv0 = *(const u32x4*)(R4 + (size_t)(rb_ + lane) * 3072 + vcol + 8 * wid); pv1 = *(const u32x4*)(R4 + (size_t)(rb_ + lane) * 3072 + vcol + 64 + 8 * wid); } while (0)
#define SC_STOREQK() do { if (pass == 2) { *(u32x4*)(lds + RQ + sr0 * 256 + (tid & 15) * 16) = pq0; *(u32x4*)(lds + RQ + sr1 * 256 + (tid & 15) * 16) = pq1; } \
        *(u32x4*)(lds + RK + sr0 * 256 + (tid & 15) * 16) = pk0; *(u32x4*)(lds + RK + sr1 * 256 + (tid & 15) * 16) = pk1; \
        if (tid < 128) *(u32x4*)(lds + RR + srr * 32 + (tid & 1) * 16) = pr; } while (0)
        const int sr0 = dir ? 63 - (tid >> 4) : (tid >> 4), sr1 = dir ? 31 - (tid >> 4) : 32 + (tid >> 4);
        const int srr = dir ? 63 - (tid >> 1) : (tid >> 1), svi = dir ? 63 - lane : lane;
        SC_LOADQK(n0); SC_STOREQK(); SC_LOADQK(n0 + 1); SC_LOADV(n0);
        for (int n = n0; n < n0 + nlen; ++n) {
            int r32v = r32, hiv = hi; asm volatile("" : "+v"(r32v), "+v"(hiv));
            SC_BAR();
            { char* vb = lds + VT + (8 * wid) * 144 + svi * 2;
              const unsigned w0[4] = {pv0.x, pv0.y, pv0.z, pv0.w}, w1[4] = {pv1.x, pv1.y, pv1.z, pv1.w};
#pragma unroll
              for (int e = 0; e < 4; ++e) { *(bf16_t*)(vb + (2 * e) * 144) = (bf16_t)(w0[e] & 0xffffu); *(bf16_t*)(vb + (2 * e + 1) * 144) = (bf16_t)(w0[e] >> 16);
                  *(bf16_t*)(vb + (64 + 2 * e) * 144) = (bf16_t)(w1[e] & 0xffffu); *(bf16_t*)(vb + (64 + 2 * e + 1) * 144) = (bf16_t)(w1[e] >> 16); }
              if (n + 1 < n0 + nlen) SC_LOADV(n + 1); }
            {
                f32x16 cum; float cl;
                if (gla) {
                    f32x16 la;
                    { const bf16x8 a0 = *(const bf16x8*)(lds + RR + (32 * pti + r32v) * 32 + hiv * 16);
                      la = SMFMA(a0, w2h, (f32x16{})); la = SMFMA(a0, w2l, la); }
                    float ssum = 0.f;
#pragma unroll
                    for (int r = 0; r < 16; ++r) { const float x0 = la[r] + bias;
                        la[r] = (fminf(x0, 0.f) - __logf(1.f + __expf(-fabsf(x0)))) * (1.4426950408889634f / 16.f);
                        ssum += la[r]; }
                    const float cs_own = ssum + __shfl_xor(ssum, 32);
                    if (hiv == 0) *(float*)(lds + CSUM + (pti * 128 + pd) * 4) = cs_own;
                    SC_BAR();
                    const float cs_other = *(const float*)(lds + CSUM + ((1 - pti) * 128 + pd) * 4);
                    cl = cs_own + cs_other;
                    bf16x8 tri0, tri1;
#pragma unroll
                    for (int j = 0; j < 8; ++j) { const int k0 = 8 * (j >> 2) + 4 * hiv + (j & 3);
                        tri0[j] = (short)(r32v >= k0 ? 0x3F80 : 0); tri1[j] = (short)(r32v >= k0 + 16 ? 0x3F80 : 0); }
                    cum = f32x16{};
#pragma unroll
                    for (int st = 0; st < 2; ++st) { bf16x8 h8, l8;
#pragma unroll
                        for (int j = 0; j < 8; ++j) { const float v = la[8 * st + j]; const unsigned u = __float_as_uint(v) & 0xffff0000u; const float res = v - __uint_as_float(u);
                            h8[j] = (short)(u >> 16); l8[j] = (short)(__float_as_uint(res) >> 16); }
                        const bf16x8 am = st ? tri1 : tri0; cum = SMFMA(am, h8, cum); cum = SMFMA(am, l8, cum); }
                    if (pti) {
#pragma unroll
                        for (int r = 0; r < 16; ++r) cum[r] += cs_other; }
                    __builtin_amdgcn_sched_barrier(0);
                } else {
#pragma unroll
                    for (int r = 0; r < 16; ++r) cum[r] = (float)(32 * pti + crow(r, hiv) + 1) * lg;
                    cl = 64.f * lg;
                }
                clsum += cl;
                {
                    const int ibase = 32 * pti + 4 * hiv; const float ecl = __builtin_amdgcn_exp2f(cl);
                    const char* rqb = lds + RQ + ibase * 256 + pd * 2; const char* rkb = lds + RK + ibase * 256 + pd * 2;
                    char* qdb = lds + QD + ibase * 272 + pd * 2; char* knb = lds + KN + ibase * 272 + pd * 2; char* keb = lds + KET + pd * 144 + ibase * 2;
                    if (pass == 2) {
#pragma unroll
                        for (int r = 0; r < 16; ++r) { const int cr = (r & 3) + 8 * (r >> 2);
                            const float c = cum[r]; const float e1 = __builtin_amdgcn_exp2f(c), e2 = __builtin_amdgcn_exp2f(-c);
                            const float q = bf2f(*(const bf16_t*)(rqb + cr * 256)), k = bf2f(*(const bf16_t*)(rkb + cr * 256));
                            const float kn = k * e2;
                            *(bf16_t*)(qdb + cr * 272) = f2bf(q * e1);
                            *(bf16_t*)(knb + cr * 272) = f2bf(kn);
                            *(bf16_t*)(keb + cr * 2) = f2bf(kn * ecl);
                            if ((r & 3) == 3) { asm volatile("" ::: "memory"); } }
                    } else {
#pragma unroll
                        for (int r = 0; r < 16; ++r) { const int cr = (r & 3) + 8 * (r >> 2);
                            const float k = bf2f(*(const bf16_t*)(rkb + cr * 256));
                            *(bf16_t*)(keb + cr * 2) = f2bf(k * __builtin_amdgcn_exp2f(cl - cum[r]));
                            if ((r & 3) == 3) { asm volatile("" ::: "memory"); } }
                    }
                    if (pti == 0 && hiv == 0) *(float*)(lds + DEC + pd * 4) = ecl;
                }
            }
            SC_BAR();
            if (n + 1 < n0 + nlen) { SC_STOREQK(); if (n + 2 < n0 + nlen) SC_LOADQK(n + 2); }
            f32x16 oacc = {};
            if (pass == 2) {
                if (wid < 3) {
                    const int ti = (wid + 1) >> 1, tj = wid >> 1; f32x16 T0 = {};
#pragma unroll
                    for (int kk = 0; kk < 8; ++kk) { const bf16x8 a = *(const bf16x8*)(lds + QD + (32 * ti + r32v) * 272 + (16 * kk + 8 * hiv) * 2), bb = *(const bf16x8*)(lds + KN + (32 * tj + r32v) * 272 + (16 * kk + 8 * hiv) * 2);
                        T0 = SMFMA(a, bb, T0); }
#pragma unroll
                    for (int r = 0; r < 16; ++r) { const int cr = (r & 3) + 8 * (r >> 2); const int ib = 32 * ti + 4 * hiv, j = 32 * tj + r32v; int jm = j - (dir ? 0 : 1) - ib; asm volatile("" : "+v"(jm));
                        *(bf16_t*)(lds + PM + ib * 144 + j * 2 + cr * 144) = f2bf(cr > jm ? T0[r] : 0.f); }
                }
                { const int ti = wid >> 2, vj = wid & 3;
#pragma unroll
                  for (int kk = 0; kk < 8; ++kk) { const bf16x8 a = *(const bf16x8*)(lds + QD + (32 * ti + r32v) * 272 + (16 * kk + 8 * hiv) * 2), bb = *(const bf16x8*)(lds + ST + (32 * vj + r32v) * 272 + (16 * kk + 8 * hiv) * 2);
                      oacc = SMFMA(a, bb, oacc); } }
            }
            {
                const float dc0 = *(const float*)(lds + DEC + (32 * dt0 + r32v) * 4), dc1 = *(const float*)(lds + DEC + (32 * (dt0 + 1) + r32v) * 4);
#pragma unroll
                for (int r = 0; r < 16; ++r) { S0[r] *= dc0; S1[r] *= dc1; }
#pragma unroll
                for (int kk = 0; kk < 4; ++kk) { const bf16x8 a = *(const bf16x8*)(lds + VT + (32 * vt + r32v) * 144 + (16 * kk + 8 * hiv) * 2);
                    const bf16x8 b0 = *(const bf16x8*)(lds + KET + (32 * dt0 + r32v) * 144 + (16 * kk + 8 * hiv) * 2), b1 = *(const bf16x8*)(lds + KET + (32 * (dt0 + 1) + r32v) * 144 + (16 * kk + 8 * hiv) * 2);
                    S0 = SMFMA(a, b0, S0); S1 = SMFMA(a, b1, S1); }
            }
            if (pass == 2) {
                SC_BAR();
                { const int ti = wid >> 2, vj = wid & 3;
#pragma unroll
                  for (int kk = 0; kk < 4; ++kk) { const bf16x8 a = *(const bf16x8*)(lds + PM + (32 * ti + r32v) * 144 + (16 * kk + 8 * hiv) * 2), bb = *(const bf16x8*)(lds + VT + (32 * vj + r32v) * 144 + (16 * kk + 8 * hiv) * 2);
                      oacc = SMFMA(a, bb, oacc); }
                  const int rb = ROWBASE(n);
#pragma unroll
                  for (int r = 0; r < 16; ++r) { const int i = 32 * ti + crow(r, hiv), row = rb + (dir ? 63 - i : i);
                      Od[(size_t)row * 1024 + ocol + 32 * vj + r32v] = f2bf(oacc[r]); } }
#pragma unroll
                for (int r = 0; r < 16; ++r) { const int cr = (r & 3) + 8 * (r >> 2); char* stb = lds + ST + (32 * vt + 4 * hiv) * 272 + (32 * dt0 + r32v) * 2;
                    *(bf16_t*)(stb + cr * 272) = f2bf(S0[r]); *(bf16_t*)(stb + cr * 272 + 64) = f2bf(S1[r]); }
            }
        }
        if (pass == 1) {
            bf16_t* U = UST + (size_t)(uidx0 + seg) * 16384;
#pragma unroll
            for (int r = 0; r < 16; ++r) { const int v = 32 * vt + crow(r, hi);
                U[v * 128 + 32 * dt0 + r32] = f2bf(S0[r]); U[v * 128 + 32 * (dt0 + 1) + r32] = f2bf(S1[r]); }
            if (pti == 0 && hi == 0) DLG[(size_t)(uidx0 + seg) * 128 + pd] = clsum;
        }
#undef ROWBASE
#undef SC_LOADQK
#undef SC_LOADV
#undef SC_STOREQK
    }
    __syncthreads();
}

constexpr int PH_PER_LAYER = 13, N_PHASES = 1 + 2 * PH_PER_LAYER;
#ifndef PHEN
#define PHEN(q) 1
#endif
#ifdef PROBE_GEMM
#define REPG for (int rep_ = 0; rep_ < 2; ++rep_)
#else
#define REPG
#endif
#ifdef PROBE_EW
#define REPE for (int rep_ = 0; rep_ < 2; ++rep_)
#else
#define REPE
#endif
#define PH(k) if (lo <= (k) && (k) < hi && ((k) == lo || (xcd_barrier(xbar), true)))
template <int l>
DI void layer_program(const Params& P, int lo, int hi, LAS unsigned char* lds, unsigned char* lds_raw, const XcdBarrier& xbar) {
    constexpr int base = 1 + PH_PER_LAYER * l;
    constexpr int Mlat = (l == 0) ? TA : TL;
#define WSP(T, off) ((T*)(P.ws + (off)))
#define MODL (WSP(const float, WS_MOD) + (size_t)l * 5 * 6144)
#define HIN_L ((l == 0) ? P.in[I_X] : (const float*)P.out)
#define HIN_C ((l == 0) ? P.in[I_CTX] : WSP(const float, WS_HC))
    PH(base + 0) if (PHEN(0)) REPE { if (blockIdx.x == 0 && threadIdx.x < 64) WSP(unsigned, WS_QKM)[threadIdx.x] = 0u;
        phase_norm(HIN_L, HIN_C, P.in[I_N1W] + l * DM, MODL, 0, 1, WSP(bf16_t, WS_A), TA); if (l > 0) phase_wconv_mixer(P, l, lds); }
    PH(base + 1) if (PHEN(1)) { Epi<EM_INPROJ> E{}; E.O0 = WSP(bf16_t, WS_R4); E.O1 = WSP(bf16_t, WS_SM); E.fa = WSP(const float, WS_ROT); run_gemm<EM_INPROJ>(lds, WSP(bf16_t, WS_A), 1024, WSP(bf16_t, WS_WT) + WT_IN, TA, 3584, 1024, E); }
    PH(base + 2) if (PHEN(6)) phase_scan(P, l, (char*)lds_raw, 1);
    PH(base + 3) if (PHEN(6)) phase_scan(P, l, (char*)lds_raw, 2);
    PH(base + 4) if (PHEN(2)) REPG { { Epi<EM_PLAIN> E{}; E.O0 = WSP(bf16_t, WS_Q); E.ld0 = 768; run_gemm<EM_PLAIN>(lds, WSP(bf16_t, WS_SM), 512, WSP(bf16_t, WS_WT) + WT_QB, TA, 768, 256, E); }
                  { Epi<EM_KV> E2{}; E2.O0 = WSP(bf16_t, WS_K); E2.O1 = WSP(bf16_t, WS_V); run_gemm<EM_KV>(lds, WSP(bf16_t, WS_SM) + 256, 512, WSP(bf16_t, WS_WT) + WT_KVB, TA, 1024, 128, E2); } }
    PH(base + 5) if (PHEN(3)) {
#ifdef PROBE_EW
        phase_qkpost(P, l, (LAS unsigned*)lds, true);
#endif
        phase_qkpost(P, l, (LAS unsigned*)lds); }
    PH(base + 6) if (PHEN(4)) phase_attention(P, l, (char*)lds_raw, WSP(bf16_t, WS_Q), 768);
    PH(base + 7) if (PHEN(8)) { EpiGates E{}; E.G3 = WSP(bf16_t, WS_R4); E.OF = WSP(bf16_t, WS_OF); E.OB = WSP(const bf16_t, WS_OB); E.bgate = P.in[I_BGATE] + (size_t)l * 3072; E.gon = P.in[I_GON] + l * 128; E.RS = (LAS float*)(lds + 131072);
                   run_gemm_gates(lds, WSP(bf16_t, WS_A), WSP(bf16_t, WS_WT) + WT_IN + (size_t)3584 * 1024, Mlat, E); }
    PH(base + 8) if (PHEN(9)) REPG {
        { Epi<EM_BRANCH> E{}; E.O0 = WSP(bf16_t, WS_OB); E.Gsrc = WSP(bf16_t, WS_R4); E.ipar = 0; run_gemm<EM_BRANCH>(lds, WSP(bf16_t, WS_Q), 768, WSP(bf16_t, WS_WT) + WT_BR, Mlat, 1024, 512, E); }
        { Epi<EM_BRANCH> E{}; E.O0 = WSP(bf16_t, WS_OB); E.Gsrc = WSP(bf16_t, WS_R4) + 1024; E.ipar = 1; run_gemm<EM_BRANCH>(lds, WSP(bf16_t, WS_OF), 1024, WSP(bf16_t, WS_WT) + WT_BR + (size_t)1024 * 512, Mlat, 1024, 512, E); }
        { Epi<EM_BRANCH> E{}; E.O0 = WSP(bf16_t, WS_OB); E.Gsrc = WSP(bf16_t, WS_R4) + 2048; E.ipar = 2; run_gemm<EM_BRANCH>(lds, WSP(bf16_t, WS_OF) + 512, 1024, WSP(bf16_t, WS_WT) + WT_BR + (size_t)2048 * 512, Mlat, 1024, 512, E); } }
    PH(base + 9) if (PHEN(10)) { Epi<EM_RES> E{}; E.fa = MODL; E.ipar = 2; E.hin_l = HIN_L; E.hin_c = HIN_C; E.hout_l = P.out; E.hout_c = WSP(float, WS_HC);
                   run_gemm<EM_RES>(lds, WSP(bf16_t, WS_OB), 1024, WSP(bf16_t, WS_WT) + WT_OUT, Mlat, 1024, 1024, E); }
    PH(base + 10) if (PHEN(11)) REPE { phase_norm(P.out, WSP(const float, WS_HC), P.in[I_N2W] + l * DM, MODL, 3, 4, WSP(bf16_t, WS_A), Mlat); phase_wconv_ffn(P, l, lds); }
    PH(base + 11) if (PHEN(12)) { EpiFfnConv E{}; E.ACT = WSP(bf16_t, WS_G); E.HALO = WSP(float, WS_U); E.wdw = P.in[I_WDW] + (size_t)l * 3 * DFF; E.bdw = P.in[I_BDW] + (size_t)l * DFF; E.X = (LAS float*)(lds + 131072);
                   run_gemm_ffnconv(lds, WSP(bf16_t, WS_A), WSP(bf16_t, WS_WT) + WT_F1, Mlat, E); }
    PH(base + 12) if (PHEN(14)) { phase_convfix_mine(P, l, Mlat); Epi<EM_RES> E{}; E.fa = MODL; E.ipar = 5; E.hin_l = P.out; E.hin_c = WSP(const float, WS_HC); E.hout_l = P.out; E.hout_c = WSP(float, WS_HC);
                   run_gemm<EM_RES>(lds, WSP(bf16_t, WS_G), DFF, WSP(bf16_t, WS_WT) + WT_F2, Mlat, 1024, DFF, E); }
}
__global__ void __launch_bounds__(NTHREADS, 2) fwd_kernel(Params P) {
    extern __shared__ __attribute__((aligned(16))) unsigned char lds_raw[];
    LAS unsigned char* lds = (LAS unsigned char*)lds_raw;
    cg::grid_group grid = cg::this_grid();
    const int lo = P.ph_lo, hi = P.ph_hi;
    Params* G = (Params*)(P.ws + WS_PAR + (size_t)blockIdx.x * 256);
    if (threadIdx.x == 0) {
#pragma unroll
        for (int i = 0; i < 26; ++i) G->in[i] = P.in[i];
        G->out = P.out; G->ws = P.ws; G->ph_lo = lo; G->ph_hi = hi;
    }
    __syncthreads();
    asm volatile("" ::: "memory");
    const Params& Q = *G;
    if (threadIdx.x < 4) ((LAS unsigned*)(lds + LDS_BARW))[threadIdx.x] = 0u;
    __syncthreads();
    const XcdBarrier xbar = xcd_barrier_post((unsigned*)(P.ws + WS_BAR), (volatile LAS unsigned*)(lds + LDS_BARW));
    if (lo < 0) grid.sync();
    PH(0) REPE { phase_prologue(Q, lds); __syncthreads(); phase_wconv_mixer(Q, 0, lds); __syncthreads(); }
    layer_program<0>(Q, lo, hi, lds, lds_raw, xbar);
    layer_program<1>(Q, lo, hi, lds, lds_raw, xbar);
#ifdef PROBE_SYNC
    for (int i = 0; i < 20; ++i) xcd_barrier(xbar);
#endif
}

#ifndef N_LAUNCH_MODE
#define N_LAUNCH_MODE 1
#endif
extern "C" void kernel_launch(void* const* d_in, const int* in_sizes, int n_in, void* d_out, int out_size, void* d_ws, size_t ws_size, hipStream_t stream) {
    static int grid_blocks = 0;
    if (!grid_blocks) {
        if (n_in != 26 || ws_size < WS_NEED) { fprintf(stderr, "kernel_launch: bad inputs (n_in %d, ws %zu < %zu)\n", n_in, ws_size, (size_t)WS_NEED); return; }
        if (hipFuncSetAttribute((const void*)fwd_kernel, hipFuncAttributeMaxDynamicSharedMemorySize, LDS_BYTES) != hipSuccess) { fprintf(stderr, "kernel_launch: hipFuncSetAttribute failed\n"); return; }
        int dev = 0, cus = 0, per_cu = 0;
        hipGetDevice(&dev);
        hipDeviceGetAttribute(&cus, hipDeviceAttributeMultiprocessorCount, dev);
        hipOccupancyMaxActiveBlocksPerMultiprocessor(&per_cu, fwd_kernel, NTHREADS, LDS_BYTES);
        if (per_cu < 1) { fprintf(stderr, "kernel_launch: occupancy query returned %d\n", per_cu); return; }
        grid_blocks = cus * 1;
    }
    Params p{};
    for (int i = 0; i < 26; ++i) p.in[i] = (const float*)d_in[i];
    p.out = (float*)d_out; p.ws = (unsigned char*)d_ws;
#if N_LAUNCH_MODE == 1
    p.ph_lo = 0; p.ph_hi = N_PHASES;
    if (hipMemsetAsync((unsigned char*)d_ws + WS_BAR, 0, XCD_BAR_WORDS * 4, stream) != hipSuccess) { fprintf(stderr, "kernel_launch: memset of the barrier words failed\n"); return; }
    void* args[] = {&p};
    hipError_t e = hipLaunchCooperativeKernel((const void*)fwd_kernel, dim3(grid_blocks), dim3(NTHREADS), args, LDS_BYTES, stream);
    if (e != hipSuccess) fprintf(stderr, "cooperative launch failed: %s (grid %d)\n", hipGetErrorString(e), grid_blocks);
#else
    for (int ph = 0; ph < N_PHASES; ++ph) {
        p.ph_lo = ph; p.ph_hi = ph + 1;
        hipLaunchKernelGGL(fwd_kernel, dim3(grid_blocks), dim3(NTHREADS), LDS_BYTES, stream, p);
    }
#endif
}
```

```cpp
#include <hip/hip_runtime.h>
#include <hip/hip_bf16.h>
#include <hip/hip_cooperative_groups.h>
#include <cstdio>
#include <cstdint>
namespace cg = cooperative_groups;
#define DI __device__ __forceinline__
#define LAS __attribute__((address_space(3)))
namespace pg8 {
#define PG8_LAS __attribute__((address_space(3)))
typedef unsigned short bf16_t;
typedef short bf16x8 __attribute__((ext_vector_type(8)));
typedef float f32x4 __attribute__((ext_vector_type(4)));
typedef unsigned u32x4 __attribute__((ext_vector_type(4)));
constexpr int BM = 256, BK = 64, HALF = 128, HTB = HALF * BK * 2  , STAGE_BYTES = 8 * HTB, NXCD = 8, WGM = 8;

__host__ __device__ __forceinline__ int lds_byte(int r, int c) { const int st = (r >> 4) * 2 + (c >> 5), rr = r & 15, cc = c & 31, ob = rr * 64 + cc * 2; return st * 1024 + (ob ^ (((ob >> 9) & 1) << 5)); }
__host__ __device__ __forceinline__ void stage_rc(int b, int& R, int& C) { const int st = b / 1024, sb = b % 1024, swz = sb ^ (((sb >> 9) & 1) << 5); R = (st >> 1) * 16 + swz / 64; C = (st & 1) * 32 + (swz % 64) / 2; }
__host__ __device__ __forceinline__ int perm32(int rho) { const int n = rho >> 4, i = rho & 15; return 8 * (i >> 2) + 4 * n + (i & 3); }

struct Unit { int pm, pn; };
struct Gemm { const bf16_t* A; const bf16_t* Bt; int M, N, K, lda, ldb; };

struct StaticOrder {
    int nM, nN, nwg, G, c;
    __host__ __device__ void init(int M, int N, int G_, int c_) { nM = M / BM; nN = N / BM; nwg = nM * nN; G = G_; c = c_; }
    __host__ __device__ bool next(int i, Unit& u) const {
        const long L = (long)i * G + c; if (L >= nwg) return false;
        int wgid = (int)L; { const int q = nwg / NXCD, r = nwg % NXCD, xcd = wgid % NXCD, off = wgid / NXCD; wgid = (xcd < r ? xcd * (q + 1) : r * (q + 1) + (xcd - r) * q) + off; }
        const int nig = WGM * nN, gid = wgid / nig, fm = gid * WGM, gsz = (nM - fm) < WGM ? (nM - fm) : WGM;
        u.pm = fm + ((wgid % nig) % gsz); u.pn = (wgid % nig) / gsz; return true;
    }
    __device__ __forceinline__ void a_ready(const Unit&) const {}
    __device__ __forceinline__ void done(const Unit&) const {}
};

__device__ __forceinline__ unsigned cvt_pk_bf16(float lo, float hi) { unsigned r; asm volatile("v_cvt_pk_bf16_f32 %0, %1, %2" : "=v"(r) : "v"(lo), "v"(hi)); return r; }
template <class Epi, class Sched, bool ALIGN_EPI = false, bool SP2 = false>
__device__ __forceinline__ void gemm_phase(PG8_LAS unsigned char* lds, const Gemm g, const Sched& S, const Epi& E) {
    const int tid = threadIdx.x, wid = __builtin_amdgcn_readfirstlane(tid >> 6), lane = tid & 63, wr = wid >> 2, wc = wid & 3, fr = lane & 15, fq = lane >> 4;
    const int K = g.K, nt = K / BK;
    unsigned voffA[2], voffB[2];
#pragma unroll
    for (int i = 0; i < 2; ++i) { int R, C; stage_rc(tid * 16 + i * 8192, R, C); const int Rb = Epi::PERM ? ((R & ~31) + perm32(R & 31)) : R;
        voffA[i] = (unsigned)(R * g.lda + C) * 2u; voffB[i] = (unsigned)(Rb * g.ldb + C) * 2u; }
    const size_t kstep = (size_t)(BK * 2);
    const size_t hstep = (size_t)HALF * g.ldb * 2;
    const size_t tstep = 2 * hstep; const size_t hstepA = (size_t)HALF * g.lda * 2; const size_t tstepA = 2 * hstepA;
    const unsigned ldsw = (unsigned)wid * 1024u;
    const int aoff = lds_byte(wr * 64 + fr, fq * 8), boff = lds_byte(wc * 32 + fr, fq * 8);
#define PG8_SA(b, h) (((b) * 2 + (h)) * HTB)
#define PG8_SB(b, h) ((4 + (b) * 2 + (h)) * HTB)
#define PG8_STAGE(bufoff, gbase, voff) do { _Pragma("unroll") for (int _i = 0; _i < 2; ++_i) \
        __builtin_amdgcn_global_load_lds((const unsigned*)((const char*)(gbase) + (voff)[_i]), (PG8_LAS unsigned*)(lds + (bufoff) + ldsw + _i * 8192), 16, 0, 0); } while (0)
#define PG8_LDA(dst, b, h) do { _Pragma("unroll") for (int m = 0; m < 4; ++m) _Pragma("unroll") for (int k = 0; k < 2; ++k) dst[m][k] = *(const PG8_LAS bf16x8*)(lds + PG8_SA(b, h) + aoff + m * 2048 + k * 1024); } while (0)
#define PG8_LDB(dst, b, h) do { _Pragma("unroll") for (int n = 0; n < 2; ++n) _Pragma("unroll") for (int k = 0; k < 2; ++k) dst[n][k] = *(const PG8_LAS bf16x8*)(lds + PG8_SB(b, h) + boff + n * 2048 + k * 1024); } while (0)
#define PG8_MMA(ai, bj, At, Bt) do { __builtin_amdgcn_s_setprio(1); _Pragma("unroll") for (int m = 0; m < 4; ++m) _Pragma("unroll") for (int n = 0; n < 2; ++n) _Pragma("unroll") for (int k = 0; k < 2; ++k) \
        acc[ai][bj][m][n] = __builtin_amdgcn_mfma_f32_16x16x32_bf16(Bt[n][k], At[m][k], acc[ai][bj][m][n], 0, 0, 0); __builtin_amdgcn_s_setprio(0); } while (0)
#define PG8_WAIT_V(n) asm volatile("s_waitcnt vmcnt(" #n ")" ::: "memory")
#define PG8_WAIT_L(n) asm volatile("s_waitcnt lgkmcnt(" #n ")" ::: "memory")
#define PG8_BAR __builtin_amdgcn_s_barrier()
#define PG8_SCHED __builtin_amdgcn_sched_barrier(0)
    Unit cur, nxt; int ui = 0;
    if (!S.next(0, cur)) return;
    f32x4 acc[2][2][4][2];
#pragma unroll
    for (int a = 0; a < 2; ++a)
#pragma unroll
        for (int b = 0; b < 2; ++b)
#pragma unroll
            for (int m = 0; m < 4; ++m)
#pragma unroll
                for (int n = 0; n < 2; ++n) acc[a][b][m][n] = (f32x4){0.f, 0.f, 0.f, 0.f};
    bf16x8 At[4][2], B0[2][2], B1[2][2];
    const char* cA = (const char*)g.A + (size_t)cur.pm * tstepA; const char* cB = (const char*)g.Bt + (size_t)cur.pn * tstep;
    S.a_ready(cur);
    if constexpr (SP2) {
        PG8_STAGE(PG8_SB(0, 0), cB, voffB); PG8_STAGE(PG8_SB(0, 1), cB + hstep, voffB); PG8_STAGE(PG8_SA(0, 0), cA, voffA); PG8_STAGE(PG8_SA(0, 1), cA + hstepA, voffA);
        if (wr == 1) PG8_BAR;
        PG8_WAIT_V(2); PG8_BAR;
        PG8_STAGE(PG8_SB(1, 0), cB + kstep, voffB); PG8_STAGE(PG8_SA(1, 0), cA + kstep, voffA); PG8_STAGE(PG8_SB(1, 1), cB + hstep + kstep, voffB);
        PG8_WAIT_V(6); PG8_BAR;
    } else {
        PG8_STAGE(PG8_SB(0, 0), cB, voffB); PG8_STAGE(PG8_SA(0, 0), cA, voffA); PG8_STAGE(PG8_SB(0, 1), cB + hstep, voffB); PG8_STAGE(PG8_SA(0, 1), cA + hstepA, voffA);
        if (wr == 1) PG8_BAR;
        PG8_WAIT_V(4); PG8_BAR;
        PG8_STAGE(PG8_SB(1, 0), cB + kstep, voffB); PG8_STAGE(PG8_SA(1, 0), cA + kstep, voffA); PG8_STAGE(PG8_SB(1, 1), cB + hstep + kstep, voffB);
        PG8_WAIT_V(6); PG8_BAR;
    }
    for (;;) {
        const bool has_next = S.next(ui + 1, nxt);
        const char* nA = has_next ? (const char*)g.A + (size_t)nxt.pm * tstepA : cA; const char* nB = has_next ? (const char*)g.Bt + (size_t)nxt.pn * tstep : cB;
        for (int t = 0; t < nt; t += 2) {
            const bool last = (t == nt - 2);
            const char* a1 = cA + (size_t)(t + 1) * kstep;
            const char* a2 = last ? nA : cA + (size_t)(t + 2) * kstep; const char* b2 = last ? nB : cB + (size_t)(t + 2) * kstep;
            const char* a3 = a2 + kstep; const char* b3 = b2 + kstep;
            if (last && has_next) S.a_ready(nxt);
            if constexpr (SP2) {
            PG8_LDB(B0, 0, 0); PG8_LDB(B1, 0, 1); PG8_SCHED; PG8_LDA(At, 0, 0); PG8_STAGE(PG8_SA(1, 1), a1 + hstepA, voffA);
            PG8_WAIT_V(8); PG8_WAIT_L(0); PG8_BAR; PG8_MMA(0, 0, At, B0); PG8_MMA(0, 1, At, B1); PG8_BAR; PG8_SCHED;
            PG8_LDA(At, 0, 1); PG8_STAGE(PG8_SB(0, 0), b2, voffB); PG8_STAGE(PG8_SB(0, 1), b2 + hstep, voffB); PG8_STAGE(PG8_SA(0, 0), a2, voffA);
            PG8_WAIT_V(8); PG8_WAIT_L(0); PG8_BAR; PG8_MMA(1, 0, At, B0); PG8_MMA(1, 1, At, B1); PG8_BAR; PG8_SCHED;
            PG8_LDB(B0, 1, 0); PG8_LDB(B1, 1, 1); PG8_SCHED; PG8_LDA(At, 1, 0); PG8_STAGE(PG8_SA(0, 1), a2 + hstepA, voffA);
            PG8_WAIT_V(8); PG8_WAIT_L(0); PG8_BAR; PG8_MMA(0, 0, At, B0); PG8_MMA(0, 1, At, B1); PG8_BAR; PG8_SCHED;
            PG8_LDA(At, 1, 1); PG8_STAGE(PG8_SB(1, 0), b3, voffB); PG8_STAGE(PG8_SB(1, 1), b3 + hstep, voffB); PG8_STAGE(PG8_SA(1, 0), a3, voffA);
            PG8_WAIT_V(8); PG8_WAIT_L(0); PG8_BAR; PG8_MMA(1, 0, At, B0); PG8_MMA(1, 1, At, B1); PG8_BAR; PG8_SCHED;
            } else {
            PG8_LDB(B0, 0, 0); PG8_SCHED; PG8_LDA(At, 0, 0); PG8_STAGE(PG8_SA(1, 1), a1 + hstepA, voffA);
            PG8_WAIT_L(8); PG8_BAR; PG8_WAIT_L(0); PG8_MMA(0, 0, At, B0); PG8_BAR; PG8_SCHED;
            PG8_LDB(B1, 0, 1); PG8_STAGE(PG8_SB(0, 0), b2, voffB);
            PG8_BAR; PG8_WAIT_L(0); PG8_MMA(0, 1, At, B1); PG8_BAR;
            PG8_LDA(At, 0, 1); PG8_STAGE(PG8_SA(0, 0), a2, voffA);
            PG8_BAR; PG8_WAIT_L(0); PG8_MMA(1, 0, At, B0); PG8_BAR; PG8_SCHED;
            PG8_STAGE(PG8_SB(0, 1), b2 + hstep, voffB);
            PG8_WAIT_V(6); PG8_BAR; PG8_MMA(1, 1, At, B1); PG8_BAR;
            PG8_LDB(B0, 1, 0); PG8_SCHED; PG8_LDA(At, 1, 0); PG8_STAGE(PG8_SA(0, 1), a2 + hstepA, voffA);
            PG8_WAIT_L(8); PG8_BAR; PG8_WAIT_L(0); PG8_MMA(0, 0, At, B0); PG8_BAR; PG8_SCHED;
            PG8_LDB(B1, 1, 1); PG8_STAGE(PG8_SB(1, 0), b3, voffB);
            PG8_BAR; PG8_WAIT_L(0); PG8_MMA(0, 1, At, B1); PG8_BAR;
            PG8_LDA(At, 1, 1); PG8_STAGE(PG8_SA(1, 0), a3, voffA);
            PG8_BAR; PG8_WAIT_L(0); PG8_MMA(1, 0, At, B0); PG8_BAR; PG8_SCHED;
            PG8_STAGE(PG8_SB(1, 1), b3 + hstep, voffB);
            PG8_WAIT_V(6); PG8_BAR; PG8_MMA(1, 1, At, B1); PG8_BAR;
            }
        }
        if constexpr (ALIGN_EPI) { if (wr == 0) PG8_BAR; }
        if constexpr (!Epi::AFTER_DRAIN) { E(acc, cur, wr, wc, fr, fq); S.done(cur); }
        if (!has_next) break;
#pragma unroll
        for (int a = 0; a < 2; ++a)
#pragma unroll
            for (int b = 0; b < 2; ++b)
#pragma unroll
                for (int m = 0; m < 4; ++m)
#pragma unroll
                    for (int n = 0; n < 2; ++n) acc[a][b][m][n] = (f32x4){0.f, 0.f, 0.f, 0.f};
        cur = nxt; cA = nA; cB = nB; ++ui;
        if constexpr (ALIGN_EPI) { if (wr == 1) PG8_BAR; }
    }
    PG8_WAIT_V(0);
    if constexpr (!ALIGN_EPI) { if (wr == 0) PG8_BAR; }
    PG8_BAR;
    if constexpr (Epi::AFTER_DRAIN) { E.fused(acc, cur, wr, wc, fr, fq, lds, wid, lane); S.done(cur); }
#undef PG8_SA
#undef PG8_SB
#undef PG8_STAGE
#undef PG8_LDA
#undef PG8_LDB
#undef PG8_MMA
#undef PG8_WAIT_V
#undef PG8_WAIT_L
#undef PG8_BAR
#undef PG8_SCHED
}
}

typedef unsigned short bf16_t;
typedef short bf16x8 __attribute__((ext_vector_type(8)));
typedef short s16x4 __attribute__((ext_vector_type(4)));
typedef float f32x4 __attribute__((ext_vector_type(4)));
typedef float f32x2 __attribute__((ext_vector_type(2)));
typedef float f32x16 __attribute__((ext_vector_type(16)));
typedef unsigned u32x4 __attribute__((ext_vector_type(4)));
typedef unsigned u32x2 __attribute__((ext_vector_type(2)));

constexpr int DM = 1024, NB = 4, SEQ = 8192, CTX = 256, TL = NB * SEQ, TC = NB * CTX, TA = TL + TC;
constexpr int DFF = 2816, NIN = 7616;
constexpr float EPS = 1e-6f;
constexpr int NTHREADS = 512, NWAVES = 8;

constexpr size_t al256(size_t x) { return (x + 255) / 256 * 256; }
constexpr size_t WS_MOD = 0;
constexpr size_t WS_PAR = al256(WS_MOD + (size_t)2 * 5 * 6144 * 4);
constexpr size_t WS_BAR = al256(WS_PAR + (size_t)1024 * 256);
constexpr size_t WS_QKM = al256(WS_BAR + (size_t)3456 * 4);
constexpr size_t WS_ROPE = al256(WS_QKM + 256);
constexpr size_t WS_ROT = al256(WS_ROPE + (size_t)192 * 8 * 8);
constexpr size_t WS_HC  = al256(WS_ROT + (size_t)8448 * 64 * 8);
constexpr size_t WS_WT  = al256(WS_HC + (size_t)TC * DM * 4);
constexpr size_t WT_IN = 0, WT_QB = WT_IN + (size_t)7680 * 1024, WT_KVB = WT_QB + (size_t)768 * 256, WT_BR = WT_KVB + (size_t)1024 * 128,
                 WT_OUT = WT_BR + (size_t)3 * 1024 * 512, WT_MIX_END = WT_OUT + (size_t)1024 * 1024;
constexpr size_t WT_F1 = 0, WT_F2 = (size_t)5632 * 1024, WT_FFN_END = WT_F2 + (size_t)1024 * 2816;
constexpr size_t WT_ELEMS = WT_MIX_END > WT_FFN_END ? WT_MIX_END : WT_FFN_END;
constexpr size_t WS_A   = al256(WS_WT + WT_ELEMS * 2);
constexpr size_t WS_SM  = al256(WS_A + (size_t)TA * 1024 * 2);
constexpr size_t WS_Q   = al256(WS_SM + (size_t)TA * 512 * 2);
constexpr size_t WS_R4  = al256(WS_Q + (size_t)TA * 768 * 2);
constexpr size_t WS_OF  = al256(WS_R4 + (size_t)TA * 3072 * 2);
constexpr size_t WS_OB  = al256(WS_OF + (size_t)TA * 1024 * 2);
constexpr size_t WS_END_MIX = al256(WS_OB + (size_t)TA * 1024 * 2);
constexpr size_t WS_K   = WS_R4;
constexpr size_t WS_V   = al256(WS_K + (size_t)TA * 768 * 2);
constexpr size_t WS_G   = WS_SM;
constexpr size_t WS_U   = al256(WS_G + (size_t)TA * DFF * 2);
constexpr size_t WS_END_FFN = al256(WS_U + (size_t)132 * 6 * DFF * 4);
constexpr size_t WS_NEED = WS_END_MIX > WS_END_FFN ? WS_END_MIX : WS_END_FFN;
static_assert(WS_V + (size_t)TA * 512 * 2 <= WS_OF, "K/V overlay must fit in R4");

constexpr int LDS_BYTES = 150 * 1024;
constexpr int LDS_BARW = LDS_BYTES - 16;

struct Params { const float* in[26]; float* out; unsigned char* ws; int ph_lo, ph_hi; };
enum { I_X = 0, I_C, I_CTX, I_CCTX, I_WADA, I_BADA, I_N1W, I_N2W, I_WIN, I_BGATE, I_QNA, I_WQB, I_KVNA, I_WKVB, I_QN, I_KN, I_GK2, I_BGK, I_GON, I_RDEC, I_WBR, I_WOUT, I_WF1, I_WDW, I_BDW, I_WF2 };

DI float bflo(unsigned w) { return __uint_as_float(w << 16); }
DI float bfhi(unsigned w) { return __uint_as_float(w & 0xffff0000u); }
DI float bf2f(bf16_t x) { return __uint_as_float((unsigned)x << 16); }
DI unsigned pk2(float lo, float hi) { unsigned r; asm volatile("s_nop 0\n\tv_cvt_pk_bf16_f32 %0, %1, %2" : "=v"(r) : "v"(lo), "v"(hi)); return r; }
DI bf16_t f2bf(float x) { return (bf16_t)(pk2(x, 0.f) & 0xffffu); }
DI float wave_sum(float v) {
#pragma unroll
    for (int o = 1; o < 64; o <<= 1) v += __shfl_xor(v, o);
    return v;
}
DI float sigmoidf_(float x) { return __builtin_amdgcn_rcpf(1.f + __builtin_amdgcn_exp2f(-1.4426950408889634f * x)); }
DI void unpack8(u32x4 w, float* f) { f[0] = bflo(w.x); f[1] = bfhi(w.x); f[2] = bflo(w.y); f[3] = bfhi(w.y); f[4] = bflo(w.z); f[5] = bfhi(w.z); f[6] = bflo(w.w); f[7] = bfhi(w.w); }
DI u32x4 pack8(const float* f) { u32x4 w; w.x = pk2(f[0], f[1]); w.y = pk2(f[2], f[3]); w.z = pk2(f[4], f[5]); w.w = pk2(f[6], f[7]); return w; }

DI void rowinfo(int m, int& b, int& pos, int& isctx) {
    if (m < TL) { b = m >> 13; pos = m & 8191; isctx = 0; } else { const int j = m - TL; b = j >> 8; pos = j & 255; isctx = 1; }
}

DI void phase_prologue(const Params& P, LAS unsigned char* lds) {
    const int tid = threadIdx.x, wave = tid >> 6, lane = tid & 63;
    LAS float* cond = (LAS float*)lds;
    LAS float* part = cond + 5 * 1024;
    const float* c = P.in[I_C]; const float* cc = P.in[I_CCTX];
    for (int i = tid; i < 5 * 1024; i += NTHREADS) { const int r = i >> 10, k = i & 1023; const float v = r < 4 ? c[r * 1024 + k] : cc[k]; cond[i] = v / (1.f + expf(-v)); }
    __syncthreads();
    float* MOD = (float*)(P.ws + WS_MOD);
    for (int item = blockIdx.x; item < 192; item += gridDim.x) {
        const int l = item / 96, j0 = (item % 96) * 64;
        const float* W = P.in[I_WADA] + (size_t)l * 1024 * 6144 + j0 + lane;
        float a0 = 0.f, a1 = 0.f, a2 = 0.f, a3 = 0.f, a4 = 0.f;
#pragma unroll 16
        for (int k = wave * 128; k < wave * 128 + 128; ++k) {
            const float w = W[(size_t)k * 6144];
            a0 += cond[k] * w; a1 += cond[1024 + k] * w; a2 += cond[2048 + k] * w; a3 += cond[3072 + k] * w; a4 += cond[4096 + k] * w;
        }
        part[(wave * 5 + 0) * 64 + lane] = a0; part[(wave * 5 + 1) * 64 + lane] = a1; part[(wave * 5 + 2) * 64 + lane] = a2;
        part[(wave * 5 + 3) * 64 + lane] = a3; part[(wave * 5 + 4) * 64 + lane] = a4;
        __syncthreads();
        if (tid < 320) { const int r = tid >> 6; float s = 0.f;
            for (int w = 0; w < 8; ++w) s += part[(w * 5 + r) * 64 + lane];
            MOD[(size_t)(l * 5 + r) * 6144 + j0 + lane] = s + P.in[I_BADA][l * 6144 + j0 + lane]; }
        __syncthreads();
    }
    { f32x2* ROPE = (f32x2*)(P.ws + WS_ROPE);
      for (int i = blockIdx.x * NTHREADS + tid; i < 192 * 8; i += gridDim.x * NTHREADS) { const int p = i >> 3, f = i & 7; const float pos = (float)(p < 128 ? p : p - 128);
          const float inv = powf(10000.0f, -(float)f * 0.125f); float s, co; sincosf(pos * inv, &s, &co); ROPE[i] = (f32x2){co, s}; } }
    f32x2* ROT = (f32x2*)(P.ws + WS_ROT);
    for (int i = blockIdx.x * NTHREADS + tid; i < 8448 * 64; i += gridDim.x * NTHREADS) {
        const int pos = i >> 6, j = i & 63;
        const float inv = 1.0f / powf(10000.0f, (float)j / 63.0f);
        const float ang = (float)pos * inv; float s, co; sincosf(ang, &s, &co);
        ROT[i] = (f32x2){co, s};
    }
}

DI int wmap(int id, int n) {
    switch (id) {
    case 1: if (n < 416) return n; if (n < 448) return 2464 + (n - 416); return -1;
    case 2: { if (n < 1536) return 416 + n;
              if (n < 2560) { const int base = n < 2048 ? 2496 : 3008; const int j = (n - 1536) & 511; const int hh = j >> 7, v = j & 127, g = v >> 3, e = v & 7;
                              const int d = e < 4 ? 4 * g + e : 64 + 4 * g + (e - 4); return base + hh * 128 + d; }
              return 3520 + (n - 2560); }
    case 3: if (n < 512) return 1952 + n; if (n < 1024) return 4032 + (n - 512); return 4544 + (n - 1024);
    case 4: if (n < 512) return (n >> 6) * 96 + (n & 63); { const int j = n - 512; return (j >> 5) * 96 + 64 + (j & 31); }
    case 5: if (n < 512) return (n >> 6) * 128 + (n & 63); { const int j = n - 512; return (j >> 6) * 128 + 64 + (j & 63); }
    case 6: { const int pn = n >> 8, bj = (n >> 7) & 1, j = n & 127; return bj * 2816 + 128 * pn + j; }
    default: return n;
    }
}
struct TJob { const float* W; int K, Nsrc; bf16_t* WT; int ndst, map_id; const float* kscale; };
DI void transpose_job(const TJob& J, LAS float* scr, int gw, int ngw, int lane) {
    const int nblk = J.ndst / 32, nitems = (J.K / 64) * nblk;
    for (int item = gw; item < nitems; item += ngw) {
        const int kb = item / nblk, nb = item % nblk, k0 = 64 * kb, n0 = 32 * nb;
        const int src = wmap(J.map_id, n0 + (lane & 31));
        float tv[32];
#pragma unroll
        for (int i = 0; i < 32; ++i) { const int kk = 2 * i + (lane >> 5); tv[i] = src >= 0 ? J.W[(size_t)(k0 + kk) * J.Nsrc + src] : 0.f; }
        if (J.kscale) {
#pragma unroll
            for (int i = 0; i < 32; ++i) tv[i] *= J.kscale[k0 + 2 * i + (lane >> 5)]; }
#pragma unroll
        for (int i = 0; i < 32; ++i) scr[(2 * i + (lane >> 5)) * 33 + (lane & 31)] = tv[i];
        asm volatile("s_waitcnt lgkmcnt(0)" ::: "memory");
        const int c = lane & 7;
#pragma unroll
        for (int j = 0; j < 4; ++j) { const int n = (lane >> 3) + 8 * j; const LAS float* s = scr + (8 * c) * 33 + n;
            u32x4 o; o.x = pk2(s[0 * 33], s[1 * 33]); o.y = pk2(s[2 * 33], s[3 * 33]); o.z = pk2(s[4 * 33], s[5 * 33]); o.w = pk2(s[6 * 33], s[7 * 33]);
            *(u32x4*)(J.WT + (size_t)(n0 + n) * J.K + k0 + 8 * c) = o; }
        asm volatile("s_waitcnt lgkmcnt(0)" ::: "memory");
    }
}
DI void phase_wconv_mixer(const Params& P, int l, LAS unsigned char* lds) {
    const int tid = threadIdx.x, wave = tid >> 6, lane = tid & 63, gw = blockIdx.x * NWAVES + wave, ngw = gridDim.x * NWAVES;
    LAS float* scr = (LAS float*)lds + wave * (64 * 33);
    bf16_t* WT = (bf16_t*)(P.ws + WS_WT);
    const float* win = P.in[I_WIN] + (size_t)l * 1024 * NIN;
    TJob j;
    j = TJob{win, 1024, NIN, WT + WT_IN, 512, 1, nullptr}; transpose_job(j, scr, gw, ngw, lane);
    j = TJob{win, 1024, NIN, WT + WT_IN + (size_t)512 * 1024, 3072, 2, nullptr}; transpose_job(j, scr, gw, ngw, lane);
    j = TJob{win, 1024, NIN, WT + WT_IN + (size_t)3584 * 1024, 4096, 3, nullptr}; transpose_job(j, scr, gw, ngw, lane);
    j = TJob{P.in[I_WQB] + (size_t)l * 256 * 768, 256, 768, WT + WT_QB, 768, 4, P.in[I_QNA] + l * 256}; transpose_job(j, scr, gw, ngw, lane);
    j = TJob{P.in[I_WKVB] + (size_t)l * 128 * 1024, 128, 1024, WT + WT_KVB, 1024, 5, P.in[I_KVNA] + l * 128}; transpose_job(j, scr, gw, ngw, lane);
    for (int n = 0; n < 3; ++n) { j = TJob{P.in[I_WBR] + ((size_t)l * 3 + n) * 512 * 1024, 512, 1024, WT + WT_BR + (size_t)n * 1024 * 512, 1024, 0, nullptr}; transpose_job(j, scr, gw, ngw, lane); }
    j = TJob{P.in[I_WOUT] + (size_t)l * 1024 * 1024, 1024, 1024, WT + WT_OUT, 1024, 0, nullptr}; transpose_job(j, scr, gw, ngw, lane);
}
DI void phase_wconv_ffn(const Params& P, int l, LAS unsigned char* lds) {
    const int tid = threadIdx.x, wave = tid >> 6, lane = tid & 63, gw = blockIdx.x * NWAVES + wave, ngw = gridDim.x * NWAVES;
    LAS float* scr = (LAS float*)lds + wave * (64 * 33);
    bf16_t* WT = (bf16_t*)(P.ws + WS_WT);
    TJob j;
    j = TJob{P.in[I_WF1] + (size_t)l * 1024 * 5632, 1024, 5632, WT + WT_F1, 5632, 6, nullptr}; transpose_job(j, scr, gw, ngw, lane);
    j = TJob{P.in[I_WF2] + (size_t)l * 2816 * 1024, 2816, 1024, WT + WT_F2, 1024, 0, nullptr}; transpose_job(j, scr, gw, ngw, lane);
}

DI void phase_norm(const float* __restrict__ hl, const float* hc, const float* __restrict__ nw, const float* __restrict__ MODl, int ishift, int iscale, bf16_t* __restrict__ A, int nrows,
                   const float* __restrict__ part = nullptr, int nparts = 0, const float* __restrict__ pmod = nullptr, float* hc_out = nullptr) {
    const int tid = threadIdx.x, wave = tid >> 6, lane = tid & 63, gw = blockIdx.x * NWAVES + wave, ngw = gridDim.x * NWAVES;
    f32x4 nx[4];
#define NLOAD(dst, m_) do { const float* xr_ = (m_) >= TL ? hc + (size_t)((m_) - TL) * DM : hl + (size_t)(m_) * DM; \
        _Pragma("unroll") for (int j = 0; j < 4; ++j) dst[j] = *(const f32x4*)(xr_ + 4 * lane + 256 * j); } while (0)
    if (gw < nrows) NLOAD(nx, gw);
    for (int m = gw; m < nrows; m += ngw) {
        f32x4 v[4];
#pragma unroll
        for (int j = 0; j < 4; ++j) v[j] = nx[j];
        if (m + ngw < nrows) NLOAD(nx, m + ngw);
        int b, pos, isctx; rowinfo(m, b, pos, isctx);
        if (part != nullptr && isctx) {
#pragma unroll
            for (int j = 0; j < 4; ++j) { const int c = 4 * lane + 256 * j; f32x4 acc = {0.f, 0.f, 0.f, 0.f};
                for (int s = 0; s < nparts; ++s) acc += *(const f32x4*)(part + ((size_t)s * TC + (m - TL)) * DM + c);
                v[j] += *(const f32x4*)(pmod + c) * acc;
                *(f32x4*)(hc_out + (size_t)(m - TL) * DM + c) = v[j]; }
        }
        const float* mod = MODl + (size_t)(isctx ? 4 : b) * 6144;
        float ss = 0.f;
#pragma unroll
        for (int j = 0; j < 4; ++j) ss += (v[j].x * v[j].x + v[j].y * v[j].y) + (v[j].z * v[j].z + v[j].w * v[j].w);
        const float rstd = rsqrtf(wave_sum(ss) * (1.f / DM) + EPS);
#pragma unroll
        for (int j = 0; j < 4; ++j) { const int c = 4 * lane + 256 * j;
            const f32x4 w = *(const f32x4*)(nw + c), sh = *(const f32x4*)(mod + ishift * 1024 + c), sc = *(const f32x4*)(mod + iscale * 1024 + c);
            const f32x4 y = v[j] * rstd * w * (sc + 1.f) + sh;
            u32x2 o; o.x = pk2(y.x, y.y); o.y = pk2(y.z, y.w);
            *(u32x2*)(A + (size_t)m * DM + c) = o; }
    }
#undef NLOAD
}
#include <cstdlib>
#include <vector>

#define XB_TMO      128
#define XB_XCNT(j)  (256  + 64 * (j))
#define XB_XSUB(j)  (1280 + 64 * (j))
#define XB_XGEN(j)  (2304 + 64 * (j))
#define XB_TOP      3328
#define XB_TOPGEN   3392
#define XCD_BAR_WORDS 3456
#define XB_SPIN_CAP (1u << 18)

__device__ __forceinline__ unsigned xb_ld(unsigned* p)              { return __hip_atomic_load(p, __ATOMIC_RELAXED, __HIP_MEMORY_SCOPE_AGENT); }
__device__ __forceinline__ unsigned xb_add(unsigned* p, unsigned v) { return __hip_atomic_fetch_add(p, v, __ATOMIC_RELAXED, __HIP_MEMORY_SCOPE_AGENT); }
__device__ __forceinline__ unsigned xb_xcc_id() { return (unsigned)__builtin_amdgcn_s_getreg((3 << 11) | 20) & 0xFu; }
#define XB_SPIN(cond, bar) do { unsigned _sp = 0; while (cond) { __builtin_amdgcn_s_sleep(1); \
    if ((++_sp & 255u) == 0u) { if (xb_ld(&(bar)[XB_TMO])) break; if (_sp > XB_SPIN_CAP) { atomicAdd(&(bar)[XB_TMO], 1u); break; } } } } while (0)

struct XcdBarrier {
    unsigned* bar; unsigned x;
    volatile LAS unsigned* st;
};

__device__ __forceinline__ XcdBarrier xcd_barrier_post(unsigned* bar, volatile LAS unsigned* st) {
    XcdBarrier b; b.bar = bar; b.x = xb_xcc_id(); b.st = st;
    if (threadIdx.x == 0) (void)xb_add(&bar[XB_XCNT(b.x)], 1u);
    return b;
}
__device__ __forceinline__ void xcd_barrier_complete(unsigned* bar, unsigned x, unsigned& nloc, unsigned& nx) {
    const unsigned G = gridDim.x * gridDim.y * gridDim.z;
    unsigned sum, cnt, mine, sp = 0u;
    for (;;) {
        sum = 0u; cnt = 0u; mine = 0u;
#pragma unroll
        for (unsigned j = 0; j < 16; ++j) { const unsigned c = xb_ld(&bar[XB_XCNT(j)]); sum += c; cnt += (c > 0u) ? 1u : 0u; mine = (j == x) ? c : mine; }
        if (sum == G) break;
        __builtin_amdgcn_s_sleep(1);
        if ((++sp & 255u) == 0u) { if (xb_ld(&bar[XB_TMO])) break; if (sp > XB_SPIN_CAP) { atomicAdd(&bar[XB_TMO], 1u); break; } }
    }
    nloc = mine > 0u ? mine : 1u; nx = cnt > 0u ? cnt : 1u;
}

__device__ __forceinline__ void xcd_barrier(const XcdBarrier& b) {
    asm volatile("s_waitcnt vmcnt(0)" ::: "memory");
    __syncthreads();
    if (threadIdx.x == 0) {
        unsigned* bar = b.bar;
        __builtin_amdgcn_s_waitcnt(0);
        unsigned nloc = b.st[0], nx = b.st[1];
        if (nloc == 0u) { xcd_barrier_complete(bar, b.x, nloc, nx); b.st[0] = nloc; b.st[1] = nx; }
        const unsigned old = xb_add(&bar[XB_XSUB(b.x)], 1u);
        const unsigned gen = old / nloc;
        if (old + 1u == (gen + 1u) * nloc) {
            __builtin_amdgcn_fence(__ATOMIC_RELEASE, "agent");
            asm volatile("s_waitcnt vmcnt(0)" ::: "memory");
            const unsigned og = xb_add(&bar[XB_TOP], 1u);
            const unsigned tg = og / nx;
            if (og + 1u == (tg + 1u) * nx) xb_add(&bar[XB_TOPGEN], 1u);
            else XB_SPIN(xb_ld(&bar[XB_TOPGEN]) == tg, bar);
            __builtin_amdgcn_fence(__ATOMIC_ACQUIRE, "agent");
            xb_add(&bar[XB_XGEN(b.x)], 1u);
            asm volatile("s_waitcnt vmcnt(0)" ::: "memory");
        } else {
            XB_SPIN(xb_ld(&bar[XB_XGEN(b.x)]) == gen, bar);
            __builtin_amdgcn_fence(__ATOMIC_ACQUIRE, "agent");
            asm volatile("s_waitcnt vmcnt(0)" ::: "memory");
        }
    }
    __syncthreads();
}

enum { EM_PLAIN = 0, EM_KV, EM_BIG, EM_GATES, EM_BRANCH, EM_RES, EM_FFNIN, EM_INPROJ, EM_PART };
template <int MODE> struct Epi {
    static constexpr bool PERM = true, AFTER_DRAIN = false;
    bf16_t* O0; int ld0; bf16_t* O1; int ld1;
    const bf16_t* Gsrc;
    const float* fa;
    const float* hin_l; const float* hin_c; float* hout_l; float* hout_c;
    int ipar;
    DI void emit(int row, int col, f32x4 v0, f32x4 v1) const {
        float f[8] = {v0[0], v0[1], v0[2], v0[3], v1[0], v1[1], v1[2], v1[3]};
        if (MODE == EM_INPROJ) {
            if (col < 512) { *(u32x4*)(O1 + (size_t)row * 512 + col) = pack8(f); return; }
            col -= 512;
        }
        if (MODE == EM_PLAIN) {
            *(u32x4*)(O0 + (size_t)row * ld0 + col) = pack8(f);
        } else if (MODE == EM_KV) {
            if (col < 512) *(u32x4*)(O0 + (size_t)row * 768 + col) = pack8(f);
            else           *(u32x4*)(O1 + (size_t)row * 512 + (col - 512)) = pack8(f);
        } else if (MODE == EM_FFNIN) {
            if (col < DFF) *(u32x4*)(O0 + (size_t)row * DFF + col) = pack8(f);
            else           *(u32x4*)(O1 + (size_t)row * DFF + (col - DFF)) = pack8(f);
        } else if (MODE == EM_BIG || MODE == EM_INPROJ) {
            const float QS = 0.08838834764831845f;
            if (col < 512) { for (int i = 0; i < 8; ++i) f[i] *= QS; }
            else if (col >= 1536 && col < 2560) {
                int b, pos, isctx; rowinfo(row, b, pos, isctx);
                const int sp = isctx ? pos : CTX + pos;
                const int g = ((col - 1536) & 127) >> 3;
                const f32x2* rot = (const f32x2*)fa + (size_t)sp * 64 + 4 * g;
                const float sc = col >= 2048 ? QS : 1.f;
#pragma unroll
                for (int e = 0; e < 4; ++e) { const f32x2 cs = rot[e]; const float x1 = f[e], x2 = f[4 + e];
                    f[e] = (x1 * cs.x - x2 * cs.y) * sc; f[4 + e] = (x1 * cs.y + x2 * cs.x) * sc; }
            }
            *(u32x4*)(O0 + (size_t)row * 3072 + col) = pack8(f);
        } else if (MODE == EM_GATES) {
            if (col < 1024) {
                bf16_t* p = O1 + (size_t)row * 1024 + col; float on[8]; unpack8(*(const u32x4*)p, on);
#pragma unroll
                for (int i = 0; i < 8; ++i) f[i] = on[i] * f[i] * sigmoidf_(f[i]);
                *(u32x4*)p = pack8(f);
            } else {
                const int cc = col - 1024; const f32x4 b0 = *(const f32x4*)(fa + cc), b1 = *(const f32x4*)(fa + cc + 4);
                const float bb[8] = {b0[0], b0[1], b0[2], b0[3], b1[0], b1[1], b1[2], b1[3]};
#pragma unroll
                for (int i = 0; i < 8; ++i) f[i] = sigmoidf_(f[i] + bb[i]);
                *(u32x4*)(O0 + (size_t)row * 3072 + cc) = pack8(f);
            }
        } else if (MODE == EM_BRANCH) {
            float g[8]; unpack8(*(const u32x4*)(Gsrc + (size_t)row * 3072 + col), g);
            bf16_t* p = O0 + (size_t)row * 1024 + col;
            if (ipar > 0) { float pr[8]; unpack8(*(const u32x4*)p, pr);
#pragma unroll
                for (int i = 0; i < 8; ++i) f[i] = pr[i] + g[i] * f[i]; }
            else {
#pragma unroll
                for (int i = 0; i < 8; ++i) f[i] = g[i] * f[i]; }
            *(u32x4*)p = pack8(f);
        } else if (MODE == EM_PART) {
            float* o_ = hout_c + (size_t)row * DM + col;
            *(f32x4*)o_ = v0; *(f32x4*)(o_ + 4) = v1;
        } else if (MODE == EM_RES) {
            int b, pos, isctx; rowinfo(row, b, pos, isctx);
            const float* hi_ = isctx ? hin_c + (size_t)(row - TL) * DM : hin_l + (size_t)row * DM;
            float* ho_ = isctx ? hout_c + (size_t)(row - TL) * DM : hout_l + (size_t)row * DM;
            const float* mod = fa + (size_t)(isctx ? 4 : b) * 6144 + ipar * 1024 + col;
            const f32x4 m0 = *(const f32x4*)mod, m1 = *(const f32x4*)(mod + 4);
            const f32x4 h0 = *(const f32x4*)(hi_ + col), h1 = *(const f32x4*)(hi_ + col + 4);
            *(f32x4*)(ho_ + col) = h0 + m0 * v0; *(f32x4*)(ho_ + col + 4) = h1 + m1 * v1;
        }
    }
    DI void operator()(const pg8::f32x4 (&acc)[2][2][4][2], const pg8::Unit& u, int wr, int wc, int fr, int fq) const {
#pragma unroll
        for (int ai = 0; ai < 2; ++ai)
#pragma unroll
            for (int m = 0; m < 4; ++m) { const int row = u.pm * 256 + ai * 128 + wr * 64 + m * 16 + fr;
#pragma unroll
                for (int bj = 0; bj < 2; ++bj) { const int col = u.pn * 256 + bj * 128 + wc * 32 + 8 * fq;
                    emit(row, col, acc[ai][bj][m][0], acc[ai][bj][m][1]); } }
    }
};

DI float dpp_ror1(float x) { return __int_as_float(__builtin_amdgcn_update_dpp(0, __float_as_int(x), 0x121, 0xf, 0xf, false)); }
DI float dpp_ror15(float x) { return __int_as_float(__builtin_amdgcn_update_dpp(0, __float_as_int(x), 0x12F, 0xf, 0xf, false)); }
DI float gelu_gate(float x, float u) { const float t2 = (-1.5957691216057308f * 1.4426950408889634f) * (x + 0.044715f * x * x * x); return x * __builtin_amdgcn_rcpf(1.f + __builtin_amdgcn_exp2f(t2)) * u; }
struct EpiFfnConv {
    static constexpr bool PERM = true, AFTER_DRAIN = false;
    bf16_t* ACT; float* HALO; const float* wdw; const float* bdw; LAS float* X;
    DI void operator()(const pg8::f32x4 (&acc)[2][2][4][2], const pg8::Unit& u, int wr, int wc, int fr, int fq) const {
        const int ch = 128 * u.pn + 32 * wc + 8 * fq, xc = 32 * wc + 8 * fq;
        float w0[8], w1[8], w2[8], bb[8];
#pragma unroll
        for (int k = 0; k < 8; ++k) { w0[k] = wdw[ch + k]; w1[k] = wdw[DFF + ch + k]; w2[k] = wdw[2 * DFF + ch + k]; bb[k] = bdw[ch + k]; }
#pragma unroll
        for (int ai = 0; ai < 2; ++ai) {
            if (fr == 0) {
#pragma unroll
                for (int k = 0; k < 8; ++k) X[((ai * 2 + wr) * 2 + 0) * 128 + xc + k] = acc[ai][0][0][k >> 2][k & 3]; }
            if (fr == 15) {
#pragma unroll
                for (int k = 0; k < 8; ++k) X[((ai * 2 + wr) * 2 + 1) * 128 + xc + k] = acc[ai][0][3][k >> 2][k & 3]; }
        }
        asm volatile("s_waitcnt lgkmcnt(0)" ::: "memory"); __builtin_amdgcn_s_barrier(); asm volatile("" ::: "memory");
        const bool first_tile_row_is_seq_start = (u.pm >= TL / 256) || ((u.pm & 31) == 0);
        const bool last_tile_row_is_seq_end = (u.pm >= TL / 256) || ((u.pm & 31) == 31);
#pragma unroll
        for (int ai = 0; ai < 2; ++ai) {
            float top[8], bot[8];
            { const int tsel = wr == 1 ? ((ai * 2 + 0) * 2 + 1) : ((0 * 2 + 1) * 2 + 1);
              const bool tval = (wr == 1) || (ai == 1);
              const int bsel = wr == 0 ? ((ai * 2 + 1) * 2 + 0) : ((1 * 2 + 0) * 2 + 0);
              const bool bval = (wr == 0) || (ai == 0);
#pragma unroll
              for (int k = 0; k < 8; ++k) { top[k] = tval ? X[tsel * 128 + xc + k] : 0.f; bot[k] = bval ? X[bsel * 128 + xc + k] : 0.f; } }
#pragma unroll
            for (int m = 0; m < 4; ++m) {
                const int row = u.pm * 256 + ai * 128 + wr * 64 + m * 16 + fr;
                float o[8], xs[8];
#pragma unroll
                for (int k = 0; k < 8; ++k) {
                    const float g = acc[ai][0][m][k >> 2][k & 3], up = acc[ai][1][m][k >> 2][k & 3];
                    const float pa = dpp_ror1(g);
                    const float pb = m > 0 ? dpp_ror1(acc[ai][0][m > 0 ? m - 1 : 0][k >> 2][k & 3]) : top[k];
                    const float na = dpp_ror15(g);
                    const float nb = m < 3 ? dpp_ror15(acc[ai][0][m < 3 ? m + 1 : 3][k >> 2][k & 3]) : bot[k];
                    const float gp = fr > 0 ? pa : pb, gn = fr < 15 ? na : nb;
                    const float x = w0[k] * gp + w1[k] * g + w2[k] * gn + bb[k];
                    xs[k] = x; o[k] = gelu_gate(x, up);
                }
                *(u32x4*)(ACT + (size_t)row * DFF + ch) = pack8(o);
                if (ai == 0 && m == 0 && wr == 0 && fr == 0 && !first_tile_row_is_seq_start) { float* h = HALO + ((size_t)u.pm * 6 + 0) * DFF + ch;
#pragma unroll
                    for (int k = 0; k < 8; ++k) { h[k] = acc[0][0][0][k >> 2][k & 3]; h[DFF + k] = xs[k]; h[2 * DFF + k] = acc[0][1][0][k >> 2][k & 3]; } }
                if (ai == 1 && m == 3 && wr == 1 && fr == 15 && !last_tile_row_is_seq_end) { float* h = HALO + ((size_t)u.pm * 6 + 3) * DFF + ch;
#pragma unroll
                    for (int k = 0; k < 8; ++k) { h[k] = acc[1][0][3][k >> 2][k & 3]; h[DFF + k] = xs[k]; h[2 * DFF + k] = acc[1][1][3][k >> 2][k & 3]; } }
            }
        }
    }
};
DI void convfix_tile(const Params& P, int l, int pm) {
    if (pm >= TL / 256) return;
    bf16_t* ACT = (bf16_t*)(P.ws + WS_G); const float* HALO = (const float*)(P.ws + WS_U);
    const float* wdw = P.in[I_WDW] + (size_t)l * 3 * DFF;
    for (int c = threadIdx.x; c < 2 * DFF; c += NTHREADS) {
        const int which = c >= DFF, ch = which ? c - DFF : c;
        if (which == 0) {
            if ((pm & 31) == 0) continue;
            const float* hf = HALO + ((size_t)pm * 6 + 0) * DFF + ch; const float g_prev = HALO[((size_t)(pm - 1) * 6 + 3) * DFF + ch];
            ACT[(size_t)(pm * 256) * DFF + ch] = f2bf(gelu_gate(hf[DFF] + wdw[ch] * g_prev, hf[2 * DFF]));
        } else {
            if ((pm & 31) == 31) continue;
            const float* hl = HALO + ((size_t)pm * 6 + 3) * DFF + ch; const float g_next = HALO[((size_t)(pm + 1) * 6 + 0) * DFF + ch];
            ACT[(size_t)(pm * 256 + 255) * DFF + ch] = f2bf(gelu_gate(hl[DFF] + wdw[2 * DFF + ch] * g_next, hl[2 * DFF]));
        }
    }
}
DI void phase_convfix_mine(const Params& P, int l, int M) {
    pg8::StaticOrder S; S.init(M, 1024, (int)gridDim.x, (int)blockIdx.x);
    pg8::Unit u; int prev = -1;
    for (int i = 0; S.next(i, u); ++i) { if (u.pm != prev) convfix_tile(P, l, u.pm); prev = u.pm; }
    asm volatile("s_waitcnt vmcnt(0)" ::: "memory");
    __syncthreads();
}

struct EpiGates {
    static constexpr bool PERM = true, AFTER_DRAIN = false;
    bf16_t* G3; bf16_t* OF; const bf16_t* OB; const float* bgate; const float* gon; LAS float* RS;
    DI void operator()(const pg8::f32x4 (&acc)[2][2][4][2], const pg8::Unit& u, int wr, int wc, int fr, int fq) const {
        if (u.pn < 4) {
#pragma unroll
            for (int ai = 0; ai < 2; ++ai)
#pragma unroll
                for (int m = 0; m < 4; ++m) { const int lr = ai * 128 + wr * 64 + m * 16 + fr, row = u.pm * 256 + lr;
#pragma unroll
                    for (int bj = 0; bj < 2; ++bj) { const int col = u.pn * 256 + bj * 128 + wc * 32 + 8 * fq;
                        float a[8], b[8]; unpack8(*(const u32x4*)(OF + (size_t)row * 1024 + col), a); unpack8(*(const u32x4*)(OB + (size_t)row * 1024 + col), b);
                        float ss = 0.f;
#pragma unroll
                        for (int k = 0; k < 8; ++k) { const float o = a[k] + b[k]; ss += o * o; }
                        ss += __shfl_xor(ss, 16); ss += __shfl_xor(ss, 32);
                        if (fq == 0) RS[(lr * 2 + bj) * 4 + wc] = ss; } }
            asm volatile("s_waitcnt lgkmcnt(0)" ::: "memory"); __builtin_amdgcn_s_barrier(); asm volatile("" ::: "memory");
#pragma unroll
            for (int ai = 0; ai < 2; ++ai)
#pragma unroll
                for (int m = 0; m < 4; ++m) { const int lr = ai * 128 + wr * 64 + m * 16 + fr, row = u.pm * 256 + lr;
#pragma unroll
                    for (int bj = 0; bj < 2; ++bj) { const int col = u.pn * 256 + bj * 128 + wc * 32 + 8 * fq, hd = 2 * u.pn + bj, cw = wc * 32 + 8 * fq;
                        bf16_t* p = OF + (size_t)row * 1024 + col;
                        float a[8], b[8]; unpack8(*(const u32x4*)p, a); unpack8(*(const u32x4*)(OB + (size_t)row * 1024 + col), b);
                        const f32x4 t = *(const LAS f32x4*)(RS + (lr * 2 + bj) * 4);
                        const float rstd = rsqrtf(((t[0] + t[1]) + (t[2] + t[3])) * (1.f / 128.f) + EPS);
                        float f[8];
#pragma unroll
                        for (int k = 0; k < 8; ++k) { const float g = acc[ai][bj][m][k >> 2][k & 3]; const float w = hd < 4 ? gon[cw + k] : 1.f;
                            f[k] = (a[k] + b[k]) * rstd * w * g * sigmoidf_(g); }
                        *(u32x4*)p = pack8(f); } }
        } else {
#pragma unroll
            for (int ai = 0; ai < 2; ++ai)
#pragma unroll
                for (int m = 0; m < 4; ++m) { const int row = u.pm * 256 + ai * 128 + wr * 64 + m * 16 + fr;
#pragma unroll
                    for (int bj = 0; bj < 2; ++bj) { const int cc = u.pn * 256 + bj * 128 + wc * 32 + 8 * fq - 1024;
                        const f32x4 b0 = *(const f32x4*)(bgate + cc), b1 = *(const f32x4*)(bgate + cc + 4);
                        float f[8];
#pragma unroll
                        for (int k = 0; k < 8; ++k) f[k] = sigmoidf_(acc[ai][bj][m][k >> 2][k & 3] + (k < 4 ? b0[k & 3] : b1[k & 3]));
                        *(u32x4*)(G3 + (size_t)row * 3072 + cc) = pack8(f); } }
        }
    }
};
DI void run_gemm_gates(LAS unsigned char* lds, const bf16_t* A, const bf16_t* Bt, int M, const EpiGates& E) {
    pg8::Gemm g{A, Bt, M, 4096, 1024, 1024, 1024}; pg8::StaticOrder S; S.init(M, 4096, (int)gridDim.x, (int)blockIdx.x);
    pg8::gemm_phase<EpiGates, pg8::StaticOrder, true, true>((PG8_LAS unsigned char*)lds, g, S, E);
}
template <int MODE>
DI void run_gemm(LAS unsigned char* lds, const bf16_t* A, int lda, const bf16_t* Bt, int M, int N, int K, const Epi<MODE>& E) {
    int Kop = K; if (K < 512) asm volatile("" : "+s"(Kop));
    pg8::Gemm g{A, Bt, M, N, Kop, lda, Kop}; pg8::StaticOrder S; S.init(M, N, (int)gridDim.x, (int)blockIdx.x);
    pg8::gemm_phase<Epi<MODE>, pg8::StaticOrder, true, true>((PG8_LAS unsigned char*)lds, g, S, E);
}
template <int MODE>
DI void run_gemm_slice(LAS unsigned char* lds, const bf16_t* A, int lda, const bf16_t* Bt, int ldb, int M, int N, int K, const Epi<MODE>& E, int boff) {
    int Kop = K; asm volatile("" : "+s"(Kop));
    pg8::Gemm g{A, Bt, M, N, Kop, lda, ldb}; pg8::StaticOrder S; S.init(M, N, (int)gridDim.x, (int)((blockIdx.x + gridDim.x - boff) % gridDim.x));
    pg8::gemm_phase<Epi<MODE>, pg8::StaticOrder, true, true>((PG8_LAS unsigned char*)lds, g, S, E);
}
DI void run_gemm_ffnconv(LAS unsigned char* lds, const bf16_t* A, const bf16_t* Bt, int M, const EpiFfnConv& E) {
    pg8::Gemm g{A, Bt, M, 5632, 1024, 1024, 1024}; pg8::StaticOrder S; S.init(M, 5632, (int)gridDim.x, (int)blockIdx.x);
    pg8::gemm_phase<EpiFfnConv, pg8::StaticOrder, true, true>((PG8_LAS unsigned char*)lds, g, S, E);
}

DI void phase_qkpost(const Params& P, int l, LAS unsigned* lmax, const bool probe = false) {
    const int tid = threadIdx.x, wave = tid >> 6, lane = tid & 63, gw = blockIdx.x * NWAVES + wave, ngw = gridDim.x * NWAVES;
    const bf16_t* __restrict__ SM = (const bf16_t*)(P.ws + WS_SM); bf16_t* __restrict__ Q = (bf16_t*)(P.ws + WS_Q); bf16_t* __restrict__ K = (bf16_t*)(P.ws + WS_K); bf16_t* __restrict__ V = (bf16_t*)(P.ws + WS_V);
    const f32x2* __restrict__ ROPE = (const f32x2*)(P.ws + WS_ROPE);
    const float* qn = P.in[I_QN] + l * 96; const float* kn = P.in[I_KN] + l * 96;
    const int s = lane & 7, h = lane >> 3;
    float qnw[12], knw[12];
#pragma unroll
    for (int i = 0; i < 8; ++i) { qnw[i] = qn[8 * s + i]; knw[i] = kn[8 * s + i]; }
#pragma unroll
    for (int i = 0; i < 4; ++i) { qnw[8 + i] = qn[64 + 4 * s + i]; knw[8 + i] = kn[64 + 4 * s + i]; }
    const bool second = (s & 2) != 0;
    constexpr float QC = 0.10206207261596575f * 1.4426950408889634f;
    if (tid < 64) lmax[tid] = 0u;
    __syncthreads();
    u32x2 n_cq, n_kr, n_qr; unsigned n_ckv; u32x4 n_qn, n_kn, n_v;
#define QLOAD(m_) do { const bf16_t* sm_ = SM + (size_t)(m_) * 512; n_cq = *(const u32x2*)(sm_ + 4 * lane); n_ckv = *(const unsigned*)(sm_ + 256 + 2 * lane); n_kr = *(const u32x2*)(sm_ + 384 + 4 * s); \
        n_qn = *(const u32x4*)(Q + (size_t)(m_) * 768 + 64 * h + 8 * s); n_qr = *(const u32x2*)(Q + (size_t)(m_) * 768 + 512 + 32 * h + 4 * s); \
        n_kn = *(const u32x4*)(K + (size_t)(m_) * 768 + 64 * h + 8 * s); n_v = *(const u32x4*)(V + (size_t)(m_) * 512 + 8 * lane); } while (0)
    if (gw < TA) QLOAD(gw);
    for (int m = gw; m < TA; m += ngw) {
        const u32x2 cq = n_cq, krr = n_kr, qrr = n_qr; const unsigned ckv = n_ckv; const u32x4 qnn = n_qn, knn = n_kn, vraw = n_v;
        if (m + ngw < TA) QLOAD(m + ngw);
        int b, pos, isctx; rowinfo(m, b, pos, isctx);
        float a0 = bflo(cq.x), a1 = bfhi(cq.x), a2 = bflo(cq.y), a3 = bfhi(cq.y), c0 = bflo(ckv), c1 = bfhi(ckv);
        const float s_q = rsqrtf(wave_sum(a0 * a0 + a1 * a1 + a2 * a2 + a3 * a3) * (1.f / 256.f) + EPS);
        const float s_kv = rsqrtf(wave_sum(c0 * c0 + c1 * c1) * (1.f / 128.f) + EPS);
        float cs[4], sn[4];
        if (!isctx) { const f32x2* rp = ROPE + ((s < 4) ? (pos >> 6) : 128 + (pos & 63)) * 8 + 4 * (s & 1);
#pragma unroll
            for (int e = 0; e < 4; ++e) { const f32x2 t = rp[e]; cs[e] = t.x; sn[e] = t.y; } }
        else {
#pragma unroll
            for (int e = 0; e < 4; ++e) { cs[e] = 1.f; sn[e] = 0.f; } }
        {
            bf16_t* qp = (probe ? (bf16_t*)(P.ws + WS_R4) : Q) + (size_t)m * 768;
            float z[12]; unpack8(qnn, z);
            z[8] = bflo(qrr.x); z[9] = bfhi(qrr.x); z[10] = bflo(qrr.y); z[11] = bfhi(qrr.y);
            float ss = 0.f;
#pragma unroll
            for (int i = 0; i < 12; ++i) { z[i] *= s_q; ss += z[i] * z[i]; }
            ss += __shfl_xor(ss, 1); ss += __shfl_xor(ss, 2); ss += __shfl_xor(ss, 4);
            const float r = rsqrtf(ss * (1.f / 96.f) + EPS);
#pragma unroll
            for (int i = 0; i < 12; ++i) z[i] *= r * qnw[i] * QC;
            { float n2 = 0.f;
#pragma unroll
              for (int i = 0; i < 12; ++i) n2 += z[i] * z[i];
              n2 += __shfl_xor(n2, 1); n2 += __shfl_xor(n2, 2); n2 += __shfl_xor(n2, 4);
              if (s == 0 && !probe) atomicMax((unsigned*)&lmax[(b * 8 + h) * 2], __float_as_uint(n2)); }
#pragma unroll
            for (int e = 0; e < 4; ++e) { const float mine = z[8 + e], other = __shfl_xor(mine, 2);
                z[8 + e] = second ? (other * sn[e] + mine * cs[e]) : (mine * cs[e] - other * sn[e]); }
            *(u32x4*)(qp + 64 * h + 8 * s) = pack8(z);
            u32x2 o; o.x = pk2(z[8], z[9]); o.y = pk2(z[10], z[11]); *(u32x2*)(qp + 512 + 32 * h + 4 * s) = o;
        }
        {
            bf16_t* kp = (probe ? (bf16_t*)(P.ws + WS_R4) + (size_t)TA * 768 : K) + (size_t)m * 768;
            float z[12]; unpack8(knn, z);
#pragma unroll
            for (int i = 0; i < 8; ++i) z[i] *= s_kv;
            z[8] = bflo(krr.x); z[9] = bfhi(krr.x); z[10] = bflo(krr.y); z[11] = bfhi(krr.y);
            float ss = 0.f;
#pragma unroll
            for (int i = 0; i < 12; ++i) ss += z[i] * z[i];
            ss += __shfl_xor(ss, 1); ss += __shfl_xor(ss, 2); ss += __shfl_xor(ss, 4);
            const float r = rsqrtf(ss * (1.f / 96.f) + EPS);
#pragma unroll
            for (int i = 0; i < 12; ++i) z[i] *= r * knw[i];
            { float n2 = 0.f;
#pragma unroll
              for (int i = 0; i < 12; ++i) n2 += z[i] * z[i];
              n2 += __shfl_xor(n2, 1); n2 += __shfl_xor(n2, 2); n2 += __shfl_xor(n2, 4);
              if (s == 0 && !probe) atomicMax((unsigned*)&lmax[(b * 8 + h) * 2 + 1], __float_as_uint(n2)); }
#pragma unroll
            for (int e = 0; e < 4; ++e) { const float mine = z[8 + e], other = __shfl_xor(mine, 2);
                z[8 + e] = second ? (other * sn[e] + mine * cs[e]) : (mine * cs[e] - other * sn[e]); }
            *(u32x4*)(kp + 64 * h + 8 * s) = pack8(z);
            u32x2 o; o.x = pk2(z[8], z[9]); o.y = pk2(z[10], z[11]); *(u32x2*)(kp + 512 + 32 * h + 4 * s) = o;
            float vv[8]; unpack8(vraw, vv);
#pragma unroll
            for (int i = 0; i < 8; ++i) vv[i] *= s_kv;
            *(u32x4*)((probe ? (bf16_t*)(P.ws + WS_R4) + (size_t)TA * 1536 : V) + (size_t)m * 512 + 8 * lane) = pack8(vv);
        }
    }
#undef QLOAD
    __syncthreads();
    if (tid < 64 && !probe) atomicMax((unsigned*)(P.ws + WS_QKM) + tid, lmax[tid]);
}

DI void phase_scanpost(const Params& P, int l, int nrows, const bool probe = false) {
    const int tid = threadIdx.x, wave = tid >> 6, lane = tid & 63, gw = blockIdx.x * NWAVES + wave, ngw = gridDim.x * NWAVES;
    bf16_t* __restrict__ OF = (bf16_t*)(P.ws + WS_OF); const bf16_t* __restrict__ OB = (const bf16_t*)(P.ws + WS_OB);
    const float* gw_ = P.in[I_GON] + l * 128;
    const int sub = lane & 7, hd = lane >> 3;
    float w[16];
#pragma unroll
    for (int i = 0; i < 16; ++i) w[i] = hd < 4 ? gw_[16 * sub + i] : 1.f;
    u32x4 nf0, nf1, nb0, nb1;
#define PLOAD(m_) do { const bf16_t* pf_ = OF + (size_t)(m_) * 1024 + 16 * lane; const bf16_t* pb_ = OB + (size_t)(m_) * 1024 + 16 * lane; \
        nf0 = *(const u32x4*)pf_; nf1 = *(const u32x4*)(pf_ + 8); nb0 = *(const u32x4*)pb_; nb1 = *(const u32x4*)(pb_ + 8); } while (0)
    if (gw < nrows) PLOAD(gw);
    for (int m = gw; m < nrows; m += ngw) {
        float a[16], bq[16];
        unpack8(nf0, a); unpack8(nf1, a + 8); unpack8(nb0, bq); unpack8(nb1, bq + 8);
        if (m + ngw < nrows) PLOAD(m + ngw);
        float ss = 0.f;
#pragma unroll
        for (int i = 0; i < 16; ++i) { a[i] += bq[i]; ss += a[i] * a[i]; }
        ss += __shfl_xor(ss, 1); ss += __shfl_xor(ss, 2); ss += __shfl_xor(ss, 4);
        const float r = rsqrtf(ss * (1.f / 128.f) + EPS);
#pragma unroll
        for (int i = 0; i < 16; ++i) a[i] *= r * w[i];
        bf16_t* pf = (probe ? (bf16_t*)(P.ws + WS_R4) : OF) + (size_t)m * 1024 + 16 * lane;
        *(u32x4*)pf = pack8(a); *(u32x4*)(pf + 8) = pack8(a + 8);
    }
#undef PLOAD
}

DI void phase_conv(const Params& P, int l, int nrows) {
    const bf16_t* __restrict__ G = (const bf16_t*)(P.ws + WS_G); bf16_t* __restrict__ U = (bf16_t*)(P.ws + WS_U);
    const float* __restrict__ wdw = P.in[I_WDW] + (size_t)l * 3 * DFF; const float* __restrict__ bdw = P.in[I_BDW] + (size_t)l * DFF;
    const int total = (nrows / 4) * 352;
    for (int i = blockIdx.x * NTHREADS + threadIdx.x; i < total; i += gridDim.x * NTHREADS) {
        const int quad = i / 352, c = (i - quad * 352) * 8, m0 = quad * 4;
        int b, pos, isctx; rowinfo(m0, b, pos, isctx);
        const int last = isctx ? CTX - 1 : SEQ - 1;
        u32x4 g[6], u[4];
#pragma unroll
        for (int r = 0; r < 4; ++r) { g[r + 1] = *(const u32x4*)(G + (size_t)(m0 + r) * DFF + c); u[r] = *(const u32x4*)(U + (size_t)(m0 + r) * DFF + c); }
        g[0] = pos > 0 ? *(const u32x4*)(G + (size_t)(m0 - 1) * DFF + c) : (u32x4){0u, 0u, 0u, 0u};
        g[5] = pos + 3 < last ? *(const u32x4*)(G + (size_t)(m0 + 4) * DFF + c) : (u32x4){0u, 0u, 0u, 0u};
        float w0[8], w1[8], w2[8], bb[8];
#pragma unroll
        for (int k = 0; k < 8; ++k) { w0[k] = wdw[c + k]; w1[k] = wdw[DFF + c + k]; w2[k] = wdw[2 * DFF + c + k]; bb[k] = bdw[c + k]; }
#pragma unroll
        for (int r = 0; r < 4; ++r) {
            float a0[8], a1[8], a2[8], uu[8], o[8];
            unpack8(g[r], a0); unpack8(g[r + 1], a1); unpack8(g[r + 2], a2); unpack8(u[r], uu);
#pragma unroll
            for (int k = 0; k < 8; ++k) {
                const float x = w0[k] * a0[k] + w1[k] * a1[k] + w2[k] * a2[k] + bb[k];
                const float t2 = 1.5957691216057308f * (x + 0.044715f * x * x * x);
                o[k] = x / (1.f + __expf(-t2)) * uu[k];
            }
            *(u32x4*)(U + (size_t)(m0 + r) * DFF + c) = pack8(o);
        }
    }
}

namespace att {
constexpr int NW = 8, QBLK = 32, KVBLK = 64;
constexpr float SCALE = 0.10206207261596575f;
constexpr float THR = 8.f;
constexpr int SHM_V = 64 * 128 * 2, SHM_K = 64 * 256, SHM_ATTN = 2 * SHM_V + 2 * SHM_K + NW * 64 * 4;
#define KSWZ(row, colB) ((row) * 256 + ((colB) ^ (((row) & 7) << 4)))
#define SBAR() __builtin_amdgcn_sched_barrier(0)
DI int crow(int r, int hi) { return (r & 3) + 8 * (r >> 2) + 4 * hi; }
DI unsigned cvtpk(float lo, float hi) { unsigned r; asm volatile("s_nop 0\n\tv_cvt_pk_bf16_f32 %0, %1, %2" : "=v"(r) : "v"(lo), "v"(hi)); return r; }
DI bf16x8 ld8(const bf16_t* p) { return *reinterpret_cast<const bf16x8*>(p); }

constexpr float THR2 = 11.5f;
DI void partialSM(f32x16& p0, f32x16& p1, float& m_reg, float& mn, float& alpha) {
  float pmax = p0[0]; for (int r = 1; r < 16; ++r) pmax = fmaxf(pmax, p0[r]); for (int r = 0; r < 16; ++r) pmax = fmaxf(pmax, p1[r]);
  { auto rr = __builtin_amdgcn_permlane32_swap(__float_as_uint(pmax), __float_as_uint(pmax), false, false);
    pmax = fmaxf(__uint_as_float(rr[0]), __uint_as_float(rr[1])); }
  if (__builtin_expect(__all(pmax - m_reg <= THR2), 1)) { mn = m_reg; alpha = 1.f; }
  else { mn = fmaxf(m_reg, pmax); alpha = __builtin_amdgcn_exp2f(m_reg - mn); m_reg = mn; }
  for (int r = 0; r < 16; ++r) p0[r] -= mn; for (int r = 0; r < 16; ++r) p1[r] -= mn;
  for (int r = 0; r < 16; ++r) p0[r] = __builtin_amdgcn_exp2f(p0[r]);
}
DI void partialSM_fix(f32x16& p0) { for (int r = 0; r < 16; ++r) p0[r] = __builtin_amdgcn_exp2f(p0[r]); }
DI void finishSM(f32x16& p0, f32x16& p1, float alpha, float& l_reg, bf16x8& pa0, bf16x8& pa1, bf16x8& pa2, bf16x8& pa3) {
  for (int r = 0; r < 16; ++r) p1[r] = __builtin_amdgcn_exp2f(p1[r]);
  float ps = 0; for (int r = 0; r < 16; ++r) ps += p0[r]; for (int r = 0; r < 16; ++r) ps += p1[r];
  { auto rr = __builtin_amdgcn_permlane32_swap(__float_as_uint(ps), __float_as_uint(ps), false, false);
    ps = __uint_as_float(rr[0]) + __uint_as_float(rr[1]); }
  l_reg = l_reg * alpha + ps;
#define PK4(P, BASE, OUT) do { unsigned a0 = cvtpk(P[BASE + 0], P[BASE + 1]), a1 = cvtpk(P[BASE + 2], P[BASE + 3]);   \
    unsigned b0 = cvtpk(P[BASE + 4], P[BASE + 5]), b1 = cvtpk(P[BASE + 6], P[BASE + 7]);                              \
    auto r0 = __builtin_amdgcn_permlane32_swap(a0, b0, false, false); auto r1 = __builtin_amdgcn_permlane32_swap(a1, b1, false, false); \
    u32x4 w = {r0[0], r1[0], r0[1], r1[1]}; OUT = *reinterpret_cast<bf16x8*>(&w); } while (0)
  PK4(p0, 0, pa0); PK4(p0, 8, pa1); PK4(p1, 0, pa2); PK4(p1, 8, pa3);
#undef PK4
}
template <bool FIX>
DI void qkt(f32x16& p0, f32x16& p1, const char* Ks, const bf16x8* qr, int r32, int hi, const f32x16& init) {
  const f32x16 zero = {};
#pragma unroll
  for (int d0 = 0; d0 < 6; ++d0) { int cb = (d0 * 16 + hi * 8) * 2;
    bf16x8 b0 = *reinterpret_cast<const bf16x8*>(Ks + KSWZ(r32, cb));
    bf16x8 b1 = *reinterpret_cast<const bf16x8*>(Ks + KSWZ(32 + r32, cb));
    p0 = __builtin_amdgcn_mfma_f32_32x32x16_bf16(b0, qr[d0], d0 == 0 ? zero : p0, 0, 0, 0);
    p1 = __builtin_amdgcn_mfma_f32_32x32x16_bf16(b1, qr[d0], d0 == 0 ? zero : p1, 0, 0, 0); }
}
DI int v_st(int k, int c) { const int kk = (k & ~0xC) | ((k & 4) << 1) | ((k & 8) >> 1); return ((kk >> 3) * 4 + (c >> 5)) * 512 + ((kk & 7) * 32 + (c & 31)) * 2; }
DI int v_rd_base(int lane) { return ((lane & 3) << 3) | (((lane >> 2) & 3) << 6) | (((lane >> 4) & 1) << 5) | (((lane >> 5) & 1) << 8); }
constexpr int v_rd_off(int d0, int ks, int half) { return d0 * 512 + ks * 4096 + half * 2048; }
template <int OFF> DI s16x4 tr_read(int vb) {
  s16x4 r; asm volatile("ds_read_b64_tr_b16 %0, %1 offset:%2" : "=&v"(r) : "v"(vb), "i"(OFF) : "memory"); return r;
}
template <int D0> DI void pv_one(f32x16& od, int vb, bf16x8 pa0, bf16x8 pa1, bf16x8 pa2, bf16x8 pa3) {
  const s16x4 l0 = tr_read<v_rd_off(D0, 0, 0)>(vb), h0 = tr_read<v_rd_off(D0, 0, 1)>(vb), l1 = tr_read<v_rd_off(D0, 1, 0)>(vb), h1 = tr_read<v_rd_off(D0, 1, 1)>(vb);
  const s16x4 l2 = tr_read<v_rd_off(D0, 2, 0)>(vb), h2 = tr_read<v_rd_off(D0, 2, 1)>(vb), l3 = tr_read<v_rd_off(D0, 3, 0)>(vb), h3 = tr_read<v_rd_off(D0, 3, 1)>(vb);
  asm volatile("s_waitcnt lgkmcnt(0)" ::: "memory"); SBAR();
#define PK(L, H) (bf16x8){L[0], L[1], L[2], L[3], H[0], H[1], H[2], H[3]}
  od = __builtin_amdgcn_mfma_f32_32x32x16_bf16(pa0, PK(l0, h0), od, 0, 0, 0);
  od = __builtin_amdgcn_mfma_f32_32x32x16_bf16(pa1, PK(l1, h1), od, 0, 0, 0);
  od = __builtin_amdgcn_mfma_f32_32x32x16_bf16(pa2, PK(l2, h2), od, 0, 0, 0);
  od = __builtin_amdgcn_mfma_f32_32x32x16_bf16(pa3, PK(l3, h3), od, 0, 0, 0);
#undef PK
}
DI void pv_d0(f32x16* o, int vb, bf16x8 pa0, bf16x8 pa1, bf16x8 pa2, bf16x8 pa3) {
  pv_one<0>(o[0], vb, pa0, pa1, pa2, pa3); pv_one<1>(o[1], vb, pa0, pa1, pa2, pa3);
}

template <bool FIX>
DI void attn_unit(const bf16_t* Qg, bf16_t* Og, int ldo, const bf16_t* Kg, const bf16_t* Vg, int qrow0, int h, int ctxrow0, int latrow0, int NT, char* lds, float bound) {
  const int tid = threadIdx.x, wid = tid >> 6, lane = tid & 63, r32 = lane & 31, hi = lane >> 5;
  char* V_lds = lds; char* K_lds = lds + 2 * SHM_V;
  float* ws = (float*)(lds + 2 * SHM_V + 2 * SHM_K) + wid * 64; float* li_l = ws; float* al_l = ws + 32;
  float m_reg = -1e30f, l_reg = 0; f32x16 o[2] = {}; bf16x8 qr[6];
  const f32x16 init = {}; (void)bound;
  const bf16_t* Qw = Qg + (size_t)(qrow0 + wid * QBLK + r32) * 768;
#pragma unroll
  for (int d0 = 0; d0 < 6; ++d0) qr[d0] = ld8(Qw + (d0 < 4 ? 64 * h + 16 * d0 + 8 * hi : 512 + 32 * h + 16 * (d0 - 4) + 8 * hi));
  const int vr = tid >> 3, vc = tid & 7, vst = v_st(vr, 8 * vc), vcol = 64 * h + 8 * vc;
  const int c0 = tid, c1 = 512 + (tid & 255);
  const int kr0 = c0 / 12, kc0 = c0 % 12, kr1 = c1 / 12, kc1 = c1 % 12;
  const int kcol0 = kc0 < 8 ? 64 * h + 8 * kc0 : 512 + 32 * h + 8 * (kc0 - 8), kcol1 = kc1 < 8 ? 64 * h + 8 * kc1 : 512 + 32 * h + 8 * (kc1 - 8);
  const int kst0 = KSWZ(kr0, kc0 * 16), kst1 = KSWZ(kr1, kc1 * 16);
  const int vb0 = (int)(uintptr_t)V_lds + v_rd_base(lane);
  struct { bf16x8 vs0, ks0, ks1; } sr_[2] = {};
#define TROW(j) ((j) < 4 ? ctxrow0 + 64 * (j) : latrow0 + 64 * ((j) - 4))
#define SLOAD(i, j) do { const int rb_ = TROW(j); sr_[i].vs0 = ld8(Vg + (size_t)(rb_ + vr) * 512 + vcol); \
    sr_[i].ks0 = ld8(Kg + (size_t)(rb_ + kr0) * 768 + kcol0); if (tid < 256) sr_[i].ks1 = ld8(Kg + (size_t)(rb_ + kr1) * 768 + kcol1); } while (0)
#define SWRITE(b, i) do { *(bf16x8*)(V_lds + (b) * SHM_V + vst) = sr_[i].vs0; \
    *(bf16x8*)(K_lds + (b) * SHM_K + kst0) = sr_[i].ks0; if (tid < 256) *(bf16x8*)(K_lds + (b) * SHM_K + kst1) = sr_[i].ks1; } while (0)
#define SWAIT() asm volatile("s_waitcnt vmcnt(3)" ::: "memory")
#define PSM(p0_, p1_, mn_, al_) do { if (FIX) { partialSM_fix(p0_); al_ = 1.f; } else partialSM(p0_, p1_, m_reg, mn_, al_); } while (0)
#define RESC(a) do { if (!FIX) if (__any((a) < 1.f)) { if (hi == 0) al_l[r32] = (a); asm volatile("s_waitcnt lgkmcnt(0)" ::: "memory"); \
    for (int d = 0; d < 2; ++d) for (int r = 0; r < 16; ++r) o[d][r] *= al_l[crow(r, hi)]; } } while (0)
  f32x16 pA0, pA1, pB0, pB1; float mnA, mnB, alA, alB; bf16x8 pa0, pa1, pa2, pa3;
  constexpr int SE = 0, SO = 1;
  SLOAD(SE, 0); asm volatile("s_waitcnt vmcnt(0)" ::: "memory"); SWRITE(0, SE); __syncthreads();
  qkt<FIX>(pA0, pA1, K_lds, qr, r32, hi, init); PSM(pA0, pA1, mnA, alA);
  SLOAD(SO, 1); if (2 < NT) SLOAD(SE, 2);
  SWAIT(); SWRITE(1, SO); __syncthreads();
  for (int j = 1; j + 1 < NT; j += 2) {
    SBAR(); qkt<FIX>(pB0, pB1, K_lds + SHM_K, qr, r32, hi, init);
    finishSM(pA0, pA1, alA, l_reg, pa0, pa1, pa2, pa3); SBAR();
    SLOAD(SO, j + 2); SBAR();
    pv_d0(o, vb0, pa0, pa1, pa2, pa3); PSM(pB0, pB1, mnB, alB);
    __syncthreads(); SWAIT(); SWRITE(0, SE);
    RESC(alB); __syncthreads();
    SBAR(); qkt<FIX>(pA0, pA1, K_lds, qr, r32, hi, init);
    finishSM(pB0, pB1, alB, l_reg, pa0, pa1, pa2, pa3); SBAR();
    if (j + 3 < NT) SLOAD(SE, j + 3); SBAR();
    pv_d0(o, vb0 + SHM_V, pa0, pa1, pa2, pa3); PSM(pA0, pA1, mnA, alA);
    __syncthreads(); SWAIT(); SWRITE(1, SO);
    RESC(alA); __syncthreads();
  }
  SBAR(); qkt<FIX>(pB0, pB1, K_lds + SHM_K, qr, r32, hi, init);
  finishSM(pA0, pA1, alA, l_reg, pa0, pa1, pa2, pa3); SBAR();
  pv_d0(o, vb0, pa0, pa1, pa2, pa3); PSM(pB0, pB1, mnB, alB);
  __syncthreads(); RESC(alB);
  finishSM(pB0, pB1, alB, l_reg, pa0, pa1, pa2, pa3); SBAR();
  pv_d0(o, vb0 + SHM_V, pa0, pa1, pa2, pa3);
  if (hi == 0) li_l[r32] = l_reg; asm volatile("s_waitcnt lgkmcnt(0)" ::: "memory");
  float rli[16];
#pragma unroll
  for (int r = 0; r < 16; ++r) rli[r] = __builtin_amdgcn_rcpf(li_l[crow(r, hi)]);
  bf16_t* Ow = Og + (size_t)(qrow0 + wid * QBLK) * ldo + 64 * h;
#pragma unroll
  for (int r = 0; r < 16; ++r) { const int orow = crow(r, hi);
#pragma unroll
    for (int d0 = 0; d0 < 2; ++d0) Ow[(size_t)orow * ldo + d0 * 32 + r32] = f2bf(o[d0][r] * rli[r]); }
#undef TROW
#undef SLOAD
#undef SWRITE
#undef SWAIT
#undef RESC
#undef PSM
}
}

DI void phase_attention(const Params& P, int l, char* lds, bf16_t* Og, int ldo) {
    const bf16_t* Q = (const bf16_t*)(P.ws + WS_Q); const bf16_t* K = (const bf16_t*)(P.ws + WS_K); const bf16_t* V = (const bf16_t*)(P.ws + WS_V);
    const unsigned* QKM = (const unsigned*)(P.ws + WS_QKM);
    for (int u = blockIdx.x; u < 1024 + (l == 0 ? 32 : 0); u += gridDim.x) {
        int b, h, qrow0, nt;
        if (u < 1024) { const int bh = (u >> 8) * 8 + (u & 7), qb = (u >> 3) & 31; b = bh >> 3; h = bh & 7; qrow0 = b * SEQ + 256 * qb; nt = 132; }
        else { b = (u - 1024) >> 3; h = (u - 1024) & 7; qrow0 = TL + b * CTX; nt = 4; }
        const float bound = sqrtf(__uint_as_float(QKM[(b * 8 + h) * 2]) * __uint_as_float(QKM[(b * 8 + h) * 2 + 1])) * 1.01f + 0.5f;
        __syncthreads();
        if (bound <= 48.f) att::attn_unit<true>(Q, Og, ldo, K, V, qrow0, h, TL + b * CTX, b * SEQ, nt, lds, bound);
        else att::attn_unit<false>(Q, Og, ldo, K, V, qrow0, h, TL + b * CTX, b * SEQ, nt, lds, 0.f);
    }
    __syncthreads();
}

namespace scn {
constexpr int RQ = 0, RK = 16384, RR = 32768;
constexpr int QD = 34816;
constexpr int KN = QD + 64 * 272;
constexpr int KET = KN + 64 * 272;
constexpr int VT = KET + 128 * 144;
constexpr int ST = VT + 128 * 144;
constexpr int PM = ST + 128 * 272;
constexpr int DEC = PM + 64 * 144;
constexpr int CSUM = DEC + 512;
constexpr int END = CSUM + 1024;
static_assert(END <= LDS_BYTES - 16, "scan LDS");
constexpr size_t US_OFF = 0, DL_OFF = (size_t)64 * 3 * 16384 * 2;
static_assert(DL_OFF + (size_t)64 * 3 * 128 * 4 <= (size_t)3584 * 1024 * 2, "scan hand-off must fit in the dead part of the weight region");
DI int crow(int r, int hi) { return (r & 3) + 8 * (r >> 2) + 4 * hi; }
#define SC_BAR() do { asm volatile("s_waitcnt lgkmcnt(0)" ::: "memory"); __builtin_amdgcn_s_barrier(); asm volatile("" ::: "memory"); } while (0)
#define SMFMA(a, b, c) __builtin_amdgcn_mfma_f32_32x32x16_bf16((a), (b), (c), 0, 0, 0)
}
DI void phase_scan(const Params& P, int l, char* lds, const int pass) {
    using namespace scn;
    const int tid = threadIdx.x, wid = tid >> 6, lane = tid & 63, r32 = lane & 31, hi = lane >> 5;
    const bf16_t* R4 = (const bf16_t*)(P.ws + WS_R4); const bf16_t* SM = (const bf16_t*)(P.ws + WS_SM);
    bf16_t* UST = (bf16_t*)(P.ws + WS_WT + US_OFF); float* DLG = (float*)(P.ws + WS_WT + DL_OFF);
    const int nitems = pass == 1 ? 192 : 256;
    for (int item = blockIdx.x; item < nitems; item += gridDim.x) {
        bool gla; int seg, g;
        if (pass == 1) { gla = item < 128; if (gla) { seg = item & 3; g = item >> 2; } else { seg = (item - 128) & 1; g = (item - 128) >> 1; } }
        else { gla = item < 160; if (gla) { seg = item % 5; g = item / 5; } else { seg = (item - 160) % 3; g = (item - 160) / 3; } }
        const int dir = g & 1, hh = (g >> 1) & 3, b = g >> 3, hd = hh + (gla ? 0 : 4);
        const int uidx0 = gla ? g * 4 : 128 + g * 2;
        const int n0 = gla ? seg * 26 + (seg < 2 ? seg : 2) : 44 * seg, nlen = gla ? (seg < 2 ? 27 : 26) : 44;
        const int qcol = gla ? hh * 128 : 1536 + hh * 128, kcol = gla ? 512 + hh * 128 : 2048 + hh * 128, vcol = (gla ? 1024 : 2560) + hh * 128;
        bf16_t* Od = (bf16_t*)(P.ws + (dir ? WS_OB : WS_OF)); const int ocol = hd * 128;
        const int pti = wid >> 2, pdj = wid & 3, pd = 32 * pdj + r32;
        const int vt = wid >> 1, dt0 = 2 * (wid & 1);
        bf16x8 w2h = {0, 0, 0, 0, 0, 0, 0, 0}, w2l = {0, 0, 0, 0, 0, 0, 0, 0}; float bias = 0.f, lg = 0.f;
        if (gla) { const float* W2 = P.in[I_GK2] + (size_t)(l * 2 + dir) * 16 * 512 + hh * 128 + pd;
#pragma unroll
            for (int j = 0; j < 8; ++j) { const float w = W2[(8 * hi + j) * 512]; const unsigned u = __float_as_uint(w) & 0xffff0000u; const float res = w - __uint_as_float(u);
                w2h[j] = (short)(u >> 16); w2l[j] = (short)(__float_as_uint(res) >> 16); }
            bias = P.in[I_BGK][(l * 2 + dir) * 512 + hh * 128 + pd]; }
        else lg = -expf(P.in[I_RDEC][(l * 2 + dir) * 4 + hh]) * 1.4426950408889634f;
        f32x16 S0 = {}, S1 = {}; float clsum = 0.f;
        __syncthreads();
        if (pass == 2) {
            for (int sp = 0; sp < seg; ++sp) {
                const bf16_t* U = UST + (size_t)(uidx0 + sp) * 16384; const float* DL = DLG + (size_t)(uidx0 + sp) * 128;
                const float e0 = __builtin_amdgcn_exp2f(DL[32 * dt0 + r32]), e1 = __builtin_amdgcn_exp2f(DL[32 * (dt0 + 1) + r32]);
#pragma unroll
                for (int r = 0; r < 16; ++r) { const int v = 32 * vt + crow(r, hi);
                    S0[r] = S0[r] * e0 + bf2f(U[v * 128 + 32 * dt0 + r32]); S1[r] = S1[r] * e1 + bf2f(U[v * 128 + 32 * (dt0 + 1) + r32]); }
            }
#pragma unroll
            for (int r = 0; r < 16; ++r) { const int v = 32 * vt + crow(r, hi);
                *(bf16_t*)(lds + ST + v * 272 + (32 * dt0 + r32) * 2) = f2bf(S0[r]); *(bf16_t*)(lds + ST + v * 272 + (32 * (dt0 + 1) + r32) * 2) = f2bf(S1[r]); }
            { const int i = tid >> 4, j = 32 + (tid & 15) * 2; *(unsigned*)(lds + PM + i * 144 + j * 2) = 0u; }
        }
        u32x4 pq0 = {0u, 0u, 0u, 0u}, pq1 = pq0, pk0, pk1, pr = pq0, pv0, pv1;
#define ROWBASE(n) (dir == 0 ? ((n) < 4 ? TL + b * CTX + 64 * (n) : b * SEQ + 64 * ((n) - 4)) : ((n) < 4 ? TL + b * CTX + 64 * (3 - (n)) : b * SEQ + 64 * (127 - ((n) - 4))))
#define SC_LOADQK(n) do { const int rb_ = ROWBASE(n); \
        if (pass == 2) { pq0 = *(const u32x4*)(R4 + (size_t)(rb_ + (tid >> 4)) * 3072 + qcol + 8 * (tid & 15)); pq1 = *(const u32x4*)(R4 + (size_t)(rb_ + 32 + (tid >> 4)) * 3072 + qcol + 8 * (tid & 15)); } \
        pk0 = *(const u32x4*)(R4 + (size_t)(rb_ + (tid >> 4)) * 3072 + kcol + 8 * (tid & 15)); pk1 = *(const u32x4*)(R4 + (size_t)(rb_ + 32 + (tid >> 4)) * 3072 + kcol + 8 * (tid & 15)); \
        if (tid < 128) pr = *(const u32x4*)(SM + (size_t)(rb_ + (tid >> 1)) * 512 + 416 + dir * 16 + 8 * (tid & 1)); } while (0)
#define SC_LOADV(n) do { const int rb_ = ROWBASE(n); \
        pv0 = *(const u32x4*)(R4 + (size_t)(rb_ + lane) * 3072 + vcol + 8 * wid); pv1 = *(const u32x4*)(R4 + (size_t)(rb_ + lane) * 3072 + vcol + 64 + 8 * wid); } while (0)
#define SC_STOREQK() do { if (pass == 2) { *(u32x4*)(lds + RQ + sr0 * 256 + (tid & 15) * 16) = pq0; *(u32x4*)(lds + RQ + sr1 * 256 + (tid & 15) * 16) = pq1; } \
        *(u32x4*)(lds + RK + sr0 * 256 + (tid & 15) * 16) = pk0; *(u32x4*)(lds + RK + sr1 * 256 + (tid & 15) * 16) = pk1; \
        if (tid < 128) *(u32x4*)(lds + RR + srr * 32 + (tid & 1) * 16) = pr; } while (0)
        const int sr0 = dir ? 63 - (tid >> 4) : (tid >> 4), sr1 = dir ? 31 - (tid >> 4) : 32 + (tid >> 4);
        const int srr = dir ? 63 - (tid >> 1) : (tid >> 1), svi = dir ? 63 - lane : lane;
        SC_LOADQK(n0); SC_STOREQK(); SC_LOADQK(n0 + 1); SC_LOADV(n0);
        for (int n = n0; n < n0 + nlen; ++n) {
            int r32v = r32, hiv = hi; asm volatile("" : "+v"(r32v), "+v"(hiv));
            SC_BAR();
            { char* vb = lds + VT + (8 * wid) * 144 + svi * 2;
              const unsigned w0[4] = {pv0.x, pv0.y, pv0.z, pv0.w}, w1[4] = {pv1.x, pv1.y, pv1.z, pv1.w};
#pragma unroll
              for (int e = 0; e < 4; ++e) { *(bf16_t*)(vb + (2 * e) * 144) = (bf16_t)(w0[e] & 0xffffu); *(bf16_t*)(vb + (2 * e + 1) * 144) = (bf16_t)(w0[e] >> 16);
                  *(bf16_t*)(vb + (64 + 2 * e) * 144) = (bf16_t)(w1[e] & 0xffffu); *(bf16_t*)(vb + (64 + 2 * e + 1) * 144) = (bf16_t)(w1[e] >> 16); }
              if (n + 1 < n0 + nlen) SC_LOADV(n + 1); }
            {
                f32x16 cum; float cl;
                if (gla) {
                    f32x16 la;
                    { const bf16x8 a0 = *(const bf16x8*)(lds + RR + (32 * pti + r32v) * 32 + hiv * 16);
                      la = SMFMA(a0, w2h, (f32x16{})); la = SMFMA(a0, w2l, la); }
                    float ssum = 0.f;
#pragma unroll
                    for (int r = 0; r < 16; ++r) { const float x0 = la[r] + bias;
                        la[r] = (fminf(x0, 0.f) - __logf(1.f + __expf(-fabsf(x0)))) * (1.4426950408889634f / 16.f);
                        ssum += la[r]; }
                    const float cs_own = ssum + __shfl_xor(ssum, 32);
                    if (hiv == 0) *(float*)(lds + CSUM + (pti * 128 + pd) * 4) = cs_own;
                    SC_BAR();
                    const float cs_other = *(const float*)(lds + CSUM + ((1 - pti) * 128 + pd) * 4);
                    cl = cs_own + cs_other;
                    bf16x8 tri0, tri1;
#pragma unroll
                    for (int j = 0; j < 8; ++j) { const int k0 = 8 * (j >> 2) + 4 * hiv + (j & 3);
                        tri0[j] = (short)(r32v >= k0 ? 0x3F80 : 0); tri1[j] = (short)(r32v >= k0 + 16 ? 0x3F80 : 0); }
                    cum = f32x16{};
#pragma unroll
                    for (int st = 0; st < 2; ++st) { bf16x8 h8, l8;
#pragma unroll
                        for (int j = 0; j < 8; ++j) { const float v = la[8 * st + j]; const unsigned u = __float_as_uint(v) & 0xffff0000u; const float res = v - __uint_as_float(u);
                            h8[j] = (short)(u >> 16); l8[j] = (short)(__float_as_uint(res) >> 16); }
                        const bf16x8 am = st ? tri1 : tri0; cum = SMFMA(am, h8, cum); cum = SMFMA(am, l8, cum); }
                    if (pti) {
#pragma unroll
                        for (int r = 0; r < 16; ++r) cum[r] += cs_other; }
                    __builtin_amdgcn_sched_barrier(0);
                } else {
#pragma unroll
                    for (int r = 0; r < 16; ++r) cum[r] = (float)(32 * pti + crow(r, hiv) + 1) * lg;
                    cl = 64.f * lg;
                }
                clsum += cl;
                {
                    const int ibase = 32 * pti + 4 * hiv; const float ecl = __builtin_amdgcn_exp2f(cl);
                    const char* rqb = lds + RQ + ibase * 256 + pd * 2; const char* rkb = lds + RK + ibase * 256 + pd * 2;
                    char* qdb = lds + QD + ibase * 272 + pd * 2; char* knb = lds + KN + ibase * 272 + pd * 2; char* keb = lds + KET + pd * 144 + ibase * 2;
                    if (pass == 2) {
#pragma unroll
                        for (int r = 0; r < 16; ++r) { const int cr = (r & 3) + 8 * (r >> 2);
                            const float c = cum[r]; const float e1 = __builtin_amdgcn_exp2f(c), e2 = __builtin_amdgcn_exp2f(-c);
                            const float q = bf2f(*(const bf16_t*)(rqb + cr * 256)), k = bf2f(*(const bf16_t*)(rkb + cr * 256));
                            const float kn = k * e2;
                            *(bf16_t*)(qdb + cr * 272) = f2bf(q * e1);
                            *(bf16_t*)(knb + cr * 272) = f2bf(kn);
                            *(bf16_t*)(keb + cr * 2) = f2bf(kn * ecl);
                            if ((r & 3) == 3) { asm volatile("" ::: "memory"); } }
                    } else {
#pragma unroll
                        for (int r = 0; r < 16; ++r) { const int cr = (r & 3) + 8 * (r >> 2);
                            const float k = bf2f(*(const bf16_t*)(rkb + cr * 256));
                            *(bf16_t*)(keb + cr * 2) = f2bf(k * __builtin_amdgcn_exp2f(cl - cum[r]));
                            if ((r & 3) == 3) { asm volatile("" ::: "memory"); } }
                    }
                    if (pti == 0 && hiv == 0) *(float*)(lds + DEC + pd * 4) = ecl;
                }
            }
            SC_BAR();
            if (n + 1 < n0 + nlen) { SC_STOREQK(); if (n + 2 < n0 + nlen) SC_LOADQK(n + 2); }
            f32x16 oacc = {};
            if (pass == 2) {
                if (wid < 3) {
                    const int ti = (wid + 1) >> 1, tj = wid >> 1; f32x16 T0 = {};
#pragma unroll
                    for (int kk = 0; kk < 8; ++kk) { const bf16x8 a = *(const bf16x8*)(lds + QD + (32 * ti + r32v) * 272 + (16 * kk + 8 * hiv) * 2), bb = *(const bf16x8*)(lds + KN + (32 * tj + r32v) * 272 + (16 * kk + 8 * hiv) * 2);
                        T0 = SMFMA(a, bb, T0); }
#pragma unroll
                    for (int r = 0; r < 16; ++r) { const int cr = (r & 3) + 8 * (r >> 2); const int ib = 32 * ti + 4 * hiv, j = 32 * tj + r32v; int jm = j - (dir ? 0 : 1) - ib; asm volatile("" : "+v"(jm));
                        *(bf16_t*)(lds + PM + ib * 144 + j * 2 + cr * 144) = f2bf(cr > jm ? T0[r] : 0.f); }
                }
                { const int ti = wid >> 2, vj = wid & 3;
#pragma unroll
                  for (int kk = 0; kk < 8; ++kk) { const bf16x8 a = *(const bf16x8*)(lds + QD + (32 * ti + r32v) * 272 + (16 * kk + 8 * hiv) * 2), bb = *(const bf16x8*)(lds + ST + (32 * vj + r32v) * 272 + (16 * kk + 8 * hiv) * 2);
                      oacc = SMFMA(a, bb, oacc); } }
            }
            {
                const float dc0 = *(const float*)(lds + DEC + (32 * dt0 + r32v) * 4), dc1 = *(const float*)(lds + DEC + (32 * (dt0 + 1) + r32v) * 4);
#pragma unroll
                for (int r = 0; r < 16; ++r) { S0[r] *= dc0; S1[r] *= dc1; }
#pragma unroll
                for (int kk = 0; kk < 4; ++kk) { const bf16x8 a = *(const bf16x8*)(lds + VT + (32 * vt + r32v) * 144 + (16 * kk + 8 * hiv) * 2);
                    const bf16x8 b0 = *(const bf16x8*)(lds + KET + (32 * dt0 + r32v) * 144 + (16 * kk + 8 * hiv) * 2), b1 = *(const bf16x8*)(lds + KET + (32 * (dt0 + 1) + r32v) * 144 + (16 * kk + 8 * hiv) * 2);
                    S0 = SMFMA(a, b0, S0); S1 = SMFMA(a, b1, S1); }
            }
            if (pass == 2) {
                SC_BAR();
                { const int ti = wid >> 2, vj = wid & 3;
#pragma unroll
                  for (int kk = 0; kk < 4; ++kk) { const bf16x8 a = *(const bf16x8*)(lds + PM + (32 * ti + r32v) * 144 + (16 * kk + 8 * hiv) * 2), bb = *(const bf16x8*)(lds + VT + (32 * vj + r32v) * 144 + (16 * kk + 8 * hiv) * 2);
                      oacc = SMFMA(a, bb, oacc); }
                  const int rb = ROWBASE(n);
#pragma unroll
                  for (int r = 0; r < 16; ++r) { const int i = 32 * ti + crow(r, hiv), row = rb + (dir ? 63 - i : i);
                      Od[(size_t)row * 1024 + ocol + 32 * vj + r32v] = f2bf(oacc[r]); } }
#pragma unroll
                for (int r = 0; r < 16; ++r) { const int cr = (r & 3) + 8 * (r >> 2); char* stb = lds + ST + (32 * vt + 4 * hiv) * 272 + (32 * dt0 + r32v) * 2;
                    *(bf16_t*)(stb + cr * 272) = f2bf(S0[r]); *(bf16_t*)(stb + cr * 272 + 64) = f2bf(S1[r]); }
            }
        }
        if (pass == 1) {
            bf16_t* U = UST + (size_t)(uidx0 + seg) * 16384;
#pragma unroll
            for (int r = 0; r < 16; ++r) { const int v = 32 * vt + crow(r, hi);
                U[v * 128 + 32 * dt0 + r32] = f2bf(S0[r]); U[v * 128 + 32 * (dt0 + 1) + r32] = f2bf(S1[r]); }
            if (pti == 0 && hi == 0) DLG[(size_t)(uidx0 + seg) * 128 + pd] = clsum;
        }
#undef ROWBASE
#undef SC_LOADQK
#undef SC_LOADV
#undef SC_STOREQK
    }
    __syncthreads();
}

constexpr int PH_PER_LAYER = 13, N_PHASES = 1 + 2 * PH_PER_LAYER;
#ifndef PHEN
#define PHEN(q) 1
#endif
#ifdef PROBE_GEMM
#define REPG for (int rep_ = 0; rep_ < 2; ++rep_)
#else
#define REPG
#endif
#ifdef PROBE_EW
#define REPE for (int rep_ = 0; rep_ < 2; ++rep_)
#else
#define REPE
#endif
#define PH(k) if (lo <= (k) && (k) < hi && ((k) == lo || (xcd_barrier(xbar), true)))
template <int l>
DI void layer_program(const Params& P, int lo, int hi, LAS unsigned char* lds, unsigned char* lds_raw, const XcdBarrier& xbar) {
    constexpr int base = 1 + PH_PER_LAYER * l;
    constexpr int Mlat = (l == 0) ? TA : TL;
#define WSP(T, off) ((T*)(P.ws + (off)))
#define MODL (WSP(const float, WS_MOD) + (size_t)l * 5 * 6144)
#define HIN_L ((l == 0) ? P.in[I_X] : (const float*)P.out)
#define HIN_C ((l == 0) ? P.in[I_CTX] : WSP(const float, WS_HC))
    PH(base + 0) if (PHEN(0)) REPE { if (blockIdx.x == 0 && threadIdx.x < 64) WSP(unsigned, WS_QKM)[threadIdx.x] = 0u;
        if (l == 0) phase_norm(HIN_L, HIN_C, P.in[I_N1W] + l * DM, MODL, 0, 1, WSP(bf16_t, WS_A), TA);
        else phase_norm(HIN_L, HIN_C, P.in[I_N1W] + l * DM, MODL, 0, 1, WSP(bf16_t, WS_A), TA, WSP(const float, WS_OF), 11, WSP(const float, WS_MOD) + (size_t)4 * 6144 + 5 * 1024, WSP(float, WS_HC)); if (l > 0) phase_wconv_mixer(P, l, lds); }
    PH(base + 1) if (PHEN(1)) { Epi<EM_INPROJ> E{}; E.O0 = WSP(bf16_t, WS_R4); E.O1 = WSP(bf16_t, WS_SM); E.fa = WSP(const float, WS_ROT); run_gemm<EM_INPROJ>(lds, WSP(bf16_t, WS_A), 1024, WSP(bf16_t, WS_WT) + WT_IN, TA, 3584, 1024, E); }
    PH(base + 2) if (PHEN(6)) phase_scan(P, l, (char*)lds_raw, 1);
    PH(base + 3) if (PHEN(6)) phase_scan(P, l, (char*)lds_raw, 2);
    PH(base + 4) if (PHEN(2)) REPG { { Epi<EM_PLAIN> E{}; E.O0 = WSP(bf16_t, WS_Q); E.ld0 = 768; run_gemm<EM_PLAIN>(lds, WSP(bf16_t, WS_SM), 512, WSP(bf16_t, WS_WT) + WT_QB, TA, 768, 256, E); }
                  { Epi<EM_KV> E2{}; E2.O0 = WSP(bf16_t, WS_K); E2.O1 = WSP(bf16_t, WS_V); run_gemm<EM_KV>(lds, WSP(bf16_t, WS_SM) + 256, 512, WSP(bf16_t, WS_WT) + WT_KVB, TA, 1024, 128, E2); } }
    PH(base + 5) if (PHEN(3)) {
#ifdef PROBE_EW
        phase_qkpost(P, l, (LAS unsigned*)lds, true);
#endif
        phase_qkpost(P, l, (LAS unsigned*)lds); }
    PH(base + 6) if (PHEN(4)) phase_attention(P, l, (char*)lds_raw, WSP(bf16_t, WS_Q), 768);
    PH(base + 7) if (PHEN(8)) { EpiGates E{}; E.G3 = WSP(bf16_t, WS_R4); E.OF = WSP(bf16_t, WS_OF); E.OB = WSP(const bf16_t, WS_OB); E.bgate = P.in[I_BGATE] + (size_t)l * 3072; E.gon = P.in[I_GON] + l * 128; E.RS = (LAS float*)(lds + 131072);
                   run_gemm_gates(lds, WSP(bf16_t, WS_A), WSP(bf16_t, WS_WT) + WT_IN + (size_t)3584 * 1024, Mlat, E); }
    PH(base + 8) if (PHEN(9)) REPG {
        { Epi<EM_BRANCH> E{}; E.O0 = WSP(bf16_t, WS_OB); E.Gsrc = WSP(bf16_t, WS_R4); E.ipar = 0; run_gemm<EM_BRANCH>(lds, WSP(bf16_t, WS_Q), 768, WSP(bf16_t, WS_WT) + WT_BR, Mlat, 1024, 512, E); }
        { Epi<EM_BRANCH> E{}; E.O0 = WSP(bf16_t, WS_OB); E.Gsrc = WSP(bf16_t, WS_R4) + 1024; E.ipar = 1; run_gemm<EM_BRANCH>(lds, WSP(bf16_t, WS_OF), 1024, WSP(bf16_t, WS_WT) + WT_BR + (size_t)1024 * 512, Mlat, 1024, 512, E); }
        { Epi<EM_BRANCH> E{}; E.O0 = WSP(bf16_t, WS_OB); E.Gsrc = WSP(bf16_t, WS_R4) + 2048; E.ipar = 2; run_gemm<EM_BRANCH>(lds, WSP(bf16_t, WS_OF) + 512, 1024, WSP(bf16_t, WS_WT) + WT_BR + (size_t)2048 * 512, Mlat, 1024, 512, E); } }
    PH(base + 9) if (PHEN(10)) { { Epi<EM_RES> E{}; E.fa = MODL; E.ipar = 2; E.hin_l = HIN_L; E.hin_c = HIN_C; E.hout_l = P.out; E.hout_c = WSP(float, WS_HC);
                   run_gemm<EM_RES>(lds, WSP(bf16_t, WS_OB), 1024, WSP(bf16_t, WS_WT) + WT_OUT, TL, 1024, 1024, E); }
        if (l == 0) {
            for (int s = 0; s < 4; ++s) { Epi<EM_PART> E{}; E.hout_c = WSP(float, WS_OF) + (size_t)s * TC * DM;
                run_gemm_slice<EM_PART>(lds, WSP(bf16_t, WS_OB) + (size_t)TL * 1024 + s * 256, 1024, WSP(bf16_t, WS_WT) + WT_OUT + s * 256, 1024, TC, 1024, 256, E, 16 * s); } } }
    PH(base + 10) if (PHEN(11)) REPE { if (l == 0) phase_norm(P.out, P.in[I_CTX], P.in[I_N2W] + l * DM, MODL, 3, 4, WSP(bf16_t, WS_A), Mlat, WSP(const float, WS_OF), 4, MODL + (size_t)4 * 6144 + 2 * 1024, WSP(float, WS_HC));
        else phase_norm(P.out, WSP(const float, WS_HC), P.in[I_N2W] + l * DM, MODL, 3, 4, WSP(bf16_t, WS_A), Mlat);
        phase_wconv_ffn(P, l, lds); }
    PH(base + 11) if (PHEN(12)) { EpiFfnConv E{}; E.ACT = WSP(bf16_t, WS_G); E.HALO = WSP(float, WS_U); E.wdw = P.in[I_WDW] + (size_t)l * 3 * DFF; E.bdw = P.in[I_BDW] + (size_t)l * DFF; E.X = (LAS float*)(lds + 131072);
                   run_gemm_ffnconv(lds, WSP(bf16_t, WS_A), WSP(bf16_t, WS_WT) + WT_F1, Mlat, E); }
    PH(base + 12) if (PHEN(14)) { phase_convfix_mine(P, l, TL);
        { Epi<EM_RES> E{}; E.fa = MODL; E.ipar = 5; E.hin_l = P.out; E.hin_c = WSP(const float, WS_HC); E.hout_l = P.out; E.hout_c = WSP(float, WS_HC);
          run_gemm<EM_RES>(lds, WSP(bf16_t, WS_G), DFF, WSP(bf16_t, WS_WT) + WT_F2, TL, 1024, DFF, E); }
        if (l == 0) {
            for (int s = 0; s < 11; ++s) { Epi<EM_PART> E{}; E.hout_c = WSP(float, WS_OF) + (size_t)s * TC * DM;
                run_gemm_slice<EM_PART>(lds, WSP(bf16_t, WS_G) + (size_t)TL * DFF + s * 256, DFF, WSP(bf16_t, WS_WT) + WT_F2 + s * 256, DFF, TC, 1024, 256, E, 16 * s); } } }
}
__global__ void __launch_bounds__(NTHREADS, 2) fwd_kernel(Params P) {
    extern __shared__ __attribute__((aligned(16))) unsigned char lds_raw[];
    LAS unsigned char* lds = (LAS unsigned char*)lds_raw;
    cg::grid_group grid = cg::this_grid();
    const int lo = P.ph_lo, hi = P.ph_hi;
    Params* G = (Params*)(P.ws + WS_PAR + (size_t)blockIdx.x * 256);
    if (threadIdx.x == 0) {
#pragma unroll
        for (int i = 0; i < 26; ++i) G->in[i] = P.in[i];
        G->out = P.out; G->ws = P.ws; G->ph_lo = lo; G->ph_hi = hi;
    }
    __syncthreads();
    asm volatile("" ::: "memory");
    const Params& Q = *G;
    if (threadIdx.x < 4) ((LAS unsigned*)(lds + LDS_BARW))[threadIdx.x] = 0u;
    __syncthreads();
    const XcdBarrier xbar = xcd_barrier_post((unsigned*)(P.ws + WS_BAR), (volatile LAS unsigned*)(lds + LDS_BARW));
    if (lo < 0) grid.sync();
    PH(0) REPE { phase_prologue(Q, lds); __syncthreads(); phase_wconv_mixer(Q, 0, lds); __syncthreads(); }
    layer_program<0>(Q, lo, hi, lds, lds_raw, xbar);
    layer_program<1>(Q, lo, hi, lds, lds_raw, xbar);
#ifdef PROBE_SYNC
    for (int i = 0; i < 20; ++i) xcd_barrier(xbar);
#endif
}

#ifndef N_LAUNCH_MODE
#define N_LAUNCH_MODE 1
#endif
extern "C" void kernel_launch(void* const* d_in, const int* in_sizes, int n_in, void* d_out, int out_size, void* d_ws, size_t ws_size, hipStream_t stream) {
    static int grid_blocks = 0;
    if (!grid_blocks) {
        if (n_in != 26 || ws_size < WS_NEED) { fprintf(stderr, "kernel_launch: bad inputs (n_in %d, ws %zu < %zu)\n", n_in, ws_size, (size_t)WS_NEED); return; }
        if (hipFuncSetAttribute((const void*)fwd_kernel, hipFuncAttributeMaxDynamicSharedMemorySize, LDS_BYTES) != hipSuccess) { fprintf(stderr, "kernel_launch: hipFuncSetAttribute failed\n"); return; }
        int dev = 0, cus = 0, per_cu = 0;
        hipGetDevice(&dev);
        hipDeviceGetAttribute(&cus, hipDeviceAttributeMultiprocessorCount, dev);
        hipOccupancyMaxActiveBlocksPerMultiprocessor(&per_cu, fwd_kernel, NTHREADS, LDS_BYTES);
        if (per_cu < 1) { fprintf(stderr, "kernel_launch: occupancy query returned %d\n", per_cu); return; }
        grid_blocks = cus * 1;
    }
    Params p{};
    for (int i = 0; i < 26; ++i) p.in[i] = (const float*)d_in[i];
    p.out = (float*)d_out; p.ws = (unsigned char*)d_ws;
#if N_LAUNCH_MODE == 1
    p.ph_lo = 0; p.ph_hi = N_PHASES;
    if (hipMemsetAsync((unsigned char*)d_ws + WS_BAR, 0, XCD_BAR_WORDS * 4, stream) != hipSuccess) { fprintf(stderr, "kernel_launch: memset of the barrier words failed\n"); return; }
    void* args[] = {&p};
    hipError_t e = hipLaunchCooperativeKernel((const void*)fwd_kernel, dim3(grid_blocks), dim3(NTHREADS), args, LDS_BYTES, stream);
    if (e != hipSuccess) fprintf(stderr, "cooperative launch failed: %s (grid %d)\n", hipGetErrorString(e), grid_blocks);
#else
    for (int ph = 0; ph < N_PHASES; ++ph) {
        p.ph_lo = ph; p.ph_hi = ph + 1;
        hipLaunchKernelGGL(fwd_kernel, dim3(grid_blocks), dim3(NTHREADS), LDS_BYTES, stream, p);
    }
#endif
}
```
